# Optimizing an MI355X kernel written in HIP

```python
import math
import jax, jax.numpy as jnp
from jax import lax
import numpy as np

D_MODEL = 2048
BATCH = 2
SEQ = 16384
DEPTH = 4

CHUNK = 64
QBLOCK = 128
N_MEM = 256
ATTN_WIDTH = D_MODEL // 2
SSM_WIDTH = D_MODEL - ATTN_WIDTH
DIFF_HEAD_DIM = 64
DIFF_V_DIM = 2 * DIFF_HEAD_DIM
DIFF_HEADS = ATTN_WIDTH // DIFF_V_DIM
SSM_GROUP = 16
SSM_GROUPS = SSM_WIDTH // SSM_GROUP
SSM_STATE = 64
XATTN_HEADS = 4
XATTN_HEAD_DIM = D_MODEL // XATTN_HEADS
D_FF = ((8 * D_MODEL // 3 + 255) // 256) * 256
IN_WIDTH = 3 * ATTN_WIDTH + SSM_WIDTH
ALPHA = (2 * DEPTH) ** 0.25
BETA = (8 * DEPTH) ** -0.25
LN_EPS = 1e-5
RMS_EPS = 1e-5
NEG_BIG = -1e30

kernel_name = "hymba_diffattn_s5_macaron_deepnorm"


def layer_norm(x, g, b):
    xf = x.astype(jnp.float32)
    mu = jnp.mean(xf, axis=-1, keepdims=True)
    var = jnp.mean(jnp.square(xf - mu), axis=-1, keepdims=True)
    y = (xf - mu) * lax.rsqrt(var + LN_EPS)
    return (y * g.astype(jnp.float32) + b.astype(jnp.float32)).astype(x.dtype)


def swiglu(x, w_gate, w_up, w_down):
    return (jax.nn.silu(x @ w_gate) * (x @ w_up)) @ w_down


def diff_attention(q, k, v, lam, norm_g, lam_init):
    b_, s_, h_, _, dh = q.shape
    nb = s_ // QBLOCK
    q_blocks = q.reshape(b_, nb, QBLOCK, h_, 2, dh).transpose(1, 0, 2, 3, 4, 5)
    key_chunk = jnp.arange(s_) // CHUNK
    scale = dh ** -0.5

    def one_block(args):
        q_blk, i = args
        s = jnp.einsum('bqhmd,bkhmd->bhmqk', q_blk, k,
                       preferred_element_type=jnp.float32) * scale
        q_chunk = (i * QBLOCK + jnp.arange(QBLOCK)) // CHUNK
        mask = key_chunk[None, :] <= q_chunk[:, None]
        s = jnp.where(mask, s, NEG_BIG)
        p = jax.nn.softmax(s, axis=-1)
        w = p[:, :, 0] - lam * p[:, :, 1]
        return jnp.einsum('bhqk,bkhd->bqhd', w.astype(v.dtype), v)

    o = lax.map(one_block, (q_blocks, jnp.arange(nb)))
    o = o.transpose(1, 0, 2, 3, 4).reshape(b_, s_, h_, v.shape[-1]).astype(jnp.float32)
    o = o * lax.rsqrt(jnp.mean(jnp.square(o), axis=-1, keepdims=True) + RMS_EPS)
    o = o * norm_g.astype(jnp.float32) * (1.0 - lam_init)
    return o.reshape(b_, s_, h_ * v.shape[-1]).astype(v.dtype)


def _linear_recurrence_op(e1, e2):
    a1, b1 = e1
    a2, b2 = e2
    return a1 * a2, a2 * b1 + b2


def s5_mixer(u, lam_re, lam_im, log_step, b_re, b_im, c_re, c_im, d_skip, glu_w, glu_b):
    f32 = jnp.float32
    b_, s_, _ = u.shape
    uf = u.astype(f32)
    lam = lax.complex(jnp.minimum(lam_re.astype(f32), -1e-4), lam_im.astype(f32))
    step = jnp.exp(log_step.astype(f32))[:, None]
    lam_dt = lam * step
    a_bar = jnp.exp(lam_dt)
    b_c = lax.complex(b_re.astype(f32), b_im.astype(f32))
    b_bar = ((a_bar - 1.0) / lam)[..., None] * b_c
    c_c = lax.complex(c_re.astype(f32), c_im.astype(f32))
    a_pow = jnp.exp(lam_dt[None] * jnp.arange(1, CHUNK + 1, dtype=f32)[:, None, None])
    a_seq = jnp.broadcast_to(a_bar, (b_, CHUNK, SSM_GROUPS, SSM_STATE))
    u_chunks = uf.reshape(b_, s_ // CHUNK, CHUNK, SSM_GROUPS, SSM_GROUP).transpose(1, 0, 2, 3, 4)

    def chunk_step(h, u_blk):
        bu = jnp.einsum('blgp,gnp->blgn', u_blk.astype(jnp.complex64), b_bar)
        _, h_loc = lax.associative_scan(_linear_recurrence_op, (a_seq, bu), axis=1)
        h_all = h_loc + a_pow[None] * h[:, None]
        y = jnp.einsum('blgn,gpn->blgp', h_all, c_c).real
        return h_all[:, -1], y

    h0 = jnp.zeros((b_, SSM_GROUPS, SSM_STATE), jnp.complex64)
    _, y = lax.scan(chunk_step, h0, u_chunks)
    y = y.transpose(1, 0, 2, 3, 4).reshape(b_, s_, SSM_WIDTH) + d_skip.astype(f32) * uf
    y = jax.nn.gelu(y)
    y = y * jax.nn.sigmoid(y @ glu_w.astype(f32) + glu_b.astype(f32))
    return y.astype(u.dtype)


def cross_attention(x, mem, w_q, w_k, w_v, w_o):
    b_, s_, _ = x.shape
    m_ = mem.shape[1]
    q = (x @ w_q).reshape(b_, s_, XATTN_HEADS, XATTN_HEAD_DIM)
    k = (mem @ w_k).reshape(b_, m_, XATTN_HEADS, XATTN_HEAD_DIM)
    v = (mem @ w_v).reshape(b_, m_, XATTN_HEADS, XATTN_HEAD_DIM)
    s = jnp.einsum('bshd,bmhd->bhsm', q, k, preferred_element_type=jnp.float32) * XATTN_HEAD_DIM ** -0.5
    p = jax.nn.softmax(s, axis=-1).astype(v.dtype)
    o = jnp.einsum('bhsm,bmhd->bshd', p, v).reshape(b_, s_, D_MODEL)
    return o @ w_o


def setup_inputs(seed: int = 0) -> dict:
    key = jax.random.key(seed)
    ks = list(jax.random.split(key, 48))
    it = iter(ks)
    L, D, F = DEPTH, D_MODEL, D_FF
    G, N, P = SSM_GROUPS, SSM_STATE, SSM_GROUP

    def nrm(shape, scale):
        return jax.random.normal(next(it), shape, jnp.float32) * scale

    def gain(shape):
        return 1.0 + nrm(shape, 0.02)

    col_scale = jnp.concatenate([jnp.ones((2 * ATTN_WIDTH,), jnp.float32),
                                 jnp.full((ATTN_WIDTH,), BETA, jnp.float32),
                                 jnp.ones((SSM_WIDTH,), jnp.float32)])
    inp = {}
    inp["x"] = nrm((BATCH, SEQ, D), 1.0)
    inp["mem"] = nrm((BATCH, N_MEM, D), 1.0)
    inp["ffn1_w_gate"] = nrm((L, D, F), D ** -0.5)
    inp["ffn1_w_up"] = nrm((L, D, F), D ** -0.5)
    inp["ffn1_w_down"] = nrm((L, F, D), BETA * F ** -0.5)
    inp["ln1_g"] = gain((L, D))
    inp["ln1_b"] = nrm((L, D), 0.02)
    inp["w_in"] = nrm((L, D, IN_WIDTH), D ** -0.5) * col_scale
    inp["lambda_q1"] = nrm((L, DIFF_HEAD_DIM), 0.1)
    inp["lambda_k1"] = nrm((L, DIFF_HEAD_DIM), 0.1)
    inp["lambda_q2"] = nrm((L, DIFF_HEAD_DIM), 0.1)
    inp["lambda_k2"] = nrm((L, DIFF_HEAD_DIM), 0.1)
    inp["diff_norm_g"] = gain((L, DIFF_V_DIM))
    inp["ssm_lambda_re"] = -0.5 + nrm((L, G, N), 0.01)
    inp["ssm_lambda_im"] = jnp.pi * jnp.arange(N, dtype=jnp.float32)[None, None, :] + nrm((L, G, N), 0.01)
    inp["ssm_log_step"] = jax.random.uniform(next(it), (L, G), jnp.float32,
                                             minval=math.log(1e-3), maxval=math.log(1e-1))
    inp["ssm_b_re"] = nrm((L, G, N, P), (2 * P) ** -0.5)
    inp["ssm_b_im"] = nrm((L, G, N, P), (2 * P) ** -0.5)
    inp["ssm_c_re"] = nrm((L, G, P, N), (2 * N) ** -0.5)
    inp["ssm_c_im"] = nrm((L, G, P, N), (2 * N) ** -0.5)
    inp["ssm_d"] = nrm((L, SSM_WIDTH), 1.0)
    inp["ssm_glu_w"] = nrm((L, SSM_WIDTH, SSM_WIDTH), SSM_WIDTH ** -0.5)
    inp["ssm_glu_b"] = nrm((L, SSM_WIDTH), 0.02)
    inp["w_out"] = nrm((L, D, D), BETA * D ** -0.5)
    inp["ln2_g"] = gain((L, D))
    inp["ln2_b"] = nrm((L, D), 0.02)
    inp["xattn_w_q"] = nrm((L, D, D), D ** -0.5)
    inp["xattn_w_k"] = nrm((L, D, D), D ** -0.5)
    inp["xattn_w_v"] = nrm((L, D, D), BETA * D ** -0.5)
    inp["xattn_w_o"] = nrm((L, D, D), BETA * D ** -0.5)
    inp["ln3_g"] = gain((L, D))
    inp["ln3_b"] = nrm((L, D), 0.02)
    inp["ffn2_w_gate"] = nrm((L, D, F), D ** -0.5)
    inp["ffn2_w_up"] = nrm((L, D, F), D ** -0.5)
    inp["ffn2_w_down"] = nrm((L, F, D), BETA * F ** -0.5)
    inp["ln4_g"] = gain((L, D))
    inp["ln4_b"] = nrm((L, D), 0.02)
    return inp


def reference(x, mem, ffn1_w_gate, ffn1_w_up, ffn1_w_down, ln1_g, ln1_b, w_in,
              lambda_q1, lambda_k1, lambda_q2, lambda_k2, diff_norm_g,
              ssm_lambda_re, ssm_lambda_im, ssm_log_step, ssm_b_re, ssm_b_im, ssm_c_re, ssm_c_im,
              ssm_d, ssm_glu_w, ssm_glu_b, w_out, ln2_g, ln2_b,
              xattn_w_q, xattn_w_k, xattn_w_v, xattn_w_o, ln3_g, ln3_b,
              ffn2_w_gate, ffn2_w_up, ffn2_w_down, ln4_g, ln4_b):
    b_, s_, _ = x.shape
    for l in range(DEPTH):
        lam_init = 0.8 - 0.6 * math.exp(-0.3 * l)
        x = layer_norm(ALPHA * x + 0.5 * swiglu(x, ffn1_w_gate[l], ffn1_w_up[l], ffn1_w_down[l]),
                       ln1_g[l], ln1_b[l])
        h = x @ w_in[l]
        q = h[..., :ATTN_WIDTH].reshape(b_, s_, DIFF_HEADS, 2, DIFF_HEAD_DIM)
        k = h[..., ATTN_WIDTH:2 * ATTN_WIDTH].reshape(b_, s_, DIFF_HEADS, 2, DIFF_HEAD_DIM)
        v = h[..., 2 * ATTN_WIDTH:3 * ATTN_WIDTH].reshape(b_, s_, DIFF_HEADS, DIFF_V_DIM)
        u = h[..., 3 * ATTN_WIDTH:]
        lam = (jnp.exp(jnp.sum(lambda_q1[l].astype(jnp.float32) * lambda_k1[l].astype(jnp.float32)))
               - jnp.exp(jnp.sum(lambda_q2[l].astype(jnp.float32) * lambda_k2[l].astype(jnp.float32)))
               + lam_init)
        attn_out = diff_attention(q, k, v, lam, diff_norm_g[l], lam_init)
        ssm_out = s5_mixer(u, ssm_lambda_re[l], ssm_lambda_im[l], ssm_log_step[l],
                           ssm_b_re[l], ssm_b_im[l], ssm_c_re[l], ssm_c_im[l],
                           ssm_d[l], ssm_glu_w[l], ssm_glu_b[l])
        mixed = jnp.concatenate([attn_out, ssm_out], axis=-1) @ w_out[l]
        x = layer_norm(ALPHA * x + mixed, ln2_g[l], ln2_b[l])
        x = layer_norm(ALPHA * x + cross_attention(x, mem, xattn_w_q[l], xattn_w_k[l],
                                                     xattn_w_v[l], xattn_w_o[l]),
                       ln3_g[l], ln3_b[l])
        x = layer_norm(ALPHA * x + 0.5 * swiglu(x, ffn2_w_gate[l], ffn2_w_up[l], ffn2_w_down[l]),
                       ln4_g[l], ln4_b[l])
    return x
```

```cpp
#include <hip/hip_runtime.h>
#include <hip/hip_bf16.h>
#include <cstdio>
#include <cstdint>
#include <cmath>
namespace pg8 {
#define PG8_LAS __attribute__((address_space(3)))
typedef unsigned short bf16_t;
typedef short bf16x8 __attribute__((ext_vector_type(8)));
typedef float f32x4 __attribute__((ext_vector_type(4)));
typedef float f32x2 __attribute__((ext_vector_type(2)));
typedef unsigned u32x4 __attribute__((ext_vector_type(4)));
constexpr int BM = 256, BK = 64, HALF = 128, HTB = HALF * BK * 2  , STAGE_BYTES = 8 * HTB, NXCD = 8, WGM = 8;

__host__ __device__ __forceinline__ int lds_byte(int r, int c) { const int st = (r >> 4) * 2 + (c >> 5), rr = r & 15, cc = c & 31, ob = rr * 64 + cc * 2; return st * 1024 + (ob ^ (((ob >> 9) & 1) << 5)); }
__host__ __device__ __forceinline__ void stage_rc(int b, int& R, int& C) { const int st = b / 1024, sb = b % 1024, swz = sb ^ (((sb >> 9) & 1) << 5); R = (st >> 1) * 16 + swz / 64; C = (st & 1) * 32 + (swz % 64) / 2; }
__host__ __device__ __forceinline__ int perm32(int rho) { const int n = rho >> 4, i = rho & 15; return 8 * (i >> 2) + 4 * n + (i & 3); }

struct Unit { int aoff, boff, pm, pn; };
struct Gemm { const bf16_t* A; const bf16_t* Bt; int lda, ldb, K; };

template <class Map> struct Order {
    int nM, nN, nwg, G, c; Map map;
    __device__ __forceinline__ void init(int nM_, int nN_, int G_, int c_, const Map& m) { nM = nM_; nN = nN_; nwg = nM * nN; G = G_; c = c_; map = m; }
    __device__ __forceinline__ bool next(int i, Unit& u) const {
        const long L = (long)i * G + c; if (c < 0 || L >= nwg) return false;
        int wgid = (int)L; { const int q = nwg / NXCD, r = nwg % NXCD, xcd = wgid % NXCD, off = wgid / NXCD; wgid = (xcd < r ? xcd * (q + 1) : r * (q + 1) + (xcd - r) * q) + off; }
        const int nig = WGM * nN, gid = wgid / nig, fm = gid * WGM, gsz = (nM - fm) < WGM ? (nM - fm) : WGM;
        u.pm = fm + ((wgid % nig) % gsz); u.pn = (wgid % nig) / gsz; map(u); return true;
    }
    __device__ __forceinline__ void a_ready(const Unit&) const {}
    __device__ __forceinline__ void done(const Unit&) const {}
};
struct MapStd { int lda, ldb; __device__ __forceinline__ void operator()(Unit& u) const { u.aoff = u.pm * BM * lda; u.boff = u.pn * BM * ldb; } };

__device__ __forceinline__ unsigned cvt_pk_bf16(float lo, float hi) { unsigned r; asm volatile("v_cvt_pk_bf16_f32 %0, %1, %2" : "=v"(r) : "v"(lo), "v"(hi)); return r; }
__device__ __forceinline__ float bf_lo(unsigned w) { return __uint_as_float(w << 16); }
__device__ __forceinline__ float bf_hi(unsigned w) { return __uint_as_float(w & 0xffff0000u); }
__device__ __forceinline__ float sigmoid_f(float z) { return __builtin_amdgcn_rcpf(1.0f + __builtin_amdgcn_exp2f(-1.4426950408889634f * z)); }
__device__ __forceinline__ int otid() { int t = threadIdx.x; asm volatile("" : "+v"(t)); return t; }
__device__ __forceinline__ int osgpr(int v) { asm volatile("" : "+s"(v)); return v; }
#define PG8_EPI_ARGS const f32x4 (&acc)[2][2][4][2], const Unit& u, int wr, int wc, int fr, int fq
__device__ __forceinline__ u32x4 pack8(const f32x4 v0, const f32x4 v1) { u32x4 w; w.x = cvt_pk_bf16(v0[0], v0[1]); w.y = cvt_pk_bf16(v0[2], v0[3]); w.z = cvt_pk_bf16(v1[0], v1[1]); w.w = cvt_pk_bf16(v1[2], v1[3]); return w; }

struct EpiBf16 {
    static constexpr bool PERM = true, AFTER_DRAIN = false;
    bf16_t* O; int ldc; float scale;
    __device__ __forceinline__ void operator()(PG8_EPI_ARGS) const {
        const int row0 = u.pm * BM + wr * 64 + fr, col0 = u.pn * BM + wc * 32 + 8 * fq;
#pragma unroll
        for (int ai = 0; ai < 2; ++ai)
#pragma unroll
            for (int m = 0; m < 4; ++m) { bf16_t* rowp = O + (size_t)(row0 + ai * HALF + m * 16) * ldc + col0;
#pragma unroll
                for (int bj = 0; bj < 2; ++bj) *(u32x4*)(rowp + bj * HALF) = pack8(acc[ai][bj][m][0] * scale, acc[ai][bj][m][1] * scale); }
    }
};
template <int NBJ> struct EpiF32 {
    static constexpr bool PERM = false, AFTER_DRAIN = false;
    float* O; int ldc;
    __device__ __forceinline__ void operator()(PG8_EPI_ARGS) const {
        const int row0 = u.pm * BM + wr * 64 + fr, col0 = u.pn * (NBJ == 2 ? BM : HALF) + wc * 32 + 4 * fq;
#pragma unroll
        for (int ai = 0; ai < 2; ++ai)
#pragma unroll
            for (int m = 0; m < 4; ++m) { float* rowp = O + (size_t)(row0 + ai * HALF + m * 16) * ldc + col0;
#pragma unroll
                for (int bj = 0; bj < NBJ; ++bj)
#pragma unroll
                    for (int n = 0; n < 2; ++n) *(f32x4*)(rowp + bj * HALF + n * 16) = acc[ai][bj][m][n]; }
    }
};
struct EpiSwiGLU {
    static constexpr bool PERM = true, AFTER_DRAIN = false;
    bf16_t* O; int ldc;
    __device__ __forceinline__ void operator()(PG8_EPI_ARGS) const {
        const int row0 = u.pm * BM + wr * 64 + fr, col0 = u.pn * HALF + wc * 32 + 8 * fq;
#pragma unroll
        for (int ai = 0; ai < 2; ++ai)
#pragma unroll
            for (int m = 0; m < 4; ++m) { f32x4 v[2];
#pragma unroll
                for (int n = 0; n < 2; ++n) { const f32x4 g = acc[ai][0][m][n], up = acc[ai][1][m][n];
#pragma unroll
                    for (int e = 0; e < 4; ++e) v[n][e] = g[e] * sigmoid_f(g[e]) * up[e]; }
                *(u32x4*)(O + (size_t)(row0 + ai * HALF + m * 16) * ldc + col0) = pack8(v[0], v[1]); }
    }
};
struct EpiResF32 {
    static constexpr bool PERM = false, AFTER_DRAIN = false;
    const float* res; float* O; int ldc; float alpha, scale;
    __device__ __forceinline__ void operator()(PG8_EPI_ARGS) const {
        const int row0 = u.pm * BM + wr * 64 + fr, col0 = u.pn * BM + wc * 32 + 4 * fq;
#pragma unroll
        for (int ai = 0; ai < 2; ++ai)
#pragma unroll
            for (int m = 0; m < 4; ++m) { const size_t off = (size_t)(row0 + ai * HALF + m * 16) * ldc + col0;
#pragma unroll
                for (int bj = 0; bj < 2; ++bj)
#pragma unroll
                    for (int n = 0; n < 2; ++n) { const f32x4 r = *(const f32x4*)(res + off + bj * HALF + n * 16); *(f32x4*)(O + off + bj * HALF + n * 16) = r * alpha + acc[ai][bj][m][n] * scale; }
                if (m & 1) asm volatile("" ::: "memory"); }
    }
};
template <int UGP> struct EpiWin {
    static constexpr bool PERM = true, AFTER_DRAIN = false;
    bf16_t* QKV; bf16_t* UG; float qscale;
    __device__ __forceinline__ void operator()(PG8_EPI_ARGS) const {
        const int row0 = u.pm * BM + wr * 64 + fr;
        if (u.pn < 12) {
            const float sc = u.pn < 4 ? qscale : 1.0f; const int col0 = u.pn * BM + wc * 32 + 8 * fq;
#pragma unroll
            for (int ai = 0; ai < 2; ++ai)
#pragma unroll
                for (int m = 0; m < 4; ++m) { bf16_t* rowp = QKV + (size_t)(row0 + ai * HALF + m * 16) * 3072 + col0;
#pragma unroll
                    for (int bj = 0; bj < 2; ++bj) *(u32x4*)(rowp + bj * HALF) = pack8(acc[ai][bj][m][0] * sc, acc[ai][bj][m][1] * sc); }
        } else {
#pragma unroll
            for (int ai = 0; ai < 2; ++ai)
#pragma unroll
                for (int m = 0; m < 4; ++m) { const int r = row0 + ai * HALF + m * 16, b = r >> 14, c = (r >> 6) & 255, s = r & 63;
#pragma unroll
                    for (int bj = 0; bj < 2; ++bj) { const int j0 = (u.pn - 12) * BM + bj * HALF + wc * 32 + 8 * fq, g = j0 >> 4, q0 = j0 & 15;
                        *(u32x4*)(UG + (size_t)(g * 512 + b * 256 + c) * UGP + s * 16 + q0) = pack8(acc[ai][bj][m][0], acc[ai][bj][m][1]); } }
        }
    }
};
template <int UGP> struct EpiSsmY {
    static constexpr bool PERM = true, AFTER_DRAIN = false;
    const bf16_t* UG; const float* dskip; bf16_t* YG;
    __device__ __forceinline__ void operator()(PG8_EPI_ARGS) const {
        const int R0 = u.pm * BM + wr * 64 + fr;
#pragma unroll
        for (int ai = 0; ai < 2; ++ai)
#pragma unroll
            for (int m = 0; m < 4; ++m) { const int R = R0 + ai * HALF + m * 16, g = R >> 9, b = (R >> 8) & 1, c = R & 255;
#pragma unroll
                for (int bj = 0; bj < 2; ++bj) { const int col = u.pn * BM + bj * HALF + wc * 32 + 8 * fq, t = col >> 4, p0 = col & 15;
                    const u32x4 uu = *(const u32x4*)(UG + (size_t)R * UGP + col);
                    const f32x4 d0 = *(const f32x4*)(dskip + g * 16 + p0), d1 = *(const f32x4*)(dskip + g * 16 + p0 + 4);
                    f32x4 y0 = acc[ai][bj][m][0], y1 = acc[ai][bj][m][1];
                    y0[0] += d0[0] * bf_lo(uu.x); y0[1] += d0[1] * bf_hi(uu.x); y0[2] += d0[2] * bf_lo(uu.y); y0[3] += d0[3] * bf_hi(uu.y);
                    y1[0] += d1[0] * bf_lo(uu.z); y1[1] += d1[1] * bf_hi(uu.z); y1[2] += d1[2] * bf_lo(uu.w); y1[3] += d1[3] * bf_hi(uu.w);
#pragma unroll
                    for (int e = 0; e < 4; ++e) { const float a = y0[e], bq = y1[e];
                        y0[e] = a * sigmoid_f(1.5957691216057308f * (a + 0.044715f * a * a * a)); y1[e] = bq * sigmoid_f(1.5957691216057308f * (bq + 0.044715f * bq * bq * bq)); }
                    *(u32x4*)(YG + (size_t)(b * 16384 + c * 64 + t) * 1024 + g * 16 + p0) = pack8(y0, y1); } }
    }
};
struct EpiGlu {
    static constexpr bool PERM = true, AFTER_DRAIN = false;
    const bf16_t* YG; const float* bias; bf16_t* MIX;
    __device__ __forceinline__ void operator()(PG8_EPI_ARGS) const {
        const int row0 = u.pm * BM + wr * 64 + fr, col0 = u.pn * BM + wc * 32 + 8 * fq;
#pragma unroll
        for (int ai = 0; ai < 2; ++ai)
#pragma unroll
            for (int m = 0; m < 4; ++m) { const int r = row0 + ai * HALF + m * 16;
#pragma unroll
                for (int bj = 0; bj < 2; ++bj) { const int col = col0 + bj * HALF;
                    const u32x4 yy = *(const u32x4*)(YG + (size_t)r * 1024 + col);
                    const f32x4 b0 = *(const f32x4*)(bias + col), b1 = *(const f32x4*)(bias + col + 4);
                    const f32x4 z0 = acc[ai][bj][m][0] + b0, z1 = acc[ai][bj][m][1] + b1; f32x4 o0, o1;
                    o0[0] = bf_lo(yy.x) * sigmoid_f(z0[0]); o0[1] = bf_hi(yy.x) * sigmoid_f(z0[1]); o0[2] = bf_lo(yy.y) * sigmoid_f(z0[2]); o0[3] = bf_hi(yy.y) * sigmoid_f(z0[3]);
                    o1[0] = bf_lo(yy.z) * sigmoid_f(z1[0]); o1[1] = bf_hi(yy.z) * sigmoid_f(z1[1]); o1[2] = bf_lo(yy.w) * sigmoid_f(z1[2]); o1[3] = bf_hi(yy.w) * sigmoid_f(z1[3]);
                    *(u32x4*)(MIX + (size_t)r * 2048 + 1024 + col) = pack8(o0, o1); } }
    }
};
template <class Epi, class Sched, bool ALIGN_EPI = false, bool SP2 = false>
__device__ __forceinline__ void gemm_phase(PG8_LAS unsigned char* lds, const Gemm g, const Sched& S, const Epi& E) {
    const int tid = otid(), wid = __builtin_amdgcn_readfirstlane(tid >> 6), lane = tid & 63, wr = wid >> 2, wc = wid & 3, fr = lane & 15, fq = lane >> 4;
    const int K = g.K, nt = K / BK;
    unsigned voffA[2], voffB[2];
#pragma unroll
    for (int i = 0; i < 2; ++i) { int R, C; stage_rc(tid * 16 + i * 8192, R, C); const int Rb = Epi::PERM ? ((R & ~31) + perm32(R & 31)) : R;
        voffA[i] = (unsigned)(R * g.lda + C) * 2u; voffB[i] = (unsigned)(Rb * g.ldb + C) * 2u; }
    const size_t kstep = (size_t)(BK * 2);
    const size_t hstepA = (size_t)HALF * g.lda * 2, hstepB = (size_t)HALF * g.ldb * 2;
    const unsigned ldsw = (unsigned)wid * 1024u;
    const int aoff = lds_byte(wr * 64 + fr, fq * 8), boff = lds_byte(wc * 32 + fr, fq * 8);
#define PG8_SA(b, h) (((b) * 2 + (h)) * HTB)
#define PG8_SB(b, h) ((4 + (b) * 2 + (h)) * HTB)
#define PG8_STAGE(bufoff, gbase, voff) do { _Pragma("unroll") for (int _i = 0; _i < 2; ++_i) \
        __builtin_amdgcn_global_load_lds((const unsigned*)((const char*)(gbase) + (voff)[_i]), (PG8_LAS unsigned*)(lds + (bufoff) + ldsw + _i * 8192), 16, 0, 0); } while (0)
#define PG8_LDA(dst, b, h) do { _Pragma("unroll") for (int m = 0; m < 4; ++m) _Pragma("unroll") for (int k = 0; k < 2; ++k) dst[m][k] = *(const PG8_LAS bf16x8*)(lds + PG8_SA(b, h) + aoff + m * 2048 + k * 1024); } while (0)
#define PG8_LDB(dst, b, h) do { _Pragma("unroll") for (int n = 0; n < 2; ++n) _Pragma("unroll") for (int k = 0; k < 2; ++k) dst[n][k] = *(const PG8_LAS bf16x8*)(lds + PG8_SB(b, h) + boff + n * 2048 + k * 1024); } while (0)
#define PG8_MMA(ai, bj, At, Bt) do { __builtin_amdgcn_s_setprio(1); _Pragma("unroll") for (int m = 0; m < 4; ++m) _Pragma("unroll") for (int n = 0; n < 2; ++n) _Pragma("unroll") for (int k = 0; k < 2; ++k) \
        acc[ai][bj][m][n] = __builtin_amdgcn_mfma_f32_16x16x32_bf16(Bt[n][k], At[m][k], acc[ai][bj][m][n], 0, 0, 0); __builtin_amdgcn_s_setprio(0); } while (0)
#define PG8_WAIT_V(n) asm volatile("s_waitcnt vmcnt(" #n ")" ::: "memory")
#define PG8_WAIT_L(n) asm volatile("s_waitcnt lgkmcnt(" #n ")" ::: "memory")
#define PG8_BAR __builtin_amdgcn_s_barrier()
#define PG8_SCHED __builtin_amdgcn_sched_barrier(0)
    Unit cur, nxt; int ui = 0;
    if (!S.next(0, cur)) return;
    f32x4 acc[2][2][4][2];
#pragma unroll
    for (int a = 0; a < 2; ++a)
#pragma unroll
        for (int b = 0; b < 2; ++b)
#pragma unroll
            for (int m = 0; m < 4; ++m)
#pragma unroll
                for (int n = 0; n < 2; ++n) acc[a][b][m][n] = (f32x4){0.f, 0.f, 0.f, 0.f};
    bf16x8 At[4][2], B0[2][2], B1[2][2];
    const char* cA = (const char*)g.A + (size_t)cur.aoff * 2; const char* cB = (const char*)g.Bt + (size_t)cur.boff * 2;
    S.a_ready(cur);
    if constexpr (SP2) {
        PG8_STAGE(PG8_SB(0, 0), cB, voffB); PG8_STAGE(PG8_SB(0, 1), cB + hstepB, voffB); PG8_STAGE(PG8_SA(0, 0), cA, voffA); PG8_STAGE(PG8_SA(0, 1), cA + hstepA, voffA);
        if (wr == 1) PG8_BAR;
        PG8_WAIT_V(2); PG8_BAR;
        PG8_STAGE(PG8_SB(1, 0), cB + kstep, voffB); PG8_STAGE(PG8_SA(1, 0), cA + kstep, voffA); PG8_STAGE(PG8_SB(1, 1), cB + hstepB + kstep, voffB);
        PG8_WAIT_V(6); PG8_BAR;
    } else {
        PG8_STAGE(PG8_SB(0, 0), cB, voffB); PG8_STAGE(PG8_SA(0, 0), cA, voffA); PG8_STAGE(PG8_SB(0, 1), cB + hstepB, voffB); PG8_STAGE(PG8_SA(0, 1), cA + hstepA, voffA);
        if (wr == 1) PG8_BAR;
        PG8_WAIT_V(4); PG8_BAR;
        PG8_STAGE(PG8_SB(1, 0), cB + kstep, voffB); PG8_STAGE(PG8_SA(1, 0), cA + kstep, voffA); PG8_STAGE(PG8_SB(1, 1), cB + hstepB + kstep, voffB);
        PG8_WAIT_V(6); PG8_BAR;
    }
    for (;;) {
        const bool has_next = S.next(ui + 1, nxt);
        const char* nA = has_next ? (const char*)g.A + (size_t)nxt.aoff * 2 : cA; const char* nB = has_next ? (const char*)g.Bt + (size_t)nxt.boff * 2 : cB;
        for (int t = 0; t < nt; t += 2) {
            const bool last = (t == nt - 2);
            const char* a1 = cA + (size_t)(t + 1) * kstep;
            const char* a2 = last ? nA : cA + (size_t)(t + 2) * kstep; const char* b2 = last ? nB : cB + (size_t)(t + 2) * kstep;
            const char* a3 = a2 + kstep; const char* b3 = b2 + kstep;
            if (last && has_next) S.a_ready(nxt);
            if constexpr (SP2) {
            PG8_LDB(B0, 0, 0); PG8_LDB(B1, 0, 1); PG8_SCHED; PG8_LDA(At, 0, 0); PG8_STAGE(PG8_SA(1, 1), a1 + hstepA, voffA);
            PG8_WAIT_V(8); PG8_WAIT_L(0); PG8_BAR; PG8_MMA(0, 0, At, B0); PG8_MMA(0, 1, At, B1); PG8_BAR; PG8_SCHED;
            PG8_LDA(At, 0, 1); PG8_STAGE(PG8_SB(0, 0), b2, voffB); PG8_STAGE(PG8_SB(0, 1), b2 + hstepB, voffB); PG8_STAGE(PG8_SA(0, 0), a2, voffA);
            PG8_WAIT_V(8); PG8_WAIT_L(0); PG8_BAR; PG8_MMA(1, 0, At, B0); PG8_MMA(1, 1, At, B1); PG8_BAR; PG8_SCHED;
            PG8_LDB(B0, 1, 0); PG8_LDB(B1, 1, 1); PG8_SCHED; PG8_LDA(At, 1, 0); PG8_STAGE(PG8_SA(0, 1), a2 + hstepA, voffA);
            PG8_WAIT_V(8); PG8_WAIT_L(0); PG8_BAR; PG8_MMA(0, 0, At, B0); PG8_MMA(0, 1, At, B1); PG8_BAR; PG8_SCHED;
            PG8_LDA(At, 1, 1); PG8_STAGE(PG8_SB(1, 0), b3, voffB); PG8_STAGE(PG8_SB(1, 1), b3 + hstepB, voffB); PG8_STAGE(PG8_SA(1, 0), a3, voffA);
            PG8_WAIT_V(8); PG8_WAIT_L(0); PG8_BAR; PG8_MMA(1, 0, At, B0); PG8_MMA(1, 1, At, B1); PG8_BAR; PG8_SCHED;
            } else {
            PG8_LDB(B0, 0, 0); PG8_SCHED; PG8_LDA(At, 0, 0); PG8_STAGE(PG8_SA(1, 1), a1 + hstepA, voffA);
            PG8_WAIT_L(8); PG8_BAR; PG8_WAIT_L(0); PG8_MMA(0, 0, At, B0); PG8_BAR; PG8_SCHED;
            PG8_LDB(B1, 0, 1); PG8_STAGE(PG8_SB(0, 0), b2, voffB);
            PG8_BAR; PG8_WAIT_L(0); PG8_MMA(0, 1, At, B1); PG8_BAR;
            PG8_LDA(At, 0, 1); PG8_STAGE(PG8_SA(0, 0), a2, voffA);
            PG8_BAR; PG8_WAIT_L(0); PG8_MMA(1, 0, At, B0); PG8_BAR; PG8_SCHED;
            PG8_STAGE(PG8_SB(0, 1), b2 + hstepB, voffB);
            PG8_WAIT_V(6); PG8_BAR; PG8_MMA(1, 1, At, B1); PG8_BAR;
            PG8_LDB(B0, 1, 0); PG8_SCHED; PG8_LDA(At, 1, 0); PG8_STAGE(PG8_SA(0, 1), a2 + hstepA, voffA);
            PG8_WAIT_L(8); PG8_BAR; PG8_WAIT_L(0); PG8_MMA(0, 0, At, B0); PG8_BAR; PG8_SCHED;
            PG8_LDB(B1, 1, 1); PG8_STAGE(PG8_SB(1, 0), b3, voffB);
            PG8_BAR; PG8_WAIT_L(0); PG8_MMA(0, 1, At, B1); PG8_BAR;
            PG8_LDA(At, 1, 1); PG8_STAGE(PG8_SA(1, 0), a3, voffA);
            PG8_BAR; PG8_WAIT_L(0); PG8_MMA(1, 0, At, B0); PG8_BAR; PG8_SCHED;
            PG8_STAGE(PG8_SB(1, 1), b3 + hstepB, voffB);
            PG8_WAIT_V(6); PG8_BAR; PG8_MMA(1, 1, At, B1); PG8_BAR;
            }
        }
        if constexpr (ALIGN_EPI) { if (wr == 0) PG8_BAR; }
        if constexpr (!Epi::AFTER_DRAIN) { E(acc, cur, wr, wc, fr, fq); S.done(cur); }
        if (!has_next) break;
#pragma unroll
        for (int a = 0; a < 2; ++a)
#pragma unroll
            for (int b = 0; b < 2; ++b)
#pragma unroll
                for (int m = 0; m < 4; ++m)
#pragma unroll
                    for (int n = 0; n < 2; ++n) acc[a][b][m][n] = (f32x4){0.f, 0.f, 0.f, 0.f};
        cur = nxt; cA = nA; cB = nB; ++ui;
        if constexpr (ALIGN_EPI) { if (wr == 1) PG8_BAR; }
    }
    PG8_WAIT_V(0);
    if constexpr (!ALIGN_EPI) { if (wr == 0) PG8_BAR; }
    PG8_BAR;
    if constexpr (Epi::AFTER_DRAIN) { E.fused(acc, cur, wr, wc, fr, fq, lds, wid, lane); S.done(cur); }
#undef PG8_SA
#undef PG8_SB
#undef PG8_STAGE
#undef PG8_LDA
#undef PG8_LDB
#undef PG8_MMA
#undef PG8_WAIT_V
#undef PG8_WAIT_L
#undef PG8_BAR
#undef PG8_SCHED
}
}
#include <hip/hip_bf16.h>
#include <cmath>
namespace attn_body {
using bf16=__hip_bfloat16;
using bf16x8=__attribute__((ext_vector_type(8)))short;
using s16x4=__attribute__((ext_vector_type(4)))short;
using f32x16=__attribute__((ext_vector_type(16)))float;
using u32x4=__attribute__((ext_vector_type(4)))unsigned;
constexpr int BATCH=2,NVH=32,SEQ=16384,D=64,DM=3072,DMO=2048;
constexpr int NW=8,QBLK=32,QB=QBLK*NW,KVBLK=64,NQB=SEQ/QB;
constexpr int ATTN_PITCH=DM, ATTN_UNIT_ROWS=QB;
__device__ __forceinline__ int crow(int r,int hi){return (r&3)+8*(r>>2)+4*hi;}
#define SBAR() __builtin_amdgcn_sched_barrier(0)
__device__ __forceinline__ void cmask(f32x16&p0,f32x16&p1,int jb,int qrel,int hi){
  const float NEG=-INFINITY; (void)hi;
  if(jb>(qrel>>6)){
  #pragma unroll
  for(int r=0;r<16;++r){p0[r]=NEG;p1[r]=NEG;}}
}

constexpr int NSLOT=3, SLOTB=8192;
constexpr int LDS_K=0, LDS_V=NSLOT*SLOTB, LDS_WS=2*NSLOT*SLOTB, LDS_OST=LDS_WS+NW*64*4, LDS_BYTES=LDS_OST+NW*4096;
constexpr float C2=0.125f*1.4426950408889634f;
__device__ __forceinline__ void glds16(const void*gsrc,unsigned lds_dst){unsigned keep;
  asm volatile("s_mov_b32 %0, m0\n\ts_mov_b32 m0, %2\n\ts_nop 0\n\tglobal_load_lds_dwordx4 %1, off\n\ts_mov_b32 m0, %0":"=&s"(keep):"v"(gsrc),"s"(lds_dst):"memory");}
__device__ __forceinline__ float max3f(float a,float b,float c){float r;asm("v_max3_f32 %0, %1, %2, %3":"=v"(r):"v"(a),"v"(b),"v"(c));return r;}
__device__ __forceinline__ float max2f(float a,float b){float r;asm("v_max_f32_e32 %0, %1, %2":"=v"(r):"v"(a),"v"(b));return r;}
__device__ __forceinline__ float fadd_s(float a,float b){float r;asm("v_add_f32_e32 %0, %1, %2":"=v"(r):"v"(a),"v"(b));return r;}
__device__ __forceinline__ float fsub_s(float a,float b){float r;asm("v_sub_f32_e32 %0, %1, %2":"=v"(r):"v"(a),"v"(b));return r;}
typedef float f32x2_t __attribute__((ext_vector_type(2))); typedef __bf16 bf16x2_t __attribute__((ext_vector_type(2)));
__device__ __forceinline__ unsigned cvtpk_s(float lo,float hi){f32x2_t v={lo,hi};bf16x2_t b=__builtin_convertvector(v,bf16x2_t);return __builtin_bit_cast(unsigned,b);}
#define WAIT_BAR(N) asm volatile("s_waitcnt vmcnt(" #N ") lgkmcnt(0)\n\ts_barrier":::"memory")

__device__ __forceinline__ void qkt(f32x16&p0,f32x16&p1,const char*Kslot,const bf16x8*qr,const f32x16&negm,int r32,int hi){
  const char*kb=Kslot+hi*1024+r32*16;
  #pragma unroll
  for(int d0=0;d0<4;++d0){
    const bf16x8 b0=*reinterpret_cast<const bf16x8*>(kb+d0*2048);
    const bf16x8 b1=*reinterpret_cast<const bf16x8*>(kb+d0*2048+512);
    if(d0==0){p0=__builtin_amdgcn_mfma_f32_32x32x16_bf16(b0,qr[0],negm,0,0,0);p1=__builtin_amdgcn_mfma_f32_32x32x16_bf16(b1,qr[0],negm,0,0,0);}
    else{p0=__builtin_amdgcn_mfma_f32_32x32x16_bf16(b0,qr[d0],p0,0,0,0);p1=__builtin_amdgcn_mfma_f32_32x32x16_bf16(b1,qr[d0],p1,0,0,0);}}
}
typedef __attribute__((address_space(3))) const char* lds_cptr;
typedef short v4i16_t __attribute__((ext_vector_type(4)));
__device__ __forceinline__ void kload8(bf16x8*kf,lds_cptr kp){
  kf[0]=*(const __attribute__((address_space(3))) bf16x8*)(kp);      kf[1]=*(const __attribute__((address_space(3))) bf16x8*)(kp+512);
  kf[2]=*(const __attribute__((address_space(3))) bf16x8*)(kp+2048); kf[3]=*(const __attribute__((address_space(3))) bf16x8*)(kp+2560);
  kf[4]=*(const __attribute__((address_space(3))) bf16x8*)(kp+4096); kf[5]=*(const __attribute__((address_space(3))) bf16x8*)(kp+4608);
  kf[6]=*(const __attribute__((address_space(3))) bf16x8*)(kp+6144); kf[7]=*(const __attribute__((address_space(3))) bf16x8*)(kp+6656);
}
__device__ __forceinline__ void kload2(bf16x8*kf,lds_cptr kp,int j){ kf[2*j]=*(const __attribute__((address_space(3))) bf16x8*)(kp+j*2048); kf[2*j+1]=*(const __attribute__((address_space(3))) bf16x8*)(kp+j*2048+512); }
__device__ __forceinline__ s16x4 vtr(lds_cptr p){ return __builtin_bit_cast(s16x4,__builtin_amdgcn_ds_read_tr16_b64_v4i16((__attribute__((address_space(3))) v4i16_t*)p)); }
__device__ __forceinline__ float rowmax(const f32x16&p0,const f32x16&p1){
  float a=max3f(p0[0],p0[1],p1[0]),b=max3f(p0[2],p0[3],p1[1]);a=max3f(a,p1[2],p1[3]);
  #pragma unroll
  for(int r=4;r<16;r+=4){a=max3f(a,p0[r],p0[r+1]);b=max3f(b,p0[r+2],p0[r+3]);a=max3f(a,p1[r],p1[r+1]);b=max3f(b,p1[r+2],p1[r+3]);}
  const float m=max2f(a,b);
  auto rr=__builtin_amdgcn_permlane32_swap(__float_as_uint(m),__float_as_uint(m),false,false);
  return max2f(__uint_as_float(rr[0]),__uint_as_float(rr[1]));
}
__device__ __forceinline__ void pv(f32x16*o,int vb,bf16x8 pa0,bf16x8 pa1,bf16x8 pa2,bf16x8 pa3){
  #pragma unroll
  for(int d0=0;d0<2;++d0){s16x4 lo[4],hi[4];
    #pragma unroll
    for(int ks=0;ks<4;++ks){
      asm volatile("ds_read_b64_tr_b16 %0,%1 offset:%c2":"=&v"(lo[ks]):"v"(vb),"i"(d0*4096+ks*1024):"memory");
      asm volatile("ds_read_b64_tr_b16 %0,%1 offset:%c2":"=&v"(hi[ks]):"v"(vb),"i"(d0*4096+ks*1024+512):"memory");}
    asm volatile("s_waitcnt lgkmcnt(0)":::"memory");SBAR();
    #define PK(k) (bf16x8){lo[k][0],lo[k][1],lo[k][2],lo[k][3],hi[k][0],hi[k][1],hi[k][2],hi[k][3]}
    o[d0]=__builtin_amdgcn_mfma_f32_32x32x16_bf16(pa0,PK(0),o[d0],0,0,0);
    o[d0]=__builtin_amdgcn_mfma_f32_32x32x16_bf16(pa1,PK(1),o[d0],0,0,0);
    o[d0]=__builtin_amdgcn_mfma_f32_32x32x16_bf16(pa2,PK(2),o[d0],0,0,0);
    o[d0]=__builtin_amdgcn_mfma_f32_32x32x16_bf16(pa3,PK(3),o[d0],0,0,0);
    #undef PK
  }
}

#ifndef ATTN_STORE16
#define ATTN_STORE16(p,v) (*(u32x4*)(p)=(v))
#endif
template<int THRL> __device__ __forceinline__ void attn_unit(int b,int qb,const bf16*__restrict__ Q,const bf16*__restrict__ K,const bf16*__restrict__ V,bf16*__restrict__ O,char*shm){
  const int tid=pg8::otid(),lane=tid&63,r32=lane&31,hi=lane>>5; const int wid=__builtin_amdgcn_readfirstlane(tid>>6);
  const long rowbase=(long)b*SEQ; const int q0=qb*QB;
  const bf16*Qw=Q+(rowbase+q0+wid*QBLK)*DM;
  const bf16*Kh=K+rowbase*DM,*Vh=V+rowbase*DM;
  const unsigned lds0=(unsigned)(uintptr_t)shm;
  float*wsf=(float*)(shm+LDS_WS)+wid*64;
  const bf16*ksrc=Kh+(long)lane*DM+wid*8;
  const bf16*vsrc=Vh+(long)(16*(wid&3)+(lane>>2))*DM+(wid>>2)*32+(lane&3)*8;
  const unsigned kdst=lds0+LDS_K+wid*1024, vdst=lds0+LDS_V+wid*1024;
  #define DMA_K(t,slot) glds16(ksrc+(long)(t)*KVBLK*DM,(unsigned)__builtin_amdgcn_readfirstlane(kdst+(slot)))
  #define DMA_V(t,slot) glds16(vsrc+(long)(t)*KVBLK*DM,(unsigned)__builtin_amdgcn_readfirstlane(vdst+(slot)))
  const int vb0=(int)(lds0+LDS_V)+((lane>>4)&1)*32+(lane&3)*8+(4*hi+((lane&15)>>2))*64;
  const char*Kbase=shm+LDS_K; bf16x8 kf[8];
  const lds_cptr shm3=(lds_cptr)shm; const lds_cptr kp0=shm3+LDS_K+hi*1024+r32*16; const lds_cptr vp0=shm3+LDS_V+((lane>>4)&1)*32+(lane&3)*8+(4*hi+((lane&15)>>2))*64;
  const int NT=(q0+QB)/KVBLK;
  DMA_K(0,0);DMA_V(0,0);DMA_K(1,SLOTB);
  bf16x8 qr[4];
  #pragma unroll
  for(int d0=0;d0<4;++d0)qr[d0]=*reinterpret_cast<const bf16x8*>(&Qw[(long)r32*DM+d0*16+hi*8]);
  float mhat=0.f,l_reg=0.f;f32x16 o[2];o[0]=f32x16{};o[1]=f32x16{};f32x16 negm=f32x16{};asm volatile("":"+v"(negm));
  const int qrel=wid*QBLK+r32;
  #define CMASK(P0,P1,t) do{int jb_=(t)-(NT-4); if(jb_>=0)cmask(P0,P1,jb_,qrel,hi);}while(0)
  bool resc=false;
  #define START(P0,P1) do{ const float rm=rowmax(P0,P1); resc=false; \
    { const float dl=rm; mhat=fadd_s(mhat,dl); \
      _Pragma("unroll") for(int r=0;r<16;++r){P0[r]=fsub_s(P0[r],dl);P1[r]=fsub_s(P1[r],dl);} \
      _Pragma("unroll") for(int r=0;r<16;++r)negm[r]=-mhat; asm volatile("":"+v"(negm)); } \
    _Pragma("unroll") for(int r=0;r<16;++r)P0[r]=__builtin_amdgcn_exp2f(P0[r]); }while(0)
  #define RESC() do{ if(resc){ asm volatile("s_waitcnt lgkmcnt(0)":::"memory"); \
      _Pragma("unroll") for(int d_=0;d_<2;++d_) _Pragma("unroll") for(int r=0;r<16;++r)o[d_][r]*=wsf[crow(r,hi)]; } }while(0)
  f32x16 pA0,pA1,pB0,pB1;
  int sl_prev=0,sl_cur=0,sl_next=SLOTB;
  #define ROT() do{sl_prev=sl_cur;sl_cur=sl_next;sl_next=(sl_next==(NSLOT-1)*SLOTB)?0:sl_next+SLOTB;}while(0)
  DMA_K(2,2*SLOTB);
  WAIT_BAR(3);
  qkt(pA0,pA1,Kbase,qr,negm,r32,hi);asm volatile("s_nop 15\n\ts_nop 7":"+v"(pA0),"+v"(pA1));CMASK(pA0,pA1,0);
  START(pA0,pA1);
  _Pragma("unroll") for(int r=0;r<16;++r)pA1[r]=__builtin_amdgcn_exp2f(pA1[r]);
  WAIT_BAR(0);
  DMA_K(3,0);DMA_V(1,SLOTB);
  ROT();
  kload8(kf,kp0+sl_cur);
  WAIT_BAR(2);
  s16x4 vlo[8],vhi[8]; u32x4 pw0,pw1,pw2,pw3;
  #define PKW(P,B) cvtpk_s(P[B],P[B+1])
  #define PAF(k) __builtin_bit_cast(bf16x8,pw##k)
  #define VFR(i) (bf16x8){vlo[i][0],vlo[i][1],vlo[i][2],vlo[i][3],vhi[i][0],vhi[i][1],vhi[i][2],vhi[i][3]}
  #define PIN(x) asm volatile("":"+v"(x))
  #define MX3(a,b,c) __builtin_fmaxf(__builtin_fmaxf((a),(b)),(c))
  #define GAPA(MF,A0,A1,A2,A3,W0,W1,PW) do{ MF; sacc+=A0; sacc+=A1; sacc+=A2; sacc+=A3; PIN(sacc); W0; W1; PIN(PW); SBAR(); }while(0)
  #define EX(v) __builtin_amdgcn_exp2f(v)
  #define GAPB(MF,X,B) do{ MF; X[B]=EX(X[B]); X[B+1]=EX(X[B+1]); X[B+2]=EX(X[B+2]); X[B+3]=EX(X[B+3]); PIN(X); SBAR(); }while(0)
  #define VRD(i) do{ vlo[i]=vtr(vp_+(((i)>>2)*4096+((i)&3)*1024)); vhi[i]=vtr(vp_+(((i)>>2)*4096+((i)&3)*1024+512)); }while(0)
  #define KRD(G,j) do{ if(G){ kload2(kf,kp0+sl_next,j); SBAR(); } }while(0)
  #define STEP(C0,C1,P0,P1,t,GK,GV,GL) do{ SBAR(); \
    const lds_cptr vp_=vp0+sl_prev; \
    VRD(0); SBAR(); float sacc=(P0[0]+P0[1]); \
    GAPA(C0=__builtin_amdgcn_mfma_f32_32x32x16_bf16(kf[0],qr[0],negm,0,0,0), P0[2],P0[3],P0[4],P0[5],     pw0[0]=PKW(P0,0), pw0[1]=PKW(P0,2), pw0); \
    VRD(4); SBAR(); GAPA(C1=__builtin_amdgcn_mfma_f32_32x32x16_bf16(kf[1],qr[0],negm,0,0,0), P0[6],P0[7],P0[8],P0[9],     pw0[2]=PKW(P0,4), pw0[3]=PKW(P0,6), pw0); \
    VRD(1); SBAR(); GAPA(C0=__builtin_amdgcn_mfma_f32_32x32x16_bf16(kf[2],qr[1],C0,0,0,0),   P0[10],P0[11],P0[12],P0[13], pw1[0]=PKW(P0,8), pw1[1]=PKW(P0,10), pw1); \
    VRD(5); SBAR(); GAPA(C1=__builtin_amdgcn_mfma_f32_32x32x16_bf16(kf[3],qr[1],C1,0,0,0),   P0[14],P0[15],P1[0],P1[1],   pw1[2]=PKW(P0,12),pw1[3]=PKW(P0,14), pw1); \
    VRD(2); SBAR(); GAPA(C0=__builtin_amdgcn_mfma_f32_32x32x16_bf16(kf[4],qr[2],C0,0,0,0),   P1[2],P1[3],P1[4],P1[5],     pw2[0]=PKW(P1,0), pw2[1]=PKW(P1,2), pw2); \
    VRD(6); SBAR(); GAPA(C1=__builtin_amdgcn_mfma_f32_32x32x16_bf16(kf[5],qr[2],C1,0,0,0),   P1[6],P1[7],P1[8],P1[9],     pw2[2]=PKW(P1,4), pw2[3]=PKW(P1,6), pw2); \
    VRD(3); SBAR(); GAPA(C0=__builtin_amdgcn_mfma_f32_32x32x16_bf16(kf[6],qr[3],C0,0,0,0),   P1[10],P1[11],P1[12],P1[13], pw3[0]=PKW(P1,8), pw3[1]=PKW(P1,10), pw3); \
    VRD(7); SBAR(); GAPA(C1=__builtin_amdgcn_mfma_f32_32x32x16_bf16(kf[7],qr[3],C1,0,0,0),   P1[14],P1[15],0.f,0.f,       pw3[2]=PKW(P1,12),pw3[3]=PKW(P1,14), pw3); \
    l_reg+=sacc; \
    if(GK){DMA_K((t)+3,sl_cur);} if(GV){DMA_V((t)+1,sl_next);} \
    CMASK(C0,C1,t); \
    { float a=MX3(C0[0],C0[1],C1[0]),b=MX3(C0[2],C0[3],C1[1]); a=MX3(a,C1[2],C1[3]); \
      _Pragma("unroll") for(int r=4;r<16;r+=4){a=MX3(a,C0[r],C0[r+1]);b=MX3(b,C0[r+2],C0[r+3]);a=MX3(a,C1[r],C1[r+1]);b=MX3(b,C1[r+2],C1[r+3]);} \
      float rm=__builtin_fmaxf(a,b); { auto rr=__builtin_amdgcn_permlane32_swap(__float_as_uint(rm),__float_as_uint(rm),false,false); rm=__builtin_fmaxf(__uint_as_float(rr[0]),__uint_as_float(rr[1])); } \
      resc=false; \
      if(__builtin_expect(__any(rm>(float)THRL),0)){ const float dl=__builtin_fmaxf(rm,0.f); mhat+=dl; \
        _Pragma("unroll") for(int r=0;r<16;++r){C0[r]-=dl;C1[r]-=dl;} \
        _Pragma("unroll") for(int r=0;r<16;++r)negm[r]=-mhat; asm volatile("":"+v"(negm)); \
        const float f=__builtin_amdgcn_exp2f(-dl); l_reg*=f; if(hi==0)wsf[r32]=f; resc=true; } } \
    SBAR(); \
    GAPB(o[0]=__builtin_amdgcn_mfma_f32_32x32x16_bf16(PAF(0),VFR(0),o[0],0,0,0), C0,0); \
    GAPB(o[1]=__builtin_amdgcn_mfma_f32_32x32x16_bf16(PAF(0),VFR(4),o[1],0,0,0), C0,4); \
    KRD(GL,0); GAPB(o[0]=__builtin_amdgcn_mfma_f32_32x32x16_bf16(PAF(1),VFR(1),o[0],0,0,0), C0,8); \
    KRD(GL,1); GAPB(o[1]=__builtin_amdgcn_mfma_f32_32x32x16_bf16(PAF(1),VFR(5),o[1],0,0,0), C0,12); \
    KRD(GL,2); GAPB(o[0]=__builtin_amdgcn_mfma_f32_32x32x16_bf16(PAF(2),VFR(2),o[0],0,0,0), C1,0); \
    KRD(GL,3); GAPB(o[1]=__builtin_amdgcn_mfma_f32_32x32x16_bf16(PAF(2),VFR(6),o[1],0,0,0), C1,4); \
    GAPB(o[0]=__builtin_amdgcn_mfma_f32_32x32x16_bf16(PAF(3),VFR(3),o[0],0,0,0), C1,8); \
    GAPB(o[1]=__builtin_amdgcn_mfma_f32_32x32x16_bf16(PAF(3),VFR(7),o[1],0,0,0), C1,12); \
    }while(0)
  int t=1;
  #undef CMASK
  #define CMASK(P0,P1,t) do{}while(0)
  for(;t+5<NT;t+=2){
    STEP(pB0,pB1,pA0,pA1,t,true,true,true);     WAIT_BAR(2); RESC(); ROT();
    STEP(pA0,pA1,pB0,pB1,t+1,true,true,true);   WAIT_BAR(2); RESC(); ROT();
  }
  #undef CMASK
  #define CMASK(P0,P1,t) do{int jb_=(t)-(NT-4); if(jb_>=0)cmask(P0,P1,jb_,qrel,hi);}while(0)
  #define ENDW(tt) do{ if((tt)+3<NT){WAIT_BAR(2);} else if((tt)+2<NT){WAIT_BAR(1);} else {WAIT_BAR(0);} }while(0)
  for(;t+1<NT;t+=2){
    STEP(pB0,pB1,pA0,pA1,t,(t+3<NT),(t+1<NT),(t+1<NT));       ENDW(t);   RESC(); ROT();
    STEP(pA0,pA1,pB0,pB1,t+1,(t+4<NT),(t+2<NT),(t+2<NT));     ENDW(t+1); RESC(); ROT();
  }
  STEP(pB0,pB1,pA0,pA1,NT-1,false,false,false); RESC();
  { float sacc=pB0[0]+pB0[1]; _Pragma("unroll") for(int r=2;r<16;++r)sacc+=pB0[r]; _Pragma("unroll") for(int r=0;r<16;++r)sacc+=pB1[r]; l_reg+=sacc;
    pw0=(u32x4){PKW(pB0,0),PKW(pB0,2),PKW(pB0,4),PKW(pB0,6)};pw1=(u32x4){PKW(pB0,8),PKW(pB0,10),PKW(pB0,12),PKW(pB0,14)};pw2=(u32x4){PKW(pB1,0),PKW(pB1,2),PKW(pB1,4),PKW(pB1,6)};pw3=(u32x4){PKW(pB1,8),PKW(pB1,10),PKW(pB1,12),PKW(pB1,14)};
    SBAR(); pv(o,vb0+sl_cur,PAF(0),PAF(1),PAF(2),PAF(3)); }
  #undef PKW
  #undef PAF
  #undef VFR
  #undef PIN
  #undef MX3
  #undef GAPA
  #undef GAPB
  #undef EX
  #undef VRD
  #undef KRD
  #undef STEP
  #undef ENDW
  {auto rr=__builtin_amdgcn_permlane32_swap(__float_as_uint(l_reg),__float_as_uint(l_reg),false,false);l_reg=__uint_as_float(rr[0])+__uint_as_float(rr[1]);}
  if(hi==0)wsf[32+r32]=l_reg;asm volatile("s_waitcnt lgkmcnt(0)":::"memory");
  float rli[16];
  #pragma unroll
  for(int r=0;r<16;++r)rli[r]=__builtin_amdgcn_rcpf(wsf[32+crow(r,hi)]);
  bf16*Ow=O+(rowbase+q0+wid*QBLK)*DMO;
  { bf16*stg=(bf16*)(shm+LDS_OST)+wid*2048;
    #pragma unroll
    for(int r=0;r<16;++r){const int orow=crow(r,hi);
      #pragma unroll
      for(int d0=0;d0<2;++d0)stg[orow*64+d0*32+r32]=__float2bfloat16(o[d0][r]*rli[r]);}
    asm volatile("s_waitcnt lgkmcnt(0)":::"memory");
    #pragma unroll
    for(int i=0;i<4;++i){const int row=i*8+(lane>>3),ch=lane&7; const u32x4 v=*(const u32x4*)(stg+row*64+ch*8); ATTN_STORE16(Ow+(long)row*DMO+ch*8,v);} }
  asm volatile("s_waitcnt lgkmcnt(0)\n\ts_barrier":::"memory");
  #undef DMA_K
  #undef DMA_V
  #undef CMASK
  #undef START
  #undef RESC
  #undef ROT
}
constexpr int ATTN_LDS_BYTES=LDS_BYTES;
struct AttnTensors { const bf16* QKV; bf16* O; };
struct AttnUnit { int bvh; int qb; };
struct StaticOrder {
  int vcu;
  __device__ __forceinline__ explicit StaticOrder(int grid,int block):vcu((grid%8==0)?(block%8)*(grid/8)+block/8:block){}
  __device__ __forceinline__ bool next(int i,AttnUnit&u)const{ const int L=vcu; if(i>=16||L>=256)return false; const int s=8*(L&3)+(i>>1); u.bvh=L>>2; u.qb=(i&1)?63-s:s; return true; }
  __device__ __forceinline__ void a_ready(const AttnUnit&)const{}
  __device__ __forceinline__ void done(const AttnUnit&)const{}
};
template<class Sched,int THRL=8> __device__ __forceinline__ void attn_phase(char*lds,const AttnTensors&T,const Sched&S){
  AttnUnit u;
  for(int i=0;S.next(i,u);++i){ S.a_ready(u); const int b=u.bvh>>5,vh=u.bvh&31;
    attn_unit<THRL>(b,u.qb,T.QKV+(vh>>1)*64,T.QKV+1024+(vh>>1)*64,T.QKV+2048+((vh>>2)*2+(vh&1))*64,T.O+vh*64,lds); S.done(u); }
}
#undef SBAR
#undef WAIT_BAR
}
#define GAS __attribute__((address_space(1)))
#define LAS __attribute__((address_space(3)))
typedef unsigned short bf16;
typedef unsigned v4u __attribute__((ext_vector_type(4)));
typedef float f32x4 __attribute__((ext_vector_type(4)));
typedef short bf16x8 __attribute__((ext_vector_type(8)));
typedef GAS unsigned gu32;
typedef GAS unsigned long long gu64;
#define RLX_AGENT __ATOMIC_RELAXED, __HIP_MEMORY_SCOPE_AGENT
#define LDS_WAIT() asm volatile("s_waitcnt lgkmcnt(0)" ::: "memory")
#define VM_WAIT() asm volatile("s_waitcnt vmcnt(0)" ::: "memory")
__device__ __forceinline__ unsigned long long rt() { return __builtin_amdgcn_s_memrealtime(); }
__device__ __forceinline__ unsigned f2bf(float f) { unsigned u = __builtin_bit_cast(unsigned, f); return (u + 0x7fffu + ((u >> 16) & 1u)) >> 16; }
__device__ __forceinline__ unsigned pk2(float lo, float hi) { return f2bf(lo) | (f2bf(hi) << 16); }

#define XB_TMO      128
#define XB_XCNT(j)  (256  + 64 * (j))
#define XB_XSUB(j)  (1280 + 64 * (j))
#define XB_XGEN(j)  (2304 + 64 * (j))
#define XB_TOP      3328
#define XB_TOPGEN   3392
#define XCD_BAR_WORDS 3456
#define XB_SPIN_CAP (1u << 18)

__device__ __forceinline__ unsigned xb_ld(unsigned* p)              { return __hip_atomic_load(p, __ATOMIC_RELAXED, __HIP_MEMORY_SCOPE_AGENT); }
__device__ __forceinline__ unsigned xb_add(unsigned* p, unsigned v) { return __hip_atomic_fetch_add(p, v, __ATOMIC_RELAXED, __HIP_MEMORY_SCOPE_AGENT); }
__device__ __forceinline__ unsigned xb_xcc_id() { return (unsigned)__builtin_amdgcn_s_getreg((3 << 11) | 20) & 0xFu; }
#define XB_SPIN(cond, bar) do { unsigned _sp = 0; while (cond) { __builtin_amdgcn_s_sleep(1); \
    if ((++_sp & 255u) == 0u) { if (xb_ld(&(bar)[XB_TMO])) break; if (_sp > XB_SPIN_CAP) { atomicAdd(&(bar)[XB_TMO], 1u); break; } } } } while (0)

struct XcdBarrier {
    unsigned* bar; unsigned x;
    volatile LAS unsigned* st;
};

__device__ __forceinline__ XcdBarrier xcd_barrier_post(unsigned* bar, volatile LAS unsigned* st) {
    XcdBarrier b; b.bar = bar; b.x = xb_xcc_id(); b.st = st;
    if (threadIdx.x == 0) (void)xb_add(&bar[XB_XCNT(b.x)], 1u);
    return b;
}
__device__ __forceinline__ void xcd_barrier_complete(unsigned* bar, unsigned x, unsigned& nloc, unsigned& nx) {
    const unsigned G = gridDim.x * gridDim.y * gridDim.z;
    unsigned sum, cnt, mine, sp = 0u;
    for (;;) {
        sum = 0u; cnt = 0u; mine = 0u;
#pragma unroll
        for (unsigned j = 0; j < 16; ++j) { const unsigned c = xb_ld(&bar[XB_XCNT(j)]); sum += c; cnt += (c > 0u) ? 1u : 0u; mine = (j == x) ? c : mine; }
        if (sum == G) break;
        __builtin_amdgcn_s_sleep(1);
        if ((++sp & 255u) == 0u) { if (xb_ld(&bar[XB_TMO])) break; if (sp > XB_SPIN_CAP) { atomicAdd(&bar[XB_TMO], 1u); break; } }
    }
    nloc = mine > 0u ? mine : 1u; nx = cnt > 0u ? cnt : 1u;
}

__device__ __forceinline__ void xcd_barrier(const XcdBarrier& b) {
    asm volatile("s_waitcnt vmcnt(0)" ::: "memory");
    __syncthreads();
    if (threadIdx.x == 0) {
        unsigned* bar = b.bar;
        __builtin_amdgcn_s_waitcnt(0);
        unsigned nloc = b.st[0], nx = b.st[1];
        if (nloc == 0u) { xcd_barrier_complete(bar, b.x, nloc, nx); b.st[0] = nloc; b.st[1] = nx; }
        const unsigned old = xb_add(&bar[XB_XSUB(b.x)], 1u);
        const unsigned gen = old / nloc;
        if (old + 1u == (gen + 1u) * nloc) {
            __builtin_amdgcn_fence(__ATOMIC_RELEASE, "agent");
            asm volatile("s_waitcnt vmcnt(0)" ::: "memory");
            const unsigned og = xb_add(&bar[XB_TOP], 1u);
            const unsigned tg = og / nx;
            if (og + 1u == (tg + 1u) * nx) xb_add(&bar[XB_TOPGEN], 1u);
            else XB_SPIN(xb_ld(&bar[XB_TOPGEN]) == tg, bar);
            __builtin_amdgcn_fence(__ATOMIC_ACQUIRE, "agent");
            xb_add(&bar[XB_XGEN(b.x)], 1u);
            asm volatile("s_waitcnt vmcnt(0)" ::: "memory");
        } else {
            XB_SPIN(xb_ld(&bar[XB_XGEN(b.x)]) == gen, bar);
            __builtin_amdgcn_fence(__ATOMIC_ACQUIRE, "agent");
            asm volatile("s_waitcnt vmcnt(0)" ::: "memory");
        }
    }
    __syncthreads();
}
constexpr int NWAVES = 8;
constexpr int DMODEL = 2048, NBATCH = 2, SEQ = 16384, DEPTH = 4, MT = NBATCH * SEQ, NMEM = 256, FF = 5632, INW = 4096;
constexpr int UGP = 1152;
constexpr float ALPHA = 1.6817928305074290f, LN_EPS = 1e-5f, RMS_EPS = 1e-5f;
constexpr int NIN = 37;
enum InIdx { I_X = 0, I_MEM, I_F1G, I_F1U, I_F1D, I_LN1G, I_LN1B, I_WIN, I_LQ1, I_LK1, I_LQ2, I_LK2, I_DNG, I_SLRE, I_SLIM, I_SLOG, I_SBRE, I_SBIM, I_SCRE, I_SCIM, I_SD, I_GLUW, I_GLUB,
             I_WOUT, I_LN2G, I_LN2B, I_XQ, I_XK, I_XV, I_XO, I_LN3G, I_LN3B, I_F2G, I_F2U, I_F2D, I_LN4G, I_LN4B };

constexpr size_t MiB = 1u << 20;
constexpr size_t WS_CTL = 0, CTL_ZERO_BYTES = 1 * MiB;
constexpr size_t WS_XB = 1 * MiB;
constexpr size_t WS_YPRE = WS_XB + 128 * MiB;
constexpr size_t WS_BIG = WS_YPRE + 256 * MiB;
constexpr size_t WS_HMID = WS_BIG;
constexpr size_t WS_QKV = WS_BIG;
constexpr size_t WS_UG = WS_BIG + 192 * MiB;
constexpr size_t WS_OV = WS_BIG + 264 * MiB;
constexpr size_t WS_SC = WS_BIG;
constexpr size_t WS_PB = WS_BIG + 128 * MiB;
constexpr size_t WS_MIX = WS_BIG + 392 * MiB;
constexpr size_t WS_YG = WS_MIX + 128 * MiB;
constexpr size_t WS_VS = WS_YG + 64 * MiB;
constexpr size_t WS_W = WS_VS + 16 * MiB;
constexpr size_t WS_W1GU = WS_W, WS_W1D = WS_W1GU + 44 * MiB, WS_W2GU = WS_W1D + 22 * MiB, WS_W2D = WS_W2GU + 44 * MiB, WS_WIN = WS_W2D + 22 * MiB, WS_WGLU = WS_WIN + 16 * MiB,
                 WS_WOUT = WS_WGLU + 2 * MiB, WS_WQN = WS_WOUT + 8 * MiB, WS_WKVT = WS_WQN + 8 * MiB, WS_WOT = WS_WKVT + 16 * MiB, WS_TG = WS_WOT + 8 * MiB, WS_EM = WS_TG + 144 * MiB;
constexpr size_t WS_MEMB = WS_EM + 17 * MiB;
constexpr size_t WS_KVM = WS_MEMB + 2 * MiB;
constexpr size_t WS_MQT = WS_KVM + 4 * MiB;
constexpr size_t WS_VWOT = WS_MQT + 8 * MiB;
constexpr size_t WS_END = WS_VWOT + 8 * MiB;
constexpr int CW_TMO = 0, CW_CODE = 1, CW_BAR = 4096;

constexpr int RING_OFF = 0, RING_BYTES = 131072;
constexpr int LDSCTL_OFF = RING_BYTES, MISC_OFF = LDSCTL_OFF + 320;
constexpr int LDS_BYTES = 147456;
typedef float f32x2v __attribute__((ext_vector_type(2)));
__device__ __forceinline__ float wave_sum(float v) {
#pragma unroll
    for (int o = 1; o < 64; o <<= 1) v += __shfl_xor(v, o);
    return v;
}
__device__ __forceinline__ float wave_max(float v) {
#pragma unroll
    for (int o = 1; o < 64; o <<= 1) v = fmaxf(v, __shfl_xor(v, o));
    return v;
}
__device__ __forceinline__ unsigned pkbf(float lo, float hi) { return pg8::cvt_pk_bf16(lo, hi); }
struct RmId { __device__ __forceinline__ int operator()(int n0) const { return n0; } };
struct RmGate { int add; __device__ __forceinline__ int operator()(int n0) const { return (n0 >> 7) * 256 + (n0 & 127) + add; } };
template <class RM> __device__ __forceinline__ void conv_T(const float* __restrict__ W, int K, int N, bf16* WT, int ldt, RM rm, LAS float* scr, int gw, int NGW, int lane) {
    const int nblk = N / 32, nitems = (K / 64) * nblk;
    for (int item = gw; item < nitems; item += NGW) {
        const int kb = item / nblk, nb = item - kb * nblk, k0 = 64 * kb, n0 = 32 * nb;
#pragma unroll 8
        for (int i = 0; i < 32; ++i) { const int kk = 2 * i + (lane >> 5); scr[kk * 33 + (lane & 31)] = W[(size_t)(k0 + kk) * N + n0 + (lane & 31)]; }
        LDS_WAIT(); asm volatile("" ::: "memory");
        const int c = lane & 7, drow0 = rm(n0);
#pragma unroll
        for (int j = 0; j < 4; ++j) { const int n = (lane >> 3) + 8 * j; const LAS float* s = scr + (8 * c) * 33 + n;
            v4u o; o.x = pkbf(s[0 * 33], s[1 * 33]); o.y = pkbf(s[2 * 33], s[3 * 33]); o.z = pkbf(s[4 * 33], s[5 * 33]); o.w = pkbf(s[6 * 33], s[7 * 33]);
            *(GAS v4u*)(WT + (size_t)(drow0 + n) * ldt + k0 + 8 * c) = o; }
        LDS_WAIT(); asm volatile("" ::: "memory");
    }
}
__device__ __forceinline__ void conv_copy(const float* __restrict__ W, bf16* O, size_t n, int gw, int NGW, int lane) {
    for (size_t i = ((size_t)gw * 64 + lane) * 8; i < n; i += (size_t)NGW * 64 * 8) {
        const f32x4 a = *(const GAS f32x4*)(W + i), b = *(const GAS f32x4*)(W + i + 4);
        v4u o; o.x = pkbf(a[0], a[1]); o.y = pkbf(a[2], a[3]); o.z = pkbf(b[0], b[1]); o.w = pkbf(b[2], b[3]);
        *(GAS v4u*)(O + i) = o; }
}
__device__ __forceinline__ void ln_rows(const float* __restrict__ Y, const float* __restrict__ g, const float* __restrict__ b, float* X32, bf16* XB, int gw, int NGW, int lane) {
    f32x4 gg[8], bb[8];
#pragma unroll
    for (int j = 0; j < 8; ++j) { gg[j] = *(const GAS f32x4*)(g + 4 * lane + 256 * j); bb[j] = *(const GAS f32x4*)(b + 4 * lane + 256 * j); }
    for (int m = gw; m < MT; m += NGW) {
        const GAS f32x4* yr = (const GAS f32x4*)(Y + (size_t)m * DMODEL) + lane;
        f32x4 v[8]; float s = 0.f;
#pragma unroll
        for (int j = 0; j < 8; ++j) { v[j] = yr[64 * j]; s += (v[j][0] + v[j][1]) + (v[j][2] + v[j][3]); }
        const float mean = wave_sum(s) * (1.f / DMODEL); float s2 = 0.f;
#pragma unroll
        for (int j = 0; j < 8; ++j) { v[j] = v[j] - mean; s2 += (v[j][0] * v[j][0] + v[j][1] * v[j][1]) + (v[j][2] * v[j][2] + v[j][3] * v[j][3]); }
        const float rstd = 1.f / sqrtf(wave_sum(s2) * (1.f / DMODEL) + LN_EPS);
        GAS f32x4* xo = (GAS f32x4*)(X32 + (size_t)m * DMODEL) + lane;
        GAS unsigned long long* o8 = (GAS unsigned long long*)(XB + (size_t)m * DMODEL) + lane;
#pragma unroll
        for (int j = 0; j < 8; ++j) { const f32x4 o = v[j] * rstd * gg[j] + bb[j]; xo[64 * j] = o;
            o8[64 * j] = (unsigned long long)pkbf(o[0], o[1]) | ((unsigned long long)pkbf(o[2], o[3]) << 32); }
    }
}
__device__ __forceinline__ void softmax_rows(const float* __restrict__ SC, bf16* PB, int gw, int NGW, int lane) {
    for (int m = gw; m < MT; m += NGW) {
        const GAS f32x4* sr = (const GAS f32x4*)(SC + (size_t)m * 1024) + lane;
        GAS unsigned long long* o8 = (GAS unsigned long long*)(PB + (size_t)m * 1024) + lane;
        f32x4 v[4];
#pragma unroll
        for (int j = 0; j < 4; ++j) v[j] = sr[64 * j];
#pragma unroll
        for (int j = 0; j < 4; ++j) {
            const float mx = wave_max(fmaxf(fmaxf(v[j][0], v[j][1]), fmaxf(v[j][2], v[j][3])));
            f32x4 e;
#pragma unroll
            for (int k = 0; k < 4; ++k) e[k] = __builtin_amdgcn_exp2f((v[j][k] - mx) * 1.4426950408889634f);
            const float inv = 1.0f / wave_sum((e[0] + e[1]) + (e[2] + e[3]));
            o8[64 * j] = (unsigned long long)pkbf(e[0] * inv, e[1] * inv) | ((unsigned long long)pkbf(e[2] * inv, e[3] * inv) << 32);
        }
    }
}
__device__ __forceinline__ void diff_combine(const bf16* __restrict__ OV, bf16* MIX, const float* lq1, const float* lk1, const float* lq2, const float* lk2, const float* ng, float lam_init, int gw, int NGW, int lane) {
    const float s1 = wave_sum(lq1[lane] * lk1[lane]), s2 = wave_sum(lq2[lane] * lk2[lane]);
    const float lam = expf(s1) - expf(s2) + lam_init, osc = 1.0f - lam_init;
    const int h = lane >> 3, d0 = (lane & 7) * 16;
    float gn[16];
#pragma unroll
    for (int e = 0; e < 16; ++e) gn[e] = ng[d0 + e] * osc;
    for (int m = gw; m < MT; m += NGW) {
        const bf16* o1 = OV + (size_t)m * 2048 + h * 256 + d0;
        const v4u a0 = *(const GAS v4u*)o1, a1 = *(const GAS v4u*)(o1 + 8), b0 = *(const GAS v4u*)(o1 + 128), b1 = *(const GAS v4u*)(o1 + 136);
        float x[16];
#pragma unroll
        for (int k = 0; k < 4; ++k) { x[2 * k] = pg8::bf_lo(a0[k]) - lam * pg8::bf_lo(b0[k]); x[2 * k + 1] = pg8::bf_hi(a0[k]) - lam * pg8::bf_hi(b0[k]);
            x[8 + 2 * k] = pg8::bf_lo(a1[k]) - lam * pg8::bf_lo(b1[k]); x[8 + 2 * k + 1] = pg8::bf_hi(a1[k]) - lam * pg8::bf_hi(b1[k]); }
        float ss = 0.f;
#pragma unroll
        for (int e = 0; e < 16; ++e) ss += x[e] * x[e];
        ss += __shfl_xor(ss, 1); ss += __shfl_xor(ss, 2); ss += __shfl_xor(ss, 4);
        const float r = 1.0f / sqrtf(ss * (1.0f / 128.0f) + RMS_EPS);
        v4u w0, w1;
#pragma unroll
        for (int k = 0; k < 4; ++k) { w0[k] = pkbf(x[2 * k] * r * gn[2 * k], x[2 * k + 1] * r * gn[2 * k + 1]); w1[k] = pkbf(x[8 + 2 * k] * r * gn[8 + 2 * k], x[8 + 2 * k + 1] * r * gn[8 + 2 * k + 1]); }
        bf16* op = MIX + (size_t)m * 2048 + h * 128 + d0;
        *(GAS v4u*)op = w0; *(GAS v4u*)(op + 8) = w1;
    }
}
__device__ __forceinline__ void cpow(float rez, float imz, int tau, float& re, float& im) {
    double rev = (double)imz * (double)tau * 0.15915494309189535; rev -= __builtin_rint(rev);
    const float mg = __builtin_amdgcn_exp2f(rez * (float)tau * 1.4426950408889634f), rv = (float)rev;
    re = mg * __builtin_amdgcn_cosf(rv); im = mg * __builtin_amdgcn_sinf(rv);
}
__device__ __forceinline__ void ssm_prep(const float* lam_re, const float* lam_im, const float* log_step, const float* b_re, const float* b_im, const float* c_re, const float* c_im,
                                         bf16* TG, bf16* EM, LAS unsigned char* lds, int vcu, int G, int tid) {
    LAS float* APre = (LAS float*)lds;
    LAS float* APim = APre + 65 * 64;
    LAS float* BBre = APim + 65 * 64;
    LAS float* BBim = BBre + 1024;
    LAS float* CCre = BBim + 1024;
    LAS float* CCim = CCre + 256;
    LAS float* KT = CCim + 256;
    for (int item = vcu; item < 256; item += G) {
        const int g = item >> 2, pb = item & 3;
        const float step = expf(log_step[g]);
        for (int e = tid; e < 65 * 64; e += NWAVES * 64) { const int tau = e >> 6, n = e & 63; const float lr = fminf(lam_re[g * 64 + n], -1e-4f), li = lam_im[g * 64 + n];
            float re, im; cpow(lr * step, li * step, tau, re, im); APre[e] = re; APim[e] = im; }
        for (int e = tid; e < 1024; e += NWAVES * 64) { const int n = e >> 4; const float lr = fminf(lam_re[g * 64 + n], -1e-4f), li = lam_im[g * 64 + n];
            float ar, ai; cpow(lr * step, li * step, 1, ar, ai);
            const float x = ar - 1.0f, y = ai, den = 1.0f / (lr * lr + li * li);
            const float cr = (x * lr + y * li) * den, ci = (y * lr - x * li) * den;
            const float br = b_re[(size_t)g * 1024 + e], bi = b_im[(size_t)g * 1024 + e];
            BBre[e] = cr * br - ci * bi; BBim[e] = cr * bi + ci * br; }
        for (int e = tid; e < 256; e += NWAVES * 64) { const int pl = e >> 6, n = e & 63; CCre[e] = c_re[(size_t)(g * 16 + 4 * pb + pl) * 64 + n]; CCim[e] = c_im[(size_t)(g * 16 + 4 * pb + pl) * 64 + n]; }
        __syncthreads();
        { const int pq = tid & 63, pl = pq >> 4, q = pq & 15, tb = tid >> 6; float acc[8];
#pragma unroll
          for (int k = 0; k < 8; ++k) acc[k] = 0.f;
          for (int n = 0; n < 64; ++n) { const float cr = CCre[pl * 64 + n], ci = CCim[pl * 64 + n], br = BBre[n * 16 + q], bi = BBim[n * 16 + q];
              const float cbr = cr * br - ci * bi, cbi = cr * bi + ci * br;
#pragma unroll
              for (int k = 0; k < 8; ++k) acc[k] += cbr * APre[(tb * 8 + k) * 64 + n] - cbi * APim[(tb * 8 + k) * 64 + n]; }
#pragma unroll
          for (int k = 0; k < 8; ++k) KT[(tb * 8 + k) * 64 + pq] = acc[k]; }
        __syncthreads();
        for (int idx = tid; idx < 256 * 144; idx += NWAVES * 64) {
            const int rowl = idx / 144, ch = idx - rowl * 144, t = rowl >> 2, pl = rowl & 3; float v[8];
            if (ch < 128) { const int s = ch >> 1, q0 = (ch & 1) * 8;
#pragma unroll
                for (int e = 0; e < 8; ++e) v[e] = (s <= t) ? KT[(t - s) * 64 + pl * 16 + q0 + e] : 0.f;
            } else { const int n0 = (ch - 128) * 8;
#pragma unroll
                for (int e = 0; e < 8; ++e) { const int n = (n0 + e) & 63; const float cr = CCre[pl * 64 + n], ci = CCim[pl * 64 + n], pr = APre[(t + 1) * 64 + n], pi = APim[(t + 1) * 64 + n];
                    v[e] = (n0 < 64) ? (cr * pr - ci * pi) : -(cr * pi + ci * pr); } }
            v4u o; o.x = pkbf(v[0], v[1]); o.y = pkbf(v[2], v[3]); o.z = pkbf(v[4], v[5]); o.w = pkbf(v[6], v[7]);
            *(GAS v4u*)(TG + (size_t)(g * 1024 + t * 16 + 4 * pb + pl) * UGP + ch * 8) = o;
        }
        for (int idx = tid; idx < 32 * 128; idx += NWAVES * 64) {
            const int rl = idx >> 7, ch = idx & 127, part = rl >> 4, n = 16 * pb + (rl & 15), s = ch >> 1, q0 = (ch & 1) * 8; float v[8];
            const float pr = APre[(63 - s) * 64 + n], pi = APim[(63 - s) * 64 + n];
#pragma unroll
            for (int e = 0; e < 8; ++e) { const float br = BBre[n * 16 + q0 + e], bi = BBim[n * 16 + q0 + e]; v[e] = part ? (pr * bi + pi * br) : (pr * br - pi * bi); }
            v4u o; o.x = pkbf(v[0], v[1]); o.y = pkbf(v[2], v[3]); o.z = pkbf(v[4], v[5]); o.w = pkbf(v[6], v[7]);
            *(GAS v4u*)(EM + (size_t)(g * 128 + part * 64 + n) * 1024 + ch * 8) = o;
        }
        __syncthreads();
    }
}
__device__ __forceinline__ void ssm_scan(const float* lam_re, const float* lam_im, const float* log_step, const float* VS, bf16* UG, int gb, int lane) {
    const int g = gb >> 1, b = gb & 1, n = lane;
    const float step = expf(log_step[g]), lr = fminf(lam_re[g * 64 + n], -1e-4f), li = lam_im[g * 64 + n];
    float ar, ai; cpow(lr * step, li * step, 64, ar, ai);
    const float* vs = VS + (size_t)(g * 512 + b * 256) * 128 + n; bf16* ug = UG + (size_t)(g * 512 + b * 256) * UGP + 1024 + n;
    float hr = 0.f, hi = 0.f;
    for (int c0 = 0; c0 < 256; c0 += 16) {
        float vr[16], vi[16];
#pragma unroll
        for (int k = 0; k < 16; ++k) { vr[k] = vs[(size_t)(c0 + k) * 128]; vi[k] = vs[(size_t)(c0 + k) * 128 + 64]; }
#pragma unroll
        for (int k = 0; k < 16; ++k) { const unsigned w = pkbf(hr, hi); ug[(size_t)(c0 + k) * UGP] = (bf16)(w & 0xffffu); ug[(size_t)(c0 + k) * UGP + 64] = (bf16)(w >> 16);
            const float nr = ar * hr - ai * hi + vr[k], ni = ar * hi + ai * hr + vi[k]; hr = nr; hi = ni; }
    }
}

struct MapSsmV   { __device__ __forceinline__ void operator()(pg8::Unit& u) const { u.aoff = u.pm * 256 * UGP; u.boff = (u.pm >> 1) * 128 * 1024; } };
struct MapSsmY   { __device__ __forceinline__ void operator()(pg8::Unit& u) const { u.aoff = u.pm * 256 * UGP; u.boff = ((u.pm >> 1) * 1024 + u.pn * 256) * UGP; } };
struct MapMQT    { __device__ __forceinline__ void operator()(pg8::Unit& u) const { const int b = u.pm >> 2, h = u.pm & 3; u.aoff = b * 256 * 4096 + h * 512; u.boff = u.pn * 256 * 2048 + h * 512; } };
struct MapVWOT   { __device__ __forceinline__ void operator()(pg8::Unit& u) const { const int b = u.pm >> 3, nt = u.pm & 7, h = u.pn; u.aoff = nt * 256 * 2048 + h * 512; u.boff = b * 256 * 4096 + 2048 + h * 512; } };
struct MapScores { __device__ __forceinline__ void operator()(pg8::Unit& u) const { u.aoff = u.pm * 256 * 2048; u.boff = ((u.pm >> 6) * 1024 + u.pn * 256) * 2048; } };
struct MapOut    { __device__ __forceinline__ void operator()(pg8::Unit& u) const { u.aoff = u.pm * 256 * 1024; u.boff = ((u.pm >> 6) * 2048 + u.pn * 256) * 1024; } };

struct Args { const float* in[NIN]; float* out; unsigned char* ws; };
#ifndef PHMASK
#define PHMASK 0xFFFFFFFFu
#endif
#define PH(k) ((PHMASK >> (k)) & 1u)
#define GEMM_PHASE(EPI, ORD, g, S, E) pg8::gemm_phase<EPI, ORD, true, true>(ldsl + RING_OFF, g, S, E)
typedef __attribute__((address_space(4))) const unsigned char* kargp_t;
__device__ __forceinline__ kargp_t kargs() { kargp_t p = (kargp_t)__builtin_amdgcn_kernarg_segment_ptr(); asm volatile("" : "+s"(p)); return p; }
#define INP(i) (*(const float* const __attribute__((address_space(4)))*)(kargs() + 8 * (i)))
#define P_X32 (*(float* const __attribute__((address_space(4)))*)(kargs() + 8 * NIN))
#define WSP (*(unsigned char* const __attribute__((address_space(4)))*)(kargs() + 8 * (NIN + 1)))
#define P_XB ((bf16*)(WSP + WS_XB))
#define P_YPRE ((float*)(WSP + WS_YPRE))
#define P_HMID ((bf16*)(WSP + WS_HMID))
#define P_QKV ((bf16*)(WSP + WS_QKV))
#define P_UG ((bf16*)(WSP + WS_UG))
#define P_OV ((bf16*)(WSP + WS_OV))
#define P_SC ((float*)(WSP + WS_SC))
#define P_PB ((bf16*)(WSP + WS_PB))
#define P_MIX ((bf16*)(WSP + WS_MIX))
#define P_YG ((bf16*)(WSP + WS_YG))
#define P_VS ((float*)(WSP + WS_VS))
#define P_W1GU ((bf16*)(WSP + WS_W1GU))
#define P_W1D ((bf16*)(WSP + WS_W1D))
#define P_W2GU ((bf16*)(WSP + WS_W2GU))
#define P_W2D ((bf16*)(WSP + WS_W2D))
#define P_WIN ((bf16*)(WSP + WS_WIN))
#define P_WGLU ((bf16*)(WSP + WS_WGLU))
#define P_WOUT ((bf16*)(WSP + WS_WOUT))
#define P_WQN ((bf16*)(WSP + WS_WQN))
#define P_WKVT ((bf16*)(WSP + WS_WKVT))
#define P_WOT ((bf16*)(WSP + WS_WOT))
#define P_TG ((bf16*)(WSP + WS_TG))
#define P_EM ((bf16*)(WSP + WS_EM))
#define P_MEMB ((bf16*)(WSP + WS_MEMB))
#define P_KVM ((bf16*)(WSP + WS_KVM))
#define P_MQT ((bf16*)(WSP + WS_MQT))
#define P_VWOT ((bf16*)(WSP + WS_VWOT))
__global__ void __launch_bounds__(NWAVES * 64, 2) fwd_kernel(Args args) {
    extern __shared__ __attribute__((aligned(16))) unsigned char lds[];
    LAS unsigned char* ldsl = (LAS unsigned char*)lds;
    volatile LAS unsigned* MISC = (volatile LAS unsigned*)(ldsl + MISC_OFF);
#define IDS() const int tid = pg8::otid(), lane = tid & 63, wave = __builtin_amdgcn_readfirstlane(tid >> 6); const int G = pg8::osgpr((int)gridDim.x), bx = pg8::osgpr((int)blockIdx.x), \
        vcu = (G % 8 == 0) ? (bx % 8) * (G / 8) + bx / 8 : bx, gw = vcu * NWAVES + wave, NGW = G * NWAVES; LAS float* scr = (LAS float*)(ldsl + RING_OFF + wave * 16384); \
        (void)lane; (void)gw; (void)NGW; (void)scr; (void)vcu
    { const int tid0 = threadIdx.x;
      for (int u = tid0; u < (LDS_BYTES - LDSCTL_OFF) / 4; u += NWAVES * 64) ((LAS unsigned*)(ldsl + LDSCTL_OFF))[u] = 0u; }
    __syncthreads();
    XcdBarrier bar = xcd_barrier_post((unsigned*)((gu32*)(WSP + WS_CTL) + CW_BAR), MISC + 8);
#define GRID_BAR() xcd_barrier(bar)

#define CONVERT_LAYER(L) do { const int L_ = (L); IDS(); \
        conv_T(INP(I_F1G) + (size_t)L_ * DMODEL * FF, DMODEL, FF, P_W1GU, DMODEL, RmGate{0}, scr, gw, NGW, lane); \
        conv_T(INP(I_F1U) + (size_t)L_ * DMODEL * FF, DMODEL, FF, P_W1GU, DMODEL, RmGate{128}, scr, gw, NGW, lane); \
        conv_T(INP(I_F1D) + (size_t)L_ * DMODEL * FF, FF, DMODEL, P_W1D, FF, RmId{}, scr, gw, NGW, lane); \
        conv_T(INP(I_F2G) + (size_t)L_ * DMODEL * FF, DMODEL, FF, P_W2GU, DMODEL, RmGate{0}, scr, gw, NGW, lane); \
        conv_T(INP(I_F2U) + (size_t)L_ * DMODEL * FF, DMODEL, FF, P_W2GU, DMODEL, RmGate{128}, scr, gw, NGW, lane); \
        conv_T(INP(I_F2D) + (size_t)L_ * DMODEL * FF, FF, DMODEL, P_W2D, FF, RmId{}, scr, gw, NGW, lane); \
        conv_T(INP(I_WIN) + (size_t)L_ * DMODEL * INW, DMODEL, INW, P_WIN, DMODEL, RmId{}, scr, gw, NGW, lane); \
        conv_T(INP(I_GLUW) + (size_t)L_ * 1024 * 1024, 1024, 1024, P_WGLU, 1024, RmId{}, scr, gw, NGW, lane); \
        conv_T(INP(I_WOUT) + (size_t)L_ * DMODEL * DMODEL, DMODEL, DMODEL, P_WOUT, DMODEL, RmId{}, scr, gw, NGW, lane); \
        conv_copy(INP(I_XQ) + (size_t)L_ * DMODEL * DMODEL, P_WQN, (size_t)DMODEL * DMODEL, gw, NGW, lane); \
        conv_T(INP(I_XK) + (size_t)L_ * DMODEL * DMODEL, DMODEL, DMODEL, P_WKVT, DMODEL, RmId{}, scr, gw, NGW, lane); \
        conv_T(INP(I_XV) + (size_t)L_ * DMODEL * DMODEL, DMODEL, DMODEL, P_WKVT + (size_t)DMODEL * DMODEL, DMODEL, RmId{}, scr, gw, NGW, lane); \
        conv_T(INP(I_XO) + (size_t)L_ * DMODEL * DMODEL, DMODEL, DMODEL, P_WOT, DMODEL, RmId{}, scr, gw, NGW, lane); \
        __syncthreads(); \
        ssm_prep(INP(I_SLRE) + L_ * 4096, INP(I_SLIM) + L_ * 4096, INP(I_SLOG) + L_ * 64, INP(I_SBRE) + (size_t)L_ * 65536, INP(I_SBIM) + (size_t)L_ * 65536, \
                 INP(I_SCRE) + (size_t)L_ * 65536, INP(I_SCIM) + (size_t)L_ * 65536, P_TG, P_EM, ldsl + RING_OFF, vcu, G, tid); \
    } while (0)

    { IDS(); conv_copy(INP(I_X), P_XB, (size_t)MT * DMODEL, gw, NGW, lane);
      conv_copy(INP(I_MEM), P_MEMB, (size_t)NBATCH * NMEM * DMODEL, gw, NGW, lane); }
    CONVERT_LAYER(0);
    GRID_BAR();

#pragma unroll 1
    for (int l = 0; l < DEPTH; ++l) {
        if (PH(1)) { IDS();
        { pg8::Gemm g{P_XB, P_W1GU, DMODEL, DMODEL, DMODEL}; pg8::Order<pg8::MapStd> S; S.init(MT / 256, 2 * FF / 256, G, bx, pg8::MapStd{DMODEL, DMODEL});
          pg8::EpiSwiGLU E{P_HMID, FF}; GEMM_PHASE(pg8::EpiSwiGLU, pg8::Order<pg8::MapStd>, g, S, E); }
        }
        GRID_BAR();
        if (PH(2)) { IDS();
        { pg8::Gemm g{P_HMID, P_W1D, FF, FF, FF}; pg8::Order<pg8::MapStd> S; S.init(MT / 256, DMODEL / 256, G, bx, pg8::MapStd{FF, FF});
          pg8::EpiResF32 E{(l == 0) ? INP(I_X) : (const float*)P_X32, P_YPRE, DMODEL, ALPHA, 0.5f}; GEMM_PHASE(pg8::EpiResF32, pg8::Order<pg8::MapStd>, g, S, E); }
        }
        GRID_BAR();
        if (PH(3)) { IDS();
        ln_rows(P_YPRE, INP(I_LN1G) + l * DMODEL, INP(I_LN1B) + l * DMODEL, P_X32, P_XB, gw, NGW, lane);
        }
        GRID_BAR();
        if (PH(4)) { IDS();
        { pg8::Gemm g{P_XB, P_WIN, DMODEL, DMODEL, DMODEL}; pg8::Order<pg8::MapStd> S; S.init(MT / 256, INW / 256, G, bx, pg8::MapStd{DMODEL, DMODEL});
          pg8::EpiWin<UGP> E{P_QKV, P_UG, attn_body::C2}; GEMM_PHASE(pg8::EpiWin<UGP>, pg8::Order<pg8::MapStd>, g, S, E); }
        }
        GRID_BAR();
        if (PH(5)) { IDS();
        { pg8::Gemm g{P_UG, P_EM, UGP, 1024, 1024}; pg8::Order<MapSsmV> S; S.init(128, 1, G, bx, MapSsmV{});
          pg8::EpiF32<1> E{P_VS, 128}; GEMM_PHASE(pg8::EpiF32<1>, pg8::Order<MapSsmV>, g, S, E); }
        { pg8::Gemm g{P_MEMB, P_WKVT, DMODEL, DMODEL, DMODEL}; pg8::Order<pg8::MapStd> S; S.init(2, 16, G, bx - 128, pg8::MapStd{DMODEL, DMODEL});
          pg8::EpiBf16 E{P_KVM, 4096, 1.0f}; GEMM_PHASE(pg8::EpiBf16, pg8::Order<pg8::MapStd>, g, S, E); }
        }
        GRID_BAR();
        if (PH(6)) { IDS();
        if (wave == 0 && bx < 128) ssm_scan(INP(I_SLRE) + l * 4096, INP(I_SLIM) + l * 4096, INP(I_SLOG) + l * 64, P_VS, P_UG, bx, lane);
        { const attn_body::AttnTensors AT{(const attn_body::bf16*)P_QKV, (attn_body::bf16*)P_OV};
          const attn_body::StaticOrder S((int)G, (int)bx);
          attn_body::attn_phase<attn_body::StaticOrder>((char*)lds + RING_OFF, AT, S); }
        }
        GRID_BAR();
        if (PH(7)) { IDS();
        diff_combine(P_OV, P_MIX, INP(I_LQ1) + l * 64, INP(I_LK1) + l * 64, INP(I_LQ2) + l * 64, INP(I_LK2) + l * 64, INP(I_DNG) + l * 128, 0.8f - 0.6f * expf(-0.3f * (float)l), gw, NGW, lane);
        __syncthreads();
        { pg8::Gemm g{P_UG, P_TG, UGP, UGP, UGP}; pg8::Order<MapSsmY> S; S.init(128, 4, G, bx, MapSsmY{});
          pg8::EpiSsmY<UGP> E{P_UG, INP(I_SD) + l * 1024, P_YG}; GEMM_PHASE(pg8::EpiSsmY<UGP>, pg8::Order<MapSsmY>, g, S, E); }
        { pg8::Gemm g{P_KVM, P_WQN, 4096, DMODEL, 512}; pg8::Order<MapMQT> S; S.init(8, 8, G, bx, MapMQT{});
          pg8::EpiBf16 E{P_MQT, DMODEL, 0.044194173824159216f}; GEMM_PHASE(pg8::EpiBf16, pg8::Order<MapMQT>, g, S, E); }
        { pg8::Gemm g{P_WOT, P_KVM, DMODEL, 4096, 512}; pg8::Order<MapVWOT> S; S.init(16, 4, G, bx - 64, MapVWOT{});
          pg8::EpiBf16 E{P_VWOT, 1024, 1.0f}; GEMM_PHASE(pg8::EpiBf16, pg8::Order<MapVWOT>, g, S, E); }
        }
        GRID_BAR();
        if (PH(8)) { IDS();
        { pg8::Gemm g{P_YG, P_WGLU, 1024, 1024, 1024}; pg8::Order<pg8::MapStd> S; S.init(MT / 256, 4, G, bx, pg8::MapStd{1024, 1024});
          pg8::EpiGlu E{P_YG, INP(I_GLUB) + l * 1024, P_MIX}; GEMM_PHASE(pg8::EpiGlu, pg8::Order<pg8::MapStd>, g, S, E); }
        }
        GRID_BAR();
        if (PH(9)) { IDS();
        { pg8::Gemm g{P_MIX, P_WOUT, DMODEL, DMODEL, DMODEL}; pg8::Order<pg8::MapStd> S; S.init(MT / 256, DMODEL / 256, G, bx, pg8::MapStd{DMODEL, DMODEL});
          pg8::EpiResF32 E{P_X32, P_YPRE, DMODEL, ALPHA, 1.0f}; GEMM_PHASE(pg8::EpiResF32, pg8::Order<pg8::MapStd>, g, S, E); }
        }
        GRID_BAR();
        if (PH(10)) { IDS();
        ln_rows(P_YPRE, INP(I_LN2G) + l * DMODEL, INP(I_LN2B) + l * DMODEL, P_X32, P_XB, gw, NGW, lane);
        }
        GRID_BAR();
        if (PH(11)) { IDS();
        { pg8::Gemm g{P_XB, P_MQT, DMODEL, DMODEL, DMODEL}; pg8::Order<MapScores> S; S.init(MT / 256, 4, G, bx, MapScores{});
          pg8::EpiF32<2> E{P_SC, 1024}; GEMM_PHASE(pg8::EpiF32<2>, pg8::Order<MapScores>, g, S, E); }
        }
        GRID_BAR();
        if (PH(12)) { IDS();
        softmax_rows(P_SC, P_PB, gw, NGW, lane);
        }
        GRID_BAR();
        if (PH(13)) { IDS();
        { pg8::Gemm g{P_PB, P_VWOT, 1024, 1024, 1024}; pg8::Order<MapOut> S; S.init(MT / 256, DMODEL / 256, G, bx, MapOut{});
          pg8::EpiResF32 E{P_X32, P_YPRE, DMODEL, ALPHA, 1.0f}; GEMM_PHASE(pg8::EpiResF32, pg8::Order<MapOut>, g, S, E); }
        }
        GRID_BAR();
        if (PH(14)) { IDS();
        ln_rows(P_YPRE, INP(I_LN3G) + l * DMODEL, INP(I_LN3B) + l * DMODEL, P_X32, P_XB, gw, NGW, lane);
        }
        GRID_BAR();
        if (PH(15)) { IDS();
        { pg8::Gemm g{P_XB, P_W2GU, DMODEL, DMODEL, DMODEL}; pg8::Order<pg8::MapStd> S; S.init(MT / 256, 2 * FF / 256, G, bx, pg8::MapStd{DMODEL, DMODEL});
          pg8::EpiSwiGLU E{P_HMID, FF}; GEMM_PHASE(pg8::EpiSwiGLU, pg8::Order<pg8::MapStd>, g, S, E); }
        }
        GRID_BAR();
        if (PH(16)) { IDS();
        { pg8::Gemm g{P_HMID, P_W2D, FF, FF, FF}; pg8::Order<pg8::MapStd> S; S.init(MT / 256, DMODEL / 256, G, bx, pg8::MapStd{FF, FF});
          pg8::EpiResF32 E{P_X32, P_YPRE, DMODEL, ALPHA, 0.5f}; GEMM_PHASE(pg8::EpiResF32, pg8::Order<pg8::MapStd>, g, S, E); }
        }
        GRID_BAR();
        if (PH(17)) { IDS();
        ln_rows(P_YPRE, INP(I_LN4G) + l * DMODEL, INP(I_LN4B) + l * DMODEL, P_X32, P_XB, gw, NGW, lane);
        }
        if (l + 1 < DEPTH) { CONVERT_LAYER(l + 1); GRID_BAR(); }
    }
}

extern "C" void kernel_launch(void* const* d_in, const int* in_sizes, int n_in, void* d_out, int out_size, void* d_ws, size_t ws_size, hipStream_t stream) {
    static int grid = 0;
    if (grid == 0) {
        if (n_in != NIN || in_sizes[0] != MT * DMODEL || out_size != MT * DMODEL || ws_size < WS_END) { fprintf(stderr, "kernel_launch: unexpected problem shape (n_in %d, in0 %d, out %d, ws %zu < %zu); nothing launched\n", n_in, n_in > 0 ? in_sizes[0] : -1, out_size, ws_size, (size_t)WS_END); grid = -1; return; }
        int dev = 0, cus = 0, per_cu = 0;
        if (hipGetDevice(&dev) != hipSuccess || hipDeviceGetAttribute(&cus, hipDeviceAttributeMultiprocessorCount, dev) != hipSuccess) { fprintf(stderr, "kernel_launch: device query failed\n"); grid = -1; return; }
        if (hipFuncSetAttribute((const void*)fwd_kernel, hipFuncAttributeMaxDynamicSharedMemorySize, LDS_BYTES) != hipSuccess) { fprintf(stderr, "kernel_launch: hipFuncSetAttribute failed\n"); grid = -1; return; }
        if (hipOccupancyMaxActiveBlocksPerMultiprocessor(&per_cu, (const void*)fwd_kernel, NWAVES * 64, LDS_BYTES) != hipSuccess || per_cu < 1)
            fprintf(stderr, "kernel_launch: note: occupancy query reports %d workgroups per CU\n", per_cu);
        (void)hipGetLastError();
        grid = cus;
    }
    if (grid < 0) return;
    if (hipMemsetAsync((char*)d_ws + WS_CTL, 0, CTL_ZERO_BYTES, stream) != hipSuccess) { fprintf(stderr, "kernel_launch: hipMemsetAsync failed\n"); return; }
    Args a{};
    for (int i = 0; i < NIN; ++i) a.in[i] = (const float*)d_in[i];
    a.out = (float*)d_out; a.ws = (unsigned char*)d_ws;
    hipLaunchKernelGGL(fwd_kernel, dim3(grid), dim3(NWAVES * 64), LDS_BYTES, stream, a);
    const hipError_t le = hipPeekAtLastError();
    if (le != hipSuccess) fprintf(stderr, "kernel_launch: launch failed: %s\n", hipGetErrorName(le));
}
```

```cpp
#pragma clang diagnostic ignored "-Winline-asm"
#include <hip/hip_runtime.h>
#include <hip/hip_bf16.h>
#include <cstdio>
#include <cstdint>
#include <cmath>
namespace pg8 {
#define PG8_LAS __attribute__((address_space(3)))
typedef unsigned short bf16_t;
typedef short bf16x8 __attribute__((ext_vector_type(8)));
typedef float f32x4 __attribute__((ext_vector_type(4)));
typedef float f32x2 __attribute__((ext_vector_type(2)));
typedef unsigned u32x4 __attribute__((ext_vector_type(4)));
constexpr int BM = 256, BK = 64, HALF = 128, HTB = HALF * BK * 2  , STAGE_BYTES = 8 * HTB, NXCD = 8, WGM = 8;

__host__ __device__ __forceinline__ int lds_byte(int r, int c) { const int st = (r >> 4) * 2 + (c >> 5), rr = r & 15, cc = c & 31, ob = rr * 64 + cc * 2; return st * 1024 + (ob ^ (((ob >> 9) & 1) << 5)); }
__host__ __device__ __forceinline__ void stage_rc(int b, int& R, int& C) { const int st = b / 1024, sb = b % 1024, swz = sb ^ (((sb >> 9) & 1) << 5); R = (st >> 1) * 16 + swz / 64; C = (st & 1) * 32 + (swz % 64) / 2; }
__host__ __device__ __forceinline__ int perm32(int rho) { const int n = rho >> 4, i = rho & 15; return 8 * (i >> 2) + 4 * n + (i & 3); }

struct Unit { int aoff, boff, pm, pn, nt; };
struct Gemm { const bf16_t* A; const bf16_t* Bt; int lda, ldb, K; };

template <class Map> struct Order {
    int nM, nN, nwg, G, c, wgm; Map map;
    __device__ __forceinline__ void init(int nM_, int nN_, int G_, int c_, const Map& m, int wgm_ = WGM) { nM = nM_; nN = nN_; nwg = nM * nN; G = G_; c = c_; map = m; wgm = wgm_; }
    __device__ __forceinline__ bool next(int i, Unit& u) const {
        const long L = (long)i * G + c; if (c < 0 || L >= nwg) return false;
        int wgid = (int)L; { const int q = nwg / NXCD, r = nwg % NXCD, xcd = wgid % NXCD, off = wgid / NXCD; wgid = (xcd < r ? xcd * (q + 1) : r * (q + 1) + (xcd - r) * q) + off; }
        const int nig = wgm * nN, gid = wgid / nig, fm = gid * wgm, gsz = (nM - fm) < wgm ? (nM - fm) : wgm;
        u.pm = fm + ((wgid % nig) % gsz); u.pn = (wgid % nig) / gsz; u.nt = 0; map(u); return true;
    }
    __device__ __forceinline__ void a_ready(const Unit&) const {}
    __device__ __forceinline__ void done(const Unit&) const {}
};
struct MapStd { int lda, ldb; __device__ __forceinline__ void operator()(Unit& u) const { u.aoff = u.pm * BM * lda; u.boff = u.pn * BM * ldb; } };

struct MapStdRev { int lda, ldb, nM; __device__ __forceinline__ void operator()(Unit& u) const { u.pm = nM - 1 - u.pm; u.aoff = u.pm * BM * lda; u.boff = u.pn * BM * ldb; } };

__device__ __forceinline__ unsigned cvt_pk_bf16(float lo, float hi) { unsigned r; asm volatile("v_cvt_pk_bf16_f32 %0, %1, %2" : "=v"(r) : "v"(lo), "v"(hi)); return r; }
__device__ __forceinline__ float bf_lo(unsigned w) { return __uint_as_float(w << 16); }
__device__ __forceinline__ float bf_hi(unsigned w) { return __uint_as_float(w & 0xffff0000u); }
__device__ __forceinline__ float sigmoid_f(float z) { return __builtin_amdgcn_rcpf(1.0f + __builtin_amdgcn_exp2f(-1.4426950408889634f * z)); }
__device__ __forceinline__ int otid() { int t = threadIdx.x; asm volatile("" : "+v"(t)); return t; }
__device__ __forceinline__ int osgpr(int v) { asm volatile("" : "+s"(v)); return v; }
template <int K> __device__ __forceinline__ float sw_xor(float v) { return __int_as_float(__builtin_amdgcn_ds_swizzle(__float_as_int(v), (K << 10) | 0x1f)); }
__device__ __forceinline__ float add_xor32(float v) { auto rr = __builtin_amdgcn_permlane32_swap(__float_as_uint(v), __float_as_uint(v), false, false); return __uint_as_float(rr[0]) + __uint_as_float(rr[1]); }
__device__ __forceinline__ float max_xor32(float v) { auto rr = __builtin_amdgcn_permlane32_swap(__float_as_uint(v), __float_as_uint(v), false, false); return fmaxf(__uint_as_float(rr[0]), __uint_as_float(rr[1])); }
__device__ __forceinline__ float red16_32(float v) { v += sw_xor<16>(v); return add_xor32(v); }
template <class T> __device__ __forceinline__ T* at32(const void* base, unsigned byte_off) { return (T*)((char*)const_cast<void*>(base) + byte_off); }
#define PG8_EPI_ARGS const f32x4 (&acc)[2][2][4][2], const Unit& u, int wr, int wc, int fr, int fq
__device__ __forceinline__ u32x4 pack8(const f32x4 v0, const f32x4 v1) { u32x4 w; w.x = cvt_pk_bf16(v0[0], v0[1]); w.y = cvt_pk_bf16(v0[2], v0[3]); w.z = cvt_pk_bf16(v1[0], v1[1]); w.w = cvt_pk_bf16(v1[2], v1[3]); return w; }


struct Fold { const float* stats; const float* cs; const float* cb; int ident; };
__device__ __forceinline__ void fold_row(const Fold& f, int r, float& mu, float& rs) {
    const f32x2 s = *(const f32x2*)(f.stats + 2 * (size_t)r); mu = s.x * (1.0f / 2048.0f); const float var = s.y * (1.0f / 2048.0f) - mu * mu; rs = __builtin_amdgcn_rsqf(var + 1e-5f);
}
__device__ __forceinline__ void fold_rows8(const Fold& f, int row0, float (&mu)[2][4], float (&rs)[2][4]) {
    f32x2 st[2][4];
#pragma unroll
    for (int ai = 0; ai < 2; ++ai)
#pragma unroll
        for (int m = 0; m < 4; ++m) st[ai][m] = *at32<const f32x2>(f.stats, 8u * (unsigned)(row0 + ai * HALF + m * 16));
#pragma unroll
    for (int ai = 0; ai < 2; ++ai)
#pragma unroll
        for (int m = 0; m < 4; ++m) { mu[ai][m] = st[ai][m].x * (1.0f / 2048.0f); rs[ai][m] = __builtin_amdgcn_rsqf(st[ai][m].y * (1.0f / 2048.0f) - mu[ai][m] * mu[ai][m] + 1e-5f); }
}
__device__ __forceinline__ f32x4 fold4(const f32x4 a, float mu, float rs, const f32x4 cs, const f32x4 cb) { return (a - cs * mu) * rs + cb; }

__device__ __forceinline__ void fold_prefetch(const Fold& f, const Unit& u, PG8_LAS unsigned char* pf) {
    const int tid = otid(), wid = __builtin_amdgcn_readfirstlane(tid >> 6), L = tid & 63, wr = wid >> 2, wc = wid & 3, q = (L >> 3) & 3;
    PG8_LAS unsigned char* slot = pf + wid * 2048;
    __builtin_amdgcn_global_load_lds((const unsigned*)(f.stats + 2 * (u.pm * BM + (L >> 5) * HALF + wr * 64 + (L & 31) * 2)), (PG8_LAS unsigned*)slot, 16, 0, 0);
    __builtin_amdgcn_global_load_lds((const unsigned*)(((q & 2) ? f.cb : f.cs) + u.pn * BM + (q & 1) * HALF + wc * 32 + (L & 7) * 4), (PG8_LAS unsigned*)(slot + 1024), 16, 0, 0);
}
__device__ __forceinline__ void fold_from_lds(PG8_LAS const unsigned char* pf, int wr, int wc, int fr, int fq, f32x4 (&cs)[2][2], f32x4 (&cb)[2][2], float (&mu)[2][4], float (&rs)[2][4]) {
    PG8_LAS const unsigned char* slot = pf + (wr * 4 + wc) * 2048;
    f32x2 st[2][4];
#pragma unroll
    for (int ai = 0; ai < 2; ++ai)
#pragma unroll
        for (int m = 0; m < 4; ++m) st[ai][m] = *(const PG8_LAS f32x2*)(slot + (ai * 64 + m * 16 + fr) * 8);
#pragma unroll
    for (int bj = 0; bj < 2; ++bj)
#pragma unroll
        for (int n = 0; n < 2; ++n) { cs[bj][n] = *(const PG8_LAS f32x4*)(slot + 1024 + (bj * 8 + 2 * fq + n) * 16); cb[bj][n] = *(const PG8_LAS f32x4*)(slot + 1024 + ((2 + bj) * 8 + 2 * fq + n) * 16); }
#pragma unroll
    for (int ai = 0; ai < 2; ++ai)
#pragma unroll
        for (int m = 0; m < 4; ++m) { mu[ai][m] = st[ai][m].x * (1.0f / 2048.0f); rs[ai][m] = __builtin_amdgcn_rsqf(st[ai][m].y * (1.0f / 2048.0f) - mu[ai][m] * mu[ai][m] + 1e-5f); }
}

struct EpiBf16 {
    static constexpr bool PERM = true, AFTER_DRAIN = false, PREF = false;
    bf16_t* O; int ldc; float scale;
    __device__ __forceinline__ void operator()(PG8_EPI_ARGS) const {
        const int row0 = u.pm * BM + wr * 64 + fr, col0 = u.pn * BM + wc * 32 + 8 * fq;
#pragma unroll
        for (int ai = 0; ai < 2; ++ai)
#pragma unroll
            for (int m = 0; m < 4; ++m) { const unsigned bo = 2u * (unsigned)((row0 + ai * HALF + m * 16) * ldc + col0);
#pragma unroll
                for (int bj = 0; bj < 2; ++bj) *at32<u32x4>(O, bo + 2u * bj * HALF) = pack8(acc[ai][bj][m][0] * scale, acc[ai][bj][m][1] * scale); }
    }
};
template <int NBJ> struct EpiF32 {
    static constexpr bool PERM = false, AFTER_DRAIN = false, PREF = false;
    float* O; int ldc;
    __device__ __forceinline__ void operator()(PG8_EPI_ARGS) const {
        const int row0 = u.pm * BM + wr * 64 + fr, col0 = u.pn * (NBJ == 2 ? BM : HALF) + wc * 32 + 4 * fq;
#pragma unroll
        for (int ai = 0; ai < 2; ++ai)
#pragma unroll
            for (int m = 0; m < 4; ++m) { float* rowp = O + (size_t)(row0 + ai * HALF + m * 16) * ldc + col0;
#pragma unroll
                for (int bj = 0; bj < NBJ; ++bj)
#pragma unroll
                    for (int n = 0; n < 2; ++n) *(f32x4*)(rowp + bj * HALF + n * 16) = acc[ai][bj][m][n]; }
    }
};

struct EpiScoresSm {
    static constexpr bool PERM = true, AFTER_DRAIN = false, PREF = false;
    bf16_t* PB; Fold f; PG8_LAS float* xch;
    __device__ __forceinline__ void operator()(PG8_EPI_ARGS) const {
        f32x4 (&s)[2][2][4][2] = const_cast<f32x4 (&)[2][2][4][2]>(acc);
        const int row0 = u.pm * BM + wr * 64 + fr, col0 = u.pn * BM + wc * 32 + 8 * fq, vb = (u.pm >> 6) * 1024, rl0 = wr * 64 + fr;
        { f32x4 cs[2][2], cb[2][2]; float mus[2][4], rss[2][4]; fold_rows8(f, row0, mus, rss);
#pragma unroll
          for (int bj = 0; bj < 2; ++bj)
#pragma unroll
            for (int n = 0; n < 2; ++n) { cs[bj][n] = *(const f32x4*)(f.cs + vb + col0 + bj * HALF + 4 * n); cb[bj][n] = *(const f32x4*)(f.cb + vb + col0 + bj * HALF + 4 * n); }
#pragma unroll
          for (int ai = 0; ai < 2; ++ai)
#pragma unroll
            for (int m = 0; m < 4; ++m) { const float mu = mus[ai][m], rs = rss[ai][m]; float mx = -3.0e38f;
#pragma unroll
                for (int bj = 0; bj < 2; ++bj)
#pragma unroll
                    for (int n = 0; n < 2; ++n) { const f32x4 v = fold4(s[ai][bj][m][n], mu, rs, cs[bj][n], cb[bj][n]) * 1.4426950408889634f; s[ai][bj][m][n] = v;
                        mx = fmaxf(fmaxf(mx, fmaxf(v[0], v[1])), fmaxf(v[2], v[3])); }
                mx = fmaxf(mx, sw_xor<16>(mx)); mx = max_xor32(mx);
                if (fq == 0) xch[(ai * HALF + m * 16 + rl0) * 4 + wc] = mx; } }
        asm volatile("s_waitcnt lgkmcnt(0)" ::: "memory"); __builtin_amdgcn_s_barrier(); asm volatile("" ::: "memory");
#pragma unroll
        for (int ai = 0; ai < 2; ++ai)
#pragma unroll
            for (int m = 0; m < 4; ++m) { const f32x4 q = *(const PG8_LAS f32x4*)(xch + (ai * HALF + m * 16 + rl0) * 4); const float M = fmaxf(fmaxf(q[0], q[1]), fmaxf(q[2], q[3])); float sm = 0.f;
#pragma unroll
                for (int bj = 0; bj < 2; ++bj)
#pragma unroll
                    for (int n = 0; n < 2; ++n) { f32x4 v = s[ai][bj][m][n];
#pragma unroll
                        for (int e = 0; e < 4; ++e) v[e] = __builtin_amdgcn_exp2f(v[e] - M);
                        s[ai][bj][m][n] = v; sm += (v[0] + v[1]) + (v[2] + v[3]); }
                sm = red16_32(sm);
                if (fq == 0) xch[1024 + (ai * HALF + m * 16 + rl0) * 4 + wc] = sm; }
        asm volatile("s_waitcnt lgkmcnt(0)" ::: "memory"); __builtin_amdgcn_s_barrier(); asm volatile("" ::: "memory");
#pragma unroll
        for (int ai = 0; ai < 2; ++ai)
#pragma unroll
            for (int m = 0; m < 4; ++m) { const f32x4 q = *(const PG8_LAS f32x4*)(xch + 1024 + (ai * HALF + m * 16 + rl0) * 4); const float inv = __builtin_amdgcn_rcpf((q[0] + q[1]) + (q[2] + q[3]));
                const unsigned bo = 2u * (unsigned)((row0 + ai * HALF + m * 16) * 1024 + col0);
#pragma unroll
                for (int bj = 0; bj < 2; ++bj) *at32<u32x4>(PB, bo + 2u * bj * HALF) = pack8(s[ai][bj][m][0] * inv, s[ai][bj][m][1] * inv); }
        asm volatile("s_waitcnt lgkmcnt(0)" ::: "memory");
    }
};
struct EpiSwiGLU {
    static constexpr bool PERM = true, AFTER_DRAIN = false, PREF = true;
    bf16_t* O; int ldc; Fold f; PG8_LAS unsigned char* pf;
    __device__ __forceinline__ void pref(const Unit& u) const { if (!f.ident) fold_prefetch(f, u, pf); }
    __device__ __forceinline__ void operator()(PG8_EPI_ARGS) const {
        const int row0 = u.pm * BM + wr * 64 + fr, col0 = u.pn * HALF + wc * 32 + 8 * fq;
        f32x4 cs[2][2], cb[2][2]; float mus[2][4], rss[2][4];
        if (!f.ident) {
            fold_from_lds(pf, wr, wc, fr, fq, cs, cb, mus, rss);
        } else {
#pragma unroll
            for (int ai = 0; ai < 2; ++ai)
#pragma unroll
                for (int m = 0; m < 4; ++m) { mus[ai][m] = 0.f; rss[ai][m] = 1.f; }
#pragma unroll
            for (int bj = 0; bj < 2; ++bj)
#pragma unroll
                for (int n = 0; n < 2; ++n) { cs[bj][n] = (f32x4){0.f, 0.f, 0.f, 0.f}; cb[bj][n] = (f32x4){0.f, 0.f, 0.f, 0.f}; }
        }
#pragma unroll
        for (int ai = 0; ai < 2; ++ai)
#pragma unroll
            for (int m = 0; m < 4; ++m) { const int r = row0 + ai * HALF + m * 16; f32x4 v[2]; const float mu = mus[ai][m], rs = rss[ai][m];
#pragma unroll
                for (int n = 0; n < 2; ++n) { f32x4 g = acc[ai][0][m][n], up = acc[ai][1][m][n];
                    g = fold4(g, mu, rs, cs[0][n], cb[0][n]); up = fold4(up, mu, rs, cs[1][n], cb[1][n]);
#pragma unroll
                    for (int e = 0; e < 4; ++e) v[n][e] = (g[e] * up[e]) * __builtin_amdgcn_rcpf(1.0f + __builtin_amdgcn_exp2f(-g[e])); }
                *at32<u32x4>(O, 2u * (unsigned)(r * ldc + col0)) = pack8(v[0], v[1]); }
    }
};
template <bool IDENT, bool WF32 = false, int SKIP = 0> struct EpiResLnT {
    static constexpr bool PERM = true, AFTER_DRAIN = false, PREF = false; static constexpr int RB = 4;
    const float* xin; const float* st_old; PG8_LAS const float* lgb; bf16_t* XB; u32x4* LO8; float* yf32; float* st_new; float alpha, scale;
    __device__ __forceinline__ void operator()(PG8_EPI_ARGS) const {
        const int row0 = u.pm * BM + wr * 64 + fr, col0 = u.pn * BM + wc * 32 + 8 * fq;
        PG8_LAS float* xst = const_cast<PG8_LAS float*>(lgb) + 4096;
        u32x4* lop = LO8 + ((size_t)((u.pm * 8 + u.pn) * 8 + wr * 4 + wc) * 8) * 64 + fq * 16 + fr;
#pragma unroll
        for (int ab = 0; ab < 8 / RB; ++ab) { const int ai = (ab * RB) >> 2, m0 = (ab * RB) & 3; float mu[RB], rs[RB], s1[RB], s2[RB]; u32x4 hi[RB][2], lo[RB];
            u32x4 xi[RB][2];
            { f32x2 st[RB];
              if (!IDENT) {
#pragma unroll
                for (int m = 0; m < RB; ++m) st[m] = *at32<const f32x2>(st_old, 8u * (unsigned)(row0 + ai * HALF + (m0 + m) * 16)); }
#pragma unroll
              for (int m = 0; m < RB; ++m) {
                if (!IDENT) lo[m] = (SKIP & 1) ? (u32x4){0u, 0u, 0u, 0u} : __builtin_nontemporal_load(lop + (ai * 4 + m0 + m) * 64);
#pragma unroll
                for (int bj = 0; bj < 2; ++bj) { const unsigned off = (unsigned)((row0 + ai * HALF + (m0 + m) * 16) * 2048 + col0 + bj * HALF);
                    if (IDENT) { hi[m][bj] = *at32<const u32x4>(xin, 4u * off); xi[m][bj] = *at32<const u32x4>(xin, 4u * off + 16u); }
                    else hi[m][bj] = (SKIP & 1) ? (u32x4){0u, 0u, 0u, 0u} : *at32<const u32x4>(XB, 2u * off); } }
              asm volatile("" ::: "memory");
#pragma unroll
              for (int m = 0; m < RB; ++m) { s1[m] = 0.f; s2[m] = 0.f; mu[m] = 0.f; rs[m] = 1.f;
                  if (!IDENT) { mu[m] = st[m].x * (1.0f / 2048.0f); rs[m] = __builtin_amdgcn_rsqf(st[m].y * (1.0f / 2048.0f) - mu[m] * mu[m] + 1e-5f); } } }
            u32x4 lon[RB];
#pragma unroll
            for (int bj = 0; bj < 2; ++bj) { f32x4 gg[2], bb[2];
                if (!IDENT) {
#pragma unroll
                    for (int n = 0; n < 2; ++n) { gg[n] = *(const PG8_LAS f32x4*)(lgb + col0 + bj * HALF + 4 * n); bb[n] = *(const PG8_LAS f32x4*)(lgb + 2048 + col0 + bj * HALF + 4 * n); } }
#pragma unroll
                for (int m = 0; m < RB; ++m) { const unsigned off = (unsigned)((row0 + ai * HALF + (m0 + m) * 16) * 2048 + col0 + bj * HALF); f32x4 v[2]; const u32x4 h0 = hi[m][bj];
                    if (IDENT) { const u32x4 l0 = xi[m][bj]; v[0] = (f32x4){__uint_as_float(h0.x), __uint_as_float(h0.y), __uint_as_float(h0.z), __uint_as_float(h0.w)}; v[1] = (f32x4){__uint_as_float(l0.x), __uint_as_float(l0.y), __uint_as_float(l0.z), __uint_as_float(l0.w)}; }
                    else { const unsigned w0 = bj ? lo[m].z : lo[m].x, w1 = bj ? lo[m].w : lo[m].y;
                           const f32x2 a0 = __builtin_amdgcn_cvt_pk_f32_fp8((int)w0, false), a1 = __builtin_amdgcn_cvt_pk_f32_fp8((int)w0, true), a2 = __builtin_amdgcn_cvt_pk_f32_fp8((int)w1, false), a3 = __builtin_amdgcn_cvt_pk_f32_fp8((int)w1, true);
                           v[0] = (f32x4){bf_lo(h0.x) + a0.x * 0.00390625f, bf_hi(h0.x) + a0.y * 0.00390625f, bf_lo(h0.y) + a1.x * 0.00390625f, bf_hi(h0.y) + a1.y * 0.00390625f};
                           v[1] = (f32x4){bf_lo(h0.z) + a2.x * 0.00390625f, bf_hi(h0.z) + a2.y * 0.00390625f, bf_lo(h0.w) + a3.x * 0.00390625f, bf_hi(h0.w) + a3.y * 0.00390625f}; }
#pragma unroll
                    for (int n = 0; n < 2; ++n) { f32x4 x = v[n];
                        if (!IDENT) x = (x - mu[m]) * rs[m] * gg[n] + bb[n];
                        v[n] = x * alpha + acc[ai][bj][m0 + m][n] * scale;
                        if (WF32) *at32<f32x4>(yf32, 4u * off + 16u * n) = v[n];
                        s1[m] += (v[n][0] + v[n][1]) + (v[n][2] + v[n][3]); s2[m] += (v[n][0] * v[n][0] + v[n][1] * v[n][1]) + (v[n][2] * v[n][2] + v[n][3] * v[n][3]); }
                    const u32x4 h = pack8(v[0], v[1]);
                    const f32x4 d0 = {(v[0][0] - bf_lo(h.x)) * 256.0f, (v[0][1] - bf_hi(h.x)) * 256.0f, (v[0][2] - bf_lo(h.y)) * 256.0f, (v[0][3] - bf_hi(h.y)) * 256.0f},
                                d1 = {(v[1][0] - bf_lo(h.z)) * 256.0f, (v[1][1] - bf_hi(h.z)) * 256.0f, (v[1][2] - bf_lo(h.w)) * 256.0f, (v[1][3] - bf_hi(h.w)) * 256.0f};
                    int e0 = __builtin_amdgcn_cvt_pk_fp8_f32(d0[0], d0[1], 0, false); e0 = __builtin_amdgcn_cvt_pk_fp8_f32(d0[2], d0[3], e0, true);
                    int e1 = __builtin_amdgcn_cvt_pk_fp8_f32(d1[0], d1[1], 0, false); e1 = __builtin_amdgcn_cvt_pk_fp8_f32(d1[2], d1[3], e1, true);
                    if (bj == 0) { lon[m].x = (unsigned)e0; lon[m].y = (unsigned)e1; } else { lon[m].z = (unsigned)e0; lon[m].w = (unsigned)e1; }
                    if (!(SKIP & 2)) *at32<u32x4>(XB, 2u * off) = h; } }
#pragma unroll
            for (int m = 0; m < RB; ++m) { if (!(SKIP & 2)) __builtin_nontemporal_store(lon[m], lop + (ai * 4 + m0 + m) * 64);
                const float a = red16_32(s1[m]), b = red16_32(s2[m]);
                if (fq == 0) { const int rl = ai * HALF + wr * 64 + (m0 + m) * 16 + fr; xst[rl * 8 + wc] = a; xst[rl * 8 + 4 + wc] = b; } }
            asm volatile("" ::: "memory"); }
        asm volatile("s_waitcnt lgkmcnt(0)" ::: "memory"); __builtin_amdgcn_s_barrier(); asm volatile("" ::: "memory");
        { const int t = (wr * 4 + wc) * 64 + fq * 16 + fr;
          if (t < 256 && st_new && !(SKIP & 4)) { const PG8_LAS float* p = xst + t * 8; const float sa = (p[0] + p[1]) + (p[2] + p[3]), sb = (p[4] + p[5]) + (p[6] + p[7]); float* dst = st_new + 2 * (size_t)(row0 - wr * 64 - fr + t);
              unsafeAtomicAdd(dst, sa); unsafeAtomicAdd(dst + 1, sb); }
          asm volatile("s_waitcnt lgkmcnt(0)" ::: "memory"); }
    }
};
typedef EpiResLnT<false> EpiResLn; typedef EpiResLnT<true> EpiResLn0; typedef EpiResLnT<false, true> EpiResLnF;
struct EpiMqt {
    static constexpr bool PERM = true, AFTER_DRAIN = false, PREF = false;
    bf16_t* O; int ldc; float scale; const float* gk; const float* bk; float* cs; float* cb;
    __device__ __forceinline__ void operator()(PG8_EPI_ARGS) const {
        const int row0 = u.pm * BM + wr * 64 + fr, col0 = u.pn * BM + wc * 32 + 8 * fq;
        f32x4 gg[2][2], bb[2][2];
#pragma unroll
        for (int bj = 0; bj < 2; ++bj)
#pragma unroll
            for (int n = 0; n < 2; ++n) { gg[bj][n] = *(const f32x4*)(gk + col0 + bj * HALF + 4 * n); bb[bj][n] = *(const f32x4*)(bk + col0 + bj * HALF + 4 * n); }
#pragma unroll
        for (int ai = 0; ai < 2; ++ai)
#pragma unroll
            for (int m = 0; m < 4; ++m) { const int r = row0 + ai * HALF + m * 16; float s1 = 0.f, s2 = 0.f;
#pragma unroll
                for (int bj = 0; bj < 2; ++bj) { const f32x4 v0 = acc[ai][bj][m][0] * scale, v1 = acc[ai][bj][m][1] * scale;
                    const u32x4 w = pack8(v0 * gg[bj][0], v1 * gg[bj][1]);
                    *(u32x4*)(O + (size_t)r * ldc + col0 + bj * HALF) = w;
                    s1 += (bf_lo(w.x) + bf_hi(w.x)) + (bf_lo(w.y) + bf_hi(w.y)) + (bf_lo(w.z) + bf_hi(w.z)) + (bf_lo(w.w) + bf_hi(w.w));
                    const f32x4 t0 = v0 * bb[bj][0], t1 = v1 * bb[bj][1]; s2 += (t0[0] + t0[1]) + (t0[2] + t0[3]) + (t1[0] + t1[1]) + (t1[2] + t1[3]); }
                s1 = red16_32(s1); s2 = red16_32(s2);
                if (fq == 0) { unsafeAtomicAdd(cs + r, s1); unsafeAtomicAdd(cb + r, s2); } }
    }
};
template <int UGP> struct EpiWin {
    static constexpr bool PERM = true, AFTER_DRAIN = false, PREF = true;
    bf16_t* QKV; bf16_t* UG; float qscale; Fold f; PG8_LAS unsigned char* pf;
    __device__ __forceinline__ void pref(const Unit& u) const { fold_prefetch(f, u, pf); }
    __device__ __forceinline__ void operator()(PG8_EPI_ARGS) const {
        const int row0 = u.pm * BM + wr * 64 + fr;
        f32x4 cs[2][2], cb[2][2]; float mus[2][4], rss[2][4]; fold_from_lds(pf, wr, wc, fr, fq, cs, cb, mus, rss);
        if (u.pn < 12) {
            const float sc = u.pn < 4 ? qscale : 1.0f; const int col0 = u.pn * BM + wc * 32 + 8 * fq;
#pragma unroll
            for (int ai = 0; ai < 2; ++ai)
#pragma unroll
                for (int m = 0; m < 4; ++m) { const int r = row0 + ai * HALF + m * 16; const float mu = mus[ai][m], rs = rss[ai][m]; const unsigned bo = 2u * (unsigned)(r * 3072 + col0);
#pragma unroll
                    for (int bj = 0; bj < 2; ++bj) *at32<u32x4>(QKV, bo + 2u * bj * HALF) = pack8(fold4(acc[ai][bj][m][0], mu, rs, cs[bj][0], cb[bj][0]) * sc, fold4(acc[ai][bj][m][1], mu, rs, cs[bj][1], cb[bj][1]) * sc); }
        } else {
#pragma unroll
            for (int ai = 0; ai < 2; ++ai)
#pragma unroll
                for (int m = 0; m < 4; ++m) { const int r = row0 + ai * HALF + m * 16, b = r >> 14, c = (r >> 6) & 255, s = r & 63; const float mu = mus[ai][m], rs = rss[ai][m];
#pragma unroll
                    for (int bj = 0; bj < 2; ++bj) { const int j0 = (u.pn - 12) * BM + bj * HALF + wc * 32 + 8 * fq, g = j0 >> 4, q0 = j0 & 15;
                        *at32<u32x4>(UG, 2u * (unsigned)((g * 512 + b * 256 + c) * UGP + 128 + s * 16 + q0)) = pack8(fold4(acc[ai][bj][m][0], mu, rs, cs[bj][0], cb[bj][0]), fold4(acc[ai][bj][m][1], mu, rs, cs[bj][1], cb[bj][1])); } }
        }
    }
};
template <int UGP> struct EpiSsmY {
    static constexpr bool PERM = true, AFTER_DRAIN = false, PREF = false;
    const bf16_t* UG; const float* dskip; bf16_t* YG;
    __device__ __forceinline__ void operator()(PG8_EPI_ARGS) const {
        const int R0 = u.pm * BM + wr * 64 + fr, g = R0 >> 9, b = (R0 >> 8) & 1;
        f32x4 d0[2], d1[2];
#pragma unroll
        for (int bj = 0; bj < 2; ++bj) { const int p0 = (bj * HALF + wc * 32 + 8 * fq) & 15; d0[bj] = *(const f32x4*)(dskip + g * 16 + p0); d1[bj] = *(const f32x4*)(dskip + g * 16 + p0 + 4); }
#pragma unroll
        for (int ai = 0; ai < 2; ++ai) { u32x4 uu[4][2];
#pragma unroll
            for (int m = 0; m < 4; ++m)
#pragma unroll
                for (int bj = 0; bj < 2; ++bj) uu[m][bj] = *at32<const u32x4>(UG, 2u * (unsigned)((R0 + ai * HALF + m * 16) * UGP + 128 + u.pn * BM + bj * HALF + wc * 32 + 8 * fq));
            asm volatile("" ::: "memory");
#pragma unroll
            for (int m = 0; m < 4; ++m) { const int c = (R0 + ai * HALF + m * 16) & 255;
#pragma unroll
                for (int bj = 0; bj < 2; ++bj) { const int col = u.pn * BM + bj * HALF + wc * 32 + 8 * fq, t = col >> 4, p0 = col & 15; const u32x4 w = uu[m][bj];
                    f32x4 y0 = acc[ai][bj][m][0], y1 = acc[ai][bj][m][1];
                    y0[0] += d0[bj][0] * bf_lo(w.x); y0[1] += d0[bj][1] * bf_hi(w.x); y0[2] += d0[bj][2] * bf_lo(w.y); y0[3] += d0[bj][3] * bf_hi(w.y);
                    y1[0] += d1[bj][0] * bf_lo(w.z); y1[1] += d1[bj][1] * bf_hi(w.z); y1[2] += d1[bj][2] * bf_lo(w.w); y1[3] += d1[bj][3] * bf_hi(w.w);
#pragma unroll
                    for (int e = 0; e < 4; ++e) { const float a = y0[e], bq = y1[e];
                        y0[e] = a * __builtin_amdgcn_rcpf(1.0f + __builtin_amdgcn_exp2f(-2.3022081983f * (a + 0.044715f * a * a * a))); y1[e] = bq * __builtin_amdgcn_rcpf(1.0f + __builtin_amdgcn_exp2f(-2.3022081983f * (bq + 0.044715f * bq * bq * bq))); }
                    *at32<u32x4>(YG, 2u * (unsigned)((b * 16384 + c * 64 + t) * 1024 + g * 16 + p0)) = pack8(y0, y1); } }
            asm volatile("" ::: "memory"); }
    }
};
struct EpiGlu {
    static constexpr bool PERM = true, AFTER_DRAIN = false, PREF = false;
    const bf16_t* YG; const float* bias; bf16_t* MIX;
    __device__ __forceinline__ void operator()(PG8_EPI_ARGS) const {
        const int row0 = u.pm * BM + wr * 64 + fr, col0 = u.pn * BM + wc * 32 + 8 * fq;
        f32x4 b0[2], b1[2];
#pragma unroll
        for (int bj = 0; bj < 2; ++bj) { b0[bj] = *(const f32x4*)(bias + col0 + bj * HALF); b1[bj] = *(const f32x4*)(bias + col0 + bj * HALF + 4); }
#pragma unroll
        for (int ai = 0; ai < 2; ++ai) { u32x4 yy[4][2];
#pragma unroll
            for (int m = 0; m < 4; ++m)
#pragma unroll
                for (int bj = 0; bj < 2; ++bj) yy[m][bj] = *at32<const u32x4>(YG, 2u * (unsigned)((row0 + ai * HALF + m * 16) * 1024 + col0 + bj * HALF));
            asm volatile("" ::: "memory");
#pragma unroll
            for (int m = 0; m < 4; ++m) { const int r = row0 + ai * HALF + m * 16;
#pragma unroll
                for (int bj = 0; bj < 2; ++bj) { const u32x4 w = yy[m][bj];
                    const f32x4 z0 = acc[ai][bj][m][0] + b0[bj], z1 = acc[ai][bj][m][1] + b1[bj]; f32x4 o0, o1;
                    o0[0] = bf_lo(w.x) * sigmoid_f(z0[0]); o0[1] = bf_hi(w.x) * sigmoid_f(z0[1]); o0[2] = bf_lo(w.y) * sigmoid_f(z0[2]); o0[3] = bf_hi(w.y) * sigmoid_f(z0[3]);
                    o1[0] = bf_lo(w.z) * sigmoid_f(z1[0]); o1[1] = bf_hi(w.z) * sigmoid_f(z1[1]); o1[2] = bf_lo(w.w) * sigmoid_f(z1[2]); o1[3] = bf_hi(w.w) * sigmoid_f(z1[3]);
                    *at32<u32x4>(MIX, 2u * (unsigned)(r * 2048 + 1024 + col0 + bj * HALF)) = pack8(o0, o1); } }
            asm volatile("" ::: "memory"); }
    }
};
#ifndef PG8_ASMDMA
#define PG8_ASMDMA 1
#endif
#ifndef PG8_BAL
#define PG8_BAL 1
#endif
template <class Epi, class Sched, bool ALIGN_EPI = false, bool SP2 = false>
__device__ __forceinline__ void gemm_phase(PG8_LAS unsigned char* lds, const Gemm g, const Sched& S, const Epi& E) {
    const int tid = otid(), wid = __builtin_amdgcn_readfirstlane(tid >> 6), lane = tid & 63, wr = wid >> 2, wc = wid & 3, fr = lane & 15, fq = lane >> 4;
    const int K = g.K, nt_def = K / BK;
    unsigned voffA[2], voffB[2];
#pragma unroll
    for (int i = 0; i < 2; ++i) { int R, C; stage_rc(tid * 16 + i * 8192, R, C); const int Rb = Epi::PERM ? ((R & ~31) + perm32(R & 31)) : R;
        voffA[i] = (unsigned)(R * g.lda + C) * 2u; voffB[i] = (unsigned)(Rb * g.ldb + C) * 2u; }
    const size_t kstep = (size_t)(BK * 2);
    const size_t hstepA = (size_t)HALF * g.lda * 2, hstepB = (size_t)HALF * g.ldb * 2;
    const unsigned ldsbase = (unsigned)(__UINTPTR_TYPE__)lds;
    const unsigned ldsw = (unsigned)wid * 1024u;
    const int aoff = lds_byte(wr * 64 + fr, fq * 8), boff = lds_byte(wc * 32 + fr, fq * 8);
#define PG8_SA(b, h) (((b) * 2 + (h)) * HTB)
#define PG8_SB(b, h) ((4 + (b) * 2 + (h)) * HTB)
#if PG8_ASMDMA
#define PG8_STAGE(bufoff, gbase, voff) do { _Pragma("unroll") for (int _i = 0; _i < 2; ++_i) { \
        const unsigned la_ = (unsigned)__builtin_amdgcn_readfirstlane((int)(ldsbase + (unsigned)(bufoff) + ldsw + (unsigned)(_i * 8192))); const char* gb_ = (const char*)(gbase); \
        asm volatile("s_mov_b32 m0, %2\n\ts_nop 0\n\tglobal_load_lds_dwordx4 %0, %1" :: "v"((voff)[_i]), "s"(gb_), "s"(la_) : "memory", "m0"); } } while (0)
#else
#define PG8_STAGE(bufoff, gbase, voff) do { _Pragma("unroll") for (int _i = 0; _i < 2; ++_i) \
        __builtin_amdgcn_global_load_lds((const unsigned*)((const char*)(gbase) + (voff)[_i]), (PG8_LAS unsigned*)(lds + (bufoff) + ldsw + _i * 8192), 16, 0, 0); } while (0)
#endif
#define PG8_LDA(dst, b, h) do { _Pragma("unroll") for (int m = 0; m < 4; ++m) _Pragma("unroll") for (int k = 0; k < 2; ++k) dst[m][k] = *(const PG8_LAS bf16x8*)(lds + PG8_SA(b, h) + aoff + m * 2048 + k * 1024); } while (0)
#define PG8_LDB(dst, b, h) do { _Pragma("unroll") for (int n = 0; n < 2; ++n) _Pragma("unroll") for (int k = 0; k < 2; ++k) dst[n][k] = *(const PG8_LAS bf16x8*)(lds + PG8_SB(b, h) + boff + n * 2048 + k * 1024); } while (0)
#define PG8_MMA(ai, bj, At, Bt) do { __builtin_amdgcn_s_setprio(1); _Pragma("unroll") for (int m = 0; m < 4; ++m) _Pragma("unroll") for (int n = 0; n < 2; ++n) _Pragma("unroll") for (int k = 0; k < 2; ++k) \
        acc[ai][bj][m][n] = __builtin_amdgcn_mfma_f32_16x16x32_bf16(Bt[n][k], At[m][k], acc[ai][bj][m][n], 0, 0, 0); __builtin_amdgcn_s_setprio(0); } while (0)
#define PG8_WAIT_V(n) asm volatile("s_waitcnt vmcnt(" #n ")" ::: "memory")
#define PG8_WAIT_L(n) asm volatile("s_waitcnt lgkmcnt(" #n ")" ::: "memory")
#define PG8_BAR __builtin_amdgcn_s_barrier()
#define PG8_SCHED __builtin_amdgcn_sched_barrier(0)
    Unit cur, nxt; int ui = 0;
    if (!S.next(0, cur)) return;
    f32x4 acc[2][2][4][2];
#pragma unroll
    for (int a = 0; a < 2; ++a)
#pragma unroll
        for (int b = 0; b < 2; ++b)
#pragma unroll
            for (int m = 0; m < 4; ++m)
#pragma unroll
                for (int n = 0; n < 2; ++n) acc[a][b][m][n] = (f32x4){0.f, 0.f, 0.f, 0.f};
    bf16x8 At[4][2], B0[2][2], B1[2][2];
    const char* cA = (const char*)g.A + (size_t)cur.aoff * 2; const char* cB = (const char*)g.Bt + (size_t)cur.boff * 2;
    S.a_ready(cur);
    if constexpr (SP2) {
        PG8_STAGE(PG8_SB(0, 0), cB, voffB); PG8_STAGE(PG8_SB(0, 1), cB + hstepB, voffB); PG8_STAGE(PG8_SA(0, 0), cA, voffA); PG8_STAGE(PG8_SA(0, 1), cA + hstepA, voffA);
        if (wr == 1) PG8_BAR;
        PG8_WAIT_V(2); PG8_BAR;
#if PG8_BAL
        PG8_STAGE(PG8_SB(1, 0), cB + kstep, voffB); PG8_STAGE(PG8_SB(1, 1), cB + hstepB + kstep, voffB);
        PG8_WAIT_V(4); PG8_BAR;
#else
        PG8_STAGE(PG8_SB(1, 0), cB + kstep, voffB); PG8_STAGE(PG8_SA(1, 0), cA + kstep, voffA); PG8_STAGE(PG8_SB(1, 1), cB + hstepB + kstep, voffB);
        PG8_WAIT_V(6); PG8_BAR;
#endif
    } else {
        PG8_STAGE(PG8_SB(0, 0), cB, voffB); PG8_STAGE(PG8_SA(0, 0), cA, voffA); PG8_STAGE(PG8_SB(0, 1), cB + hstepB, voffB); PG8_STAGE(PG8_SA(0, 1), cA + hstepA, voffA);
        if (wr == 1) PG8_BAR;
        PG8_WAIT_V(4); PG8_BAR;
        PG8_STAGE(PG8_SB(1, 0), cB + kstep, voffB); PG8_STAGE(PG8_SA(1, 0), cA + kstep, voffA); PG8_STAGE(PG8_SB(1, 1), cB + hstepB + kstep, voffB);
        PG8_WAIT_V(6); PG8_BAR;
    }
    for (;;) {
        const bool has_next = S.next(ui + 1, nxt);
        const char* nA = has_next ? (const char*)g.A + (size_t)nxt.aoff * 2 : cA; const char* nB = has_next ? (const char*)g.Bt + (size_t)nxt.boff * 2 : cB;
        const int nt = cur.nt ? cur.nt : nt_def;
        for (int t = 0; t < nt; t += 2) {
            const bool last = (t == nt - 2);
            const char* a1 = cA + (size_t)(t + 1) * kstep;
            const char* a2 = last ? nA : cA + (size_t)(t + 2) * kstep; const char* b2 = last ? nB : cB + (size_t)(t + 2) * kstep;
            const char* a3 = a2 + kstep; const char* b3 = b2 + kstep;
            if (last && has_next) S.a_ready(nxt);
            if constexpr (Epi::PREF) { if (last) E.pref(cur); }
            if constexpr (SP2) {
#if PG8_BAL
            PG8_LDB(B0, 0, 0); PG8_LDB(B1, 0, 1); PG8_SCHED; PG8_LDA(At, 0, 0); PG8_STAGE(PG8_SA(1, 0), a1, voffA); PG8_STAGE(PG8_SA(1, 1), a1 + hstepA, voffA);
            PG8_WAIT_V(8); PG8_WAIT_L(0); PG8_BAR; PG8_MMA(0, 0, At, B0); PG8_MMA(0, 1, At, B1); PG8_BAR; PG8_SCHED;
            PG8_LDA(At, 0, 1); PG8_STAGE(PG8_SB(0, 0), b2, voffB); PG8_STAGE(PG8_SB(0, 1), b2 + hstepB, voffB);
            PG8_WAIT_V(6); PG8_WAIT_L(0); PG8_BAR; PG8_MMA(1, 0, At, B0); PG8_MMA(1, 1, At, B1); PG8_BAR; PG8_SCHED;
            PG8_LDB(B0, 1, 0); PG8_LDB(B1, 1, 1); PG8_SCHED; PG8_LDA(At, 1, 0); PG8_STAGE(PG8_SA(0, 0), a2, voffA); PG8_STAGE(PG8_SA(0, 1), a2 + hstepA, voffA);
            PG8_WAIT_V(8); PG8_WAIT_L(0); PG8_BAR; PG8_MMA(0, 0, At, B0); PG8_MMA(0, 1, At, B1); PG8_BAR; PG8_SCHED;
            PG8_LDA(At, 1, 1); PG8_STAGE(PG8_SB(1, 0), b3, voffB); PG8_STAGE(PG8_SB(1, 1), b3 + hstepB, voffB);
            PG8_WAIT_V(6); PG8_WAIT_L(0); PG8_BAR; PG8_MMA(1, 0, At, B0); PG8_MMA(1, 1, At, B1); PG8_BAR; PG8_SCHED;
            (void)a3;
#else
            PG8_LDB(B0, 0, 0); PG8_LDB(B1, 0, 1); PG8_SCHED; PG8_LDA(At, 0, 0); PG8_STAGE(PG8_SA(1, 1), a1 + hstepA, voffA);
            PG8_WAIT_V(8); PG8_WAIT_L(0); PG8_BAR; PG8_MMA(0, 0, At, B0); PG8_MMA(0, 1, At, B1); PG8_BAR; PG8_SCHED;
            PG8_LDA(At, 0, 1); PG8_STAGE(PG8_SB(0, 0), b2, voffB); PG8_STAGE(PG8_SB(0, 1), b2 + hstepB, voffB); PG8_STAGE(PG8_SA(0, 0), a2, voffA);
            PG8_WAIT_V(8); PG8_WAIT_L(0); PG8_BAR; PG8_MMA(1, 0, At, B0); PG8_MMA(1, 1, At, B1); PG8_BAR; PG8_SCHED;
            PG8_LDB(B0, 1, 0); PG8_LDB(B1, 1, 1); PG8_SCHED; PG8_LDA(At, 1, 0); PG8_STAGE(PG8_SA(0, 1), a2 + hstepA, voffA);
            PG8_WAIT_V(8); PG8_WAIT_L(0); PG8_BAR; PG8_MMA(0, 0, At, B0); PG8_MMA(0, 1, At, B1); PG8_BAR; PG8_SCHED;
            PG8_LDA(At, 1, 1); PG8_STAGE(PG8_SB(1, 0), b3, voffB); PG8_STAGE(PG8_SB(1, 1), b3 + hstepB, voffB); PG8_STAGE(PG8_SA(1, 0), a3, voffA);
            PG8_WAIT_V(8); PG8_WAIT_L(0); PG8_BAR; PG8_MMA(1, 0, At, B0); PG8_MMA(1, 1, At, B1); PG8_BAR; PG8_SCHED;
#endif
            } else {
            PG8_LDB(B0, 0, 0); PG8_SCHED; PG8_LDA(At, 0, 0); PG8_STAGE(PG8_SA(1, 1), a1 + hstepA, voffA);
            PG8_WAIT_L(8); PG8_BAR; PG8_WAIT_L(0); PG8_MMA(0, 0, At, B0); PG8_BAR; PG8_SCHED;
            PG8_LDB(B1, 0, 1); PG8_STAGE(PG8_SB(0, 0), b2, voffB);
            PG8_BAR; PG8_WAIT_L(0); PG8_MMA(0, 1, At, B1); PG8_BAR;
            PG8_LDA(At, 0, 1); PG8_STAGE(PG8_SA(0, 0), a2, voffA);
            PG8_BAR; PG8_WAIT_L(0); PG8_MMA(1, 0, At, B0); PG8_BAR; PG8_SCHED;
            PG8_STAGE(PG8_SB(0, 1), b2 + hstepB, voffB);
            PG8_WAIT_V(6); PG8_BAR; PG8_MMA(1, 1, At, B1); PG8_BAR;
            PG8_LDB(B0, 1, 0); PG8_SCHED; PG8_LDA(At, 1, 0); PG8_STAGE(PG8_SA(0, 1), a2 + hstepA, voffA);
            PG8_WAIT_L(8); PG8_BAR; PG8_WAIT_L(0); PG8_MMA(0, 0, At, B0); PG8_BAR; PG8_SCHED;
            PG8_LDB(B1, 1, 1); PG8_STAGE(PG8_SB(1, 0), b3, voffB);
            PG8_BAR; PG8_WAIT_L(0); PG8_MMA(0, 1, At, B1); PG8_BAR;
            PG8_LDA(At, 1, 1); PG8_STAGE(PG8_SA(1, 0), a3, voffA);
            PG8_BAR; PG8_WAIT_L(0); PG8_MMA(1, 0, At, B0); PG8_BAR; PG8_SCHED;
            PG8_STAGE(PG8_SB(1, 1), b3 + hstepB, voffB);
            PG8_WAIT_V(6); PG8_BAR; PG8_MMA(1, 1, At, B1); PG8_BAR;
            }
        }
        if constexpr (ALIGN_EPI) { if (wr == 0) PG8_BAR; }
        if constexpr (!Epi::AFTER_DRAIN) { E(acc, cur, wr, wc, fr, fq); S.done(cur); }
        if (!has_next) break;
#pragma unroll
        for (int a = 0; a < 2; ++a)
#pragma unroll
            for (int b = 0; b < 2; ++b)
#pragma unroll
                for (int m = 0; m < 4; ++m)
#pragma unroll
                    for (int n = 0; n < 2; ++n) acc[a][b][m][n] = (f32x4){0.f, 0.f, 0.f, 0.f};
        cur = nxt; cA = nA; cB = nB; ++ui;
        if constexpr (ALIGN_EPI) { if (wr == 1) PG8_BAR; }
    }
    PG8_WAIT_V(0);
    if constexpr (!ALIGN_EPI) { if (wr == 0) PG8_BAR; }
    PG8_BAR;
    if constexpr (Epi::AFTER_DRAIN) { E.fused(acc, cur, wr, wc, fr, fq, lds, wid, lane); S.done(cur); }
#undef PG8_SA
#undef PG8_SB
#undef PG8_STAGE
#undef PG8_LDA
#undef PG8_LDB
#undef PG8_MMA
#undef PG8_WAIT_V
#undef PG8_WAIT_L
#undef PG8_BAR
#undef PG8_SCHED
}
}
#include <hip/hip_bf16.h>
#include <cmath>
namespace attn_body {
using bf16=__hip_bfloat16;
using bf16x8=__attribute__((ext_vector_type(8)))short;
using s16x4=__attribute__((ext_vector_type(4)))short;
using f32x16=__attribute__((ext_vector_type(16)))float;
using u32x4=__attribute__((ext_vector_type(4)))unsigned;
constexpr int BATCH=2,NVH=32,SEQ=16384,D=64,DM=3072,DMO=2048;
constexpr int NW=8,QBLK=32,QB=QBLK*NW,KVBLK=64,NQB=SEQ/QB;
constexpr int ATTN_PITCH=DM, ATTN_UNIT_ROWS=QB;
__device__ __forceinline__ int crow(int r,int hi){return (r&3)+8*(r>>2)+4*hi;}
#define SBAR() __builtin_amdgcn_sched_barrier(0)
__device__ __forceinline__ void cmask(f32x16&p0,f32x16&p1,int jb,int qrel,int hi){
  const float NEG=-INFINITY; (void)hi;
  if(jb>(qrel>>6)){
  #pragma unroll
  for(int r=0;r<16;++r){p0[r]=NEG;p1[r]=NEG;}}
}

constexpr int NSLOT=3, SLOTB=8192;
constexpr int LDS_K=0, LDS_V=NSLOT*SLOTB, LDS_WS=2*NSLOT*SLOTB, LDS_OST=LDS_WS+NW*64*4, LDS_BYTES=LDS_OST+NW*4096;
constexpr float C2=0.125f*1.4426950408889634f;
__device__ __forceinline__ void glds16(const void*gsrc,unsigned lds_dst){unsigned keep;
  asm volatile("s_mov_b32 %0, m0\n\ts_mov_b32 m0, %2\n\ts_nop 0\n\tglobal_load_lds_dwordx4 %1, off\n\ts_mov_b32 m0, %0":"=&s"(keep):"v"(gsrc),"s"(lds_dst):"memory");}
__device__ __forceinline__ void glds16s(const void*gbase,unsigned voff,unsigned lds_dst){
  asm volatile("s_mov_b32 m0, %2\n\ts_nop 0\n\tglobal_load_lds_dwordx4 %0, %1"::"v"(voff),"s"(gbase),"s"(lds_dst):"memory","m0");}
__device__ __forceinline__ float max3f(float a,float b,float c){float r;asm("v_max3_f32 %0, %1, %2, %3":"=v"(r):"v"(a),"v"(b),"v"(c));return r;}
__device__ __forceinline__ float max2f(float a,float b){float r;asm("v_max_f32_e32 %0, %1, %2":"=v"(r):"v"(a),"v"(b));return r;}
__device__ __forceinline__ float fadd_s(float a,float b){float r;asm("v_add_f32_e32 %0, %1, %2":"=v"(r):"v"(a),"v"(b));return r;}
__device__ __forceinline__ float fsub_s(float a,float b){float r;asm("v_sub_f32_e32 %0, %1, %2":"=v"(r):"v"(a),"v"(b));return r;}
typedef float f32x2_t __attribute__((ext_vector_type(2))); typedef __bf16 bf16x2_t __attribute__((ext_vector_type(2)));
__device__ __forceinline__ unsigned cvtpk_s(float lo,float hi){f32x2_t v={lo,hi};bf16x2_t b=__builtin_convertvector(v,bf16x2_t);return __builtin_bit_cast(unsigned,b);}
#define WAIT_BAR(N) asm volatile("s_waitcnt vmcnt(" #N ") lgkmcnt(0)\n\ts_barrier":::"memory")

__device__ __forceinline__ void qkt(f32x16&p0,f32x16&p1,const char*Kslot,const bf16x8*qr,const f32x16&negm,int r32,int hi){
  const char*kb=Kslot+hi*1024+r32*16;
  #pragma unroll
  for(int d0=0;d0<4;++d0){
    const bf16x8 b0=*reinterpret_cast<const bf16x8*>(kb+d0*2048);
    const bf16x8 b1=*reinterpret_cast<const bf16x8*>(kb+d0*2048+512);
    if(d0==0){p0=__builtin_amdgcn_mfma_f32_32x32x16_bf16(b0,qr[0],negm,0,0,0);p1=__builtin_amdgcn_mfma_f32_32x32x16_bf16(b1,qr[0],negm,0,0,0);}
    else{p0=__builtin_amdgcn_mfma_f32_32x32x16_bf16(b0,qr[d0],p0,0,0,0);p1=__builtin_amdgcn_mfma_f32_32x32x16_bf16(b1,qr[d0],p1,0,0,0);}}
}
typedef __attribute__((address_space(3))) const char* lds_cptr;
typedef short v4i16_t __attribute__((ext_vector_type(4)));
__device__ __forceinline__ void kload8(bf16x8*kf,lds_cptr kp){
  kf[0]=*(const __attribute__((address_space(3))) bf16x8*)(kp);      kf[1]=*(const __attribute__((address_space(3))) bf16x8*)(kp+512);
  kf[2]=*(const __attribute__((address_space(3))) bf16x8*)(kp+2048); kf[3]=*(const __attribute__((address_space(3))) bf16x8*)(kp+2560);
  kf[4]=*(const __attribute__((address_space(3))) bf16x8*)(kp+4096); kf[5]=*(const __attribute__((address_space(3))) bf16x8*)(kp+4608);
  kf[6]=*(const __attribute__((address_space(3))) bf16x8*)(kp+6144); kf[7]=*(const __attribute__((address_space(3))) bf16x8*)(kp+6656);
}
__device__ __forceinline__ void kload2(bf16x8*kf,lds_cptr kp,int j){ kf[2*j]=*(const __attribute__((address_space(3))) bf16x8*)(kp+j*2048); kf[2*j+1]=*(const __attribute__((address_space(3))) bf16x8*)(kp+j*2048+512); }
__device__ __forceinline__ s16x4 vtr(lds_cptr p){ return __builtin_bit_cast(s16x4,__builtin_amdgcn_ds_read_tr16_b64_v4i16((__attribute__((address_space(3))) v4i16_t*)p)); }
__device__ __forceinline__ float rowmax(const f32x16&p0,const f32x16&p1){
  float a=max3f(p0[0],p0[1],p1[0]),b=max3f(p0[2],p0[3],p1[1]);a=max3f(a,p1[2],p1[3]);
  #pragma unroll
  for(int r=4;r<16;r+=4){a=max3f(a,p0[r],p0[r+1]);b=max3f(b,p0[r+2],p0[r+3]);a=max3f(a,p1[r],p1[r+1]);b=max3f(b,p1[r+2],p1[r+3]);}
  const float m=max2f(a,b);
  auto rr=__builtin_amdgcn_permlane32_swap(__float_as_uint(m),__float_as_uint(m),false,false);
  return max2f(__uint_as_float(rr[0]),__uint_as_float(rr[1]));
}
__device__ __forceinline__ void pv(f32x16*o,int vb,bf16x8 pa0,bf16x8 pa1,bf16x8 pa2,bf16x8 pa3){
  #pragma unroll
  for(int d0=0;d0<2;++d0){s16x4 lo[4],hi[4];
    #pragma unroll
    for(int ks=0;ks<4;++ks){
      asm volatile("ds_read_b64_tr_b16 %0,%1 offset:%c2":"=&v"(lo[ks]):"v"(vb),"i"(d0*4096+ks*1024):"memory");
      asm volatile("ds_read_b64_tr_b16 %0,%1 offset:%c2":"=&v"(hi[ks]):"v"(vb),"i"(d0*4096+ks*1024+512):"memory");}
    asm volatile("s_waitcnt lgkmcnt(0)":::"memory");SBAR();
    #define PK(k) (bf16x8){lo[k][0],lo[k][1],lo[k][2],lo[k][3],hi[k][0],hi[k][1],hi[k][2],hi[k][3]}
    o[d0]=__builtin_amdgcn_mfma_f32_32x32x16_bf16(pa0,PK(0),o[d0],0,0,0);
    o[d0]=__builtin_amdgcn_mfma_f32_32x32x16_bf16(pa1,PK(1),o[d0],0,0,0);
    o[d0]=__builtin_amdgcn_mfma_f32_32x32x16_bf16(pa2,PK(2),o[d0],0,0,0);
    o[d0]=__builtin_amdgcn_mfma_f32_32x32x16_bf16(pa3,PK(3),o[d0],0,0,0);
    #undef PK
  }
}

#ifndef ATTN_STORE16
#define ATTN_STORE16(p,v) __builtin_nontemporal_store((v),(u32x4*)(p))
#endif
template<int THRL> __device__ __forceinline__ void attn_unit(int b,int qb,const bf16*__restrict__ Q,const bf16*__restrict__ K,const bf16*__restrict__ V,bf16*__restrict__ O,char*shm){
  const int tid=pg8::otid(),lane=tid&63,r32=lane&31,hi=lane>>5; const int wid=__builtin_amdgcn_readfirstlane(tid>>6);
  const long rowbase=(long)b*SEQ; const int q0=qb*QB;
  const bf16*Qw=Q+(rowbase+q0+wid*QBLK)*DM;
  const bf16*Kh=K+rowbase*DM,*Vh=V+rowbase*DM;
  const unsigned lds0=(unsigned)(uintptr_t)shm;
  float*wsf=(float*)(shm+LDS_WS)+wid*64;
  const bf16*ksrc=Kh+(long)lane*DM+wid*8;
  const bf16*vsrc=Vh+(long)(16*(wid&3)+(lane>>2))*DM+(wid>>2)*32+(lane&3)*8;
  const unsigned kdst=lds0+LDS_K+wid*1024, vdst=lds0+LDS_V+wid*1024;
  #define DMA_K(t,slot) glds16(ksrc+(long)(t)*KVBLK*DM,(unsigned)__builtin_amdgcn_readfirstlane(kdst+(slot)))
  #define DMA_V(t,slot) glds16(vsrc+(long)(t)*KVBLK*DM,(unsigned)__builtin_amdgcn_readfirstlane(vdst+(slot)))
  const int vb0=(int)(lds0+LDS_V)+((lane>>4)&1)*32+(lane&3)*8+(4*hi+((lane&15)>>2))*64;
  const char*Kbase=shm+LDS_K; bf16x8 kf[8];
  const lds_cptr shm3=(lds_cptr)shm; const lds_cptr kp0=shm3+LDS_K+hi*1024+r32*16; const lds_cptr vp0=shm3+LDS_V+((lane>>4)&1)*32+(lane&3)*8+(4*hi+((lane&15)>>2))*64;
  const int NT=(q0+QB)/KVBLK;
  DMA_K(0,0);DMA_V(0,0);DMA_K(1,SLOTB);
  bf16x8 qr[4];
  #pragma unroll
  for(int d0=0;d0<4;++d0)qr[d0]=*reinterpret_cast<const bf16x8*>(&Qw[(long)r32*DM+d0*16+hi*8]);
  float mhat=0.f,l_reg=0.f;f32x16 o[2];o[0]=f32x16{};o[1]=f32x16{};f32x16 negm=f32x16{};asm volatile("":"+v"(negm));
  const int qrel=wid*QBLK+r32;
  #define CMASK(P0,P1,t) do{int jb_=(t)-(NT-4); if(jb_>=0)cmask(P0,P1,jb_,qrel,hi);}while(0)
  bool resc=false;
  #define START(P0,P1) do{ const float rm=rowmax(P0,P1); resc=false; \
    { const float dl=rm; mhat=fadd_s(mhat,dl); \
      _Pragma("unroll") for(int r=0;r<16;++r){P0[r]=fsub_s(P0[r],dl);P1[r]=fsub_s(P1[r],dl);} \
      _Pragma("unroll") for(int r=0;r<16;++r)negm[r]=-mhat; asm volatile("":"+v"(negm)); } \
    _Pragma("unroll") for(int r=0;r<16;++r)P0[r]=__builtin_amdgcn_exp2f(P0[r]); }while(0)
  #define RESC() do{ if(resc){ asm volatile("s_waitcnt lgkmcnt(0)":::"memory"); \
      _Pragma("unroll") for(int d_=0;d_<2;++d_) _Pragma("unroll") for(int r=0;r<16;++r)o[d_][r]*=wsf[crow(r,hi)]; } }while(0)
  f32x16 pA0,pA1,pB0,pB1;
  int sl_prev=0,sl_cur=0,sl_next=SLOTB;
  #define ROT() do{sl_prev=sl_cur;sl_cur=sl_next;sl_next=(sl_next==(NSLOT-1)*SLOTB)?0:sl_next+SLOTB;}while(0)
  DMA_K(2,2*SLOTB);
  WAIT_BAR(3);
  qkt(pA0,pA1,Kbase,qr,negm,r32,hi);asm volatile("s_nop 15\n\ts_nop 7":"+v"(pA0),"+v"(pA1));CMASK(pA0,pA1,0);
  START(pA0,pA1);
  _Pragma("unroll") for(int r=0;r<16;++r)pA1[r]=__builtin_amdgcn_exp2f(pA1[r]);
  WAIT_BAR(0);
  DMA_K(3,0);DMA_V(1,SLOTB);
  ROT();
  kload8(kf,kp0+sl_cur);
  WAIT_BAR(2);
  s16x4 vlo[8],vhi[8]; u32x4 pw0,pw1,pw2,pw3;
  #define PKW(P,B) cvtpk_s(P[B],P[B+1])
  #define PAF(k) __builtin_bit_cast(bf16x8,pw##k)
  #define VFR(i) (bf16x8){vlo[i][0],vlo[i][1],vlo[i][2],vlo[i][3],vhi[i][0],vhi[i][1],vhi[i][2],vhi[i][3]}
  #define PIN(x) asm volatile("":"+v"(x))
  #define MX3(a,b,c) __builtin_fmaxf(__builtin_fmaxf((a),(b)),(c))
  #define GAPA(MF,A0,A1,A2,A3,W0,W1,PW) do{ MF; sacc+=A0; sacc+=A1; sacc+=A2; sacc+=A3; PIN(sacc); W0; W1; PIN(PW); SBAR(); }while(0)
  #define EX(v) __builtin_amdgcn_exp2f(v)
  #define GAPB(MF,X,B) do{ MF; X[B]=EX(X[B]); X[B+1]=EX(X[B+1]); X[B+2]=EX(X[B+2]); X[B+3]=EX(X[B+3]); PIN(X); SBAR(); }while(0)
  #define VRD(i) do{ vlo[i]=vtr(vp_+(((i)>>2)*4096+((i)&3)*1024)); vhi[i]=vtr(vp_+(((i)>>2)*4096+((i)&3)*1024+512)); }while(0)
  #define KRD(G,j) do{ if(G){ kload2(kf,kp0+sl_next,j); SBAR(); } }while(0)
  #define STEP(C0,C1,P0,P1,t,GK,GV,GL) do{ SBAR(); \
    const lds_cptr vp_=vp0+sl_prev; \
    VRD(0); SBAR(); float sacc=(P0[0]+P0[1]); \
    GAPA(C0=__builtin_amdgcn_mfma_f32_32x32x16_bf16(kf[0],qr[0],negm,0,0,0), P0[2],P0[3],P0[4],P0[5],     pw0[0]=PKW(P0,0), pw0[1]=PKW(P0,2), pw0); \
    VRD(4); SBAR(); GAPA(C1=__builtin_amdgcn_mfma_f32_32x32x16_bf16(kf[1],qr[0],negm,0,0,0), P0[6],P0[7],P0[8],P0[9],     pw0[2]=PKW(P0,4), pw0[3]=PKW(P0,6), pw0); \
    VRD(1); SBAR(); GAPA(C0=__builtin_amdgcn_mfma_f32_32x32x16_bf16(kf[2],qr[1],C0,0,0,0),   P0[10],P0[11],P0[12],P0[13], pw1[0]=PKW(P0,8), pw1[1]=PKW(P0,10), pw1); \
    VRD(5); SBAR(); GAPA(C1=__builtin_amdgcn_mfma_f32_32x32x16_bf16(kf[3],qr[1],C1,0,0,0),   P0[14],P0[15],P1[0],P1[1],   pw1[2]=PKW(P0,12),pw1[3]=PKW(P0,14), pw1); \
    VRD(2); SBAR(); GAPA(C0=__builtin_amdgcn_mfma_f32_32x32x16_bf16(kf[4],qr[2],C0,0,0,0),   P1[2],P1[3],P1[4],P1[5],     pw2[0]=PKW(P1,0), pw2[1]=PKW(P1,2), pw2); \
    VRD(6); SBAR(); GAPA(C1=__builtin_amdgcn_mfma_f32_32x32x16_bf16(kf[5],qr[2],C1,0,0,0),   P1[6],P1[7],P1[8],P1[9],     pw2[2]=PKW(P1,4), pw2[3]=PKW(P1,6), pw2); \
    VRD(3); SBAR(); GAPA(C0=__builtin_amdgcn_mfma_f32_32x32x16_bf16(kf[6],qr[3],C0,0,0,0),   P1[10],P1[11],P1[12],P1[13], pw3[0]=PKW(P1,8), pw3[1]=PKW(P1,10), pw3); \
    VRD(7); SBAR(); GAPA(C1=__builtin_amdgcn_mfma_f32_32x32x16_bf16(kf[7],qr[3],C1,0,0,0),   P1[14],P1[15],0.f,0.f,       pw3[2]=PKW(P1,12),pw3[3]=PKW(P1,14), pw3); \
    l_reg+=sacc; \
    if(GK){DMA_K((t)+3,sl_cur);} if(GV){DMA_V((t)+1,sl_next);} \
    CMASK(C0,C1,t); \
    { float a=MX3(C0[0],C0[1],C1[0]),b=MX3(C0[2],C0[3],C1[1]); a=MX3(a,C1[2],C1[3]); \
      _Pragma("unroll") for(int r=4;r<16;r+=4){a=MX3(a,C0[r],C0[r+1]);b=MX3(b,C0[r+2],C0[r+3]);a=MX3(a,C1[r],C1[r+1]);b=MX3(b,C1[r+2],C1[r+3]);} \
      float rm=__builtin_fmaxf(a,b); { auto rr=__builtin_amdgcn_permlane32_swap(__float_as_uint(rm),__float_as_uint(rm),false,false); rm=__builtin_fmaxf(__uint_as_float(rr[0]),__uint_as_float(rr[1])); } \
      resc=false; \
      if(__builtin_expect(__any(rm>(float)THRL),0)){ const float dl=__builtin_fmaxf(rm,0.f); mhat+=dl; \
        _Pragma("unroll") for(int r=0;r<16;++r){C0[r]-=dl;C1[r]-=dl;} \
        _Pragma("unroll") for(int r=0;r<16;++r)negm[r]=-mhat; asm volatile("":"+v"(negm)); \
        const float f=__builtin_amdgcn_exp2f(-dl); l_reg*=f; if(hi==0)wsf[r32]=f; resc=true; } } \
    SBAR(); \
    GAPB(o[0]=__builtin_amdgcn_mfma_f32_32x32x16_bf16(PAF(0),VFR(0),o[0],0,0,0), C0,0); \
    GAPB(o[1]=__builtin_amdgcn_mfma_f32_32x32x16_bf16(PAF(0),VFR(4),o[1],0,0,0), C0,4); \
    KRD(GL,0); GAPB(o[0]=__builtin_amdgcn_mfma_f32_32x32x16_bf16(PAF(1),VFR(1),o[0],0,0,0), C0,8); \
    KRD(GL,1); GAPB(o[1]=__builtin_amdgcn_mfma_f32_32x32x16_bf16(PAF(1),VFR(5),o[1],0,0,0), C0,12); \
    KRD(GL,2); GAPB(o[0]=__builtin_amdgcn_mfma_f32_32x32x16_bf16(PAF(2),VFR(2),o[0],0,0,0), C1,0); \
    KRD(GL,3); GAPB(o[1]=__builtin_amdgcn_mfma_f32_32x32x16_bf16(PAF(2),VFR(6),o[1],0,0,0), C1,4); \
    GAPB(o[0]=__builtin_amdgcn_mfma_f32_32x32x16_bf16(PAF(3),VFR(3),o[0],0,0,0), C1,8); \
    GAPB(o[1]=__builtin_amdgcn_mfma_f32_32x32x16_bf16(PAF(3),VFR(7),o[1],0,0,0), C1,12); \
    }while(0)
  int t=1;
  #undef CMASK
  #define CMASK(P0,P1,t) do{}while(0)
  for(;t+5<NT;t+=2){
    STEP(pB0,pB1,pA0,pA1,t,true,true,true);     WAIT_BAR(2); RESC(); ROT();
    STEP(pA0,pA1,pB0,pB1,t+1,true,true,true);   WAIT_BAR(2); RESC(); ROT();
  }
  #undef CMASK
  #define CMASK(P0,P1,t) do{int jb_=(t)-(NT-4); if(jb_>=0)cmask(P0,P1,jb_,qrel,hi);}while(0)
  #define ENDW(tt) do{ if((tt)+3<NT){WAIT_BAR(2);} else if((tt)+2<NT){WAIT_BAR(1);} else {WAIT_BAR(0);} }while(0)
  for(;t+1<NT;t+=2){
    STEP(pB0,pB1,pA0,pA1,t,(t+3<NT),(t+1<NT),(t+1<NT));       ENDW(t);   RESC(); ROT();
    STEP(pA0,pA1,pB0,pB1,t+1,(t+4<NT),(t+2<NT),(t+2<NT));     ENDW(t+1); RESC(); ROT();
  }
  STEP(pB0,pB1,pA0,pA1,NT-1,false,false,false); RESC();
  { float sacc=pB0[0]+pB0[1]; _Pragma("unroll") for(int r=2;r<16;++r)sacc+=pB0[r]; _Pragma("unroll") for(int r=0;r<16;++r)sacc+=pB1[r]; l_reg+=sacc;
    pw0=(u32x4){PKW(pB0,0),PKW(pB0,2),PKW(pB0,4),PKW(pB0,6)};pw1=(u32x4){PKW(pB0,8),PKW(pB0,10),PKW(pB0,12),PKW(pB0,14)};pw2=(u32x4){PKW(pB1,0),PKW(pB1,2),PKW(pB1,4),PKW(pB1,6)};pw3=(u32x4){PKW(pB1,8),PKW(pB1,10),PKW(pB1,12),PKW(pB1,14)};
    SBAR(); pv(o,vb0+sl_cur,PAF(0),PAF(1),PAF(2),PAF(3)); }
  #undef PKW
  #undef PAF
  #undef VFR
  #undef PIN
  #undef MX3
  #undef GAPA
  #undef GAPB
  #undef EX
  #undef VRD
  #undef KRD
  #undef STEP
  #undef ENDW
  {auto rr=__builtin_amdgcn_permlane32_swap(__float_as_uint(l_reg),__float_as_uint(l_reg),false,false);l_reg=__uint_as_float(rr[0])+__uint_as_float(rr[1]);}
  if(hi==0)wsf[32+r32]=l_reg;asm volatile("s_waitcnt lgkmcnt(0)":::"memory");
  float rli[16];
  #pragma unroll
  for(int r=0;r<16;++r)rli[r]=__builtin_amdgcn_rcpf(wsf[32+crow(r,hi)]);
  bf16*Ow=O+(rowbase+q0+wid*QBLK)*DMO;
  { bf16*stg=(bf16*)(shm+LDS_OST)+wid*2048;
    #pragma unroll
    for(int r=0;r<16;++r){const int orow=crow(r,hi);
      #pragma unroll
      for(int d0=0;d0<2;++d0)stg[orow*64+d0*32+r32]=__float2bfloat16(o[d0][r]*rli[r]);}
    asm volatile("s_waitcnt lgkmcnt(0)":::"memory");
    #pragma unroll
    for(int i=0;i<4;++i){const int row=i*8+(lane>>3),ch=lane&7; const u32x4 v=*(const u32x4*)(stg+row*64+ch*8); ATTN_STORE16(Ow+(long)row*DMO+ch*8,v);} }
  asm volatile("s_waitcnt lgkmcnt(0)\n\ts_barrier":::"memory");
  #undef DMA_K
  #undef DMA_V
  #undef CMASK
  #undef START
  #undef RESC
  #undef ROT
}
constexpr int ATTN_LDS_BYTES=LDS_BYTES;
struct AttnTensors { const bf16* QKV; bf16* O; };
struct AttnUnit { int bvh; int qb; };
struct StaticOrder {
  int vcu;
  __device__ __forceinline__ explicit StaticOrder(int grid,int block):vcu((grid%8==0)?(block%8)*(grid/8)+block/8:block){}
  __device__ __forceinline__ bool next(int i,AttnUnit&u)const{ const int L=vcu; if(i>=16||L>=256)return false; const int s=8*(L&3)+(i>>1); u.bvh=L>>2; u.qb=(i&1)?63-s:s; return true; }
  __device__ __forceinline__ void a_ready(const AttnUnit&)const{}
  __device__ __forceinline__ void done(const AttnUnit&)const{}
};
template<class Sched,int THRL=8> __device__ __forceinline__ void attn_phase(char*lds,const AttnTensors&T,const Sched&S){
  AttnUnit u;
  for(int i=0;S.next(i,u);++i){ S.a_ready(u); const int b=u.bvh>>5,vh=u.bvh&31;
    attn_unit<THRL>(b,u.qb,T.QKV+(vh>>1)*64,T.QKV+1024+(vh>>1)*64,T.QKV+2048+((vh>>2)*2+(vh&1))*64,T.O+vh*64,lds); S.done(u); }
}

constexpr int KSLOT2=8192, VSLOT2=16384;
constexpr int LDS2_K=0, LDS2_V=NSLOT*KSLOT2, LDS2_WS=LDS2_V+NSLOT*VSLOT2, LDS2_OST=LDS2_WS+NW*64*4, LDS2_BYTES=LDS2_OST+NW*4096;
#define WAIT_BAR2(N) asm volatile("s_waitcnt vmcnt(" #N ") lgkmcnt(0)\n\ts_barrier":::"memory")
template<int THRL> __device__ __forceinline__ void attn_unit2(int b,int qb,const bf16*__restrict__ Q,const bf16*__restrict__ K,const bf16*__restrict__ V,bf16*__restrict__ O,char*shm){
  const int tid=pg8::otid(),lane=tid&63,r32=lane&31,hi=lane>>5; const int wid=__builtin_amdgcn_readfirstlane(tid>>6);
  const long rowbase=(long)b*SEQ; const int q0=qb*QB;
  const bf16*Qw=Q+(rowbase+q0+wid*QBLK)*DM;
  const bf16*Kh=K+rowbase*DM,*Vh=V+rowbase*DM;
  const unsigned lds0=(unsigned)(uintptr_t)shm;
  float*wsf=(float*)(shm+LDS2_WS)+wid*64;
  const unsigned kvoff=(unsigned)((lane*DM+wid*8)*2);
  const unsigned vvoff=(unsigned)(((16*(wid&3)+(lane>>2))*DM+(wid>>2)*32+(lane&3)*8)*2);
  const unsigned kdst=lds0+LDS2_K+wid*1024, vdst=lds0+LDS2_V+wid*1024;
  #define DMA_K(t,slot) glds16s(Kh+(long)(t)*KVBLK*DM,kvoff,(unsigned)__builtin_amdgcn_readfirstlane(kdst+(slot)))
  #define DMA_V(t,slot) do{ glds16s(Vh+(long)(t)*KVBLK*DM,vvoff,(unsigned)__builtin_amdgcn_readfirstlane(vdst+2*(slot))); glds16s(Vh+(long)(t)*KVBLK*DM+64,vvoff,(unsigned)__builtin_amdgcn_readfirstlane(vdst+2*(slot)+8192)); }while(0)
  const char*Kbase=shm+LDS2_K; bf16x8 kf[8];
  const lds_cptr shm3=(lds_cptr)shm; const lds_cptr kp0=shm3+LDS2_K+hi*1024+r32*16; const lds_cptr vp0=shm3+LDS2_V+((lane>>4)&1)*32+(lane&3)*8+(4*hi+((lane&15)>>2))*64;
  const int NT=(q0+QB)/KVBLK;
  DMA_K(0,0);DMA_V(0,0);DMA_K(1,KSLOT2);
  bf16x8 qr[4];
  #pragma unroll
  for(int d0=0;d0<4;++d0)qr[d0]=*reinterpret_cast<const bf16x8*>(&Qw[(long)r32*DM+d0*16+hi*8]);
  float mhat=0.f,l_reg=0.f;f32x16 o[4];o[0]=f32x16{};o[1]=f32x16{};o[2]=f32x16{};o[3]=f32x16{};
  f32x16 negm=f32x16{};asm volatile("":"+v"(negm));
  const int qrel=wid*QBLK+r32;
  #define CMASK(P0,P1,t) do{int jb_=(t)-(NT-4); if(jb_>=0)cmask(P0,P1,jb_,qrel,hi);}while(0)
  bool resc=false;
  #define RESC() do{ if(resc){ asm volatile("s_waitcnt lgkmcnt(0)":::"memory"); \
      _Pragma("unroll") for(int d_=0;d_<4;++d_) _Pragma("unroll") for(int r=0;r<16;++r)o[d_][r]*=wsf[crow(r,hi)]; } }while(0)
  f32x16 pA0,pA1,pB0,pB1;
  int sl_prev=0,sl_cur=0,sl_next=KSLOT2;
  #define ROT() do{sl_prev=sl_cur;sl_cur=sl_next;sl_next=(sl_next==(NSLOT-1)*KSLOT2)?0:sl_next+KSLOT2;}while(0)
  DMA_K(2,2*KSLOT2);
  WAIT_BAR2(4);
  qkt(pA0,pA1,Kbase,qr,negm,r32,hi);asm volatile("s_nop 15\n\ts_nop 7":"+v"(pA0),"+v"(pA1));CMASK(pA0,pA1,0);
  { const float rm=rowmax(pA0,pA1); mhat=rm;
    #pragma unroll
    for(int r=0;r<16;++r)negm[r]=-mhat;
    asm volatile("":"+v"(negm));
    #pragma unroll
    for(int r=0;r<16;++r){pA0[r]=__builtin_amdgcn_exp2f(pA0[r]-mhat);pA1[r]=__builtin_amdgcn_exp2f(pA1[r]-mhat);} }
  WAIT_BAR2(0);
  DMA_K(3,0);DMA_V(1,KSLOT2);
  ROT();
  kload8(kf,kp0+sl_cur);
  WAIT_BAR2(3);
  s16x4 vlo[8],vhi[8]; u32x4 pw0,pw1,pw2,pw3;
  #define PKW(P,B) cvtpk_s(P[B],P[B+1])
  #define PAF(k) __builtin_bit_cast(bf16x8,pw##k)
  #define PAFI(k) ((k)==0?PAF(0):(k)==1?PAF(1):(k)==2?PAF(2):PAF(3))
  #define VFR(i) (bf16x8){vlo[i][0],vlo[i][1],vlo[i][2],vlo[i][3],vhi[i][0],vhi[i][1],vhi[i][2],vhi[i][3]}
  #define PIN(x) asm volatile("":"+v"(x))
  #define MX3(a,b,c) __builtin_fmaxf(__builtin_fmaxf((a),(b)),(c))
  #define MFMA(a,b,c) __builtin_amdgcn_mfma_f32_32x32x16_bf16(a,b,c,0,0,0)
  #define GAPA(MF,A0,A1,A2,A3,W0,W1,PW) do{ MF; sacc+=A0; sacc+=A1; sacc+=A2; sacc+=A3; PIN(sacc); W0; W1; PIN(PW); SBAR(); }while(0)
  #define EX(v) __builtin_amdgcn_exp2f(v)
  #define GAPB(MF,X,B) do{ MF; X[B]=EX(X[B]); X[B+1]=EX(X[B+1]); PIN(X); SBAR(); }while(0)
  #define VOFF(j) ((((j)&3)*4096)+(((j)>>2)*1024))
  #define VRD(s_,j) do{ vlo[s_]=vtr(vp_+VOFF(j)); vhi[s_]=vtr(vp_+VOFF(j)+512); }while(0)
  #define KRD(G,j) do{ if(G){ kload2(kf,kp0+sl_next,j); SBAR(); } }while(0)
  #define PVM(j,PA) o[(j)&3]=MFMA(PA,VFR((j)&7),o[(j)&3])
  #define STEP(C0,C1,P0,P1,t,GK,GV,GL) do{ SBAR(); \
    const lds_cptr vp_=vp0+2*sl_prev; \
    VRD(0,0); SBAR(); float sacc=(P0[0]+P0[1]); \
    GAPA(C0=MFMA(kf[0],qr[0],negm), P0[2],P0[3],P0[4],P0[5],     pw0[0]=PKW(P0,0), pw0[1]=PKW(P0,2), pw0); \
    VRD(1,1); SBAR(); GAPA(C1=MFMA(kf[1],qr[0],negm), P0[6],P0[7],P0[8],P0[9],     pw0[2]=PKW(P0,4), pw0[3]=PKW(P0,6), pw0); \
    VRD(2,2); SBAR(); GAPA(C0=MFMA(kf[2],qr[1],C0),   P0[10],P0[11],P0[12],P0[13], pw1[0]=PKW(P0,8), pw1[1]=PKW(P0,10), pw1); \
    VRD(3,3); SBAR(); GAPA(C1=MFMA(kf[3],qr[1],C1),   P0[14],P0[15],P1[0],P1[1],   pw1[2]=PKW(P0,12),pw1[3]=PKW(P0,14), pw1); \
    VRD(4,4); SBAR(); GAPA(C0=MFMA(kf[4],qr[2],C0),   P1[2],P1[3],P1[4],P1[5],     pw2[0]=PKW(P1,0), pw2[1]=PKW(P1,2), pw2); \
    VRD(5,5); SBAR(); GAPA(C1=MFMA(kf[5],qr[2],C1),   P1[6],P1[7],P1[8],P1[9],     pw2[2]=PKW(P1,4), pw2[3]=PKW(P1,6), pw2); \
    VRD(6,6); SBAR(); GAPA(C0=MFMA(kf[6],qr[3],C0),   P1[10],P1[11],P1[12],P1[13], pw3[0]=PKW(P1,8), pw3[1]=PKW(P1,10), pw3); \
    VRD(7,7); SBAR(); GAPA(C1=MFMA(kf[7],qr[3],C1),   P1[14],P1[15],0.f,0.f,       pw3[2]=PKW(P1,12),pw3[3]=PKW(P1,14), pw3); \
    l_reg+=sacc; \
    if(GK){DMA_K((t)+3,sl_cur);} if(GV){DMA_V((t)+1,sl_next);} \
    CMASK(C0,C1,t); \
    { float a=MX3(C0[0],C0[1],C1[0]),b_=MX3(C0[2],C0[3],C1[1]); a=MX3(a,C1[2],C1[3]); \
      _Pragma("unroll") for(int r=4;r<16;r+=4){a=MX3(a,C0[r],C0[r+1]);b_=MX3(b_,C0[r+2],C0[r+3]);a=MX3(a,C1[r],C1[r+1]);b_=MX3(b_,C1[r+2],C1[r+3]);} \
      float rm=__builtin_fmaxf(a,b_); { auto rr=__builtin_amdgcn_permlane32_swap(__float_as_uint(rm),__float_as_uint(rm),false,false); rm=__builtin_fmaxf(__uint_as_float(rr[0]),__uint_as_float(rr[1])); } \
      resc=false; \
      if(__builtin_expect(__any(rm>(float)THRL),0)){ const float dl=__builtin_fmaxf(rm,0.f); mhat+=dl; \
        _Pragma("unroll") for(int r=0;r<16;++r){C0[r]-=dl;C1[r]-=dl;} \
        _Pragma("unroll") for(int r=0;r<16;++r)negm[r]=-mhat; asm volatile("":"+v"(negm)); \
        const float f=__builtin_amdgcn_exp2f(-dl); l_reg*=f; if(hi==0)wsf[r32]=f; resc=true; } } \
    SBAR(); \
    GAPB(PVM(0,PAF(0)),C0,0);  VRD(0,8);  SBAR(); \
    GAPB(PVM(1,PAF(0)),C0,2);  VRD(1,9);  SBAR(); \
    GAPB(PVM(2,PAF(0)),C0,4);  VRD(2,10); SBAR(); \
    GAPB(PVM(3,PAF(0)),C0,6);  VRD(3,11); SBAR(); \
    GAPB(PVM(4,PAF(1)),C0,8);  VRD(4,12); SBAR(); \
    GAPB(PVM(5,PAF(1)),C0,10); VRD(5,13); SBAR(); \
    GAPB(PVM(6,PAF(1)),C0,12); VRD(6,14); SBAR(); \
    GAPB(PVM(7,PAF(1)),C0,14); VRD(7,15); SBAR(); \
    GAPB(PVM(8,PAF(2)),C1,0); \
    GAPB(PVM(9,PAF(2)),C1,2); \
    KRD(GL,0); GAPB(PVM(10,PAF(2)),C1,4); \
    KRD(GL,1); GAPB(PVM(11,PAF(2)),C1,6); \
    KRD(GL,2); GAPB(PVM(12,PAF(3)),C1,8); \
    KRD(GL,3); GAPB(PVM(13,PAF(3)),C1,10); \
    GAPB(PVM(14,PAF(3)),C1,12); \
    GAPB(PVM(15,PAF(3)),C1,14); \
    }while(0)
  int t=1;
  #undef CMASK
  #define CMASK(P0,P1,t) do{}while(0)
  for(;t+5<NT;t+=2){
    STEP(pB0,pB1,pA0,pA1,t,true,true,true);     WAIT_BAR2(3); RESC(); ROT();
    STEP(pA0,pA1,pB0,pB1,t+1,true,true,true);   WAIT_BAR2(3); RESC(); ROT();
  }
  #undef CMASK
  #define CMASK(P0,P1,t) do{int jb_=(t)-(NT-4); if(jb_>=0)cmask(P0,P1,jb_,qrel,hi);}while(0)
  #define ENDW(tt) do{ if((tt)+3<NT){WAIT_BAR2(3);} else if((tt)+2<NT){WAIT_BAR2(2);} else {WAIT_BAR2(0);} }while(0)
  for(;t+1<NT;t+=2){
    STEP(pB0,pB1,pA0,pA1,t,(t+3<NT),(t+1<NT),(t+1<NT));       ENDW(t);   RESC(); ROT();
    STEP(pA0,pA1,pB0,pB1,t+1,(t+4<NT),(t+2<NT),(t+2<NT));     ENDW(t+1); RESC(); ROT();
  }
  STEP(pB0,pB1,pA0,pA1,NT-1,false,false,false); RESC();
  { float sacc=pB0[0]+pB0[1]; _Pragma("unroll") for(int r=2;r<16;++r)sacc+=pB0[r]; _Pragma("unroll") for(int r=0;r<16;++r)sacc+=pB1[r]; l_reg+=sacc;
    pw0=(u32x4){PKW(pB0,0),PKW(pB0,2),PKW(pB0,4),PKW(pB0,6)};pw1=(u32x4){PKW(pB0,8),PKW(pB0,10),PKW(pB0,12),PKW(pB0,14)};pw2=(u32x4){PKW(pB1,0),PKW(pB1,2),PKW(pB1,4),PKW(pB1,6)};pw3=(u32x4){PKW(pB1,8),PKW(pB1,10),PKW(pB1,12),PKW(pB1,14)};
    SBAR(); const lds_cptr vp_=vp0+2*sl_cur;
    #pragma unroll
    for(int d0=0;d0<4;++d0){
      #pragma unroll
      for(int ks=0;ks<4;++ks){ vlo[ks]=vtr(vp_+d0*4096+ks*1024); vhi[ks]=vtr(vp_+d0*4096+ks*1024+512); }
      o[d0]=MFMA(PAF(0),VFR(0),o[d0]); o[d0]=MFMA(PAF(1),VFR(1),o[d0]); o[d0]=MFMA(PAF(2),VFR(2),o[d0]); o[d0]=MFMA(PAF(3),VFR(3),o[d0]); } }
  #undef PKW
  #undef PAF
  #undef PAFI
  #undef VFR
  #undef PIN
  #undef MX3
  #undef MFMA
  #undef GAPA
  #undef GAPB
  #undef EX
  #undef VOFF
  #undef VRD
  #undef KRD
  #undef PVM
  #undef STEP
  #undef ENDW
  {auto rr=__builtin_amdgcn_permlane32_swap(__float_as_uint(l_reg),__float_as_uint(l_reg),false,false);l_reg=__uint_as_float(rr[0])+__uint_as_float(rr[1]);}
  if(hi==0)wsf[32+r32]=l_reg;asm volatile("s_waitcnt lgkmcnt(0)":::"memory");
  float rli[16];
  #pragma unroll
  for(int r=0;r<16;++r)rli[r]=__builtin_amdgcn_rcpf(wsf[32+crow(r,hi)]);
  bf16*Ow=O+(rowbase+q0+wid*QBLK)*DMO;
  { bf16*stg=(bf16*)(shm+LDS2_OST)+wid*2048;
    #pragma unroll
    for(int hh=0;hh<2;++hh){
      #pragma unroll
      for(int r=0;r<16;++r){const int orow=crow(r,hi);
        #pragma unroll
        for(int d0=0;d0<2;++d0)stg[orow*64+d0*32+r32]=__float2bfloat16(o[hh*2+d0][r]*rli[r]);}
      asm volatile("s_waitcnt lgkmcnt(0)":::"memory");
      #pragma unroll
      for(int i=0;i<4;++i){const int row=i*8+(lane>>3),ch=lane&7; const u32x4 v=*(const u32x4*)(stg+row*64+ch*8); ATTN_STORE16(Ow+(long)row*DMO+hh*64+ch*8,v);}
      asm volatile("s_waitcnt lgkmcnt(0)":::"memory"); } }
  asm volatile("s_waitcnt lgkmcnt(0)\n\ts_barrier":::"memory");
  #undef DMA_K
  #undef DMA_V
  #undef CMASK
  #undef RESC
  #undef ROT
}
struct AttnUnit2 { int bhm; int qb; };
struct StaticOrder2 {
  int vcu;
  __device__ __forceinline__ explicit StaticOrder2(int grid,int block):vcu((grid%8==0)?(block%8)*(grid/8)+block/8:block){}
  __device__ __forceinline__ bool next(int i,AttnUnit2&u)const{ const int L=vcu; if(i>=8||L>=256)return false; const int j=L&7; u.bhm=L>>3; u.qb=8*i+((i&1)?7-j:j); return true; }
};
template<class Sched,int THRL=8> __device__ __forceinline__ void attn_phase2(char*lds,const AttnTensors&T,const Sched&S){
  AttnUnit2 u;
  for(int i=0;S.next(i,u);++i){ const int b=u.bhm>>4,hm=u.bhm&15;
    attn_unit2<THRL>(b,u.qb,T.QKV+hm*64,T.QKV+1024+hm*64,T.QKV+2048+(hm>>1)*128,T.O+hm*128,lds); }
}
#undef SBAR
#undef WAIT_BAR
}
#define GAS __attribute__((address_space(1)))
#define LAS __attribute__((address_space(3)))
typedef unsigned short bf16;
typedef unsigned v4u __attribute__((ext_vector_type(4)));
typedef float f32x4 __attribute__((ext_vector_type(4)));
typedef short bf16x8 __attribute__((ext_vector_type(8)));
typedef GAS unsigned gu32;
typedef GAS unsigned long long gu64;
#define RLX_AGENT __ATOMIC_RELAXED, __HIP_MEMORY_SCOPE_AGENT
#define LDS_WAIT() asm volatile("s_waitcnt lgkmcnt(0)" ::: "memory")
#define VM_WAIT() asm volatile("s_waitcnt vmcnt(0)" ::: "memory")
__device__ __forceinline__ unsigned long long rt() { return __builtin_amdgcn_s_memrealtime(); }
__device__ __forceinline__ unsigned f2bf(float f) { unsigned u = __builtin_bit_cast(unsigned, f); return (u + 0x7fffu + ((u >> 16) & 1u)) >> 16; }
__device__ __forceinline__ unsigned pk2(float lo, float hi) { return f2bf(lo) | (f2bf(hi) << 16); }

#define XB_TMO      128
#define XB_XCNT(j)  (256  + 64 * (j))
#define XB_XSUB(j)  (1280 + 64 * (j))
#define XB_XGEN(j)  (2304 + 64 * (j))
#define XB_TOP      3328
#define XB_TOPGEN   3392
#define XCD_BAR_WORDS 3456
#define XB_SPIN_CAP (1u << 18)

__device__ __forceinline__ unsigned xb_ld(unsigned* p)              { return __hip_atomic_load(p, __ATOMIC_RELAXED, __HIP_MEMORY_SCOPE_AGENT); }
__device__ __forceinline__ unsigned xb_add(unsigned* p, unsigned v) { return __hip_atomic_fetch_add(p, v, __ATOMIC_RELAXED, __HIP_MEMORY_SCOPE_AGENT); }
__device__ __forceinline__ unsigned xb_xcc_id() { return (unsigned)__builtin_amdgcn_s_getreg((3 << 11) | 20) & 0xFu; }
#define XB_SPIN(cond, bar) do { unsigned _sp = 0; while (cond) { __builtin_amdgcn_s_sleep(1); \
    if ((++_sp & 255u) == 0u) { if (xb_ld(&(bar)[XB_TMO])) break; if (_sp > XB_SPIN_CAP) { atomicAdd(&(bar)[XB_TMO], 1u); break; } } } } while (0)

struct XcdBarrier {
    unsigned* bar; unsigned x;
    volatile LAS unsigned* st;
};

__device__ __forceinline__ XcdBarrier xcd_barrier_post(unsigned* bar, volatile LAS unsigned* st) {
    XcdBarrier b; b.bar = bar; b.x = xb_xcc_id(); b.st = st;
    if (threadIdx.x == 0) (void)xb_add(&bar[XB_XCNT(b.x)], 1u);
    return b;
}
__device__ __forceinline__ void xcd_barrier_complete(unsigned* bar, unsigned x, unsigned& nloc, unsigned& nx) {
    const unsigned G = gridDim.x * gridDim.y * gridDim.z;
    unsigned sum, cnt, mine, sp = 0u;
    for (;;) {
        sum = 0u; cnt = 0u; mine = 0u;
#pragma unroll
        for (unsigned j = 0; j < 16; ++j) { const unsigned c = xb_ld(&bar[XB_XCNT(j)]); sum += c; cnt += (c > 0u) ? 1u : 0u; mine = (j == x) ? c : mine; }
        if (sum == G) break;
        __builtin_amdgcn_s_sleep(1);
        if ((++sp & 255u) == 0u) { if (xb_ld(&bar[XB_TMO])) break; if (sp > XB_SPIN_CAP) { atomicAdd(&bar[XB_TMO], 1u); break; } }
    }
    nloc = mine > 0u ? mine : 1u; nx = cnt > 0u ? cnt : 1u;
}

__device__ __forceinline__ void xcd_barrier(const XcdBarrier& b) {
    asm volatile("s_waitcnt vmcnt(0)" ::: "memory");
    __syncthreads();
    if (threadIdx.x == 0) {
        unsigned* bar = b.bar;
        __builtin_amdgcn_s_waitcnt(0);
        unsigned nloc = b.st[0], nx = b.st[1];
        if (nloc == 0u) { xcd_barrier_complete(bar, b.x, nloc, nx); b.st[0] = nloc; b.st[1] = nx; }
        const unsigned old = xb_add(&bar[XB_XSUB(b.x)], 1u);
        const unsigned gen = old / nloc;
        if (old + 1u == (gen + 1u) * nloc) {
            __builtin_amdgcn_fence(__ATOMIC_RELEASE, "agent");
            asm volatile("s_waitcnt vmcnt(0)" ::: "memory");
            const unsigned og = xb_add(&bar[XB_TOP], 1u);
            const unsigned tg = og / nx;
            if (og + 1u == (tg + 1u) * nx) xb_add(&bar[XB_TOPGEN], 1u);
            else XB_SPIN(xb_ld(&bar[XB_TOPGEN]) == tg, bar);
            __builtin_amdgcn_fence(__ATOMIC_ACQUIRE, "agent");
            xb_add(&bar[XB_XGEN(b.x)], 1u);
            asm volatile("s_waitcnt vmcnt(0)" ::: "memory");
        } else {
            XB_SPIN(xb_ld(&bar[XB_XGEN(b.x)]) == gen, bar);
            __builtin_amdgcn_fence(__ATOMIC_ACQUIRE, "agent");
            asm volatile("s_waitcnt vmcnt(0)" ::: "memory");
        }
    }
    __syncthreads();
}
constexpr int NWAVES = 8;
constexpr int DMODEL = 2048, NBATCH = 2, SEQ = 16384, DEPTH = 4, MT = NBATCH * SEQ, NMEM = 256, FF = 5632, INW = 4096;
constexpr int UGP = 1152;
constexpr float ALPHA = 1.6817928305074290f, LN_EPS = 1e-5f, RMS_EPS = 1e-5f;
constexpr int NIN = 37;
enum InIdx { I_X = 0, I_MEM, I_F1G, I_F1U, I_F1D, I_LN1G, I_LN1B, I_WIN, I_LQ1, I_LK1, I_LQ2, I_LK2, I_DNG, I_SLRE, I_SLIM, I_SLOG, I_SBRE, I_SBIM, I_SCRE, I_SCIM, I_SD, I_GLUW, I_GLUB,
             I_WOUT, I_LN2G, I_LN2B, I_XQ, I_XK, I_XV, I_XO, I_LN3G, I_LN3B, I_F2G, I_F2U, I_F2D, I_LN4G, I_LN4B };

constexpr size_t MiB = 1u << 20;
constexpr size_t WS_CTL = 0, CTL_ZERO_BYTES = 6 * MiB;
constexpr size_t WS_CS = 1 * MiB;
constexpr int CSL = 57344, CS1 = 0, CB1 = 11264, CS2 = 22528, CB2 = 33792, CSW = 45056, CBW = 49152, CSM = 53248, CBM = 55296;
constexpr size_t WS_ST = 2 * MiB;
constexpr size_t WS_XB = 6 * MiB;
constexpr size_t WS_YLO = WS_XB + 128 * MiB;
constexpr size_t WS_BIG = WS_YLO + 128 * MiB;
constexpr size_t WS_HMID = WS_BIG;
constexpr size_t WS_QKV = WS_BIG;
constexpr size_t WS_UG = WS_BIG + 192 * MiB;
constexpr size_t WS_OV = WS_BIG + 264 * MiB;
constexpr size_t WS_SC = WS_BIG;
constexpr size_t WS_PB = WS_BIG + 128 * MiB;
constexpr size_t WS_MIX = WS_BIG + 392 * MiB;
constexpr size_t WS_YG = WS_MIX + 128 * MiB;
constexpr size_t WS_VS = WS_YG + 64 * MiB;
constexpr size_t WS_W = WS_VS + 16 * MiB;
constexpr size_t WS_W1GU = WS_W, WS_W1D = WS_W1GU + 44 * MiB, WS_W2GU = WS_W1D + 22 * MiB, WS_W2D = WS_W2GU + 44 * MiB, WS_WIN = WS_W2D + 22 * MiB, WS_WGLU = WS_WIN + 16 * MiB,
                 WS_WOUT = WS_WGLU + 2 * MiB, WS_WQN = WS_WOUT + 8 * MiB, WS_WKVT = WS_WQN + 8 * MiB, WS_WOT = WS_WKVT + 16 * MiB, WS_TG = WS_WOT + 8 * MiB, WS_EM = WS_TG + 144 * MiB;
constexpr size_t WS_MEMB = WS_EM + 17 * MiB;
constexpr size_t WS_KVM = WS_MEMB + 2 * MiB;
constexpr size_t WS_MQT = WS_KVM + 4 * MiB;
constexpr size_t WS_VWOT = WS_MQT + 8 * MiB;
constexpr size_t WS_END = WS_VWOT + 8 * MiB;
constexpr int CW_TMO = 0, CW_CODE = 1, CW_BAR = 4096;

constexpr int RING_OFF = 0, RING_BYTES = 131072;
constexpr int LDSCTL_OFF = RING_BYTES, MISC_OFF = LDSCTL_OFF + 320;
constexpr int XCH_OFF = LDSCTL_OFF + 1024;
constexpr int GB_OFF = LDSCTL_OFF + 1024;
constexpr int XST_OFF = GB_OFF + 16384;
static_assert(XST_OFF == GB_OFF + 4096 * 4, "the residual epilogue finds its table right behind the gain | bias image");
constexpr int LDS_BYTES = 163840;
typedef float f32x2v __attribute__((ext_vector_type(2)));
__device__ __forceinline__ float wave_sum(float v) {
    v += pg8::sw_xor<1>(v); v += pg8::sw_xor<2>(v); v += pg8::sw_xor<4>(v); v += pg8::sw_xor<8>(v); v += pg8::sw_xor<16>(v); return pg8::add_xor32(v);
}
__device__ __forceinline__ float wave_max(float v) {
    v = fmaxf(v, pg8::sw_xor<1>(v)); v = fmaxf(v, pg8::sw_xor<2>(v)); v = fmaxf(v, pg8::sw_xor<4>(v)); v = fmaxf(v, pg8::sw_xor<8>(v)); v = fmaxf(v, pg8::sw_xor<16>(v)); return pg8::max_xor32(v);
}
__device__ __forceinline__ unsigned pkbf(float lo, float hi) { return pg8::cvt_pk_bf16(lo, hi); }
struct RmId { __device__ __forceinline__ int operator()(int n0) const { return n0; } };
struct RmGate { int add; __device__ __forceinline__ int operator()(int n0) const { return (n0 >> 7) * 256 + (n0 & 127) + add; } };
template <class RM> __device__ __forceinline__ void conv_T(const float* __restrict__ W, int K, int N, bf16* WT, int ldt, RM rm, const float* gk, const float* bk, float* cs, float* cb, LAS float* scr, int gw, int NGW, int lane, int rot, float wscale = 1.0f) {
    const int nblk = N / 32, nchunks = (K / 512) * nblk, c = lane & 7, r8 = lane >> 3;
    for (int chunk = (gw + NGW - rot % NGW) % NGW; chunk < nchunks; chunk += NGW) {
        const int kc = chunk / nblk, nb = chunk - kc * nblk, n0 = 32 * nb, drow0 = rm(n0);
        const float* wp = W + (size_t)(kc * 512 + r8) * N + n0 + 4 * c;
        float a1[4] = {0.f, 0.f, 0.f, 0.f}, a2[4] = {0.f, 0.f, 0.f, 0.f};
        f32x4 ld[8];
#pragma unroll
        for (int i = 0; i < 8; ++i) ld[i] = __builtin_nontemporal_load((const GAS f32x4*)(wp + (size_t)(8 * i) * N));
#pragma unroll 1
        for (int j = 0; j < 8; ++j) {
            const int k0 = kc * 512 + 64 * j;
#pragma unroll
            for (int i = 0; i < 8; ++i) { LAS float* d = scr + (8 * i + r8) * 33 + 4 * c; d[0] = ld[i][0]; d[1] = ld[i][1]; d[2] = ld[i][2]; d[3] = ld[i][3]; }
            if (j < 7) {
#pragma unroll
                for (int i = 0; i < 8; ++i) ld[i] = __builtin_nontemporal_load((const GAS f32x4*)(wp + (size_t)(64 * (j + 1) + 8 * i) * N)); }
            f32x4 g0, g1, b0, b1;
            if (gk) { g0 = *(const GAS f32x4*)(gk + k0 + 8 * c); g1 = *(const GAS f32x4*)(gk + k0 + 8 * c + 4); b0 = *(const GAS f32x4*)(bk + k0 + 8 * c); b1 = *(const GAS f32x4*)(bk + k0 + 8 * c + 4); }
            LDS_WAIT(); asm volatile("" ::: "memory");
#pragma unroll
            for (int jj = 0; jj < 4; ++jj) { const int n = r8 + 8 * jj; const LAS float* s = scr + (8 * c) * 33 + n;
                float w[8];
#pragma unroll
                for (int e = 0; e < 8; ++e) w[e] = s[e * 33] * wscale;
                v4u o;
                if (gk) {
                    o.x = pkbf(w[0] * g0[0], w[1] * g0[1]); o.y = pkbf(w[2] * g0[2], w[3] * g0[3]); o.z = pkbf(w[4] * g1[0], w[5] * g1[1]); o.w = pkbf(w[6] * g1[2], w[7] * g1[3]);
                    a1[jj] += (pg8::bf_lo(o.x) + pg8::bf_hi(o.x)) + (pg8::bf_lo(o.y) + pg8::bf_hi(o.y)) + (pg8::bf_lo(o.z) + pg8::bf_hi(o.z)) + (pg8::bf_lo(o.w) + pg8::bf_hi(o.w));
                    a2[jj] += (w[0] * b0[0] + w[1] * b0[1]) + (w[2] * b0[2] + w[3] * b0[3]) + (w[4] * b1[0] + w[5] * b1[1]) + (w[6] * b1[2] + w[7] * b1[3]);
                } else { o.x = pkbf(w[0], w[1]); o.y = pkbf(w[2], w[3]); o.z = pkbf(w[4], w[5]); o.w = pkbf(w[6], w[7]); }
                *(GAS v4u*)(WT + (size_t)(drow0 + n) * ldt + k0 + 8 * c) = o; }
            LDS_WAIT(); asm volatile("" ::: "memory");
        }
        if (gk) {
#pragma unroll
            for (int jj = 0; jj < 4; ++jj) { float s1 = a1[jj], s2 = a2[jj];
                s1 += pg8::sw_xor<1>(s1); s1 += pg8::sw_xor<2>(s1); s1 += pg8::sw_xor<4>(s1); s2 += pg8::sw_xor<1>(s2); s2 += pg8::sw_xor<2>(s2); s2 += pg8::sw_xor<4>(s2);
                if (c == 0) { unsafeAtomicAdd(cs + drow0 + r8 + 8 * jj, s1); unsafeAtomicAdd(cb + drow0 + r8 + 8 * jj, s2); } } }
    }
}
__device__ __forceinline__ void conv_copy(const float* __restrict__ W, bf16* O, size_t n, int gw, int NGW, int lane) {
    for (size_t i = ((size_t)gw * 64 + lane) * 8; i < n; i += (size_t)NGW * 64 * 8) {
        const f32x4 a = *(const GAS f32x4*)(W + i), b = *(const GAS f32x4*)(W + i + 4);
        v4u o; o.x = pkbf(a[0], a[1]); o.y = pkbf(a[2], a[3]); o.z = pkbf(b[0], b[1]); o.w = pkbf(b[2], b[3]);
        *(GAS v4u*)(O + i) = o; }
}
__device__ __forceinline__ void ln_rows(const float* Y, const float* __restrict__ g, const float* __restrict__ b, float* X32, bf16* XB, int gw, int NGW, int lane) {
    f32x4 gg[8], bb[8];
#pragma unroll
    for (int j = 0; j < 8; ++j) { gg[j] = *(const GAS f32x4*)(g + 4 * lane + 256 * j); bb[j] = *(const GAS f32x4*)(b + 4 * lane + 256 * j); }
    for (int m = gw; m < MT; m += NGW) {
        const GAS f32x4* yr = (const GAS f32x4*)(Y + (size_t)m * DMODEL) + lane;
        f32x4 v[8]; float s = 0.f;
#pragma unroll
        for (int j = 0; j < 8; ++j) { v[j] = yr[64 * j]; s += (v[j][0] + v[j][1]) + (v[j][2] + v[j][3]); }
        const float mean = wave_sum(s) * (1.f / DMODEL); float s2 = 0.f;
#pragma unroll
        for (int j = 0; j < 8; ++j) { v[j] = v[j] - mean; s2 += (v[j][0] * v[j][0] + v[j][1] * v[j][1]) + (v[j][2] * v[j][2] + v[j][3] * v[j][3]); }
        const float rstd = 1.f / sqrtf(wave_sum(s2) * (1.f / DMODEL) + LN_EPS);
        GAS f32x4* xo = (GAS f32x4*)(X32 + (size_t)m * DMODEL) + lane;
        GAS unsigned long long* o8 = (GAS unsigned long long*)(XB + (size_t)m * DMODEL) + lane;
#pragma unroll
        for (int j = 0; j < 8; ++j) { const f32x4 o = v[j] * rstd * gg[j] + bb[j]; xo[64 * j] = o;
            if (XB) o8[64 * j] = (unsigned long long)pkbf(o[0], o[1]) | ((unsigned long long)pkbf(o[2], o[3]) << 32); }
    }
}
__device__ __forceinline__ void final_ln_planes(const bf16* XB, const pg8::u32x4* LO8, const float* st, const float* g, const float* b, float* out, int gw, int NGW, int lane) {
    const int fq = lane >> 4, fr = lane & 15;
    for (int it = gw; it < 1024 * 64; it += NGW) {
        const int am = it & 7, wv = (it >> 3) & 7, tile = it >> 6, pm = tile >> 3, pn = tile & 7, wr = wv >> 2, wc = wv & 3, ai = am >> 2, mm = am & 3;
        const int r = pm * 256 + ai * 128 + wr * 64 + mm * 16 + fr, col0 = pn * 256 + wc * 32 + 8 * fq;
        const pg8::u32x4 lo = LO8[(size_t)it * 64 + lane];
        const v4u h0 = *(const GAS v4u*)(XB + (size_t)r * DMODEL + col0), h1 = *(const GAS v4u*)(XB + (size_t)r * DMODEL + col0 + 128);
        const f32x2v s = *(const GAS f32x2v*)(st + 2 * (size_t)r);
        const float mu = s.x * (1.0f / 2048.0f), rs = __builtin_amdgcn_rsqf(s.y * (1.0f / 2048.0f) - mu * mu + LN_EPS);
#pragma unroll
        for (int bj = 0; bj < 2; ++bj) { const v4u h = bj ? h1 : h0; const unsigned w0 = bj ? lo.z : lo.x, w1 = bj ? lo.w : lo.y; const int c = col0 + bj * 128;
            const f32x2v a0 = __builtin_amdgcn_cvt_pk_f32_fp8((int)w0, false), a1 = __builtin_amdgcn_cvt_pk_f32_fp8((int)w0, true), a2 = __builtin_amdgcn_cvt_pk_f32_fp8((int)w1, false), a3 = __builtin_amdgcn_cvt_pk_f32_fp8((int)w1, true);
            const f32x4 y0 = {pg8::bf_lo(h[0]) + a0.x * 0.00390625f, pg8::bf_hi(h[0]) + a0.y * 0.00390625f, pg8::bf_lo(h[1]) + a1.x * 0.00390625f, pg8::bf_hi(h[1]) + a1.y * 0.00390625f};
            const f32x4 y1 = {pg8::bf_lo(h[2]) + a2.x * 0.00390625f, pg8::bf_hi(h[2]) + a2.y * 0.00390625f, pg8::bf_lo(h[3]) + a3.x * 0.00390625f, pg8::bf_hi(h[3]) + a3.y * 0.00390625f};
            const f32x4 g0 = *(const GAS f32x4*)(g + c), g1 = *(const GAS f32x4*)(g + c + 4), b0 = *(const GAS f32x4*)(b + c), b1 = *(const GAS f32x4*)(b + c + 4);
            *(GAS f32x4*)(out + (size_t)r * DMODEL + c) = (y0 - mu) * rs * g0 + b0; *(GAS f32x4*)(out + (size_t)r * DMODEL + c + 4) = (y1 - mu) * rs * g1 + b1; }
    }
}
__device__ __forceinline__ void softmax_rows(const float* __restrict__ SC, bf16* PB, int gw, int NGW, int lane) {
    for (int m = gw; m < MT; m += NGW) {
        const GAS f32x4* sr = (const GAS f32x4*)(SC + (size_t)m * 1024) + lane;
        GAS unsigned long long* o8 = (GAS unsigned long long*)(PB + (size_t)m * 1024) + lane;
        f32x4 v[4];
#pragma unroll
        for (int j = 0; j < 4; ++j) v[j] = sr[64 * j];
#pragma unroll
        for (int j = 0; j < 4; ++j) {
            const float mx = wave_max(fmaxf(fmaxf(v[j][0], v[j][1]), fmaxf(v[j][2], v[j][3])));
            f32x4 e;
#pragma unroll
            for (int k = 0; k < 4; ++k) e[k] = __builtin_amdgcn_exp2f((v[j][k] - mx) * 1.4426950408889634f);
            const float inv = 1.0f / wave_sum((e[0] + e[1]) + (e[2] + e[3]));
            o8[64 * j] = (unsigned long long)pkbf(e[0] * inv, e[1] * inv) | ((unsigned long long)pkbf(e[2] * inv, e[3] * inv) << 32);
        }
    }
}
__device__ __forceinline__ void diff_combine(const bf16* __restrict__ OV, bf16* MIX, const float* lq1, const float* lk1, const float* lq2, const float* lk2, const float* ng, float lam_init, int gw, int NGW, int lane) {
    const float s1 = wave_sum(lq1[lane] * lk1[lane]), s2 = wave_sum(lq2[lane] * lk2[lane]);
    const float lam = expf(s1) - expf(s2) + lam_init, osc = 1.0f - lam_init;
    const int h = lane >> 3, d0 = (lane & 7) * 16;
    float gn[16];
#pragma unroll
    for (int e = 0; e < 16; ++e) gn[e] = ng[d0 + e] * osc;
    for (int m0 = gw; m0 < MT; m0 += 2 * NGW) {
        const int m1 = m0 + NGW; const bool has1 = m1 < MT;
        const bf16* o1 = OV + (size_t)m0 * 2048 + h * 256 + d0; const bf16* p1 = OV + (size_t)(has1 ? m1 : m0) * 2048 + h * 256 + d0;
        v4u q[2][4];
        q[0][0] = *(const GAS v4u*)o1; q[0][1] = *(const GAS v4u*)(o1 + 8); q[0][2] = *(const GAS v4u*)(o1 + 128); q[0][3] = *(const GAS v4u*)(o1 + 136);
        q[1][0] = *(const GAS v4u*)p1; q[1][1] = *(const GAS v4u*)(p1 + 8); q[1][2] = *(const GAS v4u*)(p1 + 128); q[1][3] = *(const GAS v4u*)(p1 + 136);
#pragma unroll
        for (int t = 0; t < 2; ++t) { if (t == 1 && !has1) break;
            const v4u a0 = q[t][0], a1 = q[t][1], b0 = q[t][2], b1 = q[t][3]; float x[16];
#pragma unroll
            for (int k = 0; k < 4; ++k) { x[2 * k] = pg8::bf_lo(a0[k]) - lam * pg8::bf_lo(b0[k]); x[2 * k + 1] = pg8::bf_hi(a0[k]) - lam * pg8::bf_hi(b0[k]);
                x[8 + 2 * k] = pg8::bf_lo(a1[k]) - lam * pg8::bf_lo(b1[k]); x[8 + 2 * k + 1] = pg8::bf_hi(a1[k]) - lam * pg8::bf_hi(b1[k]); }
            float ss = 0.f;
#pragma unroll
            for (int e = 0; e < 16; ++e) ss += x[e] * x[e];
            ss += pg8::sw_xor<1>(ss); ss += pg8::sw_xor<2>(ss); ss += pg8::sw_xor<4>(ss);
            const float r = __builtin_amdgcn_rsqf(ss * (1.0f / 128.0f) + RMS_EPS);
            v4u w0, w1;
#pragma unroll
            for (int k = 0; k < 4; ++k) { w0[k] = pkbf(x[2 * k] * r * gn[2 * k], x[2 * k + 1] * r * gn[2 * k + 1]); w1[k] = pkbf(x[8 + 2 * k] * r * gn[8 + 2 * k], x[8 + 2 * k + 1] * r * gn[8 + 2 * k + 1]); }
            bf16* op = MIX + (size_t)(t ? m1 : m0) * 2048 + h * 128 + d0;
            *(GAS v4u*)op = w0; *(GAS v4u*)(op + 8) = w1; }
    }
}
__device__ __forceinline__ void cpow(float rez, float imz, int tau, float& re, float& im) {
    double rev = (double)imz * (double)tau * 0.15915494309189535; rev -= __builtin_rint(rev);
    const float mg = __builtin_amdgcn_exp2f(rez * (float)tau * 1.4426950408889634f), rv = (float)rev;
    re = mg * __builtin_amdgcn_cosf(rv); im = mg * __builtin_amdgcn_sinf(rv);
}
__device__ __forceinline__ void ssm_prep(const float* lam_re, const float* lam_im, const float* log_step, const float* b_re, const float* b_im, const float* c_re, const float* c_im,
                                         bf16* TG, bf16* EM, LAS unsigned char* lds, int vcu, int G, int tid, bool skipz) {
    LAS float* APre = (LAS float*)lds;
    LAS float* APim = APre + 65 * 64;
    LAS float* BBre = APim + 65 * 64;
    LAS float* BBim = BBre + 1024;
    LAS float* CCre = BBim + 1024;
    LAS float* CCim = CCre + 256;
    LAS float* KT = CCim + 256;
    for (int item = vcu; item < 256; item += G) {
        const int g = item >> 2, pb = item & 3;
        const float step = expf(log_step[g]);
        for (int e = tid; e < 65 * 64; e += NWAVES * 64) { const int tau = e >> 6, n = e & 63; const float lr = fminf(lam_re[g * 64 + n], -1e-4f), li = lam_im[g * 64 + n];
            float re, im; cpow(lr * step, li * step, tau, re, im); APre[e] = re; APim[e] = im; }
        for (int e = tid; e < 1024; e += NWAVES * 64) { const int n = e >> 4; const float lr = fminf(lam_re[g * 64 + n], -1e-4f), li = lam_im[g * 64 + n];
            float ar, ai; cpow(lr * step, li * step, 1, ar, ai);
            const float x = ar - 1.0f, y = ai, den = 1.0f / (lr * lr + li * li);
            const float cr = (x * lr + y * li) * den, ci = (y * lr - x * li) * den;
            const float br = b_re[(size_t)g * 1024 + e], bi = b_im[(size_t)g * 1024 + e];
            BBre[e] = cr * br - ci * bi; BBim[e] = cr * bi + ci * br; }
        for (int e = tid; e < 256; e += NWAVES * 64) { const int pl = e >> 6, n = e & 63; CCre[e] = c_re[(size_t)(g * 16 + 4 * pb + pl) * 64 + n]; CCim[e] = c_im[(size_t)(g * 16 + 4 * pb + pl) * 64 + n]; }
        __syncthreads();
        { const int pq = tid & 63, pl = pq >> 4, q = pq & 15, tb = tid >> 6; float acc[8];
#pragma unroll
          for (int k = 0; k < 8; ++k) acc[k] = 0.f;
          for (int n = 0; n < 64; ++n) { const float cr = CCre[pl * 64 + n], ci = CCim[pl * 64 + n], br = BBre[n * 16 + q], bi = BBim[n * 16 + q];
              const float cbr = cr * br - ci * bi, cbi = cr * bi + ci * br;
#pragma unroll
              for (int k = 0; k < 8; ++k) acc[k] += cbr * APre[(tb * 8 + k) * 64 + n] - cbi * APim[(tb * 8 + k) * 64 + n]; }
#pragma unroll
          for (int k = 0; k < 8; ++k) KT[(tb * 8 + k) * 64 + pq] = acc[k]; }
        __syncthreads();
        for (int idx = tid; idx < 256 * 144; idx += NWAVES * 64) {
            const int rowl = idx / 144, ch = idx - rowl * 144, t = rowl >> 2, pl = rowl & 3; float v[8];
            if (ch >= 16) { const int s = (ch - 16) >> 1, q0 = ((ch - 16) & 1) * 8;
                if (s > (t | 15)) continue;
                if (skipz && s > t) continue;
#pragma unroll
                for (int e = 0; e < 8; ++e) v[e] = (s <= t) ? KT[(t - s) * 64 + pl * 16 + q0 + e] : 0.f;
            } else { const int n0 = ch * 8;
#pragma unroll
                for (int e = 0; e < 8; ++e) { const int n = (n0 + e) & 63; const float cr = CCre[pl * 64 + n], ci = CCim[pl * 64 + n], pr = APre[(t + 1) * 64 + n], pi = APim[(t + 1) * 64 + n];
                    v[e] = (n0 < 64) ? (cr * pr - ci * pi) : -(cr * pi + ci * pr); } }
            v4u o; o.x = pkbf(v[0], v[1]); o.y = pkbf(v[2], v[3]); o.z = pkbf(v[4], v[5]); o.w = pkbf(v[6], v[7]);
            *(GAS v4u*)(TG + (size_t)(g * 1024 + t * 16 + 4 * pb + pl) * UGP + ch * 8) = o;
        }
        for (int idx = tid; idx < 32 * 128; idx += NWAVES * 64) {
            const int rl = idx >> 7, ch = idx & 127, part = rl >> 4, n = 16 * pb + (rl & 15), s = ch >> 1, q0 = (ch & 1) * 8; float v[8];
            const float pr = APre[(63 - s) * 64 + n], pi = APim[(63 - s) * 64 + n];
#pragma unroll
            for (int e = 0; e < 8; ++e) { const float br = BBre[n * 16 + q0 + e], bi = BBim[n * 16 + q0 + e]; v[e] = part ? (pr * bi + pi * br) : (pr * br - pi * bi); }
            v4u o; o.x = pkbf(v[0], v[1]); o.y = pkbf(v[2], v[3]); o.z = pkbf(v[4], v[5]); o.w = pkbf(v[6], v[7]);
            *(GAS v4u*)(EM + (size_t)(g * 128 + part * 64 + n) * 1024 + ch * 8) = o;
        }
        __syncthreads();
    }
}
__device__ __forceinline__ void ssm_scan8(const float* lam_re, const float* lam_im, const float* log_step, const float* VS, bf16* UG, int gb, int wave, int lane, LAS float* xl) {
    const int g = gb >> 1, b = gb & 1, n = lane;
    const float step = expf(log_step[g]), lr = fminf(lam_re[g * 64 + n], -1e-4f), li = lam_im[g * 64 + n];
    float ar, ai; cpow(lr * step, li * step, 64, ar, ai);
    const float* vs = VS + (size_t)(g * 512 + b * 256 + 32 * wave) * 128 + n; bf16* ug = UG + (size_t)(g * 512 + b * 256 + 32 * wave) * UGP + n;
    float vr[32], vi[32];
#pragma unroll
    for (int k = 0; k < 32; ++k) { vr[k] = vs[(size_t)k * 128]; vi[k] = vs[(size_t)k * 128 + 64]; }
    float hr = 0.f, hi = 0.f;
#pragma unroll
    for (int k = 0; k < 32; ++k) { const float nr = ar * hr - ai * hi + vr[k], ni = ar * hi + ai * hr + vi[k]; hr = nr; hi = ni; }
    xl[(wave * 64 + n) * 2] = hr; xl[(wave * 64 + n) * 2 + 1] = hi;
    float pr = ar, pi = ai;
#pragma unroll
    for (int q = 0; q < 5; ++q) { const float tr = pr * pr - pi * pi, ti = 2.f * pr * pi; pr = tr; pi = ti; }
    asm volatile("s_waitcnt lgkmcnt(0)" ::: "memory"); __syncthreads();
    hr = 0.f; hi = 0.f;
    for (int v = 0; v < wave; ++v) { const float er = xl[(v * 64 + n) * 2], ei = xl[(v * 64 + n) * 2 + 1]; const float nr = pr * hr - pi * hi + er, ni = pr * hi + pi * hr + ei; hr = nr; hi = ni; }
#pragma unroll
    for (int k = 0; k < 32; ++k) { const unsigned w = pkbf(hr, hi); ug[(size_t)k * UGP] = (bf16)(w & 0xffffu); ug[(size_t)k * UGP + 64] = (bf16)(w >> 16);
        const float nr = ar * hr - ai * hi + vr[k], ni = ar * hi + ai * hr + vi[k]; hr = nr; hi = ni; }
    asm volatile("s_waitcnt lgkmcnt(0)" ::: "memory"); __syncthreads();
}

struct MapSsmV   { __device__ __forceinline__ void operator()(pg8::Unit& u) const { u.aoff = u.pm * 256 * UGP; u.boff = (u.pm >> 1) * 128 * 1024; } };
struct MapSsmY   { __device__ __forceinline__ void operator()(pg8::Unit& u) const { if ((u.pm >> 3) & 1) u.pn = 3 - u.pn;
        u.aoff = u.pm * 256 * UGP; u.boff = ((u.pm >> 1) * 1024 + u.pn * 256) * UGP; u.nt = 6 + 4 * u.pn; } };
struct MapMQT    { __device__ __forceinline__ void operator()(pg8::Unit& u) const { const int b = u.pm >> 2, h = u.pm & 3; u.aoff = b * 256 * 4096 + h * 512; u.boff = u.pn * 256 * 2048 + h * 512; } };
struct MapVWOT   { __device__ __forceinline__ void operator()(pg8::Unit& u) const { const int b = u.pm >> 3, nt = u.pm & 7, h = u.pn; u.aoff = nt * 256 * 2048 + h * 512; u.boff = b * 256 * 4096 + 2048 + h * 512; } };
struct MapScores { __device__ __forceinline__ void operator()(pg8::Unit& u) const { u.aoff = u.pm * 256 * 2048; u.boff = ((u.pm >> 6) * 1024 + u.pn * 256) * 2048; } };
struct MapOut    { __device__ __forceinline__ void operator()(pg8::Unit& u) const { u.aoff = u.pm * 256 * 1024; u.boff = ((u.pm >> 6) * 2048 + u.pn * 256) * 1024; } };

#ifndef WGM_N8
#define WGM_N8 4
#endif
#ifndef WGM_FF
#define WGM_FF 4
#endif
#ifndef STAG_G
#define STAG_G 1
#endif
#ifndef STAG_US
#define STAG_US 0
#endif
__device__ __forceinline__ void stagger(int bx, int us) {
    const int grp = (bx >> 3) % STAG_G;
    if (STAG_G > 1 && grp) { const unsigned long long t0 = __builtin_amdgcn_s_memrealtime(), dt = (unsigned long long)(grp * us) * 100ull;
        while (__builtin_amdgcn_s_memrealtime() - t0 < dt) __builtin_amdgcn_s_sleep(16); }
}
struct Args { const float* in[NIN]; float* out; unsigned char* ws; };
#ifndef PHMASK
#define PHMASK 0xFFFFFFFFu
#endif
#define PH(k) ((PHMASK >> (k)) & 1u)
#ifndef PROBE_DUP
#define PROBE_DUP -1
#endif
#ifndef PROBE_DUP2
#define PROBE_DUP2 -1
#endif
#ifndef PROBE_DUP3
#define PROBE_DUP3 -1
#endif
#ifndef PROBE_DUP4
#define PROBE_DUP4 -1
#endif
#define PD(k) (PROBE_DUP == (k) || PROBE_DUP2 == (k) || PROBE_DUP3 == (k) || PROBE_DUP4 == (k))
#define P_DUMY ((float*)(WSP + WS_END))
#define P_DUMXB ((bf16*)(WSP + WS_END + 256 * MiB))
#define P_DUMST ((float*)(WSP + WS_END + 384 * MiB))
#define LOAD_GB(gp, bp) do { const float* g_ = (gp); const float* b_ = (bp); LAS float* d_ = (LAS float*)(ldsl + GB_OFF); \
        for (int i_ = tid; i_ < DMODEL; i_ += NWAVES * 64) { d_[i_] = g_[i_]; d_[DMODEL + i_] = b_[i_]; } __syncthreads(); } while (0)
#define LGB ((LAS const float*)(ldsl + GB_OFF))
#define GEMM_PHASE(EPI, ORD, g, S, E) pg8::gemm_phase<EPI, ORD, true, true>(ldsl + RING_OFF, g, S, E)
#ifndef SWIGLU_ALIGN
#define SWIGLU_ALIGN true
#endif
#define GEMM_PHASE_SW(EPI, ORD, g, S, E) pg8::gemm_phase<EPI, ORD, SWIGLU_ALIGN, true>(ldsl + RING_OFF, g, S, E)
typedef __attribute__((address_space(4))) const unsigned char* kargp_t;
__device__ __forceinline__ kargp_t kargs() { kargp_t p = (kargp_t)__builtin_amdgcn_kernarg_segment_ptr(); asm volatile("" : "+s"(p)); return p; }
#define INP(i) (*(const float* const __attribute__((address_space(4)))*)(kargs() + 8 * (i)))
#define P_X32 (*(float* const __attribute__((address_space(4)))*)(kargs() + 8 * NIN))
#define WSP (*(unsigned char* const __attribute__((address_space(4)))*)(kargs() + 8 * (NIN + 1)))
#define P_XB ((bf16*)(WSP + WS_XB))
#define P_YLO ((pg8::u32x4*)(WSP + WS_YLO))
#define P_CS(l, off) ((float*)(WSP + WS_CS) + (size_t)(l) * CSL + (off))
#define P_ST(i) ((float*)(WSP + WS_ST) + (size_t)(i) * (2 * MT))
#define P_HMID ((bf16*)(WSP + WS_HMID))
#define P_QKV ((bf16*)(WSP + WS_QKV))
#define P_UG ((bf16*)(WSP + WS_UG))
#define P_OV ((bf16*)(WSP + WS_OV))
#define P_SC ((float*)(WSP + WS_SC))
#define P_PB ((bf16*)(WSP + WS_PB))
#define P_MIX ((bf16*)(WSP + WS_MIX))
#define P_YG ((bf16*)(WSP + WS_YG))
#define P_VS ((float*)(WSP + WS_VS))
#define P_W1GU ((bf16*)(WSP + WS_W1GU))
#define P_W1D ((bf16*)(WSP + WS_W1D))
#define P_W2GU ((bf16*)(WSP + WS_W2GU))
#define P_W2D ((bf16*)(WSP + WS_W2D))
#define P_WIN ((bf16*)(WSP + WS_WIN))
#define P_WGLU ((bf16*)(WSP + WS_WGLU))
#define P_WOUT ((bf16*)(WSP + WS_WOUT))
#define P_WQN ((bf16*)(WSP + WS_WQN))
#define P_WKVT ((bf16*)(WSP + WS_WKVT))
#define P_WOT ((bf16*)(WSP + WS_WOT))
#define P_TG ((bf16*)(WSP + WS_TG))
#define P_EM ((bf16*)(WSP + WS_EM))
#define P_MEMB ((bf16*)(WSP + WS_MEMB))
#define P_KVM ((bf16*)(WSP + WS_KVM))
#define P_MQT ((bf16*)(WSP + WS_MQT))
#define P_VWOT ((bf16*)(WSP + WS_VWOT))
__global__ void __launch_bounds__(NWAVES * 64, 2) fwd_kernel(Args args) {
    extern __shared__ __attribute__((aligned(16))) unsigned char lds[];
    LAS unsigned char* ldsl = (LAS unsigned char*)lds;
    volatile LAS unsigned* MISC = (volatile LAS unsigned*)(ldsl + MISC_OFF);
#define IDS() const int tid = pg8::otid(), lane = tid & 63, wave = __builtin_amdgcn_readfirstlane(tid >> 6); const int G = pg8::osgpr((int)gridDim.x), bx = pg8::osgpr((int)blockIdx.x), \
        vcu = (G % 8 == 0) ? (bx % 8) * (G / 8) + bx / 8 : bx, gw = vcu * NWAVES + wave, NGW = G * NWAVES; LAS float* scr = (LAS float*)(ldsl + RING_OFF + wave * 16384); \
        (void)lane; (void)gw; (void)NGW; (void)scr; (void)vcu
    { const int tid0 = threadIdx.x;
      for (int u = tid0; u < (LDS_BYTES - LDSCTL_OFF) / 4; u += NWAVES * 64) ((LAS unsigned*)(ldsl + LDSCTL_OFF))[u] = 0u; }
    __syncthreads();
    (void)xcd_barrier_post((unsigned*)((gu32*)(WSP + WS_CTL) + CW_BAR), MISC + 8);
#define GRID_BAR() do { XcdBarrier b_; b_.bar = (unsigned*)((gu32*)(WSP + WS_CTL) + CW_BAR); b_.x = xb_xcc_id(); b_.st = (volatile LAS unsigned*)(ldsl + MISC_OFF) + 8; xcd_barrier(b_); } while (0)

#define CONVERT_LAYER(L, MODE) do { const int L_ = (L); IDS();     \
        if ((MODE) != 2) { \
        conv_T(INP(I_F1G) + (size_t)L_ * DMODEL * FF, DMODEL, FF, P_W1GU, DMODEL, RmGate{0}, L_ ? INP(I_LN4G) + (L_ - 1) * DMODEL : nullptr, INP(I_LN4B) + (L_ ? L_ - 1 : 0) * DMODEL, P_CS(L_, CS1), P_CS(L_, CB1), scr, gw, NGW, lane, 0, 1.4426950408889634f); \
        conv_T(INP(I_F1U) + (size_t)L_ * DMODEL * FF, DMODEL, FF, P_W1GU, DMODEL, RmGate{128}, L_ ? INP(I_LN4G) + (L_ - 1) * DMODEL : nullptr, INP(I_LN4B) + (L_ ? L_ - 1 : 0) * DMODEL, P_CS(L_, CS1), P_CS(L_, CB1), scr, gw, NGW, lane, 704, 0.6931471805599453f); \
        conv_T(INP(I_F1D) + (size_t)L_ * DMODEL * FF, FF, DMODEL, P_W1D, FF, RmId{}, nullptr, nullptr, nullptr, nullptr, scr, gw, NGW, lane, 1408); \
        conv_T(INP(I_F2G) + (size_t)L_ * DMODEL * FF, DMODEL, FF, P_W2GU, DMODEL, RmGate{0}, INP(I_LN3G) + L_ * DMODEL, INP(I_LN3B) + L_ * DMODEL, P_CS(L_, CS2), P_CS(L_, CB2), scr, gw, NGW, lane, 2112, 1.4426950408889634f); \
        conv_T(INP(I_F2U) + (size_t)L_ * DMODEL * FF, DMODEL, FF, P_W2GU, DMODEL, RmGate{128}, INP(I_LN3G) + L_ * DMODEL, INP(I_LN3B) + L_ * DMODEL, P_CS(L_, CS2), P_CS(L_, CB2), scr, gw, NGW, lane, 2816, 0.6931471805599453f); \
        } if ((MODE) != 1) { \
        conv_T(INP(I_F2D) + (size_t)L_ * DMODEL * FF, FF, DMODEL, P_W2D, FF, RmId{}, nullptr, nullptr, nullptr, nullptr, scr, gw, NGW, lane, 3520); \
        } if ((MODE) != 2) { \
        conv_T(INP(I_WIN) + (size_t)L_ * DMODEL * INW, DMODEL, INW, P_WIN, DMODEL, RmId{}, INP(I_LN1G) + L_ * DMODEL, INP(I_LN1B) + L_ * DMODEL, P_CS(L_, CSW), P_CS(L_, CBW), scr, gw, NGW, lane, 4224); \
        conv_T(INP(I_GLUW) + (size_t)L_ * 1024 * 1024, 1024, 1024, P_WGLU, 1024, RmId{}, nullptr, nullptr, nullptr, nullptr, scr, gw, NGW, lane, 4736); \
        conv_T(INP(I_WOUT) + (size_t)L_ * DMODEL * DMODEL, DMODEL, DMODEL, P_WOUT, DMODEL, RmId{}, nullptr, nullptr, nullptr, nullptr, scr, gw, NGW, lane, 4800); \
        conv_copy(INP(I_XQ) + (size_t)L_ * DMODEL * DMODEL, P_WQN, (size_t)DMODEL * DMODEL, gw, NGW, lane); \
        conv_T(INP(I_XK) + (size_t)L_ * DMODEL * DMODEL, DMODEL, DMODEL, P_WKVT, DMODEL, RmId{}, nullptr, nullptr, nullptr, nullptr, scr, gw, NGW, lane, 5056); \
        conv_T(INP(I_XV) + (size_t)L_ * DMODEL * DMODEL, DMODEL, DMODEL, P_WKVT + (size_t)DMODEL * DMODEL, DMODEL, RmId{}, nullptr, nullptr, nullptr, nullptr, scr, gw, NGW, lane, 5312); \
        conv_T(INP(I_XO) + (size_t)L_ * DMODEL * DMODEL, DMODEL, DMODEL, P_WOT, DMODEL, RmId{}, nullptr, nullptr, nullptr, nullptr, scr, gw, NGW, lane, 5568); \
        __syncthreads(); \
        ssm_prep(INP(I_SLRE) + L_ * 4096, INP(I_SLIM) + L_ * 4096, INP(I_SLOG) + L_ * 64, INP(I_SBRE) + (size_t)L_ * 65536, INP(I_SBIM) + (size_t)L_ * 65536, \
                 INP(I_SCRE) + (size_t)L_ * 65536, INP(I_SCIM) + (size_t)L_ * 65536, P_TG, P_EM, ldsl + RING_OFF, vcu, G, tid, L_ > 0); \
        } \
    } while (0)
#define CONVERT_DUMMY(L) do { const int L_ = (L); IDS(); \
        conv_T(INP(I_F1G) + (size_t)L_ * DMODEL * FF, DMODEL, FF, ((bf16*)((unsigned char*)P_W1GU + (WS_END - WS_W))), DMODEL, RmGate{0}, L_ ? INP(I_LN4G) + (L_ - 1) * DMODEL : nullptr, INP(I_LN4B) + (L_ ? L_ - 1 : 0) * DMODEL, (P_DUMST + CS1), (P_DUMST + CB1), scr, gw, NGW, lane, 0, 1.4426950408889634f); \
        conv_T(INP(I_F1U) + (size_t)L_ * DMODEL * FF, DMODEL, FF, ((bf16*)((unsigned char*)P_W1GU + (WS_END - WS_W))), DMODEL, RmGate{128}, L_ ? INP(I_LN4G) + (L_ - 1) * DMODEL : nullptr, INP(I_LN4B) + (L_ ? L_ - 1 : 0) * DMODEL, (P_DUMST + CS1), (P_DUMST + CB1), scr, gw, NGW, lane, 704, 0.6931471805599453f); \
        conv_T(INP(I_F1D) + (size_t)L_ * DMODEL * FF, FF, DMODEL, ((bf16*)((unsigned char*)P_W1D + (WS_END - WS_W))), FF, RmId{}, nullptr, nullptr, nullptr, nullptr, scr, gw, NGW, lane, 1408); \
        conv_T(INP(I_F2G) + (size_t)L_ * DMODEL * FF, DMODEL, FF, ((bf16*)((unsigned char*)P_W2GU + (WS_END - WS_W))), DMODEL, RmGate{0}, INP(I_LN3G) + L_ * DMODEL, INP(I_LN3B) + L_ * DMODEL, (P_DUMST + CS2), (P_DUMST + CB2), scr, gw, NGW, lane, 2112, 1.4426950408889634f); \
        conv_T(INP(I_F2U) + (size_t)L_ * DMODEL * FF, DMODEL, FF, ((bf16*)((unsigned char*)P_W2GU + (WS_END - WS_W))), DMODEL, RmGate{128}, INP(I_LN3G) + L_ * DMODEL, INP(I_LN3B) + L_ * DMODEL, (P_DUMST + CS2), (P_DUMST + CB2), scr, gw, NGW, lane, 2816, 0.6931471805599453f); \
        conv_T(INP(I_F2D) + (size_t)L_ * DMODEL * FF, FF, DMODEL, ((bf16*)((unsigned char*)P_W2D + (WS_END - WS_W))), FF, RmId{}, nullptr, nullptr, nullptr, nullptr, scr, gw, NGW, lane, 3520); \
        conv_T(INP(I_WIN) + (size_t)L_ * DMODEL * INW, DMODEL, INW, ((bf16*)((unsigned char*)P_WIN + (WS_END - WS_W))), DMODEL, RmId{}, INP(I_LN1G) + L_ * DMODEL, INP(I_LN1B) + L_ * DMODEL, (P_DUMST + CSW), (P_DUMST + CBW), scr, gw, NGW, lane, 4224); \
        conv_T(INP(I_GLUW) + (size_t)L_ * 1024 * 1024, 1024, 1024, ((bf16*)((unsigned char*)P_WGLU + (WS_END - WS_W))), 1024, RmId{}, nullptr, nullptr, nullptr, nullptr, scr, gw, NGW, lane, 4736); \
        conv_T(INP(I_WOUT) + (size_t)L_ * DMODEL * DMODEL, DMODEL, DMODEL, ((bf16*)((unsigned char*)P_WOUT + (WS_END - WS_W))), DMODEL, RmId{}, nullptr, nullptr, nullptr, nullptr, scr, gw, NGW, lane, 4800); \
        conv_copy(INP(I_XQ) + (size_t)L_ * DMODEL * DMODEL, ((bf16*)((unsigned char*)P_WQN + (WS_END - WS_W))), (size_t)DMODEL * DMODEL, gw, NGW, lane); \
        conv_T(INP(I_XK) + (size_t)L_ * DMODEL * DMODEL, DMODEL, DMODEL, ((bf16*)((unsigned char*)P_WKVT + (WS_END - WS_W))), DMODEL, RmId{}, nullptr, nullptr, nullptr, nullptr, scr, gw, NGW, lane, 5056); \
        conv_T(INP(I_XV) + (size_t)L_ * DMODEL * DMODEL, DMODEL, DMODEL, ((bf16*)((unsigned char*)P_WKVT + (WS_END - WS_W))) + (size_t)DMODEL * DMODEL, DMODEL, RmId{}, nullptr, nullptr, nullptr, nullptr, scr, gw, NGW, lane, 5312); \
        conv_T(INP(I_XO) + (size_t)L_ * DMODEL * DMODEL, DMODEL, DMODEL, ((bf16*)((unsigned char*)P_WOT + (WS_END - WS_W))), DMODEL, RmId{}, nullptr, nullptr, nullptr, nullptr, scr, gw, NGW, lane, 5568); \
        __syncthreads(); \
        ssm_prep(INP(I_SLRE) + L_ * 4096, INP(I_SLIM) + L_ * 4096, INP(I_SLOG) + L_ * 64, INP(I_SBRE) + (size_t)L_ * 65536, INP(I_SBIM) + (size_t)L_ * 65536, \
                 INP(I_SCRE) + (size_t)L_ * 65536, INP(I_SCIM) + (size_t)L_ * 65536, ((bf16*)((unsigned char*)P_TG + (WS_END - WS_W))), ((bf16*)((unsigned char*)P_EM + (WS_END - WS_W))), ldsl + RING_OFF, vcu, G, tid); \
    } while (0)

    { IDS(); conv_copy(INP(I_X), P_XB, (size_t)MT * DMODEL, gw, NGW, lane);
      conv_copy(INP(I_MEM), P_MEMB, (size_t)NBATCH * NMEM * DMODEL, gw, NGW, lane); }
    CONVERT_LAYER(0, 0);
    GRID_BAR();

#pragma unroll 1
    for (int l = 0; l < DEPTH; ++l) {
        if (PH(1)) { IDS();
        { pg8::Gemm g{P_XB, P_W1GU, DMODEL, DMODEL, DMODEL}; pg8::Order<pg8::MapStd> S; S.init(MT / 256, 2 * FF / 256, G, bx, pg8::MapStd{DMODEL, DMODEL}, WGM_FF);
          pg8::EpiSwiGLU E{P_HMID, FF, pg8::Fold{P_ST(l ? 4 * l - 1 : 0), P_CS(l, CS1), P_CS(l, CB1), l == 0}, ldsl + GB_OFF}; GEMM_PHASE_SW(pg8::EpiSwiGLU, pg8::Order<pg8::MapStd>, g, S, E); }
        }
        GRID_BAR();
        if (PH(2)) { IDS(); stagger(bx, STAG_US);
        { pg8::Gemm g{P_HMID, P_W1D, FF, FF, FF}; pg8::Order<pg8::MapStdRev> S; S.init(MT / 256, DMODEL / 256, G, bx, pg8::MapStdRev{FF, FF, MT / 256}, WGM_N8);
          if (l == 0) { pg8::EpiResLn0 E{INP(I_X), nullptr, LGB, P_XB, P_YLO, nullptr, P_ST(0), ALPHA, 0.5f}; GEMM_PHASE(pg8::EpiResLn0, pg8::Order<pg8::MapStdRev>, g, S, E); }
          else { LOAD_GB(INP(I_LN4G) + (l - 1) * DMODEL, INP(I_LN4B) + (l - 1) * DMODEL); pg8::EpiResLn E{nullptr, P_ST(4 * l - 1), LGB, P_XB, P_YLO, nullptr, P_ST(4 * l), ALPHA, 0.5f}; GEMM_PHASE(pg8::EpiResLn, pg8::Order<pg8::MapStdRev>, g, S, E); } }
        }
        GRID_BAR();
        if (PH(4)) { IDS();
        { pg8::Gemm g{P_XB, P_WIN, DMODEL, DMODEL, DMODEL}; pg8::Order<pg8::MapStd> S; S.init(MT / 256, INW / 256, G, bx, pg8::MapStd{DMODEL, DMODEL});
          pg8::EpiWin<UGP> E{P_QKV, P_UG, attn_body::C2, pg8::Fold{P_ST(4 * l), P_CS(l, CSW), P_CS(l, CBW), 0}, ldsl + GB_OFF}; GEMM_PHASE(pg8::EpiWin<UGP>, pg8::Order<pg8::MapStd>, g, S, E); }
        }
        GRID_BAR();
        if (PH(5)) { IDS();
        { pg8::Gemm g{P_UG + 128, P_EM, UGP, 1024, 1024}; pg8::Order<MapSsmV> S; S.init(128, 1, G, bx, MapSsmV{});
          pg8::EpiF32<1> E{P_VS, 128}; GEMM_PHASE(pg8::EpiF32<1>, pg8::Order<MapSsmV>, g, S, E); }
        { pg8::Gemm g{P_MEMB, P_WKVT, DMODEL, DMODEL, DMODEL}; pg8::Order<pg8::MapStd> S; S.init(2, 16, G, bx - 128, pg8::MapStd{DMODEL, DMODEL});
          pg8::EpiBf16 E{P_KVM, 4096, 1.0f}; GEMM_PHASE(pg8::EpiBf16, pg8::Order<pg8::MapStd>, g, S, E); }
        if (l > 0 && bx >= 128 && G == 256) { conv_T(INP(I_F2D) + (size_t)l * DMODEL * FF, FF, DMODEL, P_W2D, FF, RmId{}, nullptr, nullptr, nullptr, nullptr, scr, (bx - 128) * NWAVES + wave, 128 * NWAVES, lane, 0); }
        else if (l > 0 && G != 256) { conv_T(INP(I_F2D) + (size_t)l * DMODEL * FF, FF, DMODEL, P_W2D, FF, RmId{}, nullptr, nullptr, nullptr, nullptr, scr, gw, NGW, lane, 0); }
        __syncthreads();
        }
        if (PH(6)) { IDS();
        { pg8::Order<MapSsmV> S5; S5.init(128, 1, G, bx, MapSsmV{}); pg8::Unit u5; const bool has5 = S5.next(0, u5);
          if (has5) { __builtin_amdgcn_fence(__ATOMIC_ACQUIRE, "agent"); asm volatile("s_waitcnt vmcnt(0)" ::: "memory");
              ssm_scan8(INP(I_SLRE) + l * 4096, INP(I_SLIM) + l * 4096, INP(I_SLOG) + l * 64, P_VS, P_UG, u5.pm, wave, lane, (LAS float*)(ldsl + RING_OFF)); } }
        { const attn_body::AttnTensors AT{(const attn_body::bf16*)P_QKV, (attn_body::bf16*)P_OV};
#if defined(ATTN_V64)
          const attn_body::StaticOrder S((int)G, (int)bx);
          attn_body::attn_phase<attn_body::StaticOrder>((char*)lds + RING_OFF, AT, S); }
#else
          const attn_body::StaticOrder2 S((int)G, (int)bx);
          attn_body::attn_phase2<attn_body::StaticOrder2>((char*)lds + RING_OFF, AT, S); }
#endif
        }
        GRID_BAR();
        if (PH(7)) { IDS();
        diff_combine(P_OV, P_MIX, INP(I_LQ1) + l * 64, INP(I_LK1) + l * 64, INP(I_LQ2) + l * 64, INP(I_LK2) + l * 64, INP(I_DNG) + l * 128, 0.8f - 0.6f * expf(-0.3f * (float)l), gw, NGW, lane);
        __syncthreads();
        { pg8::Gemm g{P_UG, P_TG, UGP, UGP, UGP}; pg8::Order<MapSsmY> S; S.init(128, 4, G, bx, MapSsmY{});
          pg8::EpiSsmY<UGP> E{P_UG, INP(I_SD) + l * 1024, P_YG}; GEMM_PHASE(pg8::EpiSsmY<UGP>, pg8::Order<MapSsmY>, g, S, E); }
        { pg8::Gemm g{P_KVM, P_WQN, 4096, DMODEL, 512}; pg8::Order<MapMQT> S; S.init(8, 8, G, bx, MapMQT{});
          pg8::EpiMqt E{P_MQT, DMODEL, 0.044194173824159216f, INP(I_LN2G) + l * DMODEL, INP(I_LN2B) + l * DMODEL, P_CS(l, CSM), P_CS(l, CBM)}; GEMM_PHASE(pg8::EpiMqt, pg8::Order<MapMQT>, g, S, E); }
        { pg8::Gemm g{P_WOT, P_KVM, DMODEL, 4096, 512}; pg8::Order<MapVWOT> S; S.init(16, 4, G, bx - 64, MapVWOT{});
          pg8::EpiBf16 E{P_VWOT, 1024, 1.0f}; GEMM_PHASE(pg8::EpiBf16, pg8::Order<MapVWOT>, g, S, E); }
        }
        GRID_BAR();
        if (PH(8)) { IDS();
        { pg8::Gemm g{P_YG, P_WGLU, 1024, 1024, 1024}; pg8::Order<pg8::MapStd> S; S.init(MT / 256, 4, G, bx, pg8::MapStd{1024, 1024});
          pg8::EpiGlu E{P_YG, INP(I_GLUB) + l * 1024, P_MIX}; GEMM_PHASE(pg8::EpiGlu, pg8::Order<pg8::MapStd>, g, S, E); }
        }
        GRID_BAR();
        if (PH(9)) { IDS(); stagger(bx, STAG_US);
        { pg8::Gemm g{P_MIX, P_WOUT, DMODEL, DMODEL, DMODEL}; pg8::Order<pg8::MapStd> S; S.init(MT / 256, DMODEL / 256, G, bx, pg8::MapStd{DMODEL, DMODEL}, WGM_N8);
          LOAD_GB(INP(I_LN1G) + l * DMODEL, INP(I_LN1B) + l * DMODEL); pg8::EpiResLn E{nullptr, P_ST(4 * l), LGB, P_XB, P_YLO, nullptr, P_ST(4 * l + 1), ALPHA, 1.0f}; GEMM_PHASE(pg8::EpiResLn, pg8::Order<pg8::MapStd>, g, S, E); }
        }
        GRID_BAR();
        if (PH(11)) { IDS();
        { pg8::Gemm g{P_XB, P_MQT, DMODEL, DMODEL, DMODEL}; pg8::Order<MapScores> S; S.init(MT / 256, 4, G, bx, MapScores{});
          pg8::EpiScoresSm E{P_PB, pg8::Fold{P_ST(4 * l + 1), P_CS(l, CSM), P_CS(l, CBM), 0}, (LAS float*)(ldsl + XCH_OFF)}; GEMM_PHASE(pg8::EpiScoresSm, pg8::Order<MapScores>, g, S, E); }
        }
        GRID_BAR();
        if (PH(13)) { IDS(); stagger(bx, STAG_US);
        { pg8::Gemm g{P_PB, P_VWOT, 1024, 1024, 1024}; pg8::Order<MapOut> S; S.init(MT / 256, DMODEL / 256, G, bx, MapOut{}, WGM_N8);
          LOAD_GB(INP(I_LN2G) + l * DMODEL, INP(I_LN2B) + l * DMODEL); pg8::EpiResLn E{nullptr, P_ST(4 * l + 1), LGB, P_XB, P_YLO, nullptr, P_ST(4 * l + 2), ALPHA, 1.0f}; GEMM_PHASE(pg8::EpiResLn, pg8::Order<MapOut>, g, S, E); }
        }
        GRID_BAR();
        if (PH(15)) { IDS();
        { pg8::Gemm g{P_XB, P_W2GU, DMODEL, DMODEL, DMODEL}; pg8::Order<pg8::MapStd> S; S.init(MT / 256, 2 * FF / 256, G, bx, pg8::MapStd{DMODEL, DMODEL}, WGM_FF);
          pg8::EpiSwiGLU E{P_HMID, FF, pg8::Fold{P_ST(4 * l + 2), P_CS(l, CS2), P_CS(l, CB2), 0}, ldsl + GB_OFF}; GEMM_PHASE_SW(pg8::EpiSwiGLU, pg8::Order<pg8::MapStd>, g, S, E); }
        }
        GRID_BAR();
        if (PH(16)) { IDS(); stagger(bx, STAG_US);
        { pg8::Gemm g{P_HMID, P_W2D, FF, FF, FF}; pg8::Order<pg8::MapStdRev> S; S.init(MT / 256, DMODEL / 256, G, bx, pg8::MapStdRev{FF, FF, MT / 256}, WGM_N8);
          LOAD_GB(INP(I_LN3G) + l * DMODEL, INP(I_LN3B) + l * DMODEL);
          { pg8::EpiResLn E{nullptr, P_ST(4 * l + 2), LGB, P_XB, P_YLO, nullptr, P_ST(4 * l + 3), ALPHA, 0.5f}; GEMM_PHASE(pg8::EpiResLn, pg8::Order<pg8::MapStdRev>, g, S, E); } }
        }
        if (l + 1 < DEPTH) { CONVERT_LAYER(l + 1, 1); GRID_BAR(); }
        else { GRID_BAR(); IDS(); final_ln_planes(P_XB, P_YLO, P_ST(4 * l + 3), INP(I_LN4G) + l * DMODEL, INP(I_LN4B) + l * DMODEL, P_X32, gw, NGW, lane); }
    }
}

extern "C" void kernel_launch(void* const* d_in, const int* in_sizes, int n_in, void* d_out, int out_size, void* d_ws, size_t ws_size, hipStream_t stream) {
    static int grid = 0;
    if (grid == 0) {
        if (n_in != NIN || in_sizes[0] != MT * DMODEL || out_size != MT * DMODEL || ws_size < WS_END) { fprintf(stderr, "kernel_launch: unexpected problem shape (n_in %d, in0 %d, out %d, ws %zu < %zu); nothing launched\n", n_in, n_in > 0 ? in_sizes[0] : -1, out_size, ws_size, (size_t)WS_END); grid = -1; return; }
        int dev = 0, cus = 0, per_cu = 0;
        if (hipGetDevice(&dev) != hipSuccess || hipDeviceGetAttribute(&cus, hipDeviceAttributeMultiprocessorCount, dev) != hipSuccess) { fprintf(stderr, "kernel_launch: device query failed\n"); grid = -1; return; }
        if (hipFuncSetAttribute((const void*)fwd_kernel, hipFuncAttributeMaxDynamicSharedMemorySize, LDS_BYTES) != hipSuccess) { fprintf(stderr, "kernel_launch: hipFuncSetAttribute failed\n"); grid = -1; return; }
        if (hipOccupancyMaxActiveBlocksPerMultiprocessor(&per_cu, (const void*)fwd_kernel, NWAVES * 64, LDS_BYTES) != hipSuccess || per_cu < 1)
            fprintf(stderr, "kernel_launch: note: occupancy query reports %d workgroups per CU\n", per_cu);
        (void)hipGetLastError();
        grid = cus;
    }
    if (grid < 0) return;
    if (hipMemsetAsync((char*)d_ws + WS_CTL, 0, CTL_ZERO_BYTES, stream) != hipSuccess) { fprintf(stderr, "kernel_launch: hipMemsetAsync failed\n"); return; }
    Args a{};
    for (int i = 0; i < NIN; ++i) a.in[i] = (const float*)d_in[i];
    a.out = (float*)d_out; a.ws = (unsigned char*)d_ws;
    hipLaunchKernelGGL(fwd_kernel, dim3(grid), dim3(NWAVES * 64), LDS_BYTES, stream, a);
    const hipError_t le = hipPeekAtLastError();
    if (le != hipSuccess) fprintf(stderr, "kernel_launch: launch failed: %s\n", hipGetErrorName(le));
}
```

```cpp
#pragma clang diagnostic ignored "-Winline-asm"
#include <hip/hip_runtime.h>
#include <hip/hip_bf16.h>
#include <cstdio>
#include <cstdint>
#include <cmath>
namespace pg8 {
#define PG8_LAS __attribute__((address_space(3)))
typedef unsigned short bf16_t;
typedef short bf16x8 __attribute__((ext_vector_type(8)));
typedef float f32x4 __attribute__((ext_vector_type(4)));
typedef float f32x2 __attribute__((ext_vector_type(2)));
typedef unsigned u32x4 __attribute__((ext_vector_type(4)));
constexpr int BM = 256, BK = 64, HALF = 128, HTB = HALF * BK * 2  , STAGE_BYTES = 8 * HTB, NXCD = 8, WGM = 8;

__host__ __device__ __forceinline__ int lds_byte(int r, int c) { const int st = (r >> 4) * 2 + (c >> 5), rr = r & 15, cc = c & 31, ob = rr * 64 + cc * 2; return st * 1024 + (ob ^ (((ob >> 9) & 1) << 5)); }
__host__ __device__ __forceinline__ void stage_rc(int b, int& R, int& C) { const int st = b / 1024, sb = b % 1024, swz = sb ^ (((sb >> 9) & 1) << 5); R = (st >> 1) * 16 + swz / 64; C = (st & 1) * 32 + (swz % 64) / 2; }
__host__ __device__ __forceinline__ int perm32(int rho) { const int n = rho >> 4, i = rho & 15; return 8 * (i >> 2) + 4 * n + (i & 3); }

struct Unit { int aoff, boff, pm, pn, nt; };
struct Gemm { const bf16_t* A; const bf16_t* Bt; int lda, ldb, K; };

template <class Map> struct Order {
    int nM, nN, nwg, G, c, wgm; Map map;
    __device__ __forceinline__ void init(int nM_, int nN_, int G_, int c_, const Map& m, int wgm_ = WGM) { nM = nM_; nN = nN_; nwg = nM * nN; G = G_; c = c_; map = m; wgm = wgm_; }
    __device__ __forceinline__ bool next(int i, Unit& u) const {
        const long L = (long)i * G + c; if (c < 0 || L >= nwg) return false;
        int wgid = (int)L; { const int q = nwg / NXCD, r = nwg % NXCD, xcd = wgid % NXCD, off = wgid / NXCD; wgid = (xcd < r ? xcd * (q + 1) : r * (q + 1) + (xcd - r) * q) + off; }
        const int nig = wgm * nN, gid = wgid / nig, fm = gid * wgm, gsz = (nM - fm) < wgm ? (nM - fm) : wgm;
        u.pm = fm + ((wgid % nig) % gsz); u.pn = (wgid % nig) / gsz; u.nt = 0; map(u); return true;
    }
    __device__ __forceinline__ void a_ready(const Unit&) const {}
    __device__ __forceinline__ void done(const Unit&) const {}
};
struct MapStd { int lda, ldb; __device__ __forceinline__ void operator()(Unit& u) const { u.aoff = u.pm * BM * lda; u.boff = u.pn * BM * ldb; } };

struct MapStdRev { int lda, ldb, nM; __device__ __forceinline__ void operator()(Unit& u) const { u.pm = nM - 1 - u.pm; u.aoff = u.pm * BM * lda; u.boff = u.pn * BM * ldb; } };

__device__ __forceinline__ unsigned cvt_pk_bf16(float lo, float hi) { unsigned r; asm volatile("v_cvt_pk_bf16_f32 %0, %1, %2" : "=v"(r) : "v"(lo), "v"(hi)); return r; }
__device__ __forceinline__ float bf_lo(unsigned w) { return __uint_as_float(w << 16); }
__device__ __forceinline__ float bf_hi(unsigned w) { return __uint_as_float(w & 0xffff0000u); }
__device__ __forceinline__ float sigmoid_f(float z) { return __builtin_amdgcn_rcpf(1.0f + __builtin_amdgcn_exp2f(-1.4426950408889634f * z)); }
__device__ __forceinline__ int otid() { int t = threadIdx.x; asm volatile("" : "+v"(t)); return t; }
__device__ __forceinline__ int osgpr(int v) { asm volatile("" : "+s"(v)); return v; }
template <int K> __device__ __forceinline__ float sw_xor(float v) { return __int_as_float(__builtin_amdgcn_ds_swizzle(__float_as_int(v), (K << 10) | 0x1f)); }
__device__ __forceinline__ float add_xor32(float v) { auto rr = __builtin_amdgcn_permlane32_swap(__float_as_uint(v), __float_as_uint(v), false, false); return __uint_as_float(rr[0]) + __uint_as_float(rr[1]); }
__device__ __forceinline__ float max_xor32(float v) { auto rr = __builtin_amdgcn_permlane32_swap(__float_as_uint(v), __float_as_uint(v), false, false); return fmaxf(__uint_as_float(rr[0]), __uint_as_float(rr[1])); }
__device__ __forceinline__ float red16_32(float v) { v += sw_xor<16>(v); return add_xor32(v); }
template <class T> __device__ __forceinline__ T* at32(const void* base, unsigned byte_off) { return (T*)((char*)const_cast<void*>(base) + byte_off); }
#define PG8_EPI_ARGS const f32x4 (&acc)[2][2][4][2], const Unit& u, int wr, int wc, int fr, int fq
__device__ __forceinline__ u32x4 pack8(const f32x4 v0, const f32x4 v1) { u32x4 w; w.x = cvt_pk_bf16(v0[0], v0[1]); w.y = cvt_pk_bf16(v0[2], v0[3]); w.z = cvt_pk_bf16(v1[0], v1[1]); w.w = cvt_pk_bf16(v1[2], v1[3]); return w; }


struct Fold { const float* stats; const float* cs; const float* cb; int ident; };
__device__ __forceinline__ void fold_row(const Fold& f, int r, float& mu, float& rs) {
    const f32x2 s = *(const f32x2*)(f.stats + 2 * (size_t)r); mu = s.x * (1.0f / 2048.0f); const float var = s.y * (1.0f / 2048.0f) - mu * mu; rs = __builtin_amdgcn_rsqf(var + 1e-5f);
}
__device__ __forceinline__ void fold_rows8(const Fold& f, int row0, float (&mu)[2][4], float (&rs)[2][4]) {
    f32x2 st[2][4];
#pragma unroll
    for (int ai = 0; ai < 2; ++ai)
#pragma unroll
        for (int m = 0; m < 4; ++m) st[ai][m] = *at32<const f32x2>(f.stats, 8u * (unsigned)(row0 + ai * HALF + m * 16));
#pragma unroll
    for (int ai = 0; ai < 2; ++ai)
#pragma unroll
        for (int m = 0; m < 4; ++m) { mu[ai][m] = st[ai][m].x * (1.0f / 2048.0f); rs[ai][m] = __builtin_amdgcn_rsqf(st[ai][m].y * (1.0f / 2048.0f) - mu[ai][m] * mu[ai][m] + 1e-5f); }
}
__device__ __forceinline__ f32x4 fold4(const f32x4 a, float mu, float rs, const f32x4 cs, const f32x4 cb) { return (a - cs * mu) * rs + cb; }

__device__ __forceinline__ void fold_prefetch(const Fold& f, const Unit& u, PG8_LAS unsigned char* pf) {
    const int tid = otid(), wid = __builtin_amdgcn_readfirstlane(tid >> 6), L = tid & 63, wr = wid >> 2, wc = wid & 3, q = (L >> 3) & 3;
    PG8_LAS unsigned char* slot = pf + wid * 2048;
    __builtin_amdgcn_global_load_lds((const unsigned*)(f.stats + 2 * (u.pm * BM + (L >> 5) * HALF + wr * 64 + (L & 31) * 2)), (PG8_LAS unsigned*)slot, 16, 0, 0);
    __builtin_amdgcn_global_load_lds((const unsigned*)(((q & 2) ? f.cb : f.cs) + u.pn * BM + (q & 1) * HALF + wc * 32 + (L & 7) * 4), (PG8_LAS unsigned*)(slot + 1024), 16, 0, 0);
}
__device__ __forceinline__ void fold_from_lds(PG8_LAS const unsigned char* pf, int wr, int wc, int fr, int fq, f32x4 (&cs)[2][2], f32x4 (&cb)[2][2], float (&mu)[2][4], float (&rs)[2][4]) {
    PG8_LAS const unsigned char* slot = pf + (wr * 4 + wc) * 2048;
    f32x2 st[2][4];
#pragma unroll
    for (int ai = 0; ai < 2; ++ai)
#pragma unroll
        for (int m = 0; m < 4; ++m) st[ai][m] = *(const PG8_LAS f32x2*)(slot + (ai * 64 + m * 16 + fr) * 8);
#pragma unroll
    for (int bj = 0; bj < 2; ++bj)
#pragma unroll
        for (int n = 0; n < 2; ++n) { cs[bj][n] = *(const PG8_LAS f32x4*)(slot + 1024 + (bj * 8 + 2 * fq + n) * 16); cb[bj][n] = *(const PG8_LAS f32x4*)(slot + 1024 + ((2 + bj) * 8 + 2 * fq + n) * 16); }
#pragma unroll
    for (int ai = 0; ai < 2; ++ai)
#pragma unroll
        for (int m = 0; m < 4; ++m) { mu[ai][m] = st[ai][m].x * (1.0f / 2048.0f); rs[ai][m] = __builtin_amdgcn_rsqf(st[ai][m].y * (1.0f / 2048.0f) - mu[ai][m] * mu[ai][m] + 1e-5f); }
}

struct EpiBf16 {
    static constexpr bool PERM = true, AFTER_DRAIN = false, PREF = false;
    bf16_t* O; int ldc; float scale;
    __device__ __forceinline__ void operator()(PG8_EPI_ARGS) const {
        const int row0 = u.pm * BM + wr * 64 + fr, col0 = u.pn * BM + wc * 32 + 8 * fq;
#pragma unroll
        for (int ai = 0; ai < 2; ++ai)
#pragma unroll
            for (int m = 0; m < 4; ++m) { const unsigned bo = 2u * (unsigned)((row0 + ai * HALF + m * 16) * ldc + col0);
#pragma unroll
                for (int bj = 0; bj < 2; ++bj) *at32<u32x4>(O, bo + 2u * bj * HALF) = pack8(acc[ai][bj][m][0] * scale, acc[ai][bj][m][1] * scale); }
    }
};
template <int NBJ> struct EpiF32 {
    static constexpr bool PERM = false, AFTER_DRAIN = false, PREF = false;
    float* O; int ldc;
    __device__ __forceinline__ void operator()(PG8_EPI_ARGS) const {
        const int row0 = u.pm * BM + wr * 64 + fr, col0 = u.pn * (NBJ == 2 ? BM : HALF) + wc * 32 + 4 * fq;
#pragma unroll
        for (int ai = 0; ai < 2; ++ai)
#pragma unroll
            for (int m = 0; m < 4; ++m) { float* rowp = O + (size_t)(row0 + ai * HALF + m * 16) * ldc + col0;
#pragma unroll
                for (int bj = 0; bj < NBJ; ++bj)
#pragma unroll
                    for (int n = 0; n < 2; ++n) *(f32x4*)(rowp + bj * HALF + n * 16) = acc[ai][bj][m][n]; }
    }
};

struct EpiScoresSm {
    static constexpr bool PERM = true, AFTER_DRAIN = false, PREF = false;
    bf16_t* PB; Fold f; PG8_LAS float* xch;
    __device__ __forceinline__ void operator()(PG8_EPI_ARGS) const {
        f32x4 (&s)[2][2][4][2] = const_cast<f32x4 (&)[2][2][4][2]>(acc);
        const int row0 = u.pm * BM + wr * 64 + fr, col0 = u.pn * BM + wc * 32 + 8 * fq, vb = (u.pm >> 6) * 1024, rl0 = wr * 64 + fr;
        { f32x4 cs[2][2], cb[2][2]; float mus[2][4], rss[2][4]; fold_rows8(f, row0, mus, rss);
#pragma unroll
          for (int bj = 0; bj < 2; ++bj)
#pragma unroll
            for (int n = 0; n < 2; ++n) { cs[bj][n] = *(const f32x4*)(f.cs + vb + col0 + bj * HALF + 4 * n); cb[bj][n] = *(const f32x4*)(f.cb + vb + col0 + bj * HALF + 4 * n); }
#pragma unroll
          for (int ai = 0; ai < 2; ++ai)
#pragma unroll
            for (int m = 0; m < 4; ++m) { const float mu = mus[ai][m], rs = rss[ai][m]; float mx = -3.0e38f;
#pragma unroll
                for (int bj = 0; bj < 2; ++bj)
#pragma unroll
                    for (int n = 0; n < 2; ++n) { const f32x4 v = fold4(s[ai][bj][m][n], mu, rs, cs[bj][n], cb[bj][n]) * 1.4426950408889634f; s[ai][bj][m][n] = v;
                        mx = fmaxf(fmaxf(mx, fmaxf(v[0], v[1])), fmaxf(v[2], v[3])); }
                mx = fmaxf(mx, sw_xor<16>(mx)); mx = max_xor32(mx);
                if (fq == 0) xch[(ai * HALF + m * 16 + rl0) * 4 + wc] = mx; } }
        asm volatile("s_waitcnt lgkmcnt(0)" ::: "memory"); __builtin_amdgcn_s_barrier(); asm volatile("" ::: "memory");
#pragma unroll
        for (int ai = 0; ai < 2; ++ai)
#pragma unroll
            for (int m = 0; m < 4; ++m) { const f32x4 q = *(const PG8_LAS f32x4*)(xch + (ai * HALF + m * 16 + rl0) * 4); const float M = fmaxf(fmaxf(q[0], q[1]), fmaxf(q[2], q[3])); float sm = 0.f;
#pragma unroll
                for (int bj = 0; bj < 2; ++bj)
#pragma unroll
                    for (int n = 0; n < 2; ++n) { f32x4 v = s[ai][bj][m][n];
#pragma unroll
                        for (int e = 0; e < 4; ++e) v[e] = __builtin_amdgcn_exp2f(v[e] - M);
                        s[ai][bj][m][n] = v; sm += (v[0] + v[1]) + (v[2] + v[3]); }
                sm = red16_32(sm);
                if (fq == 0) xch[1024 + (ai * HALF + m * 16 + rl0) * 4 + wc] = sm; }
        asm volatile("s_waitcnt lgkmcnt(0)" ::: "memory"); __builtin_amdgcn_s_barrier(); asm volatile("" ::: "memory");
#pragma unroll
        for (int ai = 0; ai < 2; ++ai)
#pragma unroll
            for (int m = 0; m < 4; ++m) { const f32x4 q = *(const PG8_LAS f32x4*)(xch + 1024 + (ai * HALF + m * 16 + rl0) * 4); const float inv = __builtin_amdgcn_rcpf((q[0] + q[1]) + (q[2] + q[3]));
                const unsigned bo = 2u * (unsigned)((row0 + ai * HALF + m * 16) * 1024 + col0);
#pragma unroll
                for (int bj = 0; bj < 2; ++bj) *at32<u32x4>(PB, bo + 2u * bj * HALF) = pack8(s[ai][bj][m][0] * inv, s[ai][bj][m][1] * inv); }
        asm volatile("s_waitcnt lgkmcnt(0)" ::: "memory");
    }
};
struct EpiSwiGLU {
    static constexpr bool PERM = true, AFTER_DRAIN = false, PREF = true;
    bf16_t* O; int ldc; Fold f; PG8_LAS unsigned char* pf;
    __device__ __forceinline__ void pref(const Unit& u) const { if (!f.ident) fold_prefetch(f, u, pf); }
    __device__ __forceinline__ void operator()(PG8_EPI_ARGS) const {
        const int row0 = u.pm * BM + wr * 64 + fr, col0 = u.pn * HALF + wc * 32 + 8 * fq;
        f32x4 cs[2][2], cb[2][2]; float mus[2][4], rss[2][4];
        if (!f.ident) {
            fold_from_lds(pf, wr, wc, fr, fq, cs, cb, mus, rss);
        } else {
#pragma unroll
            for (int ai = 0; ai < 2; ++ai)
#pragma unroll
                for (int m = 0; m < 4; ++m) { mus[ai][m] = 0.f; rss[ai][m] = 1.f; }
        }
#pragma unroll
        for (int ai = 0; ai < 2; ++ai)
#pragma unroll
            for (int m = 0; m < 4; ++m) { const int r = row0 + ai * HALF + m * 16; f32x4 v[2]; const float mu = mus[ai][m], rs = rss[ai][m];
#pragma unroll
                for (int n = 0; n < 2; ++n) { f32x4 g = acc[ai][0][m][n], up = acc[ai][1][m][n];
                    if (!f.ident) { g = fold4(g, mu, rs, cs[0][n], cb[0][n]); up = fold4(up, mu, rs, cs[1][n], cb[1][n]); }
#pragma unroll
                    for (int e = 0; e < 4; ++e) v[n][e] = (g[e] * up[e]) * __builtin_amdgcn_rcpf(1.0f + __builtin_amdgcn_exp2f(-g[e])); }
                *at32<u32x4>(O, 2u * (unsigned)(r * ldc + col0)) = pack8(v[0], v[1]); }
    }
};
template <bool IDENT, bool WF32 = false, int SKIP = 0> struct EpiResLnT {
    static constexpr bool PERM = true, AFTER_DRAIN = false, PREF = false; static constexpr int RB = 2;
    const float* xin; const float* st_old; PG8_LAS const float* lgb; bf16_t* XB; u32x4* LO8; float* yf32; float* st_new; float alpha, scale;
    __device__ __forceinline__ void operator()(PG8_EPI_ARGS) const {
        const int row0 = u.pm * BM + wr * 64 + fr, col0 = u.pn * BM + wc * 32 + 8 * fq;
        PG8_LAS float* xst = const_cast<PG8_LAS float*>(lgb) + 4096;
        u32x4* lop = LO8 + ((size_t)((u.pm * 8 + u.pn) * 8 + wr * 4 + wc) * 8) * 64 + fq * 16 + fr;
        f32x2 st[2][RB]; u32x4 lo[2][RB], hi[2][RB][2], xi[2][RB][2];
#define PG8_RL_LOAD(AB, BUF) do { const int ai_ = ((AB) * RB) >> 2, m0_ = ((AB) * RB) & 3; \
            if (!IDENT) { _Pragma("unroll") for (int m = 0; m < RB; ++m) st[BUF][m] = *at32<const f32x2>(st_old, 8u * (unsigned)(row0 + ai_ * HALF + (m0_ + m) * 16)); } \
            _Pragma("unroll") for (int m = 0; m < RB; ++m) { \
                if (!IDENT) lo[BUF][m] = (SKIP & 1) ? (u32x4){0u, 0u, 0u, 0u} : __builtin_nontemporal_load(lop + (ai_ * 4 + m0_ + m) * 64); \
                _Pragma("unroll") for (int bj = 0; bj < 2; ++bj) { const unsigned off_ = (unsigned)((row0 + ai_ * HALF + (m0_ + m) * 16) * 2048 + col0 + bj * HALF); \
                    if (IDENT) { hi[BUF][m][bj] = *at32<const u32x4>(xin, 4u * off_); xi[BUF][m][bj] = *at32<const u32x4>(xin, 4u * off_ + 16u); } \
                    else hi[BUF][m][bj] = (SKIP & 1) ? (u32x4){0u, 0u, 0u, 0u} : *at32<const u32x4>(XB, 2u * off_); } } } while (0)
        PG8_RL_LOAD(0, 0);
#pragma unroll
        for (int ab = 0; ab < 8 / RB; ++ab) { const int ai = (ab * RB) >> 2, m0 = (ab * RB) & 3, cu = ab & 1; float mu[RB], rs[RB], s1[RB], s2[RB];
            if (ab + 1 < 8 / RB) PG8_RL_LOAD(ab + 1, (ab + 1) & 1);
            asm volatile("" ::: "memory");
#pragma unroll
            for (int m = 0; m < RB; ++m) { s1[m] = 0.f; s2[m] = 0.f; mu[m] = 0.f; rs[m] = 1.f;
                if (!IDENT) { mu[m] = st[cu][m].x * (1.0f / 2048.0f); rs[m] = __builtin_amdgcn_rsqf(st[cu][m].y * (1.0f / 2048.0f) - mu[m] * mu[m] + 1e-5f); } }
            u32x4 lon[RB];
#pragma unroll
            for (int bj = 0; bj < 2; ++bj) { f32x4 gg[2], bb[2];
                if (!IDENT) {
#pragma unroll
                    for (int n = 0; n < 2; ++n) { gg[n] = *(const PG8_LAS f32x4*)(lgb + col0 + bj * HALF + 4 * n); bb[n] = *(const PG8_LAS f32x4*)(lgb + 2048 + col0 + bj * HALF + 4 * n); } }
#pragma unroll
                for (int m = 0; m < RB; ++m) { const unsigned off = (unsigned)((row0 + ai * HALF + (m0 + m) * 16) * 2048 + col0 + bj * HALF); f32x4 v[2]; const u32x4 h0 = hi[cu][m][bj];
                    if (IDENT) { const u32x4 l0 = xi[cu][m][bj]; v[0] = (f32x4){__uint_as_float(h0.x), __uint_as_float(h0.y), __uint_as_float(h0.z), __uint_as_float(h0.w)}; v[1] = (f32x4){__uint_as_float(l0.x), __uint_as_float(l0.y), __uint_as_float(l0.z), __uint_as_float(l0.w)}; }
                    else { const unsigned w0 = bj ? lo[cu][m].z : lo[cu][m].x, w1 = bj ? lo[cu][m].w : lo[cu][m].y;
                           const f32x2 a0 = __builtin_amdgcn_cvt_pk_f32_fp8((int)w0, false), a1 = __builtin_amdgcn_cvt_pk_f32_fp8((int)w0, true), a2 = __builtin_amdgcn_cvt_pk_f32_fp8((int)w1, false), a3 = __builtin_amdgcn_cvt_pk_f32_fp8((int)w1, true);
                           v[0] = (f32x4){bf_lo(h0.x) + a0.x * 0.00390625f, bf_hi(h0.x) + a0.y * 0.00390625f, bf_lo(h0.y) + a1.x * 0.00390625f, bf_hi(h0.y) + a1.y * 0.00390625f};
                           v[1] = (f32x4){bf_lo(h0.z) + a2.x * 0.00390625f, bf_hi(h0.z) + a2.y * 0.00390625f, bf_lo(h0.w) + a3.x * 0.00390625f, bf_hi(h0.w) + a3.y * 0.00390625f}; }
#pragma unroll
                    for (int n = 0; n < 2; ++n) { f32x4 x = v[n];
                        if (!IDENT) x = (x - mu[m]) * rs[m] * gg[n] + bb[n];
                        v[n] = x * alpha + acc[ai][bj][m0 + m][n] * scale;
                        if (WF32) *at32<f32x4>(yf32, 4u * off + 16u * n) = v[n];
                        s1[m] += (v[n][0] + v[n][1]) + (v[n][2] + v[n][3]); s2[m] += (v[n][0] * v[n][0] + v[n][1] * v[n][1]) + (v[n][2] * v[n][2] + v[n][3] * v[n][3]); }
                    const u32x4 h = pack8(v[0], v[1]);
                    const f32x4 d0 = {(v[0][0] - bf_lo(h.x)) * 256.0f, (v[0][1] - bf_hi(h.x)) * 256.0f, (v[0][2] - bf_lo(h.y)) * 256.0f, (v[0][3] - bf_hi(h.y)) * 256.0f},
                                d1 = {(v[1][0] - bf_lo(h.z)) * 256.0f, (v[1][1] - bf_hi(h.z)) * 256.0f, (v[1][2] - bf_lo(h.w)) * 256.0f, (v[1][3] - bf_hi(h.w)) * 256.0f};
                    int e0 = __builtin_amdgcn_cvt_pk_fp8_f32(d0[0], d0[1], 0, false); e0 = __builtin_amdgcn_cvt_pk_fp8_f32(d0[2], d0[3], e0, true);
                    int e1 = __builtin_amdgcn_cvt_pk_fp8_f32(d1[0], d1[1], 0, false); e1 = __builtin_amdgcn_cvt_pk_fp8_f32(d1[2], d1[3], e1, true);
                    if (bj == 0) { lon[m].x = (unsigned)e0; lon[m].y = (unsigned)e1; } else { lon[m].z = (unsigned)e0; lon[m].w = (unsigned)e1; }
                    if (!(SKIP & 2)) *at32<u32x4>(XB, 2u * off) = h; } }
#pragma unroll
            for (int m = 0; m < RB; ++m) { if (!(SKIP & 2)) __builtin_nontemporal_store(lon[m], lop + (ai * 4 + m0 + m) * 64);
                const float a = red16_32(s1[m]), b = red16_32(s2[m]);
                if (fq == 0) { const int rl = ai * HALF + wr * 64 + (m0 + m) * 16 + fr; xst[rl * 8 + wc] = a; xst[rl * 8 + 4 + wc] = b; } }
            asm volatile("" ::: "memory"); }
        asm volatile("s_waitcnt lgkmcnt(0)" ::: "memory"); __builtin_amdgcn_s_barrier(); asm volatile("" ::: "memory");
        { const int t = (wr * 4 + wc) * 64 + fq * 16 + fr;
          if (t < 256 && st_new && !(SKIP & 4)) { const PG8_LAS float* p = xst + t * 8; const float sa = (p[0] + p[1]) + (p[2] + p[3]), sb = (p[4] + p[5]) + (p[6] + p[7]); float* dst = st_new + 2 * (size_t)(row0 - wr * 64 - fr + t);
              unsafeAtomicAdd(dst, sa); unsafeAtomicAdd(dst + 1, sb); }
          asm volatile("s_waitcnt lgkmcnt(0)" ::: "memory"); }
    }
};
typedef EpiResLnT<false> EpiResLn; typedef EpiResLnT<true> EpiResLn0; typedef EpiResLnT<false, true> EpiResLnF;
struct EpiMqt {
    static constexpr bool PERM = true, AFTER_DRAIN = false, PREF = false;
    bf16_t* O; int ldc; float scale; const float* gk; const float* bk; float* cs; float* cb;
    __device__ __forceinline__ void operator()(PG8_EPI_ARGS) const {
        const int row0 = u.pm * BM + wr * 64 + fr, col0 = u.pn * BM + wc * 32 + 8 * fq;
        f32x4 gg[2][2], bb[2][2];
#pragma unroll
        for (int bj = 0; bj < 2; ++bj)
#pragma unroll
            for (int n = 0; n < 2; ++n) { gg[bj][n] = *(const f32x4*)(gk + col0 + bj * HALF + 4 * n); bb[bj][n] = *(const f32x4*)(bk + col0 + bj * HALF + 4 * n); }
#pragma unroll
        for (int ai = 0; ai < 2; ++ai)
#pragma unroll
            for (int m = 0; m < 4; ++m) { const int r = row0 + ai * HALF + m * 16; float s1 = 0.f, s2 = 0.f;
#pragma unroll
                for (int bj = 0; bj < 2; ++bj) { const f32x4 v0 = acc[ai][bj][m][0] * scale, v1 = acc[ai][bj][m][1] * scale;
                    const u32x4 w = pack8(v0 * gg[bj][0], v1 * gg[bj][1]);
                    *(u32x4*)(O + (size_t)r * ldc + col0 + bj * HALF) = w;
                    s1 += (bf_lo(w.x) + bf_hi(w.x)) + (bf_lo(w.y) + bf_hi(w.y)) + (bf_lo(w.z) + bf_hi(w.z)) + (bf_lo(w.w) + bf_hi(w.w));
                    const f32x4 t0 = v0 * bb[bj][0], t1 = v1 * bb[bj][1]; s2 += (t0[0] + t0[1]) + (t0[2] + t0[3]) + (t1[0] + t1[1]) + (t1[2] + t1[3]); }
                s1 = red16_32(s1); s2 = red16_32(s2);
                if (fq == 0) { unsafeAtomicAdd(cs + r, s1); unsafeAtomicAdd(cb + r, s2); } }
    }
};
template <int UGP> struct EpiWin {
    static constexpr bool PERM = true, AFTER_DRAIN = false, PREF = true;
    bf16_t* QKV; bf16_t* UG; float qscale; Fold f; PG8_LAS unsigned char* pf;
    __device__ __forceinline__ void pref(const Unit& u) const { fold_prefetch(f, u, pf); }
    __device__ __forceinline__ void operator()(PG8_EPI_ARGS) const {
        const int row0 = u.pm * BM + wr * 64 + fr;
        f32x4 cs[2][2], cb[2][2]; float mus[2][4], rss[2][4]; fold_from_lds(pf, wr, wc, fr, fq, cs, cb, mus, rss);
        if (u.pn < 12) {
            const float sc = u.pn < 4 ? qscale : 1.0f; const int col0 = u.pn * BM + wc * 32 + 8 * fq;
#pragma unroll
            for (int ai = 0; ai < 2; ++ai)
#pragma unroll
                for (int m = 0; m < 4; ++m) { const int r = row0 + ai * HALF + m * 16; const float mu = mus[ai][m], rs = rss[ai][m]; const unsigned bo = 2u * (unsigned)(r * 3072 + col0);
#pragma unroll
                    for (int bj = 0; bj < 2; ++bj) *at32<u32x4>(QKV, bo + 2u * bj * HALF) = pack8(fold4(acc[ai][bj][m][0], mu, rs, cs[bj][0], cb[bj][0]) * sc, fold4(acc[ai][bj][m][1], mu, rs, cs[bj][1], cb[bj][1]) * sc); }
        } else {
#pragma unroll
            for (int ai = 0; ai < 2; ++ai)
#pragma unroll
                for (int m = 0; m < 4; ++m) { const int r = row0 + ai * HALF + m * 16, b = r >> 14, c = (r >> 6) & 255, s = r & 63; const float mu = mus[ai][m], rs = rss[ai][m];
#pragma unroll
                    for (int bj = 0; bj < 2; ++bj) { const int j0 = (u.pn - 12) * BM + bj * HALF + wc * 32 + 8 * fq, g = j0 >> 4, q0 = j0 & 15;
                        *at32<u32x4>(UG, 2u * (unsigned)((g * 512 + b * 256 + c) * UGP + 128 + s * 16 + q0)) = pack8(fold4(acc[ai][bj][m][0], mu, rs, cs[bj][0], cb[bj][0]), fold4(acc[ai][bj][m][1], mu, rs, cs[bj][1], cb[bj][1])); } }
        }
    }
};
template <int UGP> struct EpiSsmY {
    static constexpr bool PERM = true, AFTER_DRAIN = false, PREF = false;
    const bf16_t* UG; const float* dskip; bf16_t* YG;
    __device__ __forceinline__ void operator()(PG8_EPI_ARGS) const {
        const int R0 = u.pm * BM + wr * 64 + fr, g = R0 >> 9, b = (R0 >> 8) & 1;
        f32x4 d0[2], d1[2];
#pragma unroll
        for (int bj = 0; bj < 2; ++bj) { const int p0 = (bj * HALF + wc * 32 + 8 * fq) & 15; d0[bj] = *(const f32x4*)(dskip + g * 16 + p0); d1[bj] = *(const f32x4*)(dskip + g * 16 + p0 + 4); }
#pragma unroll
        for (int ai = 0; ai < 2; ++ai) { u32x4 uu[4][2];
#pragma unroll
            for (int m = 0; m < 4; ++m)
#pragma unroll
                for (int bj = 0; bj < 2; ++bj) uu[m][bj] = *at32<const u32x4>(UG, 2u * (unsigned)((R0 + ai * HALF + m * 16) * UGP + 128 + u.pn * BM + bj * HALF + wc * 32 + 8 * fq));
            asm volatile("" ::: "memory");
#pragma unroll
            for (int m = 0; m < 4; ++m) { const int c = (R0 + ai * HALF + m * 16) & 255;
#pragma unroll
                for (int bj = 0; bj < 2; ++bj) { const int col = u.pn * BM + bj * HALF + wc * 32 + 8 * fq, t = col >> 4, p0 = col & 15; const u32x4 w = uu[m][bj];
                    f32x4 y0 = acc[ai][bj][m][0], y1 = acc[ai][bj][m][1];
                    y0[0] += d0[bj][0] * bf_lo(w.x); y0[1] += d0[bj][1] * bf_hi(w.x); y0[2] += d0[bj][2] * bf_lo(w.y); y0[3] += d0[bj][3] * bf_hi(w.y);
                    y1[0] += d1[bj][0] * bf_lo(w.z); y1[1] += d1[bj][1] * bf_hi(w.z); y1[2] += d1[bj][2] * bf_lo(w.w); y1[3] += d1[bj][3] * bf_hi(w.w);
#pragma unroll
                    for (int e = 0; e < 4; ++e) { const float a = y0[e], bq = y1[e];
                        y0[e] = a * __builtin_amdgcn_rcpf(1.0f + __builtin_amdgcn_exp2f(-2.3022081983f * (a + 0.044715f * a * a * a))); y1[e] = bq * __builtin_amdgcn_rcpf(1.0f + __builtin_amdgcn_exp2f(-2.3022081983f * (bq + 0.044715f * bq * bq * bq))); }
                    *at32<u32x4>(YG, 2u * (unsigned)((b * 16384 + c * 64 + t) * 1024 + g * 16 + p0)) = pack8(y0, y1); } }
            asm volatile("" ::: "memory"); }
    }
};
struct EpiGlu {
    static constexpr bool PERM = true, AFTER_DRAIN = false, PREF = false;
    const bf16_t* YG; const float* bias; bf16_t* MIX;
    __device__ __forceinline__ void operator()(PG8_EPI_ARGS) const {
        const int row0 = u.pm * BM + wr * 64 + fr, col0 = u.pn * BM + wc * 32 + 8 * fq;
        f32x4 b0[2], b1[2];
#pragma unroll
        for (int bj = 0; bj < 2; ++bj) { b0[bj] = *(const f32x4*)(bias + col0 + bj * HALF); b1[bj] = *(const f32x4*)(bias + col0 + bj * HALF + 4); }
#pragma unroll
        for (int ai = 0; ai < 2; ++ai) { u32x4 yy[4][2];
#pragma unroll
            for (int m = 0; m < 4; ++m)
#pragma unroll
                for (int bj = 0; bj < 2; ++bj) yy[m][bj] = *at32<const u32x4>(YG, 2u * (unsigned)((row0 + ai * HALF + m * 16) * 1024 + col0 + bj * HALF));
            asm volatile("" ::: "memory");
#pragma unroll
            for (int m = 0; m < 4; ++m) { const int r = row0 + ai * HALF + m * 16;
#pragma unroll
                for (int bj = 0; bj < 2; ++bj) { const u32x4 w = yy[m][bj];
                    const f32x4 z0 = acc[ai][bj][m][0] + b0[bj], z1 = acc[ai][bj][m][1] + b1[bj]; f32x4 o0, o1;
                    o0[0] = bf_lo(w.x) * sigmoid_f(z0[0]); o0[1] = bf_hi(w.x) * sigmoid_f(z0[1]); o0[2] = bf_lo(w.y) * sigmoid_f(z0[2]); o0[3] = bf_hi(w.y) * sigmoid_f(z0[3]);
                    o1[0] = bf_lo(w.z) * sigmoid_f(z1[0]); o1[1] = bf_hi(w.z) * sigmoid_f(z1[1]); o1[2] = bf_lo(w.w) * sigmoid_f(z1[2]); o1[3] = bf_hi(w.w) * sigmoid_f(z1[3]);
                    *at32<u32x4>(MIX, 2u * (unsigned)(r * 2048 + 1024 + col0 + bj * HALF)) = pack8(o0, o1); } }
            asm volatile("" ::: "memory"); }
    }
};
#ifndef PG8_ASMDMA
#define PG8_ASMDMA 1
#endif
#ifndef PG8_BAL
#define PG8_BAL 1
#endif
template <class Epi, class Sched, bool ALIGN_EPI = false, bool SP2 = false>
__device__ __forceinline__ void gemm_phase(PG8_LAS unsigned char* lds, const Gemm g, const Sched& S, const Epi& E) {
    const int tid = otid(), wid = __builtin_amdgcn_readfirstlane(tid >> 6), lane = tid & 63, wr = wid >> 2, wc = wid & 3, fr = lane & 15, fq = lane >> 4;
    const int K = g.K, nt_def = K / BK;
    unsigned voffA[2], voffB[2];
#pragma unroll
    for (int i = 0; i < 2; ++i) { int R, C; stage_rc(tid * 16 + i * 8192, R, C); const int Rb = Epi::PERM ? ((R & ~31) + perm32(R & 31)) : R;
        voffA[i] = (unsigned)(R * g.lda + C) * 2u; voffB[i] = (unsigned)(Rb * g.ldb + C) * 2u; }
    const size_t kstep = (size_t)(BK * 2);
    const size_t hstepA = (size_t)HALF * g.lda * 2, hstepB = (size_t)HALF * g.ldb * 2;
    const unsigned ldsbase = (unsigned)(__UINTPTR_TYPE__)lds;
    const unsigned ldsw = (unsigned)wid * 1024u;
    const int aoff = lds_byte(wr * 64 + fr, fq * 8), boff = lds_byte(wc * 32 + fr, fq * 8);
#define PG8_SA(b, h) (((b) * 2 + (h)) * HTB)
#define PG8_SB(b, h) ((4 + (b) * 2 + (h)) * HTB)
#if PG8_ASMDMA
#define PG8_STAGE(bufoff, gbase, voff) do { _Pragma("unroll") for (int _i = 0; _i < 2; ++_i) { \
        const unsigned la_ = (unsigned)__builtin_amdgcn_readfirstlane((int)(ldsbase + (unsigned)(bufoff) + ldsw + (unsigned)(_i * 8192))); const char* gb_ = (const char*)(gbase); \
        asm volatile("s_mov_b32 m0, %2\n\ts_nop 0\n\tglobal_load_lds_dwordx4 %0, %1" :: "v"((voff)[_i]), "s"(gb_), "s"(la_) : "memory", "m0"); } } while (0)
#else
#define PG8_STAGE(bufoff, gbase, voff) do { _Pragma("unroll") for (int _i = 0; _i < 2; ++_i) \
        __builtin_amdgcn_global_load_lds((const unsigned*)((const char*)(gbase) + (voff)[_i]), (PG8_LAS unsigned*)(lds + (bufoff) + ldsw + _i * 8192), 16, 0, 0); } while (0)
#endif
#define PG8_LDA(dst, b, h) do { _Pragma("unroll") for (int m = 0; m < 4; ++m) _Pragma("unroll") for (int k = 0; k < 2; ++k) dst[m][k] = *(const PG8_LAS bf16x8*)(lds + PG8_SA(b, h) + aoff + m * 2048 + k * 1024); } while (0)
#define PG8_LDB(dst, b, h) do { _Pragma("unroll") for (int n = 0; n < 2; ++n) _Pragma("unroll") for (int k = 0; k < 2; ++k) dst[n][k] = *(const PG8_LAS bf16x8*)(lds + PG8_SB(b, h) + boff + n * 2048 + k * 1024); } while (0)
#define PG8_MMA(ai, bj, At, Bt) do { __builtin_amdgcn_s_setprio(1); _Pragma("unroll") for (int m = 0; m < 4; ++m) _Pragma("unroll") for (int n = 0; n < 2; ++n) _Pragma("unroll") for (int k = 0; k < 2; ++k) \
        acc[ai][bj][m][n] = __builtin_amdgcn_mfma_f32_16x16x32_bf16(Bt[n][k], At[m][k], acc[ai][bj][m][n], 0, 0, 0); __builtin_amdgcn_s_setprio(0); } while (0)
#define PG8_WAIT_V(n) asm volatile("s_waitcnt vmcnt(" #n ")" ::: "memory")
#define PG8_WAIT_L(n) asm volatile("s_waitcnt lgkmcnt(" #n ")" ::: "memory")
#define PG8_BAR __builtin_amdgcn_s_barrier()
#define PG8_SCHED __builtin_amdgcn_sched_barrier(0)
    Unit cur, nxt; int ui = 0;
    if (!S.next(0, cur)) return;
    f32x4 acc[2][2][4][2];
#pragma unroll
    for (int a = 0; a < 2; ++a)
#pragma unroll
        for (int b = 0; b < 2; ++b)
#pragma unroll
            for (int m = 0; m < 4; ++m)
#pragma unroll
                for (int n = 0; n < 2; ++n) acc[a][b][m][n] = (f32x4){0.f, 0.f, 0.f, 0.f};
    bf16x8 At[4][2], B0[2][2], B1[2][2];
    const char* cA = (const char*)g.A + (size_t)cur.aoff * 2; const char* cB = (const char*)g.Bt + (size_t)cur.boff * 2;
    S.a_ready(cur);
    if constexpr (SP2) {
        PG8_STAGE(PG8_SB(0, 0), cB, voffB); PG8_STAGE(PG8_SB(0, 1), cB + hstepB, voffB); PG8_STAGE(PG8_SA(0, 0), cA, voffA); PG8_STAGE(PG8_SA(0, 1), cA + hstepA, voffA);
        if (wr == 1) PG8_BAR;
        PG8_WAIT_V(2); PG8_BAR;
#if PG8_BAL
        PG8_STAGE(PG8_SB(1, 0), cB + kstep, voffB); PG8_STAGE(PG8_SB(1, 1), cB + hstepB + kstep, voffB);
        PG8_WAIT_V(4); PG8_BAR;
#else
        PG8_STAGE(PG8_SB(1, 0), cB + kstep, voffB); PG8_STAGE(PG8_SA(1, 0), cA + kstep, voffA); PG8_STAGE(PG8_SB(1, 1), cB + hstepB + kstep, voffB);
        PG8_WAIT_V(6); PG8_BAR;
#endif
    } else {
        PG8_STAGE(PG8_SB(0, 0), cB, voffB); PG8_STAGE(PG8_SA(0, 0), cA, voffA); PG8_STAGE(PG8_SB(0, 1), cB + hstepB, voffB); PG8_STAGE(PG8_SA(0, 1), cA + hstepA, voffA);
        if (wr == 1) PG8_BAR;
        PG8_WAIT_V(4); PG8_BAR;
        PG8_STAGE(PG8_SB(1, 0), cB + kstep, voffB); PG8_STAGE(PG8_SA(1, 0), cA + kstep, voffA); PG8_STAGE(PG8_SB(1, 1), cB + hstepB + kstep, voffB);
        PG8_WAIT_V(6); PG8_BAR;
    }
    for (;;) {
        const bool has_next = S.next(ui + 1, nxt);
        const char* nA = has_next ? (const char*)g.A + (size_t)nxt.aoff * 2 : cA; const char* nB = has_next ? (const char*)g.Bt + (size_t)nxt.boff * 2 : cB;
        const int nt = cur.nt ? cur.nt : nt_def;
        for (int t = 0; t < nt; t += 2) {
            const bool last = (t == nt - 2);
            const char* a1 = cA + (size_t)(t + 1) * kstep;
            const char* a2 = last ? nA : cA + (size_t)(t + 2) * kstep; const char* b2 = last ? nB : cB + (size_t)(t + 2) * kstep;
            const char* a3 = a2 + kstep; const char* b3 = b2 + kstep;
            if (last && has_next) S.a_ready(nxt);
            if constexpr (Epi::PREF) { if (last) E.pref(cur); }
            if constexpr (SP2) {
#if PG8_BAL
            PG8_LDB(B0, 0, 0); PG8_LDB(B1, 0, 1); PG8_SCHED; PG8_LDA(At, 0, 0); PG8_STAGE(PG8_SA(1, 0), a1, voffA); PG8_STAGE(PG8_SA(1, 1), a1 + hstepA, voffA);
            PG8_WAIT_V(8); PG8_WAIT_L(0); PG8_BAR; PG8_MMA(0, 0, At, B0); PG8_MMA(0, 1, At, B1); PG8_BAR; PG8_SCHED;
            PG8_LDA(At, 0, 1); PG8_STAGE(PG8_SB(0, 0), b2, voffB); PG8_STAGE(PG8_SB(0, 1), b2 + hstepB, voffB);
            PG8_WAIT_V(6); PG8_WAIT_L(0); PG8_BAR; PG8_MMA(1, 0, At, B0); PG8_MMA(1, 1, At, B1); PG8_BAR; PG8_SCHED;
            PG8_LDB(B0, 1, 0); PG8_LDB(B1, 1, 1); PG8_SCHED; PG8_LDA(At, 1, 0); PG8_STAGE(PG8_SA(0, 0), a2, voffA); PG8_STAGE(PG8_SA(0, 1), a2 + hstepA, voffA);
            PG8_WAIT_V(8); PG8_WAIT_L(0); PG8_BAR; PG8_MMA(0, 0, At, B0); PG8_MMA(0, 1, At, B1); PG8_BAR; PG8_SCHED;
            PG8_LDA(At, 1, 1); PG8_STAGE(PG8_SB(1, 0), b3, voffB); PG8_STAGE(PG8_SB(1, 1), b3 + hstepB, voffB);
            PG8_WAIT_V(6); PG8_WAIT_L(0); PG8_BAR; PG8_MMA(1, 0, At, B0); PG8_MMA(1, 1, At, B1); PG8_BAR; PG8_SCHED;
            (void)a3;
#else
            PG8_LDB(B0, 0, 0); PG8_LDB(B1, 0, 1); PG8_SCHED; PG8_LDA(At, 0, 0); PG8_STAGE(PG8_SA(1, 1), a1 + hstepA, voffA);
            PG8_WAIT_V(8); PG8_WAIT_L(0); PG8_BAR; PG8_MMA(0, 0, At, B0); PG8_MMA(0, 1, At, B1); PG8_BAR; PG8_SCHED;
            PG8_LDA(At, 0, 1); PG8_STAGE(PG8_SB(0, 0), b2, voffB); PG8_STAGE(PG8_SB(0, 1), b2 + hstepB, voffB); PG8_STAGE(PG8_SA(0, 0), a2, voffA);
            PG8_WAIT_V(8); PG8_WAIT_L(0); PG8_BAR; PG8_MMA(1, 0, At, B0); PG8_MMA(1, 1, At, B1); PG8_BAR; PG8_SCHED;
            PG8_LDB(B0, 1, 0); PG8_LDB(B1, 1, 1); PG8_SCHED; PG8_LDA(At, 1, 0); PG8_STAGE(PG8_SA(0, 1), a2 + hstepA, voffA);
            PG8_WAIT_V(8); PG8_WAIT_L(0); PG8_BAR; PG8_MMA(0, 0, At, B0); PG8_MMA(0, 1, At, B1); PG8_BAR; PG8_SCHED;
            PG8_LDA(At, 1, 1); PG8_STAGE(PG8_SB(1, 0), b3, voffB); PG8_STAGE(PG8_SB(1, 1), b3 + hstepB, voffB); PG8_STAGE(PG8_SA(1, 0), a3, voffA);
            PG8_WAIT_V(8); PG8_WAIT_L(0); PG8_BAR; PG8_MMA(1, 0, At, B0); PG8_MMA(1, 1, At, B1); PG8_BAR; PG8_SCHED;
#endif
            } else {
            PG8_LDB(B0, 0, 0); PG8_SCHED; PG8_LDA(At, 0, 0); PG8_STAGE(PG8_SA(1, 1), a1 + hstepA, voffA);
            PG8_WAIT_L(8); PG8_BAR; PG8_WAIT_L(0); PG8_MMA(0, 0, At, B0); PG8_BAR; PG8_SCHED;
            PG8_LDB(B1, 0, 1); PG8_STAGE(PG8_SB(0, 0), b2, voffB);
            PG8_BAR; PG8_WAIT_L(0); PG8_MMA(0, 1, At, B1); PG8_BAR;
            PG8_LDA(At, 0, 1); PG8_STAGE(PG8_SA(0, 0), a2, voffA);
            PG8_BAR; PG8_WAIT_L(0); PG8_MMA(1, 0, At, B0); PG8_BAR; PG8_SCHED;
            PG8_STAGE(PG8_SB(0, 1), b2 + hstepB, voffB);
            PG8_WAIT_V(6); PG8_BAR; PG8_MMA(1, 1, At, B1); PG8_BAR;
            PG8_LDB(B0, 1, 0); PG8_SCHED; PG8_LDA(At, 1, 0); PG8_STAGE(PG8_SA(0, 1), a2 + hstepA, voffA);
            PG8_WAIT_L(8); PG8_BAR; PG8_WAIT_L(0); PG8_MMA(0, 0, At, B0); PG8_BAR; PG8_SCHED;
            PG8_LDB(B1, 1, 1); PG8_STAGE(PG8_SB(1, 0), b3, voffB);
            PG8_BAR; PG8_WAIT_L(0); PG8_MMA(0, 1, At, B1); PG8_BAR;
            PG8_LDA(At, 1, 1); PG8_STAGE(PG8_SA(1, 0), a3, voffA);
            PG8_BAR; PG8_WAIT_L(0); PG8_MMA(1, 0, At, B0); PG8_BAR; PG8_SCHED;
            PG8_STAGE(PG8_SB(1, 1), b3 + hstepB, voffB);
            PG8_WAIT_V(6); PG8_BAR; PG8_MMA(1, 1, At, B1); PG8_BAR;
            }
        }
        if constexpr (ALIGN_EPI) { if (wr == 0) PG8_BAR; }
        if constexpr (!Epi::AFTER_DRAIN) { E(acc, cur, wr, wc, fr, fq); S.done(cur); }
        if (!has_next) break;
#pragma unroll
        for (int a = 0; a < 2; ++a)
#pragma unroll
            for (int b = 0; b < 2; ++b)
#pragma unroll
                for (int m = 0; m < 4; ++m)
#pragma unroll
                    for (int n = 0; n < 2; ++n) acc[a][b][m][n] = (f32x4){0.f, 0.f, 0.f, 0.f};
        cur = nxt; cA = nA; cB = nB; ++ui;
        if constexpr (ALIGN_EPI) { if (wr == 1) PG8_BAR; }
    }
    PG8_WAIT_V(0);
    if constexpr (!ALIGN_EPI) { if (wr == 0) PG8_BAR; }
    PG8_BAR;
    if constexpr (Epi::AFTER_DRAIN) { E.fused(acc, cur, wr, wc, fr, fq, lds, wid, lane); S.done(cur); }
#undef PG8_SA
#undef PG8_SB
#undef PG8_STAGE
#undef PG8_LDA
#undef PG8_LDB
#undef PG8_MMA
#undef PG8_WAIT_V
#undef PG8_WAIT_L
#undef PG8_BAR
#undef PG8_SCHED
}
}
#include <hip/hip_bf16.h>
#include <cmath>
namespace attn_body {
using bf16=__hip_bfloat16;
using bf16x8=__attribute__((ext_vector_type(8)))short;
using s16x4=__attribute__((ext_vector_type(4)))short;
using f32x16=__attribute__((ext_vector_type(16)))float;
using u32x4=__attribute__((ext_vector_type(4)))unsigned;
constexpr int BATCH=2,NVH=32,SEQ=16384,D=64,DM=3072,DMO=2048;
constexpr int NW=8,QBLK=32,QB=QBLK*NW,KVBLK=64,NQB=SEQ/QB;
constexpr int ATTN_PITCH=DM, ATTN_UNIT_ROWS=QB;
__device__ __forceinline__ int crow(int r,int hi){return (r&3)+8*(r>>2)+4*hi;}
#define SBAR() __builtin_amdgcn_sched_barrier(0)
__device__ __forceinline__ void cmask(f32x16&p0,f32x16&p1,int jb,int qrel,int hi){
  const float NEG=-INFINITY; (void)hi;
  if(jb>(qrel>>6)){
  #pragma unroll
  for(int r=0;r<16;++r){p0[r]=NEG;p1[r]=NEG;}}
}

constexpr int NSLOT=3, SLOTB=8192;
constexpr int LDS_K=0, LDS_V=NSLOT*SLOTB, LDS_WS=2*NSLOT*SLOTB, LDS_OST=LDS_WS+NW*64*4, LDS_BYTES=LDS_OST+NW*4096;
constexpr float C2=0.125f*1.4426950408889634f;
__device__ __forceinline__ void glds16(const void*gsrc,unsigned lds_dst){unsigned keep;
  asm volatile("s_mov_b32 %0, m0\n\ts_mov_b32 m0, %2\n\ts_nop 0\n\tglobal_load_lds_dwordx4 %1, off\n\ts_mov_b32 m0, %0":"=&s"(keep):"v"(gsrc),"s"(lds_dst):"memory");}
__device__ __forceinline__ void glds16s(const void*gbase,unsigned voff,unsigned lds_dst){
  asm volatile("s_mov_b32 m0, %2\n\ts_nop 0\n\tglobal_load_lds_dwordx4 %0, %1"::"v"(voff),"s"(gbase),"s"(lds_dst):"memory","m0");}
__device__ __forceinline__ float max3f(float a,float b,float c){float r;asm("v_max3_f32 %0, %1, %2, %3":"=v"(r):"v"(a),"v"(b),"v"(c));return r;}
__device__ __forceinline__ float max2f(float a,float b){float r;asm("v_max_f32_e32 %0, %1, %2":"=v"(r):"v"(a),"v"(b));return r;}
__device__ __forceinline__ float fadd_s(float a,float b){float r;asm("v_add_f32_e32 %0, %1, %2":"=v"(r):"v"(a),"v"(b));return r;}
__device__ __forceinline__ float fsub_s(float a,float b){float r;asm("v_sub_f32_e32 %0, %1, %2":"=v"(r):"v"(a),"v"(b));return r;}
typedef float f32x2_t __attribute__((ext_vector_type(2))); typedef __bf16 bf16x2_t __attribute__((ext_vector_type(2)));
__device__ __forceinline__ unsigned cvtpk_s(float lo,float hi){f32x2_t v={lo,hi};bf16x2_t b=__builtin_convertvector(v,bf16x2_t);return __builtin_bit_cast(unsigned,b);}
#define WAIT_BAR(N) asm volatile("s_waitcnt vmcnt(" #N ") lgkmcnt(0)\n\ts_barrier":::"memory")

__device__ __forceinline__ void qkt(f32x16&p0,f32x16&p1,const char*Kslot,const bf16x8*qr,const f32x16&negm,int r32,int hi){
  const char*kb=Kslot+hi*1024+r32*16;
  #pragma unroll
  for(int d0=0;d0<4;++d0){
    const bf16x8 b0=*reinterpret_cast<const bf16x8*>(kb+d0*2048);
    const bf16x8 b1=*reinterpret_cast<const bf16x8*>(kb+d0*2048+512);
    if(d0==0){p0=__builtin_amdgcn_mfma_f32_32x32x16_bf16(b0,qr[0],negm,0,0,0);p1=__builtin_amdgcn_mfma_f32_32x32x16_bf16(b1,qr[0],negm,0,0,0);}
    else{p0=__builtin_amdgcn_mfma_f32_32x32x16_bf16(b0,qr[d0],p0,0,0,0);p1=__builtin_amdgcn_mfma_f32_32x32x16_bf16(b1,qr[d0],p1,0,0,0);}}
}
typedef __attribute__((address_space(3))) const char* lds_cptr;
typedef short v4i16_t __attribute__((ext_vector_type(4)));
__device__ __forceinline__ void kload8(bf16x8*kf,lds_cptr kp){
  kf[0]=*(const __attribute__((address_space(3))) bf16x8*)(kp);      kf[1]=*(const __attribute__((address_space(3))) bf16x8*)(kp+512);
  kf[2]=*(const __attribute__((address_space(3))) bf16x8*)(kp+2048); kf[3]=*(const __attribute__((address_space(3))) bf16x8*)(kp+2560);
  kf[4]=*(const __attribute__((address_space(3))) bf16x8*)(kp+4096); kf[5]=*(const __attribute__((address_space(3))) bf16x8*)(kp+4608);
  kf[6]=*(const __attribute__((address_space(3))) bf16x8*)(kp+6144); kf[7]=*(const __attribute__((address_space(3))) bf16x8*)(kp+6656);
}
__device__ __forceinline__ void kload2(bf16x8*kf,lds_cptr kp,int j){ kf[2*j]=*(const __attribute__((address_space(3))) bf16x8*)(kp+j*2048); kf[2*j+1]=*(const __attribute__((address_space(3))) bf16x8*)(kp+j*2048+512); }
__device__ __forceinline__ s16x4 vtr(lds_cptr p){ return __builtin_bit_cast(s16x4,__builtin_amdgcn_ds_read_tr16_b64_v4i16((__attribute__((address_space(3))) v4i16_t*)p)); }
__device__ __forceinline__ float rowmax(const f32x16&p0,const f32x16&p1){
  float a=max3f(p0[0],p0[1],p1[0]),b=max3f(p0[2],p0[3],p1[1]);a=max3f(a,p1[2],p1[3]);
  #pragma unroll
  for(int r=4;r<16;r+=4){a=max3f(a,p0[r],p0[r+1]);b=max3f(b,p0[r+2],p0[r+3]);a=max3f(a,p1[r],p1[r+1]);b=max3f(b,p1[r+2],p1[r+3]);}
  const float m=max2f(a,b);
  auto rr=__builtin_amdgcn_permlane32_swap(__float_as_uint(m),__float_as_uint(m),false,false);
  return max2f(__uint_as_float(rr[0]),__uint_as_float(rr[1]));
}
__device__ __forceinline__ void pv(f32x16*o,int vb,bf16x8 pa0,bf16x8 pa1,bf16x8 pa2,bf16x8 pa3){
  #pragma unroll
  for(int d0=0;d0<2;++d0){s16x4 lo[4],hi[4];
    #pragma unroll
    for(int ks=0;ks<4;++ks){
      asm volatile("ds_read_b64_tr_b16 %0,%1 offset:%c2":"=&v"(lo[ks]):"v"(vb),"i"(d0*4096+ks*1024):"memory");
      asm volatile("ds_read_b64_tr_b16 %0,%1 offset:%c2":"=&v"(hi[ks]):"v"(vb),"i"(d0*4096+ks*1024+512):"memory");}
    asm volatile("s_waitcnt lgkmcnt(0)":::"memory");SBAR();
    #define PK(k) (bf16x8){lo[k][0],lo[k][1],lo[k][2],lo[k][3],hi[k][0],hi[k][1],hi[k][2],hi[k][3]}
    o[d0]=__builtin_amdgcn_mfma_f32_32x32x16_bf16(pa0,PK(0),o[d0],0,0,0);
    o[d0]=__builtin_amdgcn_mfma_f32_32x32x16_bf16(pa1,PK(1),o[d0],0,0,0);
    o[d0]=__builtin_amdgcn_mfma_f32_32x32x16_bf16(pa2,PK(2),o[d0],0,0,0);
    o[d0]=__builtin_amdgcn_mfma_f32_32x32x16_bf16(pa3,PK(3),o[d0],0,0,0);
    #undef PK
  }
}

#ifndef ATTN_STORE16
#define ATTN_STORE16(p,v) __builtin_nontemporal_store((v),(u32x4*)(p))
#endif
template<int THRL> __device__ __forceinline__ void attn_unit(int b,int qb,const bf16*__restrict__ Q,const bf16*__restrict__ K,const bf16*__restrict__ V,bf16*__restrict__ O,char*shm){
  const int tid=pg8::otid(),lane=tid&63,r32=lane&31,hi=lane>>5; const int wid=__builtin_amdgcn_readfirstlane(tid>>6);
  const long rowbase=(long)b*SEQ; const int q0=qb*QB;
  const bf16*Qw=Q+(rowbase+q0+wid*QBLK)*DM;
  const bf16*Kh=K+rowbase*DM,*Vh=V+rowbase*DM;
  const unsigned lds0=(unsigned)(uintptr_t)shm;
  float*wsf=(float*)(shm+LDS_WS)+wid*64;
  const bf16*ksrc=Kh+(long)lane*DM+wid*8;
  const bf16*vsrc=Vh+(long)(16*(wid&3)+(lane>>2))*DM+(wid>>2)*32+(lane&3)*8;
  const unsigned kdst=lds0+LDS_K+wid*1024, vdst=lds0+LDS_V+wid*1024;
  #define DMA_K(t,slot) glds16(ksrc+(long)(t)*KVBLK*DM,(unsigned)__builtin_amdgcn_readfirstlane(kdst+(slot)))
  #define DMA_V(t,slot) glds16(vsrc+(long)(t)*KVBLK*DM,(unsigned)__builtin_amdgcn_readfirstlane(vdst+(slot)))
  const int vb0=(int)(lds0+LDS_V)+((lane>>4)&1)*32+(lane&3)*8+(4*hi+((lane&15)>>2))*64;
  const char*Kbase=shm+LDS_K; bf16x8 kf[8];
  const lds_cptr shm3=(lds_cptr)shm; const lds_cptr kp0=shm3+LDS_K+hi*1024+r32*16; const lds_cptr vp0=shm3+LDS_V+((lane>>4)&1)*32+(lane&3)*8+(4*hi+((lane&15)>>2))*64;
  const int NT=(q0+QB)/KVBLK;
  DMA_K(0,0);DMA_V(0,0);DMA_K(1,SLOTB);
  bf16x8 qr[4];
  #pragma unroll
  for(int d0=0;d0<4;++d0)qr[d0]=*reinterpret_cast<const bf16x8*>(&Qw[(long)r32*DM+d0*16+hi*8]);
  float mhat=0.f,l_reg=0.f;f32x16 o[2];o[0]=f32x16{};o[1]=f32x16{};f32x16 negm=f32x16{};asm volatile("":"+v"(negm));
  const int qrel=wid*QBLK+r32;
  #define CMASK(P0,P1,t) do{int jb_=(t)-(NT-4); if(jb_>=0)cmask(P0,P1,jb_,qrel,hi);}while(0)
  bool resc=false;
  #define START(P0,P1) do{ const float rm=rowmax(P0,P1); resc=false; \
    { const float dl=rm; mhat=fadd_s(mhat,dl); \
      _Pragma("unroll") for(int r=0;r<16;++r){P0[r]=fsub_s(P0[r],dl);P1[r]=fsub_s(P1[r],dl);} \
      _Pragma("unroll") for(int r=0;r<16;++r)negm[r]=-mhat; asm volatile("":"+v"(negm)); } \
    _Pragma("unroll") for(int r=0;r<16;++r)P0[r]=__builtin_amdgcn_exp2f(P0[r]); }while(0)
  #define RESC() do{ if(resc){ asm volatile("s_waitcnt lgkmcnt(0)":::"memory"); \
      _Pragma("unroll") for(int d_=0;d_<2;++d_) _Pragma("unroll") for(int r=0;r<16;++r)o[d_][r]*=wsf[crow(r,hi)]; } }while(0)
  f32x16 pA0,pA1,pB0,pB1;
  int sl_prev=0,sl_cur=0,sl_next=SLOTB;
  #define ROT() do{sl_prev=sl_cur;sl_cur=sl_next;sl_next=(sl_next==(NSLOT-1)*SLOTB)?0:sl_next+SLOTB;}while(0)
  DMA_K(2,2*SLOTB);
  WAIT_BAR(3);
  qkt(pA0,pA1,Kbase,qr,negm,r32,hi);asm volatile("s_nop 15\n\ts_nop 7":"+v"(pA0),"+v"(pA1));CMASK(pA0,pA1,0);
  START(pA0,pA1);
  _Pragma("unroll") for(int r=0;r<16;++r)pA1[r]=__builtin_amdgcn_exp2f(pA1[r]);
  WAIT_BAR(0);
  DMA_K(3,0);DMA_V(1,SLOTB);
  ROT();
  kload8(kf,kp0+sl_cur);
  WAIT_BAR(2);
  s16x4 vlo[8],vhi[8]; u32x4 pw0,pw1,pw2,pw3;
  #define PKW(P,B) cvtpk_s(P[B],P[B+1])
  #define PAF(k) __builtin_bit_cast(bf16x8,pw##k)
  #define VFR(i) (bf16x8){vlo[i][0],vlo[i][1],vlo[i][2],vlo[i][3],vhi[i][0],vhi[i][1],vhi[i][2],vhi[i][3]}
  #define PIN(x) asm volatile("":"+v"(x))
  #define MX3(a,b,c) __builtin_fmaxf(__builtin_fmaxf((a),(b)),(c))
  #define GAPA(MF,A0,A1,A2,A3,W0,W1,PW) do{ MF; sacc+=A0; sacc+=A1; sacc+=A2; sacc+=A3; PIN(sacc); W0; W1; PIN(PW); SBAR(); }while(0)
  #define EX(v) __builtin_amdgcn_exp2f(v)
  #define GAPB(MF,X,B) do{ MF; X[B]=EX(X[B]); X[B+1]=EX(X[B+1]); X[B+2]=EX(X[B+2]); X[B+3]=EX(X[B+3]); PIN(X); SBAR(); }while(0)
  #define VRD(i) do{ vlo[i]=vtr(vp_+(((i)>>2)*4096+((i)&3)*1024)); vhi[i]=vtr(vp_+(((i)>>2)*4096+((i)&3)*1024+512)); }while(0)
  #define KRD(G,j) do{ if(G){ kload2(kf,kp0+sl_next,j); SBAR(); } }while(0)
  #define STEP(C0,C1,P0,P1,t,GK,GV,GL) do{ SBAR(); \
    const lds_cptr vp_=vp0+sl_prev; \
    VRD(0); SBAR(); float sacc=(P0[0]+P0[1]); \
    GAPA(C0=__builtin_amdgcn_mfma_f32_32x32x16_bf16(kf[0],qr[0],negm,0,0,0), P0[2],P0[3],P0[4],P0[5],     pw0[0]=PKW(P0,0), pw0[1]=PKW(P0,2), pw0); \
    VRD(4); SBAR(); GAPA(C1=__builtin_amdgcn_mfma_f32_32x32x16_bf16(kf[1],qr[0],negm,0,0,0), P0[6],P0[7],P0[8],P0[9],     pw0[2]=PKW(P0,4), pw0[3]=PKW(P0,6), pw0); \
    VRD(1); SBAR(); GAPA(C0=__builtin_amdgcn_mfma_f32_32x32x16_bf16(kf[2],qr[1],C0,0,0,0),   P0[10],P0[11],P0[12],P0[13], pw1[0]=PKW(P0,8), pw1[1]=PKW(P0,10), pw1); \
    VRD(5); SBAR(); GAPA(C1=__builtin_amdgcn_mfma_f32_32x32x16_bf16(kf[3],qr[1],C1,0,0,0),   P0[14],P0[15],P1[0],P1[1],   pw1[2]=PKW(P0,12),pw1[3]=PKW(P0,14), pw1); \
    VRD(2); SBAR(); GAPA(C0=__builtin_amdgcn_mfma_f32_32x32x16_bf16(kf[4],qr[2],C0,0,0,0),   P1[2],P1[3],P1[4],P1[5],     pw2[0]=PKW(P1,0), pw2[1]=PKW(P1,2), pw2); \
    VRD(6); SBAR(); GAPA(C1=__builtin_amdgcn_mfma_f32_32x32x16_bf16(kf[5],qr[2],C1,0,0,0),   P1[6],P1[7],P1[8],P1[9],     pw2[2]=PKW(P1,4), pw2[3]=PKW(P1,6), pw2); \
    VRD(3); SBAR(); GAPA(C0=__builtin_amdgcn_mfma_f32_32x32x16_bf16(kf[6],qr[3],C0,0,0,0),   P1[10],P1[11],P1[12],P1[13], pw3[0]=PKW(P1,8), pw3[1]=PKW(P1,10), pw3); \
    VRD(7); SBAR(); GAPA(C1=__builtin_amdgcn_mfma_f32_32x32x16_bf16(kf[7],qr[3],C1,0,0,0),   P1[14],P1[15],0.f,0.f,       pw3[2]=PKW(P1,12),pw3[3]=PKW(P1,14), pw3); \
    l_reg+=sacc; \
    if(GK){DMA_K((t)+3,sl_cur);} if(GV){DMA_V((t)+1,sl_next);} \
    CMASK(C0,C1,t); \
    { float a=MX3(C0[0],C0[1],C1[0]),b=MX3(C0[2],C0[3],C1[1]); a=MX3(a,C1[2],C1[3]); \
      _Pragma("unroll") for(int r=4;r<16;r+=4){a=MX3(a,C0[r],C0[r+1]);b=MX3(b,C0[r+2],C0[r+3]);a=MX3(a,C1[r],C1[r+1]);b=MX3(b,C1[r+2],C1[r+3]);} \
      float rm=__builtin_fmaxf(a,b); { auto rr=__builtin_amdgcn_permlane32_swap(__float_as_uint(rm),__float_as_uint(rm),false,false); rm=__builtin_fmaxf(__uint_as_float(rr[0]),__uint_as_float(rr[1])); } \
      resc=false; \
      if(__builtin_expect(__any(rm>(float)THRL),0)){ const float dl=__builtin_fmaxf(rm,0.f); mhat+=dl; \
        _Pragma("unroll") for(int r=0;r<16;++r){C0[r]-=dl;C1[r]-=dl;} \
        _Pragma("unroll") for(int r=0;r<16;++r)negm[r]=-mhat; asm volatile("":"+v"(negm)); \
        const float f=__builtin_amdgcn_exp2f(-dl); l_reg*=f; if(hi==0)wsf[r32]=f; resc=true; } } \
    SBAR(); \
    GAPB(o[0]=__builtin_amdgcn_mfma_f32_32x32x16_bf16(PAF(0),VFR(0),o[0],0,0,0), C0,0); \
    GAPB(o[1]=__builtin_amdgcn_mfma_f32_32x32x16_bf16(PAF(0),VFR(4),o[1],0,0,0), C0,4); \
    KRD(GL,0); GAPB(o[0]=__builtin_amdgcn_mfma_f32_32x32x16_bf16(PAF(1),VFR(1),o[0],0,0,0), C0,8); \
    KRD(GL,1); GAPB(o[1]=__builtin_amdgcn_mfma_f32_32x32x16_bf16(PAF(1),VFR(5),o[1],0,0,0), C0,12); \
    KRD(GL,2); GAPB(o[0]=__builtin_amdgcn_mfma_f32_32x32x16_bf16(PAF(2),VFR(2),o[0],0,0,0), C1,0); \
    KRD(GL,3); GAPB(o[1]=__builtin_amdgcn_mfma_f32_32x32x16_bf16(PAF(2),VFR(6),o[1],0,0,0), C1,4); \
    GAPB(o[0]=__builtin_amdgcn_mfma_f32_32x32x16_bf16(PAF(3),VFR(3),o[0],0,0,0), C1,8); \
    GAPB(o[1]=__builtin_amdgcn_mfma_f32_32x32x16_bf16(PAF(3),VFR(7),o[1],0,0,0), C1,12); \
    }while(0)
  int t=1;
  #undef CMASK
  #define CMASK(P0,P1,t) do{}while(0)
  for(;t+5<NT;t+=2){
    STEP(pB0,pB1,pA0,pA1,t,true,true,true);     WAIT_BAR(2); RESC(); ROT();
    STEP(pA0,pA1,pB0,pB1,t+1,true,true,true);   WAIT_BAR(2); RESC(); ROT();
  }
  #undef CMASK
  #define CMASK(P0,P1,t) do{int jb_=(t)-(NT-4); if(jb_>=0)cmask(P0,P1,jb_,qrel,hi);}while(0)
  #define ENDW(tt) do{ if((tt)+3<NT){WAIT_BAR(2);} else if((tt)+2<NT){WAIT_BAR(1);} else {WAIT_BAR(0);} }while(0)
  for(;t+1<NT;t+=2){
    STEP(pB0,pB1,pA0,pA1,t,(t+3<NT),(t+1<NT),(t+1<NT));       ENDW(t);   RESC(); ROT();
    STEP(pA0,pA1,pB0,pB1,t+1,(t+4<NT),(t+2<NT),(t+2<NT));     ENDW(t+1); RESC(); ROT();
  }
  STEP(pB0,pB1,pA0,pA1,NT-1,false,false,false); RESC();
  { float sacc=pB0[0]+pB0[1]; _Pragma("unroll") for(int r=2;r<16;++r)sacc+=pB0[r]; _Pragma("unroll") for(int r=0;r<16;++r)sacc+=pB1[r]; l_reg+=sacc;
    pw0=(u32x4){PKW(pB0,0),PKW(pB0,2),PKW(pB0,4),PKW(pB0,6)};pw1=(u32x4){PKW(pB0,8),PKW(pB0,10),PKW(pB0,12),PKW(pB0,14)};pw2=(u32x4){PKW(pB1,0),PKW(pB1,2),PKW(pB1,4),PKW(pB1,6)};pw3=(u32x4){PKW(pB1,8),PKW(pB1,10),PKW(pB1,12),PKW(pB1,14)};
    SBAR(); pv(o,vb0+sl_cur,PAF(0),PAF(1),PAF(2),PAF(3)); }
  #undef PKW
  #undef PAF
  #undef VFR
  #undef PIN
  #undef MX3
  #undef GAPA
  #undef GAPB
  #undef EX
  #undef VRD
  #undef KRD
  #undef STEP
  #undef ENDW
  {auto rr=__builtin_amdgcn_permlane32_swap(__float_as_uint(l_reg),__float_as_uint(l_reg),false,false);l_reg=__uint_as_float(rr[0])+__uint_as_float(rr[1]);}
  if(hi==0)wsf[32+r32]=l_reg;asm volatile("s_waitcnt lgkmcnt(0)":::"memory");
  float rli[16];
  #pragma unroll
  for(int r=0;r<16;++r)rli[r]=__builtin_amdgcn_rcpf(wsf[32+crow(r,hi)]);
  bf16*Ow=O+(rowbase+q0+wid*QBLK)*DMO;
  { bf16*stg=(bf16*)(shm+LDS_OST)+wid*2048;
    #pragma unroll
    for(int r=0;r<16;++r){const int orow=crow(r,hi);
      #pragma unroll
      for(int d0=0;d0<2;++d0)stg[orow*64+d0*32+r32]=__float2bfloat16(o[d0][r]*rli[r]);}
    asm volatile("s_waitcnt lgkmcnt(0)":::"memory");
    #pragma unroll
    for(int i=0;i<4;++i){const int row=i*8+(lane>>3),ch=lane&7; const u32x4 v=*(const u32x4*)(stg+row*64+ch*8); ATTN_STORE16(Ow+(long)row*DMO+ch*8,v);} }
  asm volatile("s_waitcnt lgkmcnt(0)\n\ts_barrier":::"memory");
  #undef DMA_K
  #undef DMA_V
  #undef CMASK
  #undef START
  #undef RESC
  #undef ROT
}
constexpr int ATTN_LDS_BYTES=LDS_BYTES;
struct AttnTensors { const bf16* QKV; bf16* O; };
struct AttnUnit { int bvh; int qb; };
struct StaticOrder {
  int vcu;
  __device__ __forceinline__ explicit StaticOrder(int grid,int block):vcu((grid%8==0)?(block%8)*(grid/8)+block/8:block){}
  __device__ __forceinline__ bool next(int i,AttnUnit&u)const{ const int L=vcu; if(i>=16||L>=256)return false; const int s=8*(L&3)+(i>>1); u.bvh=L>>2; u.qb=(i&1)?63-s:s; return true; }
  __device__ __forceinline__ void a_ready(const AttnUnit&)const{}
  __device__ __forceinline__ void done(const AttnUnit&)const{}
};
template<class Sched,int THRL=8> __device__ __forceinline__ void attn_phase(char*lds,const AttnTensors&T,const Sched&S){
  AttnUnit u;
  for(int i=0;S.next(i,u);++i){ S.a_ready(u); const int b=u.bvh>>5,vh=u.bvh&31;
    attn_unit<THRL>(b,u.qb,T.QKV+(vh>>1)*64,T.QKV+1024+(vh>>1)*64,T.QKV+2048+((vh>>2)*2+(vh&1))*64,T.O+vh*64,lds); S.done(u); }
}

constexpr int KSLOT2=8192, VSLOT2=16384;
constexpr int LDS2_K=0, LDS2_V=NSLOT*KSLOT2, LDS2_WS=LDS2_V+NSLOT*VSLOT2, LDS2_OST=LDS2_WS+NW*64*4, LDS2_BYTES=LDS2_OST+NW*4096;
#define WAIT_BAR2(N) asm volatile("s_waitcnt vmcnt(" #N ") lgkmcnt(0)\n\ts_barrier":::"memory")
template<int THRL> __device__ __forceinline__ void attn_unit2(int b,int qb,const bf16*__restrict__ Q,const bf16*__restrict__ K,const bf16*__restrict__ V,bf16*__restrict__ O,char*shm){
  const int tid=pg8::otid(),lane=tid&63,r32=lane&31,hi=lane>>5; const int wid=__builtin_amdgcn_readfirstlane(tid>>6);
  const long rowbase=(long)b*SEQ; const int q0=qb*QB;
  const bf16*Qw=Q+(rowbase+q0+wid*QBLK)*DM;
  const bf16*Kh=K+rowbase*DM,*Vh=V+rowbase*DM;
  const unsigned lds0=(unsigned)(uintptr_t)shm;
  float*wsf=(float*)(shm+LDS2_WS)+wid*64;
  const unsigned kvoff=(unsigned)((lane*DM+wid*8)*2);
  const unsigned vvoff=(unsigned)(((16*(wid&3)+(lane>>2))*DM+(wid>>2)*32+(lane&3)*8)*2);
  const unsigned kdst=lds0+LDS2_K+wid*1024, vdst=lds0+LDS2_V+wid*1024;
  #define DMA_K(t,slot) glds16s(Kh+(long)(t)*KVBLK*DM,kvoff,(unsigned)__builtin_amdgcn_readfirstlane(kdst+(slot)))
  #define DMA_V(t,slot) do{ glds16s(Vh+(long)(t)*KVBLK*DM,vvoff,(unsigned)__builtin_amdgcn_readfirstlane(vdst+2*(slot))); glds16s(Vh+(long)(t)*KVBLK*DM+64,vvoff,(unsigned)__builtin_amdgcn_readfirstlane(vdst+2*(slot)+8192)); }while(0)
  const char*Kbase=shm+LDS2_K; bf16x8 kf[8];
  const lds_cptr shm3=(lds_cptr)shm; const lds_cptr kp0=shm3+LDS2_K+hi*1024+r32*16; const lds_cptr vp0=shm3+LDS2_V+((lane>>4)&1)*32+(lane&3)*8+(4*hi+((lane&15)>>2))*64;
  const int NT=(q0+QB)/KVBLK;
  DMA_K(0,0);DMA_V(0,0);DMA_K(1,KSLOT2);
  bf16x8 qr[4];
  #pragma unroll
  for(int d0=0;d0<4;++d0)qr[d0]=*reinterpret_cast<const bf16x8*>(&Qw[(long)r32*DM+d0*16+hi*8]);
  float mhat=0.f,l_reg=0.f;f32x16 o[4];o[0]=f32x16{};o[1]=f32x16{};o[2]=f32x16{};o[3]=f32x16{};
  f32x16 negm=f32x16{};asm volatile("":"+v"(negm));
  const int qrel=wid*QBLK+r32;
  #define CMASK(P0,P1,t) do{int jb_=(t)-(NT-4); if(jb_>=0)cmask(P0,P1,jb_,qrel,hi);}while(0)
  bool resc=false;
  #define RESC() do{ if(resc){ asm volatile("s_waitcnt lgkmcnt(0)":::"memory"); \
      _Pragma("unroll") for(int d_=0;d_<4;++d_) _Pragma("unroll") for(int r=0;r<16;++r)o[d_][r]*=wsf[crow(r,hi)]; } }while(0)
  f32x16 pA0,pA1,pB0,pB1;
  int sl_prev=0,sl_cur=0,sl_next=KSLOT2;
  #define ROT() do{sl_prev=sl_cur;sl_cur=sl_next;sl_next=(sl_next==(NSLOT-1)*KSLOT2)?0:sl_next+KSLOT2;}while(0)
  DMA_K(2,2*KSLOT2);
  WAIT_BAR2(4);
  qkt(pA0,pA1,Kbase,qr,negm,r32,hi);asm volatile("s_nop 15\n\ts_nop 7":"+v"(pA0),"+v"(pA1));CMASK(pA0,pA1,0);
  { const float rm=rowmax(pA0,pA1); mhat=rm;
    #pragma unroll
    for(int r=0;r<16;++r)negm[r]=-mhat;
    asm volatile("":"+v"(negm));
    #pragma unroll
    for(int r=0;r<16;++r){pA0[r]=__builtin_amdgcn_exp2f(pA0[r]-mhat);pA1[r]=__builtin_amdgcn_exp2f(pA1[r]-mhat);} }
  WAIT_BAR2(0);
  DMA_K(3,0);DMA_V(1,KSLOT2);
  ROT();
  kload8(kf,kp0+sl_cur);
  WAIT_BAR2(3);
  s16x4 vlo[8],vhi[8]; u32x4 pw0,pw1,pw2,pw3;
  #define PKW(P,B) cvtpk_s(P[B],P[B+1])
  #define PAF(k) __builtin_bit_cast(bf16x8,pw##k)
  #define PAFI(k) ((k)==0?PAF(0):(k)==1?PAF(1):(k)==2?PAF(2):PAF(3))
  #define VFR(i) (bf16x8){vlo[i][0],vlo[i][1],vlo[i][2],vlo[i][3],vhi[i][0],vhi[i][1],vhi[i][2],vhi[i][3]}
  #define PIN(x) asm volatile("":"+v"(x))
  #define MX3(a,b,c) __builtin_fmaxf(__builtin_fmaxf((a),(b)),(c))
  #define MFMA(a,b,c) __builtin_amdgcn_mfma_f32_32x32x16_bf16(a,b,c,0,0,0)
  #define GAPA(MF,A0,A1,A2,A3,W0,W1,PW) do{ MF; sacc+=A0; sacc+=A1; sacc+=A2; sacc+=A3; PIN(sacc); W0; W1; PIN(PW); SBAR(); }while(0)
  #define EX(v) __builtin_amdgcn_exp2f(v)
  #define GAPB(MF,X,B) do{ MF; X[B]=EX(X[B]); X[B+1]=EX(X[B+1]); PIN(X); SBAR(); }while(0)
  #define VOFF(j) ((((j)&3)*4096)+(((j)>>2)*1024))
  #define VRD(s_,j) do{ vlo[s_]=vtr(vp_+VOFF(j)); vhi[s_]=vtr(vp_+VOFF(j)+512); }while(0)
  #define KRD(G,j) do{ if(G){ kload2(kf,kp0+sl_next,j); SBAR(); } }while(0)
  #define PVM(j,PA) o[(j)&3]=MFMA(PA,VFR((j)&7),o[(j)&3])
  #define STEP(C0,C1,P0,P1,t,GK,GV,GL) do{ SBAR(); \
    const lds_cptr vp_=vp0+2*sl_prev; \
    VRD(0,0); SBAR(); float sacc=(P0[0]+P0[1]); \
    GAPA(C0=MFMA(kf[0],qr[0],negm), P0[2],P0[3],P0[4],P0[5],     pw0[0]=PKW(P0,0), pw0[1]=PKW(P0,2), pw0); \
    VRD(1,1); SBAR(); GAPA(C1=MFMA(kf[1],qr[0],negm), P0[6],P0[7],P0[8],P0[9],     pw0[2]=PKW(P0,4), pw0[3]=PKW(P0,6), pw0); \
    VRD(2,2); SBAR(); GAPA(C0=MFMA(kf[2],qr[1],C0),   P0[10],P0[11],P0[12],P0[13], pw1[0]=PKW(P0,8), pw1[1]=PKW(P0,10), pw1); \
    VRD(3,3); SBAR(); GAPA(C1=MFMA(kf[3],qr[1],C1),   P0[14],P0[15],P1[0],P1[1],   pw1[2]=PKW(P0,12),pw1[3]=PKW(P0,14), pw1); \
    VRD(4,4); SBAR(); GAPA(C0=MFMA(kf[4],qr[2],C0),   P1[2],P1[3],P1[4],P1[5],     pw2[0]=PKW(P1,0), pw2[1]=PKW(P1,2), pw2); \
    VRD(5,5); SBAR(); GAPA(C1=MFMA(kf[5],qr[2],C1),   P1[6],P1[7],P1[8],P1[9],     pw2[2]=PKW(P1,4), pw2[3]=PKW(P1,6), pw2); \
    VRD(6,6); SBAR(); GAPA(C0=MFMA(kf[6],qr[3],C0),   P1[10],P1[11],P1[12],P1[13], pw3[0]=PKW(P1,8), pw3[1]=PKW(P1,10), pw3); \
    VRD(7,7); SBAR(); GAPA(C1=MFMA(kf[7],qr[3],C1),   P1[14],P1[15],0.f,0.f,       pw3[2]=PKW(P1,12),pw3[3]=PKW(P1,14), pw3); \
    l_reg+=sacc; \
    if(GK){DMA_K((t)+3,sl_cur);} if(GV){DMA_V((t)+1,sl_next);} \
    CMASK(C0,C1,t); \
    { float a=MX3(C0[0],C0[1],C1[0]),b_=MX3(C0[2],C0[3],C1[1]); a=MX3(a,C1[2],C1[3]); \
      _Pragma("unroll") for(int r=4;r<16;r+=4){a=MX3(a,C0[r],C0[r+1]);b_=MX3(b_,C0[r+2],C0[r+3]);a=MX3(a,C1[r],C1[r+1]);b_=MX3(b_,C1[r+2],C1[r+3]);} \
      float rm=__builtin_fmaxf(a,b_); { auto rr=__builtin_amdgcn_permlane32_swap(__float_as_uint(rm),__float_as_uint(rm),false,false); rm=__builtin_fmaxf(__uint_as_float(rr[0]),__uint_as_float(rr[1])); } \
      resc=false; \
      if(__builtin_expect(__any(rm>(float)THRL),0)){ const float dl=__builtin_fmaxf(rm,0.f); mhat+=dl; \
        _Pragma("unroll") for(int r=0;r<16;++r){C0[r]-=dl;C1[r]-=dl;} \
        _Pragma("unroll") for(int r=0;r<16;++r)negm[r]=-mhat; asm volatile("":"+v"(negm)); \
        const float f=__builtin_amdgcn_exp2f(-dl); l_reg*=f; if(hi==0)wsf[r32]=f; resc=true; } } \
    SBAR(); \
    GAPB(PVM(0,PAF(0)),C0,0);  VRD(0,8);  SBAR(); \
    GAPB(PVM(1,PAF(0)),C0,2);  VRD(1,9);  SBAR(); \
    GAPB(PVM(2,PAF(0)),C0,4);  VRD(2,10); SBAR(); \
    GAPB(PVM(3,PAF(0)),C0,6);  VRD(3,11); SBAR(); \
    GAPB(PVM(4,PAF(1)),C0,8);  VRD(4,12); SBAR(); \
    GAPB(PVM(5,PAF(1)),C0,10); VRD(5,13); SBAR(); \
    GAPB(PVM(6,PAF(1)),C0,12); VRD(6,14); SBAR(); \
    GAPB(PVM(7,PAF(1)),C0,14); VRD(7,15); SBAR(); \
    GAPB(PVM(8,PAF(2)),C1,0); \
    GAPB(PVM(9,PAF(2)),C1,2); \
    KRD(GL,0); GAPB(PVM(10,PAF(2)),C1,4); \
    KRD(GL,1); GAPB(PVM(11,PAF(2)),C1,6); \
    KRD(GL,2); GAPB(PVM(12,PAF(3)),C1,8); \
    KRD(GL,3); GAPB(PVM(13,PAF(3)),C1,10); \
    GAPB(PVM(14,PAF(3)),C1,12); \
    GAPB(PVM(15,PAF(3)),C1,14); \
    }while(0)
  int t=1;
  #undef CMASK
  #define CMASK(P0,P1,t) do{}while(0)
  for(;t+5<NT;t+=2){
    STEP(pB0,pB1,pA0,pA1,t,true,true,true);     WAIT_BAR2(3); RESC(); ROT();
    STEP(pA0,pA1,pB0,pB1,t+1,true,true,true);   WAIT_BAR2(3); RESC(); ROT();
  }
  #undef CMASK
  #define CMASK(P0,P1,t) do{int jb_=(t)-(NT-4); if(jb_>=0)cmask(P0,P1,jb_,qrel,hi);}while(0)
  #define ENDW(tt) do{ if((tt)+3<NT){WAIT_BAR2(3);} else if((tt)+2<NT){WAIT_BAR2(2);} else {WAIT_BAR2(0);} }while(0)
  for(;t+1<NT;t+=2){
    STEP(pB0,pB1,pA0,pA1,t,(t+3<NT),(t+1<NT),(t+1<NT));       ENDW(t);   RESC(); ROT();
    STEP(pA0,pA1,pB0,pB1,t+1,(t+4<NT),(t+2<NT),(t+2<NT));     ENDW(t+1); RESC(); ROT();
  }
  STEP(pB0,pB1,pA0,pA1,NT-1,false,false,false); RESC();
  { float sacc=pB0[0]+pB0[1]; _Pragma("unroll") for(int r=2;r<16;++r)sacc+=pB0[r]; _Pragma("unroll") for(int r=0;r<16;++r)sacc+=pB1[r]; l_reg+=sacc;
    pw0=(u32x4){PKW(pB0,0),PKW(pB0,2),PKW(pB0,4),PKW(pB0,6)};pw1=(u32x4){PKW(pB0,8),PKW(pB0,10),PKW(pB0,12),PKW(pB0,14)};pw2=(u32x4){PKW(pB1,0),PKW(pB1,2),PKW(pB1,4),PKW(pB1,6)};pw3=(u32x4){PKW(pB1,8),PKW(pB1,10),PKW(pB1,12),PKW(pB1,14)};
    SBAR(); const lds_cptr vp_=vp0+2*sl_cur;
    #pragma unroll
    for(int d0=0;d0<4;++d0){
      #pragma unroll
      for(int ks=0;ks<4;++ks){ vlo[ks]=vtr(vp_+d0*4096+ks*1024); vhi[ks]=vtr(vp_+d0*4096+ks*1024+512); }
      o[d0]=MFMA(PAF(0),VFR(0),o[d0]); o[d0]=MFMA(PAF(1),VFR(1),o[d0]); o[d0]=MFMA(PAF(2),VFR(2),o[d0]); o[d0]=MFMA(PAF(3),VFR(3),o[d0]); } }
  #undef PKW
  #undef PAF
  #undef PAFI
  #undef VFR
  #undef PIN
  #undef MX3
  #undef MFMA
  #undef GAPA
  #undef GAPB
  #undef EX
  #undef VOFF
  #undef VRD
  #undef KRD
  #undef PVM
  #undef STEP
  #undef ENDW
  {auto rr=__builtin_amdgcn_permlane32_swap(__float_as_uint(l_reg),__float_as_uint(l_reg),false,false);l_reg=__uint_as_float(rr[0])+__uint_as_float(rr[1]);}
  if(hi==0)wsf[32+r32]=l_reg;asm volatile("s_waitcnt lgkmcnt(0)":::"memory");
  float rli[16];
  #pragma unroll
  for(int r=0;r<16;++r)rli[r]=__builtin_amdgcn_rcpf(wsf[32+crow(r,hi)]);
  bf16*Ow=O+(rowbase+q0+wid*QBLK)*DMO;
  { bf16*stg=(bf16*)(shm+LDS2_OST)+wid*2048;
    #pragma unroll
    for(int hh=0;hh<2;++hh){
      #pragma unroll
      for(int r=0;r<16;++r){const int orow=crow(r,hi);
        #pragma unroll
        for(int d0=0;d0<2;++d0)stg[orow*64+d0*32+r32]=__float2bfloat16(o[hh*2+d0][r]*rli[r]);}
      asm volatile("s_waitcnt lgkmcnt(0)":::"memory");
      #pragma unroll
      for(int i=0;i<4;++i){const int row=i*8+(lane>>3),ch=lane&7; const u32x4 v=*(const u32x4*)(stg+row*64+ch*8); ATTN_STORE16(Ow+(long)row*DMO+hh*64+ch*8,v);}
      asm volatile("s_waitcnt lgkmcnt(0)":::"memory"); } }
  asm volatile("s_waitcnt lgkmcnt(0)\n\ts_barrier":::"memory");
  #undef DMA_K
  #undef DMA_V
  #undef CMASK
  #undef RESC
  #undef ROT
}
struct AttnUnit2 { int bhm; int qb; };
struct StaticOrder2 {
  int vcu;
  __device__ __forceinline__ explicit StaticOrder2(int grid,int block):vcu((grid%8==0)?(block%8)*(grid/8)+block/8:block){}
  __device__ __forceinline__ bool next(int i,AttnUnit2&u)const{ const int L=vcu; if(i>=8||L>=256)return false; const int j=L&7; u.bhm=L>>3; u.qb=8*i+((i&1)?7-j:j); return true; }
};
template<class Sched,int THRL=8> __device__ __forceinline__ void attn_phase2(char*lds,const AttnTensors&T,const Sched&S){
  AttnUnit2 u;
  for(int i=0;S.next(i,u);++i){ const int b=u.bhm>>4,hm=u.bhm&15;
    attn_unit2<THRL>(b,u.qb,T.QKV+hm*64,T.QKV+1024+hm*64,T.QKV+2048+(hm>>1)*128,T.O+hm*128,lds); }
}
#undef SBAR
#undef WAIT_BAR
}
#define GAS __attribute__((address_space(1)))
#define LAS __attribute__((address_space(3)))
typedef unsigned short bf16;
typedef unsigned v4u __attribute__((ext_vector_type(4)));
typedef float f32x4 __attribute__((ext_vector_type(4)));
typedef short bf16x8 __attribute__((ext_vector_type(8)));
typedef GAS unsigned gu32;
typedef GAS unsigned long long gu64;
#define RLX_AGENT __ATOMIC_RELAXED, __HIP_MEMORY_SCOPE_AGENT
#define LDS_WAIT() asm volatile("s_waitcnt lgkmcnt(0)" ::: "memory")
#define VM_WAIT() asm volatile("s_waitcnt vmcnt(0)" ::: "memory")
__device__ __forceinline__ unsigned long long rt() { return __builtin_amdgcn_s_memrealtime(); }
__device__ __forceinline__ unsigned f2bf(float f) { unsigned u = __builtin_bit_cast(unsigned, f); return (u + 0x7fffu + ((u >> 16) & 1u)) >> 16; }
__device__ __forceinline__ unsigned pk2(float lo, float hi) { return f2bf(lo) | (f2bf(hi) << 16); }

#define XB_TMO      128
#define XB_XCNT(j)  (256  + 64 * (j))
#define XB_XSUB(j)  (1280 + 64 * (j))
#define XB_XGEN(j)  (2304 + 64 * (j))
#define XB_TOP      3328
#define XB_TOPGEN   3392
#define XCD_BAR_WORDS 3456
#define XB_SPIN_CAP (1u << 18)

__device__ __forceinline__ unsigned xb_ld(unsigned* p)              { return __hip_atomic_load(p, __ATOMIC_RELAXED, __HIP_MEMORY_SCOPE_AGENT); }
__device__ __forceinline__ unsigned xb_add(unsigned* p, unsigned v) { return __hip_atomic_fetch_add(p, v, __ATOMIC_RELAXED, __HIP_MEMORY_SCOPE_AGENT); }
__device__ __forceinline__ unsigned xb_xcc_id() { return (unsigned)__builtin_amdgcn_s_getreg((3 << 11) | 20) & 0xFu; }
#define XB_SPIN(cond, bar) do { unsigned _sp = 0; while (cond) { __builtin_amdgcn_s_sleep(1); \
    if ((++_sp & 255u) == 0u) { if (xb_ld(&(bar)[XB_TMO])) break; if (_sp > XB_SPIN_CAP) { atomicAdd(&(bar)[XB_TMO], 1u); break; } } } } while (0)

struct XcdBarrier {
    unsigned* bar; unsigned x;
    volatile LAS unsigned* st;
};

__device__ __forceinline__ XcdBarrier xcd_barrier_post(unsigned* bar, volatile LAS unsigned* st) {
    XcdBarrier b; b.bar = bar; b.x = xb_xcc_id(); b.st = st;
    if (threadIdx.x == 0) (void)xb_add(&bar[XB_XCNT(b.x)], 1u);
    return b;
}
__device__ __forceinline__ void xcd_barrier_complete(unsigned* bar, unsigned x, unsigned& nloc, unsigned& nx) {
    const unsigned G = gridDim.x * gridDim.y * gridDim.z;
    unsigned sum, cnt, mine, sp = 0u;
    for (;;) {
        sum = 0u; cnt = 0u; mine = 0u;
#pragma unroll
        for (unsigned j = 0; j < 16; ++j) { const unsigned c = xb_ld(&bar[XB_XCNT(j)]); sum += c; cnt += (c > 0u) ? 1u : 0u; mine = (j == x) ? c : mine; }
        if (sum == G) break;
        __builtin_amdgcn_s_sleep(1);
        if ((++sp & 255u) == 0u) { if (xb_ld(&bar[XB_TMO])) break; if (sp > XB_SPIN_CAP) { atomicAdd(&bar[XB_TMO], 1u); break; } }
    }
    nloc = mine > 0u ? mine : 1u; nx = cnt > 0u ? cnt : 1u;
}

__device__ __forceinline__ void xcd_barrier(const XcdBarrier& b) {
    asm volatile("s_waitcnt vmcnt(0)" ::: "memory");
    __syncthreads();
    if (threadIdx.x == 0) {
        unsigned* bar = b.bar;
        __builtin_amdgcn_s_waitcnt(0);
        unsigned nloc = b.st[0], nx = b.st[1];
        if (nloc == 0u) { xcd_barrier_complete(bar, b.x, nloc, nx); b.st[0] = nloc; b.st[1] = nx; }
        const unsigned old = xb_add(&bar[XB_XSUB(b.x)], 1u);
        const unsigned gen = old / nloc;
        if (old + 1u == (gen + 1u) * nloc) {
            __builtin_amdgcn_fence(__ATOMIC_RELEASE, "agent");
            asm volatile("s_waitcnt vmcnt(0)" ::: "memory");
            const unsigned og = xb_add(&bar[XB_TOP], 1u);
            const unsigned tg = og / nx;
            if (og + 1u == (tg + 1u) * nx) xb_add(&bar[XB_TOPGEN], 1u);
            else XB_SPIN(xb_ld(&bar[XB_TOPGEN]) == tg, bar);
            __builtin_amdgcn_fence(__ATOMIC_ACQUIRE, "agent");
            xb_add(&bar[XB_XGEN(b.x)], 1u);
            asm volatile("s_waitcnt vmcnt(0)" ::: "memory");
        } else {
            XB_SPIN(xb_ld(&bar[XB_XGEN(b.x)]) == gen, bar);
            __builtin_amdgcn_fence(__ATOMIC_ACQUIRE, "agent");
            asm volatile("s_waitcnt vmcnt(0)" ::: "memory");
        }
    }
    __syncthreads();
}
constexpr int NWAVES = 8;
constexpr int DMODEL = 2048, NBATCH = 2, SEQ = 16384, DEPTH = 4, MT = NBATCH * SEQ, NMEM = 256, FF = 5632, INW = 4096;
constexpr int UGP = 1152;
constexpr float ALPHA = 1.6817928305074290f, LN_EPS = 1e-5f, RMS_EPS = 1e-5f;
constexpr int NIN = 37;
enum InIdx { I_X = 0, I_MEM, I_F1G, I_F1U, I_F1D, I_LN1G, I_LN1B, I_WIN, I_LQ1, I_LK1, I_LQ2, I_LK2, I_DNG, I_SLRE, I_SLIM, I_SLOG, I_SBRE, I_SBIM, I_SCRE, I_SCIM, I_SD, I_GLUW, I_GLUB,
             I_WOUT, I_LN2G, I_LN2B, I_XQ, I_XK, I_XV, I_XO, I_LN3G, I_LN3B, I_F2G, I_F2U, I_F2D, I_LN4G, I_LN4B };

constexpr size_t MiB = 1u << 20;
constexpr size_t WS_CTL = 0, CTL_ZERO_BYTES = 6 * MiB;
constexpr size_t WS_CS = 1 * MiB;
constexpr int CSL = 57344, CS1 = 0, CB1 = 11264, CS2 = 22528, CB2 = 33792, CSW = 45056, CBW = 49152, CSM = 53248, CBM = 55296;
constexpr size_t WS_ST = 2 * MiB;
constexpr size_t WS_XB = 6 * MiB;
constexpr size_t WS_YLO = WS_XB + 128 * MiB;
constexpr size_t WS_BIG = WS_YLO + 128 * MiB;
constexpr size_t WS_HMID = WS_BIG;
constexpr size_t WS_QKV = WS_BIG;
constexpr size_t WS_UG = WS_BIG + 192 * MiB;
constexpr size_t WS_OV = WS_BIG + 264 * MiB;
constexpr size_t WS_SC = WS_BIG;
constexpr size_t WS_PB = WS_BIG + 128 * MiB;
constexpr size_t WS_MIX = WS_BIG + 392 * MiB;
constexpr size_t WS_YG = WS_MIX + 128 * MiB;
constexpr size_t WS_VS = WS_YG + 64 * MiB;
constexpr size_t WS_W = WS_VS + 16 * MiB;
constexpr size_t WS_W1GU = WS_W, WS_W1D = WS_W1GU + 44 * MiB, WS_W2GU = WS_W1D + 22 * MiB, WS_W2D = WS_W2GU + 44 * MiB, WS_WIN = WS_W2D + 22 * MiB, WS_WGLU = WS_WIN + 16 * MiB,
                 WS_WOUT = WS_WGLU + 2 * MiB, WS_WQN = WS_WOUT + 8 * MiB, WS_WKVT = WS_WQN + 8 * MiB, WS_WOT = WS_WKVT + 16 * MiB, WS_TG = WS_WOT + 8 * MiB, WS_EM = WS_TG + 144 * MiB;
constexpr size_t WS_MEMB = WS_EM + 17 * MiB;
constexpr size_t WS_KVM = WS_MEMB + 2 * MiB;
constexpr size_t WS_MQT = WS_KVM + 4 * MiB;
constexpr size_t WS_VWOT = WS_MQT + 8 * MiB;
constexpr size_t WS_END = WS_VWOT + 8 * MiB;
constexpr int CW_TMO = 0, CW_CODE = 1, CW_BAR = 4096;

constexpr int RING_OFF = 0, RING_BYTES = 131072;
constexpr int LDSCTL_OFF = RING_BYTES, MISC_OFF = LDSCTL_OFF + 320;
constexpr int XCH_OFF = LDSCTL_OFF + 1024;
constexpr int GB_OFF = LDSCTL_OFF + 1024;
constexpr int XST_OFF = GB_OFF + 16384;
static_assert(XST_OFF == GB_OFF + 4096 * 4, "the residual epilogue finds its table right behind the gain | bias image");
constexpr int LDS_BYTES = 163840;
typedef float f32x2v __attribute__((ext_vector_type(2)));
__device__ __forceinline__ float wave_sum(float v) {
    v += pg8::sw_xor<1>(v); v += pg8::sw_xor<2>(v); v += pg8::sw_xor<4>(v); v += pg8::sw_xor<8>(v); v += pg8::sw_xor<16>(v); return pg8::add_xor32(v);
}
__device__ __forceinline__ float wave_max(float v) {
    v = fmaxf(v, pg8::sw_xor<1>(v)); v = fmaxf(v, pg8::sw_xor<2>(v)); v = fmaxf(v, pg8::sw_xor<4>(v)); v = fmaxf(v, pg8::sw_xor<8>(v)); v = fmaxf(v, pg8::sw_xor<16>(v)); return pg8::max_xor32(v);
}
__device__ __forceinline__ unsigned pkbf(float lo, float hi) { return pg8::cvt_pk_bf16(lo, hi); }
struct RmId { __device__ __forceinline__ int operator()(int n0) const { return n0; } };
struct RmGate { int add; __device__ __forceinline__ int operator()(int n0) const { return (n0 >> 7) * 256 + (n0 & 127) + add; } };
template <class RM> __device__ __forceinline__ void conv_T(const float* __restrict__ W, int K, int N, bf16* WT, int ldt, RM rm, const float* gk, const float* bk, float* cs, float* cb, LAS float* scr, int gw, int NGW, int lane, int rot, float wscale = 1.0f) {
    const int nblk = N / 32, nchunks = (K / 512) * nblk, c = lane & 7, r8 = lane >> 3;
    for (int chunk = (gw + NGW - rot % NGW) % NGW; chunk < nchunks; chunk += NGW) {
        const int kc = chunk / nblk, nb = chunk - kc * nblk, n0 = 32 * nb, drow0 = rm(n0);
        const float* wp = W + (size_t)(kc * 512 + r8) * N + n0 + 4 * c;
        float a1[4] = {0.f, 0.f, 0.f, 0.f}, a2[4] = {0.f, 0.f, 0.f, 0.f};
        f32x4 ld[8];
#pragma unroll
        for (int i = 0; i < 8; ++i) ld[i] = __builtin_nontemporal_load((const GAS f32x4*)(wp + (size_t)(8 * i) * N));
#pragma unroll 1
        for (int j = 0; j < 8; ++j) {
            const int k0 = kc * 512 + 64 * j;
#pragma unroll
            for (int i = 0; i < 8; ++i) { LAS float* d = scr + (8 * i + r8) * 33 + 4 * c; d[0] = ld[i][0]; d[1] = ld[i][1]; d[2] = ld[i][2]; d[3] = ld[i][3]; }
            if (j < 7) {
#pragma unroll
                for (int i = 0; i < 8; ++i) ld[i] = __builtin_nontemporal_load((const GAS f32x4*)(wp + (size_t)(64 * (j + 1) + 8 * i) * N)); }
            f32x4 g0, g1, b0, b1;
            if (gk) { g0 = *(const GAS f32x4*)(gk + k0 + 8 * c); g1 = *(const GAS f32x4*)(gk + k0 + 8 * c + 4); b0 = *(const GAS f32x4*)(bk + k0 + 8 * c); b1 = *(const GAS f32x4*)(bk + k0 + 8 * c + 4); }
            LDS_WAIT(); asm volatile("" ::: "memory");
#pragma unroll
            for (int jj = 0; jj < 4; ++jj) { const int n = r8 + 8 * jj; const LAS float* s = scr + (8 * c) * 33 + n;
                float w[8];
#pragma unroll
                for (int e = 0; e < 8; ++e) w[e] = s[e * 33] * wscale;
                v4u o;
                if (gk) {
                    o.x = pkbf(w[0] * g0[0], w[1] * g0[1]); o.y = pkbf(w[2] * g0[2], w[3] * g0[3]); o.z = pkbf(w[4] * g1[0], w[5] * g1[1]); o.w = pkbf(w[6] * g1[2], w[7] * g1[3]);
                    a1[jj] += (pg8::bf_lo(o.x) + pg8::bf_hi(o.x)) + (pg8::bf_lo(o.y) + pg8::bf_hi(o.y)) + (pg8::bf_lo(o.z) + pg8::bf_hi(o.z)) + (pg8::bf_lo(o.w) + pg8::bf_hi(o.w));
                    a2[jj] += (w[0] * b0[0] + w[1] * b0[1]) + (w[2] * b0[2] + w[3] * b0[3]) + (w[4] * b1[0] + w[5] * b1[1]) + (w[6] * b1[2] + w[7] * b1[3]);
                } else { o.x = pkbf(w[0], w[1]); o.y = pkbf(w[2], w[3]); o.z = pkbf(w[4], w[5]); o.w = pkbf(w[6], w[7]); }
                *(GAS v4u*)(WT + (size_t)(drow0 + n) * ldt + k0 + 8 * c) = o; }
            LDS_WAIT(); asm volatile("" ::: "memory");
        }
        if (gk) {
#pragma unroll
            for (int jj = 0; jj < 4; ++jj) { float s1 = a1[jj], s2 = a2[jj];
                s1 += pg8::sw_xor<1>(s1); s1 += pg8::sw_xor<2>(s1); s1 += pg8::sw_xor<4>(s1); s2 += pg8::sw_xor<1>(s2); s2 += pg8::sw_xor<2>(s2); s2 += pg8::sw_xor<4>(s2);
                if (c == 0) { unsafeAtomicAdd(cs + drow0 + r8 + 8 * jj, s1); unsafeAtomicAdd(cb + drow0 + r8 + 8 * jj, s2); } } }
    }
}
__device__ __forceinline__ void conv_copy(const float* __restrict__ W, bf16* O, size_t n, int gw, int NGW, int lane) {
    for (size_t i = ((size_t)gw * 64 + lane) * 8; i < n; i += (size_t)NGW * 64 * 8) {
        const f32x4 a = *(const GAS f32x4*)(W + i), b = *(const GAS f32x4*)(W + i + 4);
        v4u o; o.x = pkbf(a[0], a[1]); o.y = pkbf(a[2], a[3]); o.z = pkbf(b[0], b[1]); o.w = pkbf(b[2], b[3]);
        *(GAS v4u*)(O + i) = o; }
}
__device__ __forceinline__ void ln_rows(const float* Y, const float* __restrict__ g, const float* __restrict__ b, float* X32, bf16* XB, int gw, int NGW, int lane) {
    f32x4 gg[8], bb[8];
#pragma unroll
    for (int j = 0; j < 8; ++j) { gg[j] = *(const GAS f32x4*)(g + 4 * lane + 256 * j); bb[j] = *(const GAS f32x4*)(b + 4 * lane + 256 * j); }
    for (int m = gw; m < MT; m += NGW) {
        const GAS f32x4* yr = (const GAS f32x4*)(Y + (size_t)m * DMODEL) + lane;
        f32x4 v[8]; float s = 0.f;
#pragma unroll
        for (int j = 0; j < 8; ++j) { v[j] = yr[64 * j]; s += (v[j][0] + v[j][1]) + (v[j][2] + v[j][3]); }
        const float mean = wave_sum(s) * (1.f / DMODEL); float s2 = 0.f;
#pragma unroll
        for (int j = 0; j < 8; ++j) { v[j] = v[j] - mean; s2 += (v[j][0] * v[j][0] + v[j][1] * v[j][1]) + (v[j][2] * v[j][2] + v[j][3] * v[j][3]); }
        const float rstd = 1.f / sqrtf(wave_sum(s2) * (1.f / DMODEL) + LN_EPS);
        GAS f32x4* xo = (GAS f32x4*)(X32 + (size_t)m * DMODEL) + lane;
        GAS unsigned long long* o8 = (GAS unsigned long long*)(XB + (size_t)m * DMODEL) + lane;
#pragma unroll
        for (int j = 0; j < 8; ++j) { const f32x4 o = v[j] * rstd * gg[j] + bb[j]; xo[64 * j] = o;
            if (XB) o8[64 * j] = (unsigned long long)pkbf(o[0], o[1]) | ((unsigned long long)pkbf(o[2], o[3]) << 32); }
    }
}
__device__ __forceinline__ void final_ln_planes(const bf16* XB, const pg8::u32x4* LO8, const float* st, const float* g, const float* b, float* out, int gw, int NGW, int lane) {
    const int fq = lane >> 4, fr = lane & 15;
    for (int it = gw; it < 1024 * 64; it += NGW) {
        const int am = it & 7, wv = (it >> 3) & 7, tile = it >> 6, pm = tile >> 3, pn = tile & 7, wr = wv >> 2, wc = wv & 3, ai = am >> 2, mm = am & 3;
        const int r = pm * 256 + ai * 128 + wr * 64 + mm * 16 + fr, col0 = pn * 256 + wc * 32 + 8 * fq;
        const pg8::u32x4 lo = LO8[(size_t)it * 64 + lane];
        const v4u h0 = *(const GAS v4u*)(XB + (size_t)r * DMODEL + col0), h1 = *(const GAS v4u*)(XB + (size_t)r * DMODEL + col0 + 128);
        const f32x2v s = *(const GAS f32x2v*)(st + 2 * (size_t)r);
        const float mu = s.x * (1.0f / 2048.0f), rs = __builtin_amdgcn_rsqf(s.y * (1.0f / 2048.0f) - mu * mu + LN_EPS);
#pragma unroll
        for (int bj = 0; bj < 2; ++bj) { const v4u h = bj ? h1 : h0; const unsigned w0 = bj ? lo.z : lo.x, w1 = bj ? lo.w : lo.y; const int c = col0 + bj * 128;
            const f32x2v a0 = __builtin_amdgcn_cvt_pk_f32_fp8((int)w0, false), a1 = __builtin_amdgcn_cvt_pk_f32_fp8((int)w0, true), a2 = __builtin_amdgcn_cvt_pk_f32_fp8((int)w1, false), a3 = __builtin_amdgcn_cvt_pk_f32_fp8((int)w1, true);
            const f32x4 y0 = {pg8::bf_lo(h[0]) + a0.x * 0.00390625f, pg8::bf_hi(h[0]) + a0.y * 0.00390625f, pg8::bf_lo(h[1]) + a1.x * 0.00390625f, pg8::bf_hi(h[1]) + a1.y * 0.00390625f};
            const f32x4 y1 = {pg8::bf_lo(h[2]) + a2.x * 0.00390625f, pg8::bf_hi(h[2]) + a2.y * 0.00390625f, pg8::bf_lo(h[3]) + a3.x * 0.00390625f, pg8::bf_hi(h[3]) + a3.y * 0.00390625f};
            const f32x4 g0 = *(const GAS f32x4*)(g + c), g1 = *(const GAS f32x4*)(g + c + 4), b0 = *(const GAS f32x4*)(b + c), b1 = *(const GAS f32x4*)(b + c + 4);
            *(GAS f32x4*)(out + (size_t)r * DMODEL + c) = (y0 - mu) * rs * g0 + b0; *(GAS f32x4*)(out + (size_t)r * DMODEL + c + 4) = (y1 - mu) * rs * g1 + b1; }
    }
}
__device__ __forceinline__ void softmax_rows(const float* __restrict__ SC, bf16* PB, int gw, int NGW, int lane) {
    for (int m = gw; m < MT; m += NGW) {
        const GAS f32x4* sr = (const GAS f32x4*)(SC + (size_t)m * 1024) + lane;
        GAS unsigned long long* o8 = (GAS unsigned long long*)(PB + (size_t)m * 1024) + lane;
        f32x4 v[4];
#pragma unroll
        for (int j = 0; j < 4; ++j) v[j] = sr[64 * j];
#pragma unroll
        for (int j = 0; j < 4; ++j) {
            const float mx = wave_max(fmaxf(fmaxf(v[j][0], v[j][1]), fmaxf(v[j][2], v[j][3])));
            f32x4 e;
#pragma unroll
            for (int k = 0; k < 4; ++k) e[k] = __builtin_amdgcn_exp2f((v[j][k] - mx) * 1.4426950408889634f);
            const float inv = 1.0f / wave_sum((e[0] + e[1]) + (e[2] + e[3]));
            o8[64 * j] = (unsigned long long)pkbf(e[0] * inv, e[1] * inv) | ((unsigned long long)pkbf(e[2] * inv, e[3] * inv) << 32);
        }
    }
}
__device__ __forceinline__ void diff_combine(const bf16* __restrict__ OV, bf16* MIX, const float* lq1, const float* lk1, const float* lq2, const float* lk2, const float* ng, float lam_init, int gw, int NGW, int lane) {
    const float s1 = wave_sum(lq1[lane] * lk1[lane]), s2 = wave_sum(lq2[lane] * lk2[lane]);
    const float lam = expf(s1) - expf(s2) + lam_init, osc = 1.0f - lam_init;
    const int h = lane >> 3, d0 = (lane & 7) * 16;
    float gn[16];
#pragma unroll
    for (int e = 0; e < 16; ++e) gn[e] = ng[d0 + e] * osc;
    for (int m0 = gw; m0 < MT; m0 += 2 * NGW) {
        const int m1 = m0 + NGW; const bool has1 = m1 < MT;
        const bf16* o1 = OV + (size_t)m0 * 2048 + h * 256 + d0; const bf16* p1 = OV + (size_t)(has1 ? m1 : m0) * 2048 + h * 256 + d0;
        v4u q[2][4];
        q[0][0] = *(const GAS v4u*)o1; q[0][1] = *(const GAS v4u*)(o1 + 8); q[0][2] = *(const GAS v4u*)(o1 + 128); q[0][3] = *(const GAS v4u*)(o1 + 136);
        q[1][0] = *(const GAS v4u*)p1; q[1][1] = *(const GAS v4u*)(p1 + 8); q[1][2] = *(const GAS v4u*)(p1 + 128); q[1][3] = *(const GAS v4u*)(p1 + 136);
#pragma unroll
        for (int t = 0; t < 2; ++t) { if (t == 1 && !has1) break;
            const v4u a0 = q[t][0], a1 = q[t][1], b0 = q[t][2], b1 = q[t][3]; float x[16];
#pragma unroll
            for (int k = 0; k < 4; ++k) { x[2 * k] = pg8::bf_lo(a0[k]) - lam * pg8::bf_lo(b0[k]); x[2 * k + 1] = pg8::bf_hi(a0[k]) - lam * pg8::bf_hi(b0[k]);
                x[8 + 2 * k] = pg8::bf_lo(a1[k]) - lam * pg8::bf_lo(b1[k]); x[8 + 2 * k + 1] = pg8::bf_hi(a1[k]) - lam * pg8::bf_hi(b1[k]); }
            float ss = 0.f;
#pragma unroll
            for (int e = 0; e < 16; ++e) ss += x[e] * x[e];
            ss += pg8::sw_xor<1>(ss); ss += pg8::sw_xor<2>(ss); ss += pg8::sw_xor<4>(ss);
            const float r = __builtin_amdgcn_rsqf(ss * (1.0f / 128.0f) + RMS_EPS);
            v4u w0, w1;
#pragma unroll
            for (int k = 0; k < 4; ++k) { w0[k] = pkbf(x[2 * k] * r * gn[2 * k], x[2 * k + 1] * r * gn[2 * k + 1]); w1[k] = pkbf(x[8 + 2 * k] * r * gn[8 + 2 * k], x[8 + 2 * k + 1] * r * gn[8 + 2 * k + 1]); }
            bf16* op = MIX + (size_t)(t ? m1 : m0) * 2048 + h * 128 + d0;
            *(GAS v4u*)op = w0; *(GAS v4u*)(op + 8) = w1; }
    }
}
__device__ __forceinline__ void cpow(float rez, float imz, int tau, float& re, float& im) {
    double rev = (double)imz * (double)tau * 0.15915494309189535; rev -= __builtin_rint(rev);
    const float mg = __builtin_amdgcn_exp2f(rez * (float)tau * 1.4426950408889634f), rv = (float)rev;
    re = mg * __builtin_amdgcn_cosf(rv); im = mg * __builtin_amdgcn_sinf(rv);
}
__device__ __forceinline__ void ssm_prep(const float* lam_re, const float* lam_im, const float* log_step, const float* b_re, const float* b_im, const float* c_re, const float* c_im,
                                         bf16* TG, bf16* EM, LAS unsigned char* lds, int vcu, int G, int tid, bool skipz) {
    LAS float* APre = (LAS float*)lds;
    LAS float* APim = APre + 65 * 64;
    LAS float* BBre = APim + 65 * 64;
    LAS float* BBim = BBre + 1024;
    LAS float* CCre = BBim + 1024;
    LAS float* CCim = CCre + 256;
    LAS float* KT = CCim + 256;
    for (int item = vcu; item < 256; item += G) {
        const int g = item >> 2, pb = item & 3;
        const float step = expf(log_step[g]);
        for (int e = tid; e < 65 * 64; e += NWAVES * 64) { const int tau = e >> 6, n = e & 63; const float lr = fminf(lam_re[g * 64 + n], -1e-4f), li = lam_im[g * 64 + n];
            float re, im; cpow(lr * step, li * step, tau, re, im); APre[e] = re; APim[e] = im; }
        for (int e = tid; e < 1024; e += NWAVES * 64) { const int n = e >> 4; const float lr = fminf(lam_re[g * 64 + n], -1e-4f), li = lam_im[g * 64 + n];
            float ar, ai; cpow(lr * step, li * step, 1, ar, ai);
            const float x = ar - 1.0f, y = ai, den = 1.0f / (lr * lr + li * li);
            const float cr = (x * lr + y * li) * den, ci = (y * lr - x * li) * den;
            const float br = b_re[(size_t)g * 1024 + e], bi = b_im[(size_t)g * 1024 + e];
            BBre[e] = cr * br - ci * bi; BBim[e] = cr * bi + ci * br; }
        for (int e = tid; e < 256; e += NWAVES * 64) { const int pl = e >> 6, n = e & 63; CCre[e] = c_re[(size_t)(g * 16 + 4 * pb + pl) * 64 + n]; CCim[e] = c_im[(size_t)(g * 16 + 4 * pb + pl) * 64 + n]; }
        __syncthreads();
        { const int pq = tid & 63, pl = pq >> 4, q = pq & 15, tb = tid >> 6; float acc[8];
#pragma unroll
          for (int k = 0; k < 8; ++k) acc[k] = 0.f;
          for (int n = 0; n < 64; ++n) { const float cr = CCre[pl * 64 + n], ci = CCim[pl * 64 + n], br = BBre[n * 16 + q], bi = BBim[n * 16 + q];
              const float cbr = cr * br - ci * bi, cbi = cr * bi + ci * br;
#pragma unroll
              for (int k = 0; k < 8; ++k) acc[k] += cbr * APre[(tb * 8 + k) * 64 + n] - cbi * APim[(tb * 8 + k) * 64 + n]; }
#pragma unroll
          for (int k = 0; k < 8; ++k) KT[(tb * 8 + k) * 64 + pq] = acc[k]; }
        __syncthreads();
        for (int idx = tid; idx < 256 * 144; idx += NWAVES * 64) {
            const int rowl = idx / 144, ch = idx - rowl * 144, t = rowl >> 2, pl = rowl & 3; float v[8];
            if (ch >= 16) { const int s = (ch - 16) >> 1, q0 = ((ch - 16) & 1) * 8;
                if (s > (t | 15)) continue;
                if (skipz && s > t) continue;
#pragma unroll
                for (int e = 0; e < 8; ++e) v[e] = (s <= t) ? KT[(t - s) * 64 + pl * 16 + q0 + e] : 0.f;
            } else { const int n0 = ch * 8;
#pragma unroll
                for (int e = 0; e < 8; ++e) { const int n = (n0 + e) & 63; const float cr = CCre[pl * 64 + n], ci = CCim[pl * 64 + n], pr = APre[(t + 1) * 64 + n], pi = APim[(t + 1) * 64 + n];
                    v[e] = (n0 < 64) ? (cr * pr - ci * pi) : -(cr * pi + ci * pr); } }
            v4u o; o.x = pkbf(v[0], v[1]); o.y = pkbf(v[2], v[3]); o.z = pkbf(v[4], v[5]); o.w = pkbf(v[6], v[7]);
            *(GAS v4u*)(TG + (size_t)(g * 1024 + t * 16 + 4 * pb + pl) * UGP + ch * 8) = o;
        }
        for (int idx = tid; idx < 32 * 128; idx += NWAVES * 64) {
            const int rl = idx >> 7, ch = idx & 127, part = rl >> 4, n = 16 * pb + (rl & 15), s = ch >> 1, q0 = (ch & 1) * 8; float v[8];
            const float pr = APre[(63 - s) * 64 + n], pi = APim[(63 - s) * 64 + n];
#pragma unroll
            for (int e = 0; e < 8; ++e) { const float br = BBre[n * 16 + q0 + e], bi = BBim[n * 16 + q0 + e]; v[e] = part ? (pr * bi + pi * br) : (pr * br - pi * bi); }
            v4u o; o.x = pkbf(v[0], v[1]); o.y = pkbf(v[2], v[3]); o.z = pkbf(v[4], v[5]); o.w = pkbf(v[6], v[7]);
            *(GAS v4u*)(EM + (size_t)(g * 128 + part * 64 + n) * 1024 + ch * 8) = o;
        }
        __syncthreads();
    }
}
__device__ __forceinline__ void ssm_scan8(const float* lam_re, const float* lam_im, const float* log_step, const float* VS, bf16* UG, int gb, int wave, int lane, LAS float* xl) {
    const int g = gb >> 1, b = gb & 1, n = lane;
    const float step = expf(log_step[g]), lr = fminf(lam_re[g * 64 + n], -1e-4f), li = lam_im[g * 64 + n];
    float ar, ai; cpow(lr * step, li * step, 64, ar, ai);
    const float* vs = VS + (size_t)(g * 512 + b * 256 + 32 * wave) * 128 + n; bf16* ug = UG + (size_t)(g * 512 + b * 256 + 32 * wave) * UGP + n;
    float vr[32], vi[32];
#pragma unroll
    for (int k = 0; k < 32; ++k) { vr[k] = vs[(size_t)k * 128]; vi[k] = vs[(size_t)k * 128 + 64]; }
    float hr = 0.f, hi = 0.f;
#pragma unroll
    for (int k = 0; k < 32; ++k) { const float nr = ar * hr - ai * hi + vr[k], ni = ar * hi + ai * hr + vi[k]; hr = nr; hi = ni; }
    xl[(wave * 64 + n) * 2] = hr; xl[(wave * 64 + n) * 2 + 1] = hi;
    float pr = ar, pi = ai;
#pragma unroll
    for (int q = 0; q < 5; ++q) { const float tr = pr * pr - pi * pi, ti = 2.f * pr * pi; pr = tr; pi = ti; }
    asm volatile("s_waitcnt lgkmcnt(0)" ::: "memory"); __syncthreads();
    hr = 0.f; hi = 0.f;
    for (int v = 0; v < wave; ++v) { const float er = xl[(v * 64 + n) * 2], ei = xl[(v * 64 + n) * 2 + 1]; const float nr = pr * hr - pi * hi + er, ni = pr * hi + pi * hr + ei; hr = nr; hi = ni; }
#pragma unroll
    for (int k = 0; k < 32; ++k) { const unsigned w = pkbf(hr, hi); ug[(size_t)k * UGP] = (bf16)(w & 0xffffu); ug[(size_t)k * UGP + 64] = (bf16)(w >> 16);
        const float nr = ar * hr - ai * hi + vr[k], ni = ar * hi + ai * hr + vi[k]; hr = nr; hi = ni; }
    asm volatile("s_waitcnt lgkmcnt(0)" ::: "memory"); __syncthreads();
}

struct MapSsmV   { __device__ __forceinline__ void operator()(pg8::Unit& u) const { u.aoff = u.pm * 256 * UGP; u.boff = (u.pm >> 1) * 128 * 1024; } };
struct MapSsmY   { __device__ __forceinline__ void operator()(pg8::Unit& u) const { if ((u.pm >> 3) & 1) u.pn = 3 - u.pn;
        u.aoff = u.pm * 256 * UGP; u.boff = ((u.pm >> 1) * 1024 + u.pn * 256) * UGP; u.nt = 6 + 4 * u.pn; } };
struct MapMQT    { __device__ __forceinline__ void operator()(pg8::Unit& u) const { const int b = u.pm >> 2, h = u.pm & 3; u.aoff = b * 256 * 4096 + h * 512; u.boff = u.pn * 256 * 2048 + h * 512; } };
struct MapVWOT   { __device__ __forceinline__ void operator()(pg8::Unit& u) const { const int b = u.pm >> 3, nt = u.pm & 7, h = u.pn; u.aoff = nt * 256 * 2048 + h * 512; u.boff = b * 256 * 4096 + 2048 + h * 512; } };
struct MapScores { __device__ __forceinline__ void operator()(pg8::Unit& u) const { u.aoff = u.pm * 256 * 2048; u.boff = ((u.pm >> 6) * 1024 + u.pn * 256) * 2048; } };
struct MapOut    { __device__ __forceinline__ void operator()(pg8::Unit& u) const { u.aoff = u.pm * 256 * 1024; u.boff = ((u.pm >> 6) * 2048 + u.pn * 256) * 1024; } };

#ifndef WGM_N8
#define WGM_N8 4
#endif
#ifndef WGM_FF
#define WGM_FF 4
#endif
#ifndef STAG_G
#define STAG_G 1
#endif
#ifndef STAG_US
#define STAG_US 0
#endif
__device__ __forceinline__ void stagger(int bx, int us) {
    const int grp = (bx >> 3) % STAG_G;
    if (STAG_G > 1 && grp) { const unsigned long long t0 = __builtin_amdgcn_s_memrealtime(), dt = (unsigned long long)(grp * us) * 100ull;
        while (__builtin_amdgcn_s_memrealtime() - t0 < dt) __builtin_amdgcn_s_sleep(16); }
}
struct Args { const float* in[NIN]; float* out; unsigned char* ws; };
#ifndef PHMASK
#define PHMASK 0xFFFFFFFFu
#endif
#define PH(k) ((PHMASK >> (k)) & 1u)
#ifndef PROBE_DUP
#define PROBE_DUP -1
#endif
#ifndef PROBE_DUP2
#define PROBE_DUP2 -1
#endif
#ifndef PROBE_DUP3
#define PROBE_DUP3 -1
#endif
#ifndef PROBE_DUP4
#define PROBE_DUP4 -1
#endif
#define PD(k) (PROBE_DUP == (k) || PROBE_DUP2 == (k) || PROBE_DUP3 == (k) || PROBE_DUP4 == (k))
#define P_DUMY ((float*)(WSP + WS_END))
#define P_DUMXB ((bf16*)(WSP + WS_END + 256 * MiB))
#define P_DUMST ((float*)(WSP + WS_END + 384 * MiB))
#define LOAD_GB(gp, bp) do { const float* g_ = (gp); const float* b_ = (bp); LAS float* d_ = (LAS float*)(ldsl + GB_OFF); \
        for (int i_ = tid; i_ < DMODEL; i_ += NWAVES * 64) { d_[i_] = g_[i_]; d_[DMODEL + i_] = b_[i_]; } __syncthreads(); } while (0)
#define LGB ((LAS const float*)(ldsl + GB_OFF))
#define GEMM_PHASE(EPI, ORD, g, S, E) pg8::gemm_phase<EPI, ORD, true, true>(ldsl + RING_OFF, g, S, E)
#ifndef SWIGLU_ALIGN
#define SWIGLU_ALIGN true
#endif
#define GEMM_PHASE_SW(EPI, ORD, g, S, E) pg8::gemm_phase<EPI, ORD, SWIGLU_ALIGN, true>(ldsl + RING_OFF, g, S, E)
typedef __attribute__((address_space(4))) const unsigned char* kargp_t;
__device__ __forceinline__ kargp_t kargs() { kargp_t p = (kargp_t)__builtin_amdgcn_kernarg_segment_ptr(); asm volatile("" : "+s"(p)); return p; }
#define INP(i) (*(const float* const __attribute__((address_space(4)))*)(kargs() + 8 * (i)))
#define P_X32 (*(float* const __attribute__((address_space(4)))*)(kargs() + 8 * NIN))
#define WSP (*(unsigned char* const __attribute__((address_space(4)))*)(kargs() + 8 * (NIN + 1)))
#define P_XB ((bf16*)(WSP + WS_XB))
#define P_YLO ((pg8::u32x4*)(WSP + WS_YLO))
#define P_CS(l, off) ((float*)(WSP + WS_CS) + (size_t)(l) * CSL + (off))
#define P_ST(i) ((float*)(WSP + WS_ST) + (size_t)(i) * (2 * MT))
#define P_HMID ((bf16*)(WSP + WS_HMID))
#define P_QKV ((bf16*)(WSP + WS_QKV))
#define P_UG ((bf16*)(WSP + WS_UG))
#define P_OV ((bf16*)(WSP + WS_OV))
#define P_SC ((float*)(WSP + WS_SC))
#define P_PB ((bf16*)(WSP + WS_PB))
#define P_MIX ((bf16*)(WSP + WS_MIX))
#define P_YG ((bf16*)(WSP + WS_YG))
#define P_VS ((float*)(WSP + WS_VS))
#define P_W1GU ((bf16*)(WSP + WS_W1GU))
#define P_W1D ((bf16*)(WSP + WS_W1D))
#define P_W2GU ((bf16*)(WSP + WS_W2GU))
#define P_W2D ((bf16*)(WSP + WS_W2D))
#define P_WIN ((bf16*)(WSP + WS_WIN))
#define P_WGLU ((bf16*)(WSP + WS_WGLU))
#define P_WOUT ((bf16*)(WSP + WS_WOUT))
#define P_WQN ((bf16*)(WSP + WS_WQN))
#define P_WKVT ((bf16*)(WSP + WS_WKVT))
#define P_WOT ((bf16*)(WSP + WS_WOT))
#define P_TG ((bf16*)(WSP + WS_TG))
#define P_EM ((bf16*)(WSP + WS_EM))
#define P_MEMB ((bf16*)(WSP + WS_MEMB))
#define P_KVM ((bf16*)(WSP + WS_KVM))
#define P_MQT ((bf16*)(WSP + WS_MQT))
#define P_VWOT ((bf16*)(WSP + WS_VWOT))
__global__ void __launch_bounds__(NWAVES * 64, 2) fwd_kernel(Args args) {
    extern __shared__ __attribute__((aligned(16))) unsigned char lds[];
    LAS unsigned char* ldsl = (LAS unsigned char*)lds;
    volatile LAS unsigned* MISC = (volatile LAS unsigned*)(ldsl + MISC_OFF);
#define IDS() const int tid = pg8::otid(), lane = tid & 63, wave = __builtin_amdgcn_readfirstlane(tid >> 6); const int G = pg8::osgpr((int)gridDim.x), bx = pg8::osgpr((int)blockIdx.x), \
        vcu = (G % 8 == 0) ? (bx % 8) * (G / 8) + bx / 8 : bx, gw = vcu * NWAVES + wave, NGW = G * NWAVES; LAS float* scr = (LAS float*)(ldsl + RING_OFF + wave * 16384); \
        (void)lane; (void)gw; (void)NGW; (void)scr; (void)vcu
    { const int tid0 = threadIdx.x;
      for (int u = tid0; u < (LDS_BYTES - LDSCTL_OFF) / 4; u += NWAVES * 64) ((LAS unsigned*)(ldsl + LDSCTL_OFF))[u] = 0u; }
    __syncthreads();
    (void)xcd_barrier_post((unsigned*)((gu32*)(WSP + WS_CTL) + CW_BAR), MISC + 8);
#define GRID_BAR() do { XcdBarrier b_; b_.bar = (unsigned*)((gu32*)(WSP + WS_CTL) + CW_BAR); b_.x = xb_xcc_id(); b_.st = (volatile LAS unsigned*)(ldsl + MISC_OFF) + 8; xcd_barrier(b_); } while (0)

#define CONVERT_LAYER(L, MODE) do { const int L_ = (L); IDS();     \
        if ((MODE) != 2) { \
        conv_T(INP(I_F1G) + (size_t)L_ * DMODEL * FF, DMODEL, FF, P_W1GU, DMODEL, RmGate{0}, L_ ? INP(I_LN4G) + (L_ - 1) * DMODEL : nullptr, INP(I_LN4B) + (L_ ? L_ - 1 : 0) * DMODEL, P_CS(L_, CS1), P_CS(L_, CB1), scr, gw, NGW, lane, 0, 1.4426950408889634f); \
        conv_T(INP(I_F1U) + (size_t)L_ * DMODEL * FF, DMODEL, FF, P_W1GU, DMODEL, RmGate{128}, L_ ? INP(I_LN4G) + (L_ - 1) * DMODEL : nullptr, INP(I_LN4B) + (L_ ? L_ - 1 : 0) * DMODEL, P_CS(L_, CS1), P_CS(L_, CB1), scr, gw, NGW, lane, 704, 0.6931471805599453f); \
        conv_T(INP(I_F1D) + (size_t)L_ * DMODEL * FF, FF, DMODEL, P_W1D, FF, RmId{}, nullptr, nullptr, nullptr, nullptr, scr, gw, NGW, lane, 1408); \
        conv_T(INP(I_F2G) + (size_t)L_ * DMODEL * FF, DMODEL, FF, P_W2GU, DMODEL, RmGate{0}, INP(I_LN3G) + L_ * DMODEL, INP(I_LN3B) + L_ * DMODEL, P_CS(L_, CS2), P_CS(L_, CB2), scr, gw, NGW, lane, 2112, 1.4426950408889634f); \
        conv_T(INP(I_F2U) + (size_t)L_ * DMODEL * FF, DMODEL, FF, P_W2GU, DMODEL, RmGate{128}, INP(I_LN3G) + L_ * DMODEL, INP(I_LN3B) + L_ * DMODEL, P_CS(L_, CS2), P_CS(L_, CB2), scr, gw, NGW, lane, 2816, 0.6931471805599453f); \
        } if ((MODE) != 1) { \
        conv_T(INP(I_F2D) + (size_t)L_ * DMODEL * FF, FF, DMODEL, P_W2D, FF, RmId{}, nullptr, nullptr, nullptr, nullptr, scr, gw, NGW, lane, 3520); \
        } if ((MODE) != 2) { \
        conv_T(INP(I_WIN) + (size_t)L_ * DMODEL * INW, DMODEL, INW, P_WIN, DMODEL, RmId{}, INP(I_LN1G) + L_ * DMODEL, INP(I_LN1B) + L_ * DMODEL, P_CS(L_, CSW), P_CS(L_, CBW), scr, gw, NGW, lane, 4224); \
        conv_T(INP(I_GLUW) + (size_t)L_ * 1024 * 1024, 1024, 1024, P_WGLU, 1024, RmId{}, nullptr, nullptr, nullptr, nullptr, scr, gw, NGW, lane, 4736); \
        conv_T(INP(I_WOUT) + (size_t)L_ * DMODEL * DMODEL, DMODEL, DMODEL, P_WOUT, DMODEL, RmId{}, nullptr, nullptr, nullptr, nullptr, scr, gw, NGW, lane, 4800); \
        conv_copy(INP(I_XQ) + (size_t)L_ * DMODEL * DMODEL, P_WQN, (size_t)DMODEL * DMODEL, gw, NGW, lane); \
        conv_T(INP(I_XK) + (size_t)L_ * DMODEL * DMODEL, DMODEL, DMODEL, P_WKVT, DMODEL, RmId{}, nullptr, nullptr, nullptr, nullptr, scr, gw, NGW, lane, 5056); \
        conv_T(INP(I_XV) + (size_t)L_ * DMODEL * DMODEL, DMODEL, DMODEL, P_WKVT + (size_t)DMODEL * DMODEL, DMODEL, RmId{}, nullptr, nullptr, nullptr, nullptr, scr, gw, NGW, lane, 5312); \
        conv_T(INP(I_XO) + (size_t)L_ * DMODEL * DMODEL, DMODEL, DMODEL, P_WOT, DMODEL, RmId{}, nullptr, nullptr, nullptr, nullptr, scr, gw, NGW, lane, 5568); \
        __syncthreads(); \
        ssm_prep(INP(I_SLRE) + L_ * 4096, INP(I_SLIM) + L_ * 4096, INP(I_SLOG) + L_ * 64, INP(I_SBRE) + (size_t)L_ * 65536, INP(I_SBIM) + (size_t)L_ * 65536, \
                 INP(I_SCRE) + (size_t)L_ * 65536, INP(I_SCIM) + (size_t)L_ * 65536, P_TG, P_EM, ldsl + RING_OFF, vcu, G, tid, L_ > 0); \
        } \
    } while (0)
#define CONVERT_DUMMY(L) do { const int L_ = (L); IDS(); \
        conv_T(INP(I_F1G) + (size_t)L_ * DMODEL * FF, DMODEL, FF, ((bf16*)((unsigned char*)P_W1GU + (WS_END - WS_W))), DMODEL, RmGate{0}, L_ ? INP(I_LN4G) + (L_ - 1) * DMODEL : nullptr, INP(I_LN4B) + (L_ ? L_ - 1 : 0) * DMODEL, (P_DUMST + CS1), (P_DUMST + CB1), scr, gw, NGW, lane, 0, 1.4426950408889634f); \
        conv_T(INP(I_F1U) + (size_t)L_ * DMODEL * FF, DMODEL, FF, ((bf16*)((unsigned char*)P_W1GU + (WS_END - WS_W))), DMODEL, RmGate{128}, L_ ? INP(I_LN4G) + (L_ - 1) * DMODEL : nullptr, INP(I_LN4B) + (L_ ? L_ - 1 : 0) * DMODEL, (P_DUMST + CS1), (P_DUMST + CB1), scr, gw, NGW, lane, 704, 0.6931471805599453f); \
        conv_T(INP(I_F1D) + (size_t)L_ * DMODEL * FF, FF, DMODEL, ((bf16*)((unsigned char*)P_W1D + (WS_END - WS_W))), FF, RmId{}, nullptr, nullptr, nullptr, nullptr, scr, gw, NGW, lane, 1408); \
        conv_T(INP(I_F2G) + (size_t)L_ * DMODEL * FF, DMODEL, FF, ((bf16*)((unsigned char*)P_W2GU + (WS_END - WS_W))), DMODEL, RmGate{0}, INP(I_LN3G) + L_ * DMODEL, INP(I_LN3B) + L_ * DMODEL, (P_DUMST + CS2), (P_DUMST + CB2), scr, gw, NGW, lane, 2112, 1.4426950408889634f); \
        conv_T(INP(I_F2U) + (size_t)L_ * DMODEL * FF, DMODEL, FF, ((bf16*)((unsigned char*)P_W2GU + (WS_END - WS_W))), DMODEL, RmGate{128}, INP(I_LN3G) + L_ * DMODEL, INP(I_LN3B) + L_ * DMODEL, (P_DUMST + CS2), (P_DUMST + CB2), scr, gw, NGW, lane, 2816, 0.6931471805599453f); \
        conv_T(INP(I_F2D) + (size_t)L_ * DMODEL * FF, FF, DMODEL, ((bf16*)((unsigned char*)P_W2D + (WS_END - WS_W))), FF, RmId{}, nullptr, nullptr, nullptr, nullptr, scr, gw, NGW, lane, 3520); \
        conv_T(INP(I_WIN) + (size_t)L_ * DMODEL * INW, DMODEL, INW, ((bf16*)((unsigned char*)P_WIN + (WS_END - WS_W))), DMODEL, RmId{}, INP(I_LN1G) + L_ * DMODEL, INP(I_LN1B) + L_ * DMODEL, (P_DUMST + CSW), (P_DUMST + CBW), scr, gw, NGW, lane, 4224); \
        conv_T(INP(I_GLUW) + (size_t)L_ * 1024 * 1024, 1024, 1024, ((bf16*)((unsigned char*)P_WGLU + (WS_END - WS_W))), 1024, RmId{}, nullptr, nullptr, nullptr, nullptr, scr, gw, NGW, lane, 4736); \
        conv_T(INP(I_WOUT) + (size_t)L_ * DMODEL * DMODEL, DMODEL, DMODEL, ((bf16*)((unsigned char*)P_WOUT + (WS_END - WS_W))), DMODEL, RmId{}, nullptr, nullptr, nullptr, nullptr, scr, gw, NGW, lane, 4800); \
        conv_copy(INP(I_XQ) + (size_t)L_ * DMODEL * DMODEL, ((bf16*)((unsigned char*)P_WQN + (WS_END - WS_W))), (size_t)DMODEL * DMODEL, gw, NGW, lane); \
        conv_T(INP(I_XK) + (size_t)L_ * DMODEL * DMODEL, DMODEL, DMODEL, ((bf16*)((unsigned char*)P_WKVT + (WS_END - WS_W))), DMODEL, RmId{}, nullptr, nullptr, nullptr, nullptr, scr, gw, NGW, lane, 5056); \
        conv_T(INP(I_XV) + (size_t)L_ * DMODEL * DMODEL, DMODEL, DMODEL, ((bf16*)((unsigned char*)P_WKVT + (WS_END - WS_W))) + (size_t)DMODEL * DMODEL, DMODEL, RmId{}, nullptr, nullptr, nullptr, nullptr, scr, gw, NGW, lane, 5312); \
        conv_T(INP(I_XO) + (size_t)L_ * DMODEL * DMODEL, DMODEL, DMODEL, ((bf16*)((unsigned char*)P_WOT + (WS_END - WS_W))), DMODEL, RmId{}, nullptr, nullptr, nullptr, nullptr, scr, gw, NGW, lane, 5568); \
        __syncthreads(); \
        ssm_prep(INP(I_SLRE) + L_ * 4096, INP(I_SLIM) + L_ * 4096, INP(I_SLOG) + L_ * 64, INP(I_SBRE) + (size_t)L_ * 65536, INP(I_SBIM) + (size_t)L_ * 65536, \
                 INP(I_SCRE) + (size_t)L_ * 65536, INP(I_SCIM) + (size_t)L_ * 65536, ((bf16*)((unsigned char*)P_TG + (WS_END - WS_W))), ((bf16*)((unsigned char*)P_EM + (WS_END - WS_W))), ldsl + RING_OFF, vcu, G, tid); \
    } while (0)

    { IDS(); conv_copy(INP(I_X), P_XB, (size_t)MT * DMODEL, gw, NGW, lane);
      conv_copy(INP(I_MEM), P_MEMB, (size_t)NBATCH * NMEM * DMODEL, gw, NGW, lane); }
    CONVERT_LAYER(0, 0);
    GRID_BAR();

#pragma unroll 1
    for (int l = 0; l < DEPTH; ++l) {
        if (PH(1)) { IDS();
        { pg8::Gemm g{P_XB, P_W1GU, DMODEL, DMODEL, DMODEL}; pg8::Order<pg8::MapStd> S; S.init(MT / 256, 2 * FF / 256, G, bx, pg8::MapStd{DMODEL, DMODEL}, WGM_FF);
          pg8::EpiSwiGLU E{P_HMID, FF, pg8::Fold{P_ST(l ? 4 * l - 1 : 0), P_CS(l, CS1), P_CS(l, CB1), l == 0}, ldsl + GB_OFF}; GEMM_PHASE_SW(pg8::EpiSwiGLU, pg8::Order<pg8::MapStd>, g, S, E); }
        }
        GRID_BAR();
        if (PH(2)) { IDS(); stagger(bx, STAG_US);
        { pg8::Gemm g{P_HMID, P_W1D, FF, FF, FF}; pg8::Order<pg8::MapStdRev> S; S.init(MT / 256, DMODEL / 256, G, bx, pg8::MapStdRev{FF, FF, MT / 256}, WGM_N8);
          if (l == 0) { pg8::EpiResLn0 E{INP(I_X), nullptr, LGB, P_XB, P_YLO, nullptr, P_ST(0), ALPHA, 0.5f}; GEMM_PHASE(pg8::EpiResLn0, pg8::Order<pg8::MapStdRev>, g, S, E); }
          else { LOAD_GB(INP(I_LN4G) + (l - 1) * DMODEL, INP(I_LN4B) + (l - 1) * DMODEL); pg8::EpiResLn E{nullptr, P_ST(4 * l - 1), LGB, P_XB, P_YLO, nullptr, P_ST(4 * l), ALPHA, 0.5f}; GEMM_PHASE(pg8::EpiResLn, pg8::Order<pg8::MapStdRev>, g, S, E); } }
        }
        GRID_BAR();
        if (PH(4)) { IDS();
        { pg8::Gemm g{P_XB, P_WIN, DMODEL, DMODEL, DMODEL}; pg8::Order<pg8::MapStd> S; S.init(MT / 256, INW / 256, G, bx, pg8::MapStd{DMODEL, DMODEL});
          pg8::EpiWin<UGP> E{P_QKV, P_UG, attn_body::C2, pg8::Fold{P_ST(4 * l), P_CS(l, CSW), P_CS(l, CBW), 0}, ldsl + GB_OFF}; GEMM_PHASE(pg8::EpiWin<UGP>, pg8::Order<pg8::MapStd>, g, S, E); }
        }
        GRID_BAR();
        if (PH(5)) { IDS();
        { pg8::Gemm g{P_UG + 128, P_EM, UGP, 1024, 1024}; pg8::Order<MapSsmV> S; S.init(128, 1, G, bx, MapSsmV{});
          pg8::EpiF32<1> E{P_VS, 128}; GEMM_PHASE(pg8::EpiF32<1>, pg8::Order<MapSsmV>, g, S, E); }
        { pg8::Gemm g{P_MEMB, P_WKVT, DMODEL, DMODEL, DMODEL}; pg8::Order<pg8::MapStd> S; S.init(2, 16, G, bx - 128, pg8::MapStd{DMODEL, DMODEL});
          pg8::EpiBf16 E{P_KVM, 4096, 1.0f}; GEMM_PHASE(pg8::EpiBf16, pg8::Order<pg8::MapStd>, g, S, E); }
        if (l > 0 && bx >= 128 && G == 256) { conv_T(INP(I_F2D) + (size_t)l * DMODEL * FF, FF, DMODEL, P_W2D, FF, RmId{}, nullptr, nullptr, nullptr, nullptr, scr, (bx - 128) * NWAVES + wave, 128 * NWAVES, lane, 0); }
        else if (l > 0 && G != 256) { conv_T(INP(I_F2D) + (size_t)l * DMODEL * FF, FF, DMODEL, P_W2D, FF, RmId{}, nullptr, nullptr, nullptr, nullptr, scr, gw, NGW, lane, 0); }
        __syncthreads();
        }
        if (PH(6)) { IDS();
        { pg8::Order<MapSsmV> S5; S5.init(128, 1, G, bx, MapSsmV{}); pg8::Unit u5; const bool has5 = S5.next(0, u5);
          if (has5) { __builtin_amdgcn_fence(__ATOMIC_ACQUIRE, "agent"); asm volatile("s_waitcnt vmcnt(0)" ::: "memory");
              ssm_scan8(INP(I_SLRE) + l * 4096, INP(I_SLIM) + l * 4096, INP(I_SLOG) + l * 64, P_VS, P_UG, u5.pm, wave, lane, (LAS float*)(ldsl + RING_OFF)); } }
        { const attn_body::AttnTensors AT{(const attn_body::bf16*)P_QKV, (attn_body::bf16*)P_OV};
#if defined(ATTN_V64)
          const attn_body::StaticOrder S((int)G, (int)bx);
          attn_body::attn_phase<attn_body::StaticOrder>((char*)lds + RING_OFF, AT, S); }
#else
          const attn_body::StaticOrder2 S((int)G, (int)bx);
          attn_body::attn_phase2<attn_body::StaticOrder2>((char*)lds + RING_OFF, AT, S); }
#endif
        }
        GRID_BAR();
        if (PH(7)) { IDS();
        diff_combine(P_OV, P_MIX, INP(I_LQ1) + l * 64, INP(I_LK1) + l * 64, INP(I_LQ2) + l * 64, INP(I_LK2) + l * 64, INP(I_DNG) + l * 128, 0.8f - 0.6f * expf(-0.3f * (float)l), gw, NGW, lane);
        __syncthreads();
        { pg8::Gemm g{P_UG, P_TG, UGP, UGP, UGP}; pg8::Order<MapSsmY> S; S.init(128, 4, G, bx, MapSsmY{});
          pg8::EpiSsmY<UGP> E{P_UG, INP(I_SD) + l * 1024, P_YG}; GEMM_PHASE(pg8::EpiSsmY<UGP>, pg8::Order<MapSsmY>, g, S, E); }
        { pg8::Gemm g{P_KVM, P_WQN, 4096, DMODEL, 512}; pg8::Order<MapMQT> S; S.init(8, 8, G, bx, MapMQT{});
          pg8::EpiMqt E{P_MQT, DMODEL, 0.044194173824159216f, INP(I_LN2G) + l * DMODEL, INP(I_LN2B) + l * DMODEL, P_CS(l, CSM), P_CS(l, CBM)}; GEMM_PHASE(pg8::EpiMqt, pg8::Order<MapMQT>, g, S, E); }
        { pg8::Gemm g{P_WOT, P_KVM, DMODEL, 4096, 512}; pg8::Order<MapVWOT> S; S.init(16, 4, G, bx - 64, MapVWOT{});
          pg8::EpiBf16 E{P_VWOT, 1024, 1.0f}; GEMM_PHASE(pg8::EpiBf16, pg8::Order<MapVWOT>, g, S, E); }
        }
        GRID_BAR();
        if (PH(8)) { IDS();
        { pg8::Gemm g{P_YG, P_WGLU, 1024, 1024, 1024}; pg8::Order<pg8::MapStd> S; S.init(MT / 256, 4, G, bx, pg8::MapStd{1024, 1024});
          pg8::EpiGlu E{P_YG, INP(I_GLUB) + l * 1024, P_MIX}; GEMM_PHASE(pg8::EpiGlu, pg8::Order<pg8::MapStd>, g, S, E); }
        }
        GRID_BAR();
        if (PH(9)) { IDS(); stagger(bx, STAG_US);
        { pg8::Gemm g{P_MIX, P_WOUT, DMODEL, DMODEL, DMODEL}; pg8::Order<pg8::MapStd> S; S.init(MT / 256, DMODEL / 256, G, bx, pg8::MapStd{DMODEL, DMODEL}, WGM_N8);
          LOAD_GB(INP(I_LN1G) + l * DMODEL, INP(I_LN1B) + l * DMODEL); pg8::EpiResLn E{nullptr, P_ST(4 * l), LGB, P_XB, P_YLO, nullptr, P_ST(4 * l + 1), ALPHA, 1.0f}; GEMM_PHASE(pg8::EpiResLn, pg8::Order<pg8::MapStd>, g, S, E); }
        }
        GRID_BAR();
        if (PH(11)) { IDS();
        { pg8::Gemm g{P_XB, P_MQT, DMODEL, DMODEL, DMODEL}; pg8::Order<MapScores> S; S.init(MT / 256, 4, G, bx, MapScores{});
          pg8::EpiScoresSm E{P_PB, pg8::Fold{P_ST(4 * l + 1), P_CS(l, CSM), P_CS(l, CBM), 0}, (LAS float*)(ldsl + XCH_OFF)}; GEMM_PHASE(pg8::EpiScoresSm, pg8::Order<MapScores>, g, S, E); }
        }
        GRID_BAR();
        if (PH(13)) { IDS(); stagger(bx, STAG_US);
        { pg8::Gemm g{P_PB, P_VWOT, 1024, 1024, 1024}; pg8::Order<MapOut> S; S.init(MT / 256, DMODEL / 256, G, bx, MapOut{}, WGM_N8);
          LOAD_GB(INP(I_LN2G) + l * DMODEL, INP(I_LN2B) + l * DMODEL); pg8::EpiResLn E{nullptr, P_ST(4 * l + 1), LGB, P_XB, P_YLO, nullptr, P_ST(4 * l + 2), ALPHA, 1.0f}; GEMM_PHASE(pg8::EpiResLn, pg8::Order<MapOut>, g, S, E); }
        }
        GRID_BAR();
        if (PH(15)) { IDS();
        { pg8::Gemm g{P_XB, P_W2GU, DMODEL, DMODEL, DMODEL}; pg8::Order<pg8::MapStd> S; S.init(MT / 256, 2 * FF / 256, G, bx, pg8::MapStd{DMODEL, DMODEL}, WGM_FF);
          pg8::EpiSwiGLU E{P_HMID, FF, pg8::Fold{P_ST(4 * l + 2), P_CS(l, CS2), P_CS(l, CB2), 0}, ldsl + GB_OFF}; GEMM_PHASE_SW(pg8::EpiSwiGLU, pg8::Order<pg8::MapStd>, g, S, E); }
        }
        GRID_BAR();
        if (PH(16)) { IDS(); stagger(bx, STAG_US);
        { pg8::Gemm g{P_HMID, P_W2D, FF, FF, FF}; pg8::Order<pg8::MapStdRev> S; S.init(MT / 256, DMODEL / 256, G, bx, pg8::MapStdRev{FF, FF, MT / 256}, WGM_N8);
          LOAD_GB(INP(I_LN3G) + l * DMODEL, INP(I_LN3B) + l * DMODEL);
          { pg8::EpiResLn E{nullptr, P_ST(4 * l + 2), LGB, P_XB, P_YLO, nullptr, P_ST(4 * l + 3), ALPHA, 0.5f}; GEMM_PHASE(pg8::EpiResLn, pg8::Order<pg8::MapStdRev>, g, S, E); } }
        }
        if (l + 1 < DEPTH) { CONVERT_LAYER(l + 1, 1); GRID_BAR(); }
        else { GRID_BAR(); IDS(); final_ln_planes(P_XB, P_YLO, P_ST(4 * l + 3), INP(I_LN4G) + l * DMODEL, INP(I_LN4B) + l * DMODEL, P_X32, gw, NGW, lane); }
    }
}

extern "C" void kernel_launch(void* const* d_in, const int* in_sizes, int n_in, void* d_out, int out_size, void* d_ws, size_t ws_size, hipStream_t stream) {
    static int grid = 0;
    if (grid == 0) {
        if (n_in != NIN || in_sizes[0] != MT * DMODEL || out_size != MT * DMODEL || ws_size < WS_END) { fprintf(stderr, "kernel_launch: unexpected problem shape (n_in %d, in0 %d, out %d, ws %zu < %zu); nothing launched\n", n_in, n_in > 0 ? in_sizes[0] : -1, out_size, ws_size, (size_t)WS_END); grid = -1; return; }
        int dev = 0, cus = 0, per_cu = 0;
        if (hipGetDevice(&dev) != hipSuccess || hipDeviceGetAttribute(&cus, hipDeviceAttributeMultiprocessorCount, dev) != hipSuccess) { fprintf(stderr, "kernel_launch: device query failed\n"); grid = -1; return; }
        if (hipFuncSetAttribute((const void*)fwd_kernel, hipFuncAttributeMaxDynamicSharedMemorySize, LDS_BYTES) != hipSuccess) { fprintf(stderr, "kernel_launch: hipFuncSetAttribute failed\n"); grid = -1; return; }
        if (hipOccupancyMaxActiveBlocksPerMultiprocessor(&per_cu, (const void*)fwd_kernel, NWAVES * 64, LDS_BYTES) != hipSuccess || per_cu < 1)
            fprintf(stderr, "kernel_launch: note: occupancy query reports %d workgroups per CU\n", per_cu);
        (void)hipGetLastError();
        grid = cus;
    }
    if (grid < 0) return;
    if (hipMemsetAsync((char*)d_ws + WS_CTL, 0, CTL_ZERO_BYTES, stream) != hipSuccess) { fprintf(stderr, "kernel_launch: hipMemsetAsync failed\n"); return; }
    Args a{};
    for (int i = 0; i < NIN; ++i) a.in[i] = (const float*)d_in[i];
    a.out = (float*)d_out; a.ws = (unsigned char*)d_ws;
    hipLaunchKernelGGL(fwd_kernel, dim3(grid), dim3(NWAVES * 64), LDS_BYTES, stream, a);
    const hipError_t le = hipPeekAtLastError();
    if (le != hipSuccess) fprintf(stderr, "kernel_launch: launch failed: %s\n", hipGetErrorName(le));
}
```

```cpp
#pragma clang diagnostic ignored "-Winline-asm"
#include <hip/hip_runtime.h>
#include <hip/hip_bf16.h>
#include <cstdio>
#include <cstdint>
#include <cmath>
namespace pg8 {
#define PG8_LAS __attribute__((address_space(3)))
typedef unsigned short bf16_t;
typedef short bf16x8 __attribute__((ext_vector_type(8)));
typedef float f32x4 __attribute__((ext_vector_type(4)));
typedef float f32x2 __attribute__((ext_vector_type(2)));
typedef unsigned u32x4 __attribute__((ext_vector_type(4)));
constexpr int BM = 256, BK = 64, HALF = 128, HTB = HALF * BK * 2  , STAGE_BYTES = 8 * HTB, NXCD = 8, WGM = 8;

__host__ __device__ __forceinline__ int lds_byte(int r, int c) { const int st = (r >> 4) * 2 + (c >> 5), rr = r & 15, cc = c & 31, ob = rr * 64 + cc * 2; return st * 1024 + (ob ^ (((ob >> 9) & 1) << 5)); }
__host__ __device__ __forceinline__ void stage_rc(int b, int& R, int& C) { const int st = b / 1024, sb = b % 1024, swz = sb ^ (((sb >> 9) & 1) << 5); R = (st >> 1) * 16 + swz / 64; C = (st & 1) * 32 + (swz % 64) / 2; }
__host__ __device__ __forceinline__ int perm32(int rho) { const int n = rho >> 4, i = rho & 15; return 8 * (i >> 2) + 4 * n + (i & 3); }

struct Unit { int aoff, boff, pm, pn, nt; };
struct Gemm { const bf16_t* A; const bf16_t* Bt; int lda, ldb, K; };

template <class Map> struct Order {
    int nM, nN, nwg, G, c, wgm; Map map;
    __device__ __forceinline__ void init(int nM_, int nN_, int G_, int c_, const Map& m, int wgm_ = WGM) { nM = nM_; nN = nN_; nwg = nM * nN; G = G_; c = c_; map = m; wgm = wgm_; }
    __device__ __forceinline__ bool next(int i, Unit& u) const {
        const long L = (long)i * G + c; if (c < 0 || L >= nwg) return false;
        int wgid = (int)L; { const int q = nwg / NXCD, r = nwg % NXCD, xcd = wgid % NXCD, off = wgid / NXCD; wgid = (xcd < r ? xcd * (q + 1) : r * (q + 1) + (xcd - r) * q) + off; }
        const int nig = wgm * nN, gid = wgid / nig, fm = gid * wgm, gsz = (nM - fm) < wgm ? (nM - fm) : wgm;
        u.pm = fm + ((wgid % nig) % gsz); u.pn = (wgid % nig) / gsz; u.nt = 0; map(u); return true;
    }
    __device__ __forceinline__ void a_ready(const Unit&) const {}
    __device__ __forceinline__ void done(const Unit&) const {}
};
struct MapStd { int lda, ldb; __device__ __forceinline__ void operator()(Unit& u) const { u.aoff = u.pm * BM * lda; u.boff = u.pn * BM * ldb; } };

struct MapStdRev { int lda, ldb, nM; __device__ __forceinline__ void operator()(Unit& u) const { u.pm = nM - 1 - u.pm; u.aoff = u.pm * BM * lda; u.boff = u.pn * BM * ldb; } };

__device__ __forceinline__ unsigned cvt_pk_bf16(float lo, float hi) { unsigned r; asm volatile("v_cvt_pk_bf16_f32 %0, %1, %2" : "=v"(r) : "v"(lo), "v"(hi)); return r; }
__device__ __forceinline__ float bf_lo(unsigned w) { return __uint_as_float(w << 16); }
__device__ __forceinline__ float bf_hi(unsigned w) { return __uint_as_float(w & 0xffff0000u); }
__device__ __forceinline__ float sigmoid_f(float z) { return __builtin_amdgcn_rcpf(1.0f + __builtin_amdgcn_exp2f(-1.4426950408889634f * z)); }
__device__ __forceinline__ int otid() { int t = threadIdx.x; asm volatile("" : "+v"(t)); return t; }
__device__ __forceinline__ int osgpr(int v) { asm volatile("" : "+s"(v)); return v; }
template <int K> __device__ __forceinline__ float sw_xor(float v) { return __int_as_float(__builtin_amdgcn_ds_swizzle(__float_as_int(v), (K << 10) | 0x1f)); }
__device__ __forceinline__ float add_xor32(float v) { auto rr = __builtin_amdgcn_permlane32_swap(__float_as_uint(v), __float_as_uint(v), false, false); return __uint_as_float(rr[0]) + __uint_as_float(rr[1]); }
__device__ __forceinline__ float max_xor32(float v) { auto rr = __builtin_amdgcn_permlane32_swap(__float_as_uint(v), __float_as_uint(v), false, false); return fmaxf(__uint_as_float(rr[0]), __uint_as_float(rr[1])); }
__device__ __forceinline__ float red16_32(float v) { v += sw_xor<16>(v); return add_xor32(v); }
template <class T> __device__ __forceinline__ T* at32(const void* base, unsigned byte_off) { return (T*)((char*)const_cast<void*>(base) + byte_off); }
#define PG8_EPI_ARGS const f32x4 (&acc)[2][2][4][2], const Unit& u, int wr, int wc, int fr, int fq
__device__ __forceinline__ u32x4 pack8(const f32x4 v0, const f32x4 v1) { u32x4 w; w.x = cvt_pk_bf16(v0[0], v0[1]); w.y = cvt_pk_bf16(v0[2], v0[3]); w.z = cvt_pk_bf16(v1[0], v1[1]); w.w = cvt_pk_bf16(v1[2], v1[3]); return w; }


struct Fold { const float* stats; const float* cs; const float* cb; int ident; };
__device__ __forceinline__ void fold_row(const Fold& f, int r, float& mu, float& rs) {
    const f32x2 s = *(const f32x2*)(f.stats + 2 * (size_t)r); mu = s.x * (1.0f / 2048.0f); const float var = s.y * (1.0f / 2048.0f) - mu * mu; rs = __builtin_amdgcn_rsqf(var + 1e-5f);
}
__device__ __forceinline__ void fold_rows8(const Fold& f, int row0, float (&mu)[2][4], float (&rs)[2][4]) {
    f32x2 st[2][4];
#pragma unroll
    for (int ai = 0; ai < 2; ++ai)
#pragma unroll
        for (int m = 0; m < 4; ++m) st[ai][m] = *at32<const f32x2>(f.stats, 8u * (unsigned)(row0 + ai * HALF + m * 16));
#pragma unroll
    for (int ai = 0; ai < 2; ++ai)
#pragma unroll
        for (int m = 0; m < 4; ++m) { mu[ai][m] = st[ai][m].x * (1.0f / 2048.0f); rs[ai][m] = __builtin_amdgcn_rsqf(st[ai][m].y * (1.0f / 2048.0f) - mu[ai][m] * mu[ai][m] + 1e-5f); }
}
__device__ __forceinline__ f32x4 fold4(const f32x4 a, float mu, float rs, const f32x4 cs, const f32x4 cb) { return (a - cs * mu) * rs + cb; }

__device__ __forceinline__ void fold_prefetch(const Fold& f, const Unit& u, PG8_LAS unsigned char* pf) {
    const int tid = otid(), wid = __builtin_amdgcn_readfirstlane(tid >> 6), L = tid & 63, wr = wid >> 2, wc = wid & 3, q = (L >> 3) & 3;
    PG8_LAS unsigned char* slot = pf + wid * 2048;
    __builtin_amdgcn_global_load_lds((const unsigned*)(f.stats + 2 * (u.pm * BM + (L >> 5) * HALF + wr * 64 + (L & 31) * 2)), (PG8_LAS unsigned*)slot, 16, 0, 0);
    __builtin_amdgcn_global_load_lds((const unsigned*)(((q & 2) ? f.cb : f.cs) + u.pn * BM + (q & 1) * HALF + wc * 32 + (L & 7) * 4), (PG8_LAS unsigned*)(slot + 1024), 16, 0, 0);
}
__device__ __forceinline__ void fold_from_lds(PG8_LAS const unsigned char* pf, int wr, int wc, int fr, int fq, f32x4 (&cs)[2][2], f32x4 (&cb)[2][2], float (&mu)[2][4], float (&rs)[2][4]) {
    PG8_LAS const unsigned char* slot = pf + (wr * 4 + wc) * 2048;
    f32x2 st[2][4];
#pragma unroll
    for (int ai = 0; ai < 2; ++ai)
#pragma unroll
        for (int m = 0; m < 4; ++m) st[ai][m] = *(const PG8_LAS f32x2*)(slot + (ai * 64 + m * 16 + fr) * 8);
#pragma unroll
    for (int bj = 0; bj < 2; ++bj)
#pragma unroll
        for (int n = 0; n < 2; ++n) { cs[bj][n] = *(const PG8_LAS f32x4*)(slot + 1024 + (bj * 8 + 2 * fq + n) * 16); cb[bj][n] = *(const PG8_LAS f32x4*)(slot + 1024 + ((2 + bj) * 8 + 2 * fq + n) * 16); }
#pragma unroll
    for (int ai = 0; ai < 2; ++ai)
#pragma unroll
        for (int m = 0; m < 4; ++m) { mu[ai][m] = st[ai][m].x * (1.0f / 2048.0f); rs[ai][m] = __builtin_amdgcn_rsqf(st[ai][m].y * (1.0f / 2048.0f) - mu[ai][m] * mu[ai][m] + 1e-5f); }
}

struct EpiBf16 {
    static constexpr bool PERM = true, AFTER_DRAIN = false, PREF = false;
    bf16_t* O; int ldc; float scale;
    __device__ __forceinline__ void operator()(PG8_EPI_ARGS) const {
        const int row0 = u.pm * BM + wr * 64 + fr, col0 = u.pn * BM + wc * 32 + 8 * fq;
#pragma unroll
        for (int ai = 0; ai < 2; ++ai)
#pragma unroll
            for (int m = 0; m < 4; ++m) { const unsigned bo = 2u * (unsigned)((row0 + ai * HALF + m * 16) * ldc + col0);
#pragma unroll
                for (int bj = 0; bj < 2; ++bj) *at32<u32x4>(O, bo + 2u * bj * HALF) = pack8(acc[ai][bj][m][0] * scale, acc[ai][bj][m][1] * scale); }
    }
};
template <int NBJ> struct EpiF32 {
    static constexpr bool PERM = false, AFTER_DRAIN = false, PREF = false;
    float* O; int ldc;
    __device__ __forceinline__ void operator()(PG8_EPI_ARGS) const {
        const int row0 = u.pm * BM + wr * 64 + fr, col0 = u.pn * (NBJ == 2 ? BM : HALF) + wc * 32 + 4 * fq;
#pragma unroll
        for (int ai = 0; ai < 2; ++ai)
#pragma unroll
            for (int m = 0; m < 4; ++m) { float* rowp = O + (size_t)(row0 + ai * HALF + m * 16) * ldc + col0;
#pragma unroll
                for (int bj = 0; bj < NBJ; ++bj)
#pragma unroll
                    for (int n = 0; n < 2; ++n) *(f32x4*)(rowp + bj * HALF + n * 16) = acc[ai][bj][m][n]; }
    }
};

struct EpiScoresSm {
    static constexpr bool PERM = true, AFTER_DRAIN = false, PREF = false;
    bf16_t* PB; Fold f; PG8_LAS float* xch;
    __device__ __forceinline__ void operator()(PG8_EPI_ARGS) const {
        f32x4 (&s)[2][2][4][2] = const_cast<f32x4 (&)[2][2][4][2]>(acc);
        const int row0 = u.pm * BM + wr * 64 + fr, col0 = u.pn * BM + wc * 32 + 8 * fq, vb = (u.pm >> 6) * 1024, rl0 = wr * 64 + fr;
        { f32x4 cs[2][2], cb[2][2]; float mus[2][4], rss[2][4]; fold_rows8(f, row0, mus, rss);
#pragma unroll
          for (int bj = 0; bj < 2; ++bj)
#pragma unroll
            for (int n = 0; n < 2; ++n) { cs[bj][n] = *(const f32x4*)(f.cs + vb + col0 + bj * HALF + 4 * n); cb[bj][n] = *(const f32x4*)(f.cb + vb + col0 + bj * HALF + 4 * n); }
#pragma unroll
          for (int ai = 0; ai < 2; ++ai)
#pragma unroll
            for (int m = 0; m < 4; ++m) { const float mu = mus[ai][m], rs = rss[ai][m]; float mx = -3.0e38f;
#pragma unroll
                for (int bj = 0; bj < 2; ++bj)
#pragma unroll
                    for (int n = 0; n < 2; ++n) { const f32x4 v = fold4(s[ai][bj][m][n], mu, rs, cs[bj][n], cb[bj][n]) * 1.4426950408889634f; s[ai][bj][m][n] = v;
                        mx = fmaxf(fmaxf(mx, fmaxf(v[0], v[1])), fmaxf(v[2], v[3])); }
                mx = fmaxf(mx, sw_xor<16>(mx)); mx = max_xor32(mx);
                if (fq == 0) xch[(ai * HALF + m * 16 + rl0) * 4 + wc] = mx; } }
        asm volatile("s_waitcnt lgkmcnt(0)" ::: "memory"); __builtin_amdgcn_s_barrier(); asm volatile("" ::: "memory");
#pragma unroll
        for (int ai = 0; ai < 2; ++ai)
#pragma unroll
            for (int m = 0; m < 4; ++m) { const f32x4 q = *(const PG8_LAS f32x4*)(xch + (ai * HALF + m * 16 + rl0) * 4); const float M = fmaxf(fmaxf(q[0], q[1]), fmaxf(q[2], q[3])); float sm = 0.f;
#pragma unroll
                for (int bj = 0; bj < 2; ++bj)
#pragma unroll
                    for (int n = 0; n < 2; ++n) { f32x4 v = s[ai][bj][m][n];
#pragma unroll
                        for (int e = 0; e < 4; ++e) v[e] = __builtin_amdgcn_exp2f(v[e] - M);
                        s[ai][bj][m][n] = v; sm += (v[0] + v[1]) + (v[2] + v[3]); }
                sm = red16_32(sm);
                if (fq == 0) xch[1024 + (ai * HALF + m * 16 + rl0) * 4 + wc] = sm; }
        asm volatile("s_waitcnt lgkmcnt(0)" ::: "memory"); __builtin_amdgcn_s_barrier(); asm volatile("" ::: "memory");
#pragma unroll
        for (int ai = 0; ai < 2; ++ai)
#pragma unroll
            for (int m = 0; m < 4; ++m) { const f32x4 q = *(const PG8_LAS f32x4*)(xch + 1024 + (ai * HALF + m * 16 + rl0) * 4); const float inv = __builtin_amdgcn_rcpf((q[0] + q[1]) + (q[2] + q[3]));
                const unsigned bo = 2u * (unsigned)((row0 + ai * HALF + m * 16) * 1024 + col0);
#pragma unroll
                for (int bj = 0; bj < 2; ++bj) *at32<u32x4>(PB, bo + 2u * bj * HALF) = pack8(s[ai][bj][m][0] * inv, s[ai][bj][m][1] * inv); }
        asm volatile("s_waitcnt lgkmcnt(0)" ::: "memory");
    }
};
struct EpiSwiGLU {
    static constexpr bool PERM = true, AFTER_DRAIN = false, PREF = true;
    bf16_t* O; int ldc; Fold f; PG8_LAS unsigned char* pf;
    __device__ __forceinline__ void pref(const Unit& u) const { if (!f.ident) fold_prefetch(f, u, pf); }
    __device__ __forceinline__ void operator()(PG8_EPI_ARGS) const {
        const int row0 = u.pm * BM + wr * 64 + fr, col0 = u.pn * HALF + wc * 32 + 8 * fq;
        f32x4 cs[2][2], cb[2][2]; float mus[2][4], rss[2][4];
        if (!f.ident) {
            fold_from_lds(pf, wr, wc, fr, fq, cs, cb, mus, rss);
        } else {
#pragma unroll
            for (int ai = 0; ai < 2; ++ai)
#pragma unroll
                for (int m = 0; m < 4; ++m) { mus[ai][m] = 0.f; rss[ai][m] = 1.f; }
        }
#pragma unroll
        for (int ai = 0; ai < 2; ++ai)
#pragma unroll
            for (int m = 0; m < 4; ++m) { const int r = row0 + ai * HALF + m * 16; f32x4 v[2]; const float mu = mus[ai][m], rs = rss[ai][m];
#pragma unroll
                for (int n = 0; n < 2; ++n) { f32x4 g = acc[ai][0][m][n], up = acc[ai][1][m][n];
                    if (!f.ident) { g = fold4(g, mu, rs, cs[0][n], cb[0][n]); up = fold4(up, mu, rs, cs[1][n], cb[1][n]); }
#pragma unroll
                    for (int e = 0; e < 4; ++e) v[n][e] = (g[e] * up[e]) * __builtin_amdgcn_rcpf(1.0f + __builtin_amdgcn_exp2f(-g[e])); }
                *at32<u32x4>(O, 2u * (unsigned)(r * ldc + col0)) = pack8(v[0], v[1]); }
    }
};
template <bool IDENT, bool WF32 = false, int SKIP = 0> struct EpiResLnT {
    static constexpr bool PERM = true, AFTER_DRAIN = false, PREF = false; static constexpr int RB = 4;
    const float* xin; const float* st_old; PG8_LAS const float* lgb; bf16_t* XB; u32x4* LO8; float* yf32; float* st_new; float alpha, scale;
    __device__ __forceinline__ void operator()(PG8_EPI_ARGS) const {
        const int row0 = u.pm * BM + wr * 64 + fr, col0 = u.pn * BM + wc * 32 + 8 * fq;
        PG8_LAS float* xst = const_cast<PG8_LAS float*>(lgb) + 4096;
        u32x4* lop = LO8 + ((size_t)((u.pm * 8 + u.pn) * 8 + wr * 4 + wc) * 8) * 64 + fq * 16 + fr;
#pragma unroll
        for (int ab = 0; ab < 8 / RB; ++ab) { const int ai = (ab * RB) >> 2, m0 = (ab * RB) & 3; float mu[RB], rs[RB], s1[RB], s2[RB]; u32x4 hi[RB][2], lo[RB];
            u32x4 xi[RB][2];
            { f32x2 st[RB];
              if (!IDENT) {
#pragma unroll
                for (int m = 0; m < RB; ++m) st[m] = *at32<const f32x2>(st_old, 8u * (unsigned)(row0 + ai * HALF + (m0 + m) * 16)); }
#pragma unroll
              for (int m = 0; m < RB; ++m) {
                if (!IDENT) lo[m] = (SKIP & 1) ? (u32x4){0u, 0u, 0u, 0u} : __builtin_nontemporal_load(lop + (ai * 4 + m0 + m) * 64);
#pragma unroll
                for (int bj = 0; bj < 2; ++bj) { const unsigned off = (unsigned)((row0 + ai * HALF + (m0 + m) * 16) * 2048 + col0 + bj * HALF);
                    if (IDENT) { hi[m][bj] = *at32<const u32x4>(xin, 4u * off); xi[m][bj] = *at32<const u32x4>(xin, 4u * off + 16u); }
                    else hi[m][bj] = (SKIP & 1) ? (u32x4){0u, 0u, 0u, 0u} : *at32<const u32x4>(XB, 2u * off); } }
              asm volatile("" ::: "memory");
#pragma unroll
              for (int m = 0; m < RB; ++m) { s1[m] = 0.f; s2[m] = 0.f; mu[m] = 0.f; rs[m] = 1.f;
                  if (!IDENT) { mu[m] = st[m].x * (1.0f / 2048.0f); rs[m] = __builtin_amdgcn_rsqf(st[m].y * (1.0f / 2048.0f) - mu[m] * mu[m] + 1e-5f); } } }
            u32x4 lon[RB];
#pragma unroll
            for (int bj = 0; bj < 2; ++bj) { f32x4 gg[2], bb[2];
                if (!IDENT) {
#pragma unroll
                    for (int n = 0; n < 2; ++n) { gg[n] = *(const PG8_LAS f32x4*)(lgb + col0 + bj * HALF + 4 * n); bb[n] = *(const PG8_LAS f32x4*)(lgb + 2048 + col0 + bj * HALF + 4 * n); } }
#pragma unroll
                for (int m = 0; m < RB; ++m) { const unsigned off = (unsigned)((row0 + ai * HALF + (m0 + m) * 16) * 2048 + col0 + bj * HALF); f32x4 v[2]; const u32x4 h0 = hi[m][bj];
                    if (IDENT) { const u32x4 l0 = xi[m][bj]; v[0] = (f32x4){__uint_as_float(h0.x), __uint_as_float(h0.y), __uint_as_float(h0.z), __uint_as_float(h0.w)}; v[1] = (f32x4){__uint_as_float(l0.x), __uint_as_float(l0.y), __uint_as_float(l0.z), __uint_as_float(l0.w)}; }
                    else { const unsigned w0 = bj ? lo[m].z : lo[m].x, w1 = bj ? lo[m].w : lo[m].y;
                           const f32x2 a0 = __builtin_amdgcn_cvt_pk_f32_fp8((int)w0, false), a1 = __builtin_amdgcn_cvt_pk_f32_fp8((int)w0, true), a2 = __builtin_amdgcn_cvt_pk_f32_fp8((int)w1, false), a3 = __builtin_amdgcn_cvt_pk_f32_fp8((int)w1, true);
                           v[0] = (f32x4){bf_lo(h0.x) + a0.x * 0.00390625f, bf_hi(h0.x) + a0.y * 0.00390625f, bf_lo(h0.y) + a1.x * 0.00390625f, bf_hi(h0.y) + a1.y * 0.00390625f};
                           v[1] = (f32x4){bf_lo(h0.z) + a2.x * 0.00390625f, bf_hi(h0.z) + a2.y * 0.00390625f, bf_lo(h0.w) + a3.x * 0.00390625f, bf_hi(h0.w) + a3.y * 0.00390625f}; }
#pragma unroll
                    for (int n = 0; n < 2; ++n) { f32x4 x = v[n];
                        if (!IDENT) x = (x - mu[m]) * rs[m] * gg[n] + bb[n];
                        v[n] = x * alpha + acc[ai][bj][m0 + m][n] * scale;
                        if (WF32) *at32<f32x4>(yf32, 4u * off + 16u * n) = v[n];
                        s1[m] += (v[n][0] + v[n][1]) + (v[n][2] + v[n][3]); s2[m] += (v[n][0] * v[n][0] + v[n][1] * v[n][1]) + (v[n][2] * v[n][2] + v[n][3] * v[n][3]); }
                    const u32x4 h = pack8(v[0], v[1]);
                    const f32x4 d0 = {(v[0][0] - bf_lo(h.x)) * 256.0f, (v[0][1] - bf_hi(h.x)) * 256.0f, (v[0][2] - bf_lo(h.y)) * 256.0f, (v[0][3] - bf_hi(h.y)) * 256.0f},
                                d1 = {(v[1][0] - bf_lo(h.z)) * 256.0f, (v[1][1] - bf_hi(h.z)) * 256.0f, (v[1][2] - bf_lo(h.w)) * 256.0f, (v[1][3] - bf_hi(h.w)) * 256.0f};
                    int e0 = __builtin_amdgcn_cvt_pk_fp8_f32(d0[0], d0[1], 0, false); e0 = __builtin_amdgcn_cvt_pk_fp8_f32(d0[2], d0[3], e0, true);
                    int e1 = __builtin_amdgcn_cvt_pk_fp8_f32(d1[0], d1[1], 0, false); e1 = __builtin_amdgcn_cvt_pk_fp8_f32(d1[2], d1[3], e1, true);
                    if (bj == 0) { lon[m].x = (unsigned)e0; lon[m].y = (unsigned)e1; } else { lon[m].z = (unsigned)e0; lon[m].w = (unsigned)e1; }
                    if (!(SKIP & 2)) *at32<u32x4>(XB, 2u * off) = h; } }
#pragma unroll
            for (int m = 0; m < RB; ++m) { if (!(SKIP & 2)) __builtin_nontemporal_store(lon[m], lop + (ai * 4 + m0 + m) * 64);
                const float a = red16_32(s1[m]), b = red16_32(s2[m]);
                if (fq == 0) { const int rl = ai * HALF + wr * 64 + (m0 + m) * 16 + fr; xst[rl * 8 + wc] = a; xst[rl * 8 + 4 + wc] = b; } }
            asm volatile("" ::: "memory"); }
        asm volatile("s_waitcnt lgkmcnt(0)" ::: "memory"); __builtin_amdgcn_s_barrier(); asm volatile("" ::: "memory");
        { const int t = (wr * 4 + wc) * 64 + fq * 16 + fr;
          if (t < 256 && st_new && !(SKIP & 4)) { const PG8_LAS float* p = xst + t * 8; const float sa = (p[0] + p[1]) + (p[2] + p[3]), sb = (p[4] + p[5]) + (p[6] + p[7]); float* dst = st_new + 2 * (size_t)(row0 - wr * 64 - fr + t);
              unsafeAtomicAdd(dst, sa); unsafeAtomicAdd(dst + 1, sb); }
          asm volatile("s_waitcnt lgkmcnt(0)" ::: "memory"); }
    }
};
typedef EpiResLnT<false> EpiResLn; typedef EpiResLnT<true> EpiResLn0; typedef EpiResLnT<false, true> EpiResLnF;
struct EpiMqt {
    static constexpr bool PERM = true, AFTER_DRAIN = false, PREF = false;
    bf16_t* O; int ldc; float scale; const float* gk; const float* bk; float* cs; float* cb;
    __device__ __forceinline__ void operator()(PG8_EPI_ARGS) const {
        const int row0 = u.pm * BM + wr * 64 + fr, col0 = u.pn * BM + wc * 32 + 8 * fq;
        f32x4 gg[2][2], bb[2][2];
#pragma unroll
        for (int bj = 0; bj < 2; ++bj)
#pragma unroll
            for (int n = 0; n < 2; ++n) { gg[bj][n] = *(const f32x4*)(gk + col0 + bj * HALF + 4 * n); bb[bj][n] = *(const f32x4*)(bk + col0 + bj * HALF + 4 * n); }
#pragma unroll
        for (int ai = 0; ai < 2; ++ai)
#pragma unroll
            for (int m = 0; m < 4; ++m) { const int r = row0 + ai * HALF + m * 16; float s1 = 0.f, s2 = 0.f;
#pragma unroll
                for (int bj = 0; bj < 2; ++bj) { const f32x4 v0 = acc[ai][bj][m][0] * scale, v1 = acc[ai][bj][m][1] * scale;
                    const u32x4 w = pack8(v0 * gg[bj][0], v1 * gg[bj][1]);
                    *(u32x4*)(O + (size_t)r * ldc + col0 + bj * HALF) = w;
                    s1 += (bf_lo(w.x) + bf_hi(w.x)) + (bf_lo(w.y) + bf_hi(w.y)) + (bf_lo(w.z) + bf_hi(w.z)) + (bf_lo(w.w) + bf_hi(w.w));
                    const f32x4 t0 = v0 * bb[bj][0], t1 = v1 * bb[bj][1]; s2 += (t0[0] + t0[1]) + (t0[2] + t0[3]) + (t1[0] + t1[1]) + (t1[2] + t1[3]); }
                s1 = red16_32(s1); s2 = red16_32(s2);
                if (fq == 0) { unsafeAtomicAdd(cs + r, s1); unsafeAtomicAdd(cb + r, s2); } }
    }
};
template <int UGP> struct EpiWin {
    static constexpr bool PERM = true, AFTER_DRAIN = false, PREF = true;
    bf16_t* QKV; bf16_t* UG; float qscale; Fold f; PG8_LAS unsigned char* pf;
    __device__ __forceinline__ void pref(const Unit& u) const { fold_prefetch(f, u, pf); }
    __device__ __forceinline__ void operator()(PG8_EPI_ARGS) const {
        const int row0 = u.pm * BM + wr * 64 + fr;
        f32x4 cs[2][2], cb[2][2]; float mus[2][4], rss[2][4]; fold_from_lds(pf, wr, wc, fr, fq, cs, cb, mus, rss);
        if (u.pn < 12) {
            const float sc = u.pn < 4 ? qscale : 1.0f; const int col0 = u.pn * BM + wc * 32 + 8 * fq;
#pragma unroll
            for (int ai = 0; ai < 2; ++ai)
#pragma unroll
                for (int m = 0; m < 4; ++m) { const int r = row0 + ai * HALF + m * 16; const float mu = mus[ai][m], rs = rss[ai][m]; const unsigned bo = 2u * (unsigned)(r * 3072 + col0);
#pragma unroll
                    for (int bj = 0; bj < 2; ++bj) *at32<u32x4>(QKV, bo + 2u * bj * HALF) = pack8(fold4(acc[ai][bj][m][0], mu, rs, cs[bj][0], cb[bj][0]) * sc, fold4(acc[ai][bj][m][1], mu, rs, cs[bj][1], cb[bj][1]) * sc); }
        } else {
#pragma unroll
            for (int ai = 0; ai < 2; ++ai)
#pragma unroll
                for (int m = 0; m < 4; ++m) { const int r = row0 + ai * HALF + m * 16, b = r >> 14, c = (r >> 6) & 255, s = r & 63; const float mu = mus[ai][m], rs = rss[ai][m];
#pragma unroll
                    for (int bj = 0; bj < 2; ++bj) { const int j0 = (u.pn - 12) * BM + bj * HALF + wc * 32 + 8 * fq, g = j0 >> 4, q0 = j0 & 15;
                        *at32<u32x4>(UG, 2u * (unsigned)((g * 512 + b * 256 + c) * UGP + 128 + s * 16 + q0)) = pack8(fold4(acc[ai][bj][m][0], mu, rs, cs[bj][0], cb[bj][0]), fold4(acc[ai][bj][m][1], mu, rs, cs[bj][1], cb[bj][1])); } }
        }
    }
};
template <int UGP> struct EpiSsmY {
    static constexpr bool PERM = true, AFTER_DRAIN = false, PREF = false;
    const bf16_t* UG; const float* dskip; bf16_t* YG;
    __device__ __forceinline__ void operator()(PG8_EPI_ARGS) const {
        const int R0 = u.pm * BM + wr * 64 + fr, g = R0 >> 9, b = (R0 >> 8) & 1;
        f32x4 d0[2], d1[2];
#pragma unroll
        for (int bj = 0; bj < 2; ++bj) { const int p0 = (bj * HALF + wc * 32 + 8 * fq) & 15; d0[bj] = *(const f32x4*)(dskip + g * 16 + p0); d1[bj] = *(const f32x4*)(dskip + g * 16 + p0 + 4); }
#pragma unroll
        for (int ai = 0; ai < 2; ++ai) { u32x4 uu[4][2];
#pragma unroll
            for (int m = 0; m < 4; ++m)
#pragma unroll
                for (int bj = 0; bj < 2; ++bj) uu[m][bj] = *at32<const u32x4>(UG, 2u * (unsigned)((R0 + ai * HALF + m * 16) * UGP + 128 + u.pn * BM + bj * HALF + wc * 32 + 8 * fq));
            asm volatile("" ::: "memory");
#pragma unroll
            for (int m = 0; m < 4; ++m) { const int c = (R0 + ai * HALF + m * 16) & 255;
#pragma unroll
                for (int bj = 0; bj < 2; ++bj) { const int col = u.pn * BM + bj * HALF + wc * 32 + 8 * fq, t = col >> 4, p0 = col & 15; const u32x4 w = uu[m][bj];
                    f32x4 y0 = acc[ai][bj][m][0], y1 = acc[ai][bj][m][1];
                    y0[0] += d0[bj][0] * bf_lo(w.x); y0[1] += d0[bj][1] * bf_hi(w.x); y0[2] += d0[bj][2] * bf_lo(w.y); y0[3] += d0[bj][3] * bf_hi(w.y);
                    y1[0] += d1[bj][0] * bf_lo(w.z); y1[1] += d1[bj][1] * bf_hi(w.z); y1[2] += d1[bj][2] * bf_lo(w.w); y1[3] += d1[bj][3] * bf_hi(w.w);
#pragma unroll
                    for (int e = 0; e < 4; ++e) { const float a = y0[e], bq = y1[e];
                        y0[e] = a * __builtin_amdgcn_rcpf(1.0f + __builtin_amdgcn_exp2f(-2.3022081983f * (a + 0.044715f * a * a * a))); y1[e] = bq * __builtin_amdgcn_rcpf(1.0f + __builtin_amdgcn_exp2f(-2.3022081983f * (bq + 0.044715f * bq * bq * bq))); }
                    *at32<u32x4>(YG, 2u * (unsigned)((b * 16384 + c * 64 + t) * 1024 + g * 16 + p0)) = pack8(y0, y1); } }
            asm volatile("" ::: "memory"); }
    }
};
struct EpiGlu {
    static constexpr bool PERM = true, AFTER_DRAIN = false, PREF = false;
    const bf16_t* YG; const float* bias; bf16_t* MIX;
    __device__ __forceinline__ void operator()(PG8_EPI_ARGS) const {
        const int row0 = u.pm * BM + wr * 64 + fr, col0 = u.pn * BM + wc * 32 + 8 * fq;
        f32x4 b0[2], b1[2];
#pragma unroll
        for (int bj = 0; bj < 2; ++bj) { b0[bj] = *(const f32x4*)(bias + col0 + bj * HALF); b1[bj] = *(const f32x4*)(bias + col0 + bj * HALF + 4); }
#pragma unroll
        for (int ai = 0; ai < 2; ++ai) { u32x4 yy[4][2];
#pragma unroll
            for (int m = 0; m < 4; ++m)
#pragma unroll
                for (int bj = 0; bj < 2; ++bj) yy[m][bj] = *at32<const u32x4>(YG, 2u * (unsigned)((row0 + ai * HALF + m * 16) * 1024 + col0 + bj * HALF));
            asm volatile("" ::: "memory");
#pragma unroll
            for (int m = 0; m < 4; ++m) { const int r = row0 + ai * HALF + m * 16;
#pragma unroll
                for (int bj = 0; bj < 2; ++bj) { const u32x4 w = yy[m][bj];
                    const f32x4 z0 = acc[ai][bj][m][0] + b0[bj], z1 = acc[ai][bj][m][1] + b1[bj]; f32x4 o0, o1;
                    o0[0] = bf_lo(w.x) * sigmoid_f(z0[0]); o0[1] = bf_hi(w.x) * sigmoid_f(z0[1]); o0[2] = bf_lo(w.y) * sigmoid_f(z0[2]); o0[3] = bf_hi(w.y) * sigmoid_f(z0[3]);
                    o1[0] = bf_lo(w.z) * sigmoid_f(z1[0]); o1[1] = bf_hi(w.z) * sigmoid_f(z1[1]); o1[2] = bf_lo(w.w) * sigmoid_f(z1[2]); o1[3] = bf_hi(w.w) * sigmoid_f(z1[3]);
                    *at32<u32x4>(MIX, 2u * (unsigned)(r * 2048 + 1024 + col0 + bj * HALF)) = pack8(o0, o1); } }
            asm volatile("" ::: "memory"); }
    }
};
#ifndef PG8_ASMDMA
#define PG8_ASMDMA 1
#endif
#ifndef PG8_BAL
#define PG8_BAL 1
#endif
template <class Epi, class Sched, bool ALIGN_EPI = false, bool SP2 = false>
__device__ __forceinline__ void gemm_phase(PG8_LAS unsigned char* lds, const Gemm g, const Sched& S, const Epi& E) {
    const int tid = otid(), wid = __builtin_amdgcn_readfirstlane(tid >> 6), lane = tid & 63, wr = wid >> 2, wc = wid & 3, fr = lane & 15, fq = lane >> 4;
    const int K = g.K, nt_def = K / BK;
    unsigned voffA[2], voffB[2];
#pragma unroll
    for (int i = 0; i < 2; ++i) { int R, C; stage_rc(tid * 16 + i * 8192, R, C); const int Rb = Epi::PERM ? ((R & ~31) + perm32(R & 31)) : R;
        voffA[i] = (unsigned)(R * g.lda + C) * 2u; voffB[i] = (unsigned)(Rb * g.ldb + C) * 2u; }
    const size_t kstep = (size_t)(BK * 2);
    const size_t hstepA = (size_t)HALF * g.lda * 2, hstepB = (size_t)HALF * g.ldb * 2;
    const unsigned ldsbase = (unsigned)(__UINTPTR_TYPE__)lds;
    const unsigned ldsw = (unsigned)wid * 1024u;
    const int aoff = lds_byte(wr * 64 + fr, fq * 8), boff = lds_byte(wc * 32 + fr, fq * 8);
#define PG8_SA(b, h) (((b) * 2 + (h)) * HTB)
#define PG8_SB(b, h) ((4 + (b) * 2 + (h)) * HTB)
#if PG8_ASMDMA
#define PG8_STAGE(bufoff, gbase, voff) do { _Pragma("unroll") for (int _i = 0; _i < 2; ++_i) { \
        const unsigned la_ = (unsigned)__builtin_amdgcn_readfirstlane((int)(ldsbase + (unsigned)(bufoff) + ldsw + (unsigned)(_i * 8192))); const char* gb_ = (const char*)(gbase); \
        asm volatile("s_mov_b32 m0, %2\n\ts_nop 0\n\tglobal_load_lds_dwordx4 %0, %1" :: "v"((voff)[_i]), "s"(gb_), "s"(la_) : "memory", "m0"); } } while (0)
#else
#define PG8_STAGE(bufoff, gbase, voff) do { _Pragma("unroll") for (int _i = 0; _i < 2; ++_i) \
        __builtin_amdgcn_global_load_lds((const unsigned*)((const char*)(gbase) + (voff)[_i]), (PG8_LAS unsigned*)(lds + (bufoff) + ldsw + _i * 8192), 16, 0, 0); } while (0)
#endif
#define PG8_LDA(dst, b, h) do { _Pragma("unroll") for (int m = 0; m < 4; ++m) _Pragma("unroll") for (int k = 0; k < 2; ++k) dst[m][k] = *(const PG8_LAS bf16x8*)(lds + PG8_SA(b, h) + aoff + m * 2048 + k * 1024); } while (0)
#define PG8_LDB(dst, b, h) do { _Pragma("unroll") for (int n = 0; n < 2; ++n) _Pragma("unroll") for (int k = 0; k < 2; ++k) dst[n][k] = *(const PG8_LAS bf16x8*)(lds + PG8_SB(b, h) + boff + n * 2048 + k * 1024); } while (0)
#define PG8_MMA(ai, bj, At, Bt) do { _Pragma("unroll") for (int m = 0; m < 4; ++m) _Pragma("unroll") for (int n = 0; n < 2; ++n) _Pragma("unroll") for (int k = 0; k < 2; ++k) \
        acc[ai][bj][m][n] = __builtin_amdgcn_mfma_f32_16x16x32_bf16(Bt[n][k], At[m][k], acc[ai][bj][m][n], 0, 0, 0); } while (0)
#define PG8_WAIT_V(n) asm volatile("s_waitcnt vmcnt(" #n ")" ::: "memory")
#define PG8_WAIT_L(n) asm volatile("s_waitcnt lgkmcnt(" #n ")" ::: "memory")
#define PG8_BAR __builtin_amdgcn_s_barrier()
#define PG8_SCHED __builtin_amdgcn_sched_barrier(0)
    Unit cur, nxt; int ui = 0;
    if (!S.next(0, cur)) return;
    f32x4 acc[2][2][4][2];
#pragma unroll
    for (int a = 0; a < 2; ++a)
#pragma unroll
        for (int b = 0; b < 2; ++b)
#pragma unroll
            for (int m = 0; m < 4; ++m)
#pragma unroll
                for (int n = 0; n < 2; ++n) acc[a][b][m][n] = (f32x4){0.f, 0.f, 0.f, 0.f};
    bf16x8 At[4][2], B0[2][2], B1[2][2];
    const char* cA = (const char*)g.A + (size_t)cur.aoff * 2; const char* cB = (const char*)g.Bt + (size_t)cur.boff * 2;
    S.a_ready(cur);
    if constexpr (SP2) {
        PG8_STAGE(PG8_SB(0, 0), cB, voffB); PG8_STAGE(PG8_SB(0, 1), cB + hstepB, voffB); PG8_STAGE(PG8_SA(0, 0), cA, voffA); PG8_STAGE(PG8_SA(0, 1), cA + hstepA, voffA);
        if (wr == 1) PG8_BAR;
        PG8_WAIT_V(2); PG8_BAR;
#if PG8_BAL
        PG8_STAGE(PG8_SB(1, 0), cB + kstep, voffB); PG8_STAGE(PG8_SB(1, 1), cB + hstepB + kstep, voffB);
        PG8_WAIT_V(4); PG8_BAR;
#else
        PG8_STAGE(PG8_SB(1, 0), cB + kstep, voffB); PG8_STAGE(PG8_SA(1, 0), cA + kstep, voffA); PG8_STAGE(PG8_SB(1, 1), cB + hstepB + kstep, voffB);
        PG8_WAIT_V(6); PG8_BAR;
#endif
    } else {
        PG8_STAGE(PG8_SB(0, 0), cB, voffB); PG8_STAGE(PG8_SA(0, 0), cA, voffA); PG8_STAGE(PG8_SB(0, 1), cB + hstepB, voffB); PG8_STAGE(PG8_SA(0, 1), cA + hstepA, voffA);
        if (wr == 1) PG8_BAR;
        PG8_WAIT_V(4); PG8_BAR;
        PG8_STAGE(PG8_SB(1, 0), cB + kstep, voffB); PG8_STAGE(PG8_SA(1, 0), cA + kstep, voffA); PG8_STAGE(PG8_SB(1, 1), cB + hstepB + kstep, voffB);
        PG8_WAIT_V(6); PG8_BAR;
    }
    for (;;) {
        const bool has_next = S.next(ui + 1, nxt);
        const char* nA = has_next ? (const char*)g.A + (size_t)nxt.aoff * 2 : cA; const char* nB = has_next ? (const char*)g.Bt + (size_t)nxt.boff * 2 : cB;
        const int nt = cur.nt ? cur.nt : nt_def;
        for (int t = 0; t < nt; t += 2) {
            const bool last = (t == nt - 2);
            const char* a1 = cA + (size_t)(t + 1) * kstep;
            const char* a2 = last ? nA : cA + (size_t)(t + 2) * kstep; const char* b2 = last ? nB : cB + (size_t)(t + 2) * kstep;
            const char* a3 = a2 + kstep; const char* b3 = b2 + kstep;
            if (last && has_next) S.a_ready(nxt);
            if constexpr (Epi::PREF) { if (last) E.pref(cur); }
            if constexpr (SP2) {
#if PG8_BAL
            PG8_LDB(B0, 0, 0); PG8_LDB(B1, 0, 1); PG8_SCHED; PG8_LDA(At, 0, 0); PG8_STAGE(PG8_SA(1, 0), a1, voffA); PG8_STAGE(PG8_SA(1, 1), a1 + hstepA, voffA);
            PG8_WAIT_V(8); PG8_WAIT_L(0); PG8_BAR; __builtin_amdgcn_s_setprio(1); PG8_MMA(0, 0, At, B0); PG8_MMA(0, 1, At, B1); __builtin_amdgcn_s_setprio(0); PG8_BAR; PG8_SCHED;
            PG8_LDA(At, 0, 1); PG8_STAGE(PG8_SB(0, 0), b2, voffB); PG8_STAGE(PG8_SB(0, 1), b2 + hstepB, voffB);
            PG8_WAIT_V(6); PG8_WAIT_L(0); PG8_BAR; __builtin_amdgcn_s_setprio(1); PG8_MMA(1, 0, At, B0); PG8_MMA(1, 1, At, B1); __builtin_amdgcn_s_setprio(0); PG8_BAR; PG8_SCHED;
            PG8_LDB(B0, 1, 0); PG8_LDB(B1, 1, 1); PG8_SCHED; PG8_LDA(At, 1, 0); PG8_STAGE(PG8_SA(0, 0), a2, voffA); PG8_STAGE(PG8_SA(0, 1), a2 + hstepA, voffA);
            PG8_WAIT_V(8); PG8_WAIT_L(0); PG8_BAR; __builtin_amdgcn_s_setprio(1); PG8_MMA(0, 0, At, B0); PG8_MMA(0, 1, At, B1); __builtin_amdgcn_s_setprio(0); PG8_BAR; PG8_SCHED;
            PG8_LDA(At, 1, 1); PG8_STAGE(PG8_SB(1, 0), b3, voffB); PG8_STAGE(PG8_SB(1, 1), b3 + hstepB, voffB);
            PG8_WAIT_V(6); PG8_WAIT_L(0); PG8_BAR; __builtin_amdgcn_s_setprio(1); PG8_MMA(1, 0, At, B0); PG8_MMA(1, 1, At, B1); __builtin_amdgcn_s_setprio(0); PG8_BAR; PG8_SCHED;
            (void)a3;
#else
            PG8_LDB(B0, 0, 0); PG8_LDB(B1, 0, 1); PG8_SCHED; PG8_LDA(At, 0, 0); PG8_STAGE(PG8_SA(1, 1), a1 + hstepA, voffA);
            PG8_WAIT_V(8); PG8_WAIT_L(0); PG8_BAR; __builtin_amdgcn_s_setprio(1); PG8_MMA(0, 0, At, B0); PG8_MMA(0, 1, At, B1); __builtin_amdgcn_s_setprio(0); PG8_BAR; PG8_SCHED;
            PG8_LDA(At, 0, 1); PG8_STAGE(PG8_SB(0, 0), b2, voffB); PG8_STAGE(PG8_SB(0, 1), b2 + hstepB, voffB); PG8_STAGE(PG8_SA(0, 0), a2, voffA);
            PG8_WAIT_V(8); PG8_WAIT_L(0); PG8_BAR; __builtin_amdgcn_s_setprio(1); PG8_MMA(1, 0, At, B0); PG8_MMA(1, 1, At, B1); __builtin_amdgcn_s_setprio(0); PG8_BAR; PG8_SCHED;
            PG8_LDB(B0, 1, 0); PG8_LDB(B1, 1, 1); PG8_SCHED; PG8_LDA(At, 1, 0); PG8_STAGE(PG8_SA(0, 1), a2 + hstepA, voffA);
            PG8_WAIT_V(8); PG8_WAIT_L(0); PG8_BAR; __builtin_amdgcn_s_setprio(1); PG8_MMA(0, 0, At, B0); PG8_MMA(0, 1, At, B1); __builtin_amdgcn_s_setprio(0); PG8_BAR; PG8_SCHED;
            PG8_LDA(At, 1, 1); PG8_STAGE(PG8_SB(1, 0), b3, voffB); PG8_STAGE(PG8_SB(1, 1), b3 + hstepB, voffB); PG8_STAGE(PG8_SA(1, 0), a3, voffA);
            PG8_WAIT_V(8); PG8_WAIT_L(0); PG8_BAR; __builtin_amdgcn_s_setprio(1); PG8_MMA(1, 0, At, B0); PG8_MMA(1, 1, At, B1); __builtin_amdgcn_s_setprio(0); PG8_BAR; PG8_SCHED;
#endif
            } else {
            PG8_LDB(B0, 0, 0); PG8_SCHED; PG8_LDA(At, 0, 0); PG8_STAGE(PG8_SA(1, 1), a1 + hstepA, voffA);
            PG8_WAIT_L(8); PG8_BAR; PG8_WAIT_L(0); __builtin_amdgcn_s_setprio(1); PG8_MMA(0, 0, At, B0); __builtin_amdgcn_s_setprio(0); PG8_BAR; PG8_SCHED;
            PG8_LDB(B1, 0, 1); PG8_STAGE(PG8_SB(0, 0), b2, voffB);
            PG8_BAR; PG8_WAIT_L(0); __builtin_amdgcn_s_setprio(1); PG8_MMA(0, 1, At, B1); __builtin_amdgcn_s_setprio(0); PG8_BAR;
            PG8_LDA(At, 0, 1); PG8_STAGE(PG8_SA(0, 0), a2, voffA);
            PG8_BAR; PG8_WAIT_L(0); __builtin_amdgcn_s_setprio(1); PG8_MMA(1, 0, At, B0); __builtin_amdgcn_s_setprio(0); PG8_BAR; PG8_SCHED;
            PG8_STAGE(PG8_SB(0, 1), b2 + hstepB, voffB);
            PG8_WAIT_V(6); PG8_BAR; __builtin_amdgcn_s_setprio(1); PG8_MMA(1, 1, At, B1); __builtin_amdgcn_s_setprio(0); PG8_BAR;
            PG8_LDB(B0, 1, 0); PG8_SCHED; PG8_LDA(At, 1, 0); PG8_STAGE(PG8_SA(0, 1), a2 + hstepA, voffA);
            PG8_WAIT_L(8); PG8_BAR; PG8_WAIT_L(0); __builtin_amdgcn_s_setprio(1); PG8_MMA(0, 0, At, B0); __builtin_amdgcn_s_setprio(0); PG8_BAR; PG8_SCHED;
            PG8_LDB(B1, 1, 1); PG8_STAGE(PG8_SB(1, 0), b3, voffB);
            PG8_BAR; PG8_WAIT_L(0); __builtin_amdgcn_s_setprio(1); PG8_MMA(0, 1, At, B1); __builtin_amdgcn_s_setprio(0); PG8_BAR;
            PG8_LDA(At, 1, 1); PG8_STAGE(PG8_SA(1, 0), a3, voffA);
            PG8_BAR; PG8_WAIT_L(0); __builtin_amdgcn_s_setprio(1); PG8_MMA(1, 0, At, B0); __builtin_amdgcn_s_setprio(0); PG8_BAR; PG8_SCHED;
            PG8_STAGE(PG8_SB(1, 1), b3 + hstepB, voffB);
            PG8_WAIT_V(6); PG8_BAR; __builtin_amdgcn_s_setprio(1); PG8_MMA(1, 1, At, B1); __builtin_amdgcn_s_setprio(0); PG8_BAR;
            }
        }
        if constexpr (ALIGN_EPI) { if (wr == 0) PG8_BAR; }
        if constexpr (!Epi::AFTER_DRAIN) { E(acc, cur, wr, wc, fr, fq); S.done(cur); }
        if (!has_next) break;
#pragma unroll
        for (int a = 0; a < 2; ++a)
#pragma unroll
            for (int b = 0; b < 2; ++b)
#pragma unroll
                for (int m = 0; m < 4; ++m)
#pragma unroll
                    for (int n = 0; n < 2; ++n) acc[a][b][m][n] = (f32x4){0.f, 0.f, 0.f, 0.f};
        cur = nxt; cA = nA; cB = nB; ++ui;
        if constexpr (ALIGN_EPI) { if (wr == 1) PG8_BAR; }
    }
    PG8_WAIT_V(0);
    if constexpr (!ALIGN_EPI) { if (wr == 0) PG8_BAR; }
    PG8_BAR;
    if constexpr (Epi::AFTER_DRAIN) { E.fused(acc, cur, wr, wc, fr, fq, lds, wid, lane); S.done(cur); }
#undef PG8_SA
#undef PG8_SB
#undef PG8_STAGE
#undef PG8_LDA
#undef PG8_LDB
#undef PG8_MMA
#undef PG8_WAIT_V
#undef PG8_WAIT_L
#undef PG8_BAR
#undef PG8_SCHED
}
}
#include <hip/hip_bf16.h>
#include <cmath>
namespace attn_body {
using bf16=__hip_bfloat16;
using bf16x8=__attribute__((ext_vector_type(8)))short;
using s16x4=__attribute__((ext_vector_type(4)))short;
using f32x16=__attribute__((ext_vector_type(16)))float;
using u32x4=__attribute__((ext_vector_type(4)))unsigned;
constexpr int BATCH=2,NVH=32,SEQ=16384,D=64,DM=3072,DMO=2048;
constexpr int NW=8,QBLK=32,QB=QBLK*NW,KVBLK=64,NQB=SEQ/QB;
constexpr int ATTN_PITCH=DM, ATTN_UNIT_ROWS=QB;
__device__ __forceinline__ int crow(int r,int hi){return (r&3)+8*(r>>2)+4*hi;}
#define SBAR() __builtin_amdgcn_sched_barrier(0)
__device__ __forceinline__ void cmask(f32x16&p0,f32x16&p1,int jb,int qrel,int hi){
  const float NEG=-INFINITY; (void)hi;
  if(jb>(qrel>>6)){
  #pragma unroll
  for(int r=0;r<16;++r){p0[r]=NEG;p1[r]=NEG;}}
}

constexpr int NSLOT=3, SLOTB=8192;
constexpr int LDS_K=0, LDS_V=NSLOT*SLOTB, LDS_WS=2*NSLOT*SLOTB, LDS_OST=LDS_WS+NW*64*4, LDS_BYTES=LDS_OST+NW*4096;
constexpr float C2=0.125f*1.4426950408889634f;
__device__ __forceinline__ void glds16(const void*gsrc,unsigned lds_dst){unsigned keep;
  asm volatile("s_mov_b32 %0, m0\n\ts_mov_b32 m0, %2\n\ts_nop 0\n\tglobal_load_lds_dwordx4 %1, off\n\ts_mov_b32 m0, %0":"=&s"(keep):"v"(gsrc),"s"(lds_dst):"memory");}
__device__ __forceinline__ void glds16s(const void*gbase,unsigned voff,unsigned lds_dst){
  asm volatile("s_mov_b32 m0, %2\n\ts_nop 0\n\tglobal_load_lds_dwordx4 %0, %1"::"v"(voff),"s"(gbase),"s"(lds_dst):"memory","m0");}
__device__ __forceinline__ float max3f(float a,float b,float c){float r;asm("v_max3_f32 %0, %1, %2, %3":"=v"(r):"v"(a),"v"(b),"v"(c));return r;}
__device__ __forceinline__ float max2f(float a,float b){float r;asm("v_max_f32_e32 %0, %1, %2":"=v"(r):"v"(a),"v"(b));return r;}
__device__ __forceinline__ float fadd_s(float a,float b){float r;asm("v_add_f32_e32 %0, %1, %2":"=v"(r):"v"(a),"v"(b));return r;}
__device__ __forceinline__ float fsub_s(float a,float b){float r;asm("v_sub_f32_e32 %0, %1, %2":"=v"(r):"v"(a),"v"(b));return r;}
typedef float f32x2_t __attribute__((ext_vector_type(2))); typedef __bf16 bf16x2_t __attribute__((ext_vector_type(2)));
__device__ __forceinline__ unsigned cvtpk_s(float lo,float hi){f32x2_t v={lo,hi};bf16x2_t b=__builtin_convertvector(v,bf16x2_t);return __builtin_bit_cast(unsigned,b);}
#define WAIT_BAR(N) asm volatile("s_waitcnt vmcnt(" #N ") lgkmcnt(0)\n\ts_barrier":::"memory")

__device__ __forceinline__ void qkt(f32x16&p0,f32x16&p1,const char*Kslot,const bf16x8*qr,const f32x16&negm,int r32,int hi){
  const char*kb=Kslot+hi*1024+r32*16;
  #pragma unroll
  for(int d0=0;d0<4;++d0){
    const bf16x8 b0=*reinterpret_cast<const bf16x8*>(kb+d0*2048);
    const bf16x8 b1=*reinterpret_cast<const bf16x8*>(kb+d0*2048+512);
    if(d0==0){p0=__builtin_amdgcn_mfma_f32_32x32x16_bf16(b0,qr[0],negm,0,0,0);p1=__builtin_amdgcn_mfma_f32_32x32x16_bf16(b1,qr[0],negm,0,0,0);}
    else{p0=__builtin_amdgcn_mfma_f32_32x32x16_bf16(b0,qr[d0],p0,0,0,0);p1=__builtin_amdgcn_mfma_f32_32x32x16_bf16(b1,qr[d0],p1,0,0,0);}}
}
typedef __attribute__((address_space(3))) const char* lds_cptr;
typedef short v4i16_t __attribute__((ext_vector_type(4)));
__device__ __forceinline__ void kload8(bf16x8*kf,lds_cptr kp){
  kf[0]=*(const __attribute__((address_space(3))) bf16x8*)(kp);      kf[1]=*(const __attribute__((address_space(3))) bf16x8*)(kp+512);
  kf[2]=*(const __attribute__((address_space(3))) bf16x8*)(kp+2048); kf[3]=*(const __attribute__((address_space(3))) bf16x8*)(kp+2560);
  kf[4]=*(const __attribute__((address_space(3))) bf16x8*)(kp+4096); kf[5]=*(const __attribute__((address_space(3))) bf16x8*)(kp+4608);
  kf[6]=*(const __attribute__((address_space(3))) bf16x8*)(kp+6144); kf[7]=*(const __attribute__((address_space(3))) bf16x8*)(kp+6656);
}
__device__ __forceinline__ void kload2(bf16x8*kf,lds_cptr kp,int j){ kf[2*j]=*(const __attribute__((address_space(3))) bf16x8*)(kp+j*2048); kf[2*j+1]=*(const __attribute__((address_space(3))) bf16x8*)(kp+j*2048+512); }
__device__ __forceinline__ s16x4 vtr(lds_cptr p){ return __builtin_bit_cast(s16x4,__builtin_amdgcn_ds_read_tr16_b64_v4i16((__attribute__((address_space(3))) v4i16_t*)p)); }
__device__ __forceinline__ float rowmax(const f32x16&p0,const f32x16&p1){
  float a=max3f(p0[0],p0[1],p1[0]),b=max3f(p0[2],p0[3],p1[1]);a=max3f(a,p1[2],p1[3]);
  #pragma unroll
  for(int r=4;r<16;r+=4){a=max3f(a,p0[r],p0[r+1]);b=max3f(b,p0[r+2],p0[r+3]);a=max3f(a,p1[r],p1[r+1]);b=max3f(b,p1[r+2],p1[r+3]);}
  const float m=max2f(a,b);
  auto rr=__builtin_amdgcn_permlane32_swap(__float_as_uint(m),__float_as_uint(m),false,false);
  return max2f(__uint_as_float(rr[0]),__uint_as_float(rr[1]));
}
__device__ __forceinline__ void pv(f32x16*o,int vb,bf16x8 pa0,bf16x8 pa1,bf16x8 pa2,bf16x8 pa3){
  #pragma unroll
  for(int d0=0;d0<2;++d0){s16x4 lo[4],hi[4];
    #pragma unroll
    for(int ks=0;ks<4;++ks){
      asm volatile("ds_read_b64_tr_b16 %0,%1 offset:%c2":"=&v"(lo[ks]):"v"(vb),"i"(d0*4096+ks*1024):"memory");
      asm volatile("ds_read_b64_tr_b16 %0,%1 offset:%c2":"=&v"(hi[ks]):"v"(vb),"i"(d0*4096+ks*1024+512):"memory");}
    asm volatile("s_waitcnt lgkmcnt(0)":::"memory");SBAR();
    #define PK(k) (bf16x8){lo[k][0],lo[k][1],lo[k][2],lo[k][3],hi[k][0],hi[k][1],hi[k][2],hi[k][3]}
    o[d0]=__builtin_amdgcn_mfma_f32_32x32x16_bf16(pa0,PK(0),o[d0],0,0,0);
    o[d0]=__builtin_amdgcn_mfma_f32_32x32x16_bf16(pa1,PK(1),o[d0],0,0,0);
    o[d0]=__builtin_amdgcn_mfma_f32_32x32x16_bf16(pa2,PK(2),o[d0],0,0,0);
    o[d0]=__builtin_amdgcn_mfma_f32_32x32x16_bf16(pa3,PK(3),o[d0],0,0,0);
    #undef PK
  }
}

#ifndef ATTN_STORE16
#define ATTN_STORE16(p,v) __builtin_nontemporal_store((v),(u32x4*)(p))
#endif
template<int THRL> __device__ __forceinline__ void attn_unit(int b,int qb,const bf16*__restrict__ Q,const bf16*__restrict__ K,const bf16*__restrict__ V,bf16*__restrict__ O,char*shm){
  const int tid=pg8::otid(),lane=tid&63,r32=lane&31,hi=lane>>5; const int wid=__builtin_amdgcn_readfirstlane(tid>>6);
  const long rowbase=(long)b*SEQ; const int q0=qb*QB;
  const bf16*Qw=Q+(rowbase+q0+wid*QBLK)*DM;
  const bf16*Kh=K+rowbase*DM,*Vh=V+rowbase*DM;
  const unsigned lds0=(unsigned)(uintptr_t)shm;
  float*wsf=(float*)(shm+LDS_WS)+wid*64;
  const bf16*ksrc=Kh+(long)lane*DM+wid*8;
  const bf16*vsrc=Vh+(long)(16*(wid&3)+(lane>>2))*DM+(wid>>2)*32+(lane&3)*8;
  const unsigned kdst=lds0+LDS_K+wid*1024, vdst=lds0+LDS_V+wid*1024;
  #define DMA_K(t,slot) glds16(ksrc+(long)(t)*KVBLK*DM,(unsigned)__builtin_amdgcn_readfirstlane(kdst+(slot)))
  #define DMA_V(t,slot) glds16(vsrc+(long)(t)*KVBLK*DM,(unsigned)__builtin_amdgcn_readfirstlane(vdst+(slot)))
  const int vb0=(int)(lds0+LDS_V)+((lane>>4)&1)*32+(lane&3)*8+(4*hi+((lane&15)>>2))*64;
  const char*Kbase=shm+LDS_K; bf16x8 kf[8];
  const lds_cptr shm3=(lds_cptr)shm; const lds_cptr kp0=shm3+LDS_K+hi*1024+r32*16; const lds_cptr vp0=shm3+LDS_V+((lane>>4)&1)*32+(lane&3)*8+(4*hi+((lane&15)>>2))*64;
  const int NT=(q0+QB)/KVBLK;
  DMA_K(0,0);DMA_V(0,0);DMA_K(1,SLOTB);
  bf16x8 qr[4];
  #pragma unroll
  for(int d0=0;d0<4;++d0)qr[d0]=*reinterpret_cast<const bf16x8*>(&Qw[(long)r32*DM+d0*16+hi*8]);
  float mhat=0.f,l_reg=0.f;f32x16 o[2];o[0]=f32x16{};o[1]=f32x16{};f32x16 negm=f32x16{};asm volatile("":"+v"(negm));
  const int qrel=wid*QBLK+r32;
  #define CMASK(P0,P1,t) do{int jb_=(t)-(NT-4); if(jb_>=0)cmask(P0,P1,jb_,qrel,hi);}while(0)
  bool resc=false;
  #define START(P0,P1) do{ const float rm=rowmax(P0,P1); resc=false; \
    { const float dl=rm; mhat=fadd_s(mhat,dl); \
      _Pragma("unroll") for(int r=0;r<16;++r){P0[r]=fsub_s(P0[r],dl);P1[r]=fsub_s(P1[r],dl);} \
      _Pragma("unroll") for(int r=0;r<16;++r)negm[r]=-mhat; asm volatile("":"+v"(negm)); } \
    _Pragma("unroll") for(int r=0;r<16;++r)P0[r]=__builtin_amdgcn_exp2f(P0[r]); }while(0)
  #define RESC() do{ if(resc){ asm volatile("s_waitcnt lgkmcnt(0)":::"memory"); \
      _Pragma("unroll") for(int d_=0;d_<2;++d_) _Pragma("unroll") for(int r=0;r<16;++r)o[d_][r]*=wsf[crow(r,hi)]; } }while(0)
  f32x16 pA0,pA1,pB0,pB1;
  int sl_prev=0,sl_cur=0,sl_next=SLOTB;
  #define ROT() do{sl_prev=sl_cur;sl_cur=sl_next;sl_next=(sl_next==(NSLOT-1)*SLOTB)?0:sl_next+SLOTB;}while(0)
  DMA_K(2,2*SLOTB);
  WAIT_BAR(3);
  qkt(pA0,pA1,Kbase,qr,negm,r32,hi);asm volatile("s_nop 15\n\ts_nop 7":"+v"(pA0),"+v"(pA1));CMASK(pA0,pA1,0);
  START(pA0,pA1);
  _Pragma("unroll") for(int r=0;r<16;++r)pA1[r]=__builtin_amdgcn_exp2f(pA1[r]);
  WAIT_BAR(0);
  DMA_K(3,0);DMA_V(1,SLOTB);
  ROT();
  kload8(kf,kp0+sl_cur);
  WAIT_BAR(2);
  s16x4 vlo[8],vhi[8]; u32x4 pw0,pw1,pw2,pw3;
  #define PKW(P,B) cvtpk_s(P[B],P[B+1])
  #define PAF(k) __builtin_bit_cast(bf16x8,pw##k)
  #define VFR(i) (bf16x8){vlo[i][0],vlo[i][1],vlo[i][2],vlo[i][3],vhi[i][0],vhi[i][1],vhi[i][2],vhi[i][3]}
  #define PIN(x) asm volatile("":"+v"(x))
  #define MX3(a,b,c) __builtin_fmaxf(__builtin_fmaxf((a),(b)),(c))
  #define GAPA(MF,A0,A1,A2,A3,W0,W1,PW) do{ MF; sacc+=A0; sacc+=A1; sacc+=A2; sacc+=A3; PIN(sacc); W0; W1; PIN(PW); SBAR(); }while(0)
  #define EX(v) __builtin_amdgcn_exp2f(v)
  #define GAPB(MF,X,B) do{ MF; X[B]=EX(X[B]); X[B+1]=EX(X[B+1]); X[B+2]=EX(X[B+2]); X[B+3]=EX(X[B+3]); PIN(X); SBAR(); }while(0)
  #define VRD(i) do{ vlo[i]=vtr(vp_+(((i)>>2)*4096+((i)&3)*1024)); vhi[i]=vtr(vp_+(((i)>>2)*4096+((i)&3)*1024+512)); }while(0)
  #define KRD(G,j) do{ if(G){ kload2(kf,kp0+sl_next,j); SBAR(); } }while(0)
  #define STEP(C0,C1,P0,P1,t,GK,GV,GL) do{ SBAR(); \
    const lds_cptr vp_=vp0+sl_prev; \
    VRD(0); SBAR(); float sacc=(P0[0]+P0[1]); \
    GAPA(C0=__builtin_amdgcn_mfma_f32_32x32x16_bf16(kf[0],qr[0],negm,0,0,0), P0[2],P0[3],P0[4],P0[5],     pw0[0]=PKW(P0,0), pw0[1]=PKW(P0,2), pw0); \
    VRD(4); SBAR(); GAPA(C1=__builtin_amdgcn_mfma_f32_32x32x16_bf16(kf[1],qr[0],negm,0,0,0), P0[6],P0[7],P0[8],P0[9],     pw0[2]=PKW(P0,4), pw0[3]=PKW(P0,6), pw0); \
    VRD(1); SBAR(); GAPA(C0=__builtin_amdgcn_mfma_f32_32x32x16_bf16(kf[2],qr[1],C0,0,0,0),   P0[10],P0[11],P0[12],P0[13], pw1[0]=PKW(P0,8), pw1[1]=PKW(P0,10), pw1); \
    VRD(5); SBAR(); GAPA(C1=__builtin_amdgcn_mfma_f32_32x32x16_bf16(kf[3],qr[1],C1,0,0,0),   P0[14],P0[15],P1[0],P1[1],   pw1[2]=PKW(P0,12),pw1[3]=PKW(P0,14), pw1); \
    VRD(2); SBAR(); GAPA(C0=__builtin_amdgcn_mfma_f32_32x32x16_bf16(kf[4],qr[2],C0,0,0,0),   P1[2],P1[3],P1[4],P1[5],     pw2[0]=PKW(P1,0), pw2[1]=PKW(P1,2), pw2); \
    VRD(6); SBAR(); GAPA(C1=__builtin_amdgcn_mfma_f32_32x32x16_bf16(kf[5],qr[2],C1,0,0,0),   P1[6],P1[7],P1[8],P1[9],     pw2[2]=PKW(P1,4), pw2[3]=PKW(P1,6), pw2); \
    VRD(3); SBAR(); GAPA(C0=__builtin_amdgcn_mfma_f32_32x32x16_bf16(kf[6],qr[3],C0,0,0,0),   P1[10],P1[11],P1[12],P1[13], pw3[0]=PKW(P1,8), pw3[1]=PKW(P1,10), pw3); \
    VRD(7); SBAR(); GAPA(C1=__builtin_amdgcn_mfma_f32_32x32x16_bf16(kf[7],qr[3],C1,0,0,0),   P1[14],P1[15],0.f,0.f,       pw3[2]=PKW(P1,12),pw3[3]=PKW(P1,14), pw3); \
    l_reg+=sacc; \
    if(GK){DMA_K((t)+3,sl_cur);} if(GV){DMA_V((t)+1,sl_next);} \
    CMASK(C0,C1,t); \
    { float a=MX3(C0[0],C0[1],C1[0]),b=MX3(C0[2],C0[3],C1[1]); a=MX3(a,C1[2],C1[3]); \
      _Pragma("unroll") for(int r=4;r<16;r+=4){a=MX3(a,C0[r],C0[r+1]);b=MX3(b,C0[r+2],C0[r+3]);a=MX3(a,C1[r],C1[r+1]);b=MX3(b,C1[r+2],C1[r+3]);} \
      float rm=__builtin_fmaxf(a,b); { auto rr=__builtin_amdgcn_permlane32_swap(__float_as_uint(rm),__float_as_uint(rm),false,false); rm=__builtin_fmaxf(__uint_as_float(rr[0]),__uint_as_float(rr[1])); } \
      resc=false; \
      if(__builtin_expect(__any(rm>(float)THRL),0)){ const float dl=__builtin_fmaxf(rm,0.f); mhat+=dl; \
        _Pragma("unroll") for(int r=0;r<16;++r){C0[r]-=dl;C1[r]-=dl;} \
        _Pragma("unroll") for(int r=0;r<16;++r)negm[r]=-mhat; asm volatile("":"+v"(negm)); \
        const float f=__builtin_amdgcn_exp2f(-dl); l_reg*=f; if(hi==0)wsf[r32]=f; resc=true; } } \
    SBAR(); \
    GAPB(o[0]=__builtin_amdgcn_mfma_f32_32x32x16_bf16(PAF(0),VFR(0),o[0],0,0,0), C0,0); \
    GAPB(o[1]=__builtin_amdgcn_mfma_f32_32x32x16_bf16(PAF(0),VFR(4),o[1],0,0,0), C0,4); \
    KRD(GL,0); GAPB(o[0]=__builtin_amdgcn_mfma_f32_32x32x16_bf16(PAF(1),VFR(1),o[0],0,0,0), C0,8); \
    KRD(GL,1); GAPB(o[1]=__builtin_amdgcn_mfma_f32_32x32x16_bf16(PAF(1),VFR(5),o[1],0,0,0), C0,12); \
    KRD(GL,2); GAPB(o[0]=__builtin_amdgcn_mfma_f32_32x32x16_bf16(PAF(2),VFR(2),o[0],0,0,0), C1,0); \
    KRD(GL,3); GAPB(o[1]=__builtin_amdgcn_mfma_f32_32x32x16_bf16(PAF(2),VFR(6),o[1],0,0,0), C1,4); \
    GAPB(o[0]=__builtin_amdgcn_mfma_f32_32x32x16_bf16(PAF(3),VFR(3),o[0],0,0,0), C1,8); \
    GAPB(o[1]=__builtin_amdgcn_mfma_f32_32x32x16_bf16(PAF(3),VFR(7),o[1],0,0,0), C1,12); \
    }while(0)
  int t=1;
  #undef CMASK
  #define CMASK(P0,P1,t) do{}while(0)
  for(;t+5<NT;t+=2){
    STEP(pB0,pB1,pA0,pA1,t,true,true,true);     WAIT_BAR(2); RESC(); ROT();
    STEP(pA0,pA1,pB0,pB1,t+1,true,true,true);   WAIT_BAR(2); RESC(); ROT();
  }
  #undef CMASK
  #define CMASK(P0,P1,t) do{int jb_=(t)-(NT-4); if(jb_>=0)cmask(P0,P1,jb_,qrel,hi);}while(0)
  #define ENDW(tt) do{ if((tt)+3<NT){WAIT_BAR(2);} else if((tt)+2<NT){WAIT_BAR(1);} else {WAIT_BAR(0);} }while(0)
  for(;t+1<NT;t+=2){
    STEP(pB0,pB1,pA0,pA1,t,(t+3<NT),(t+1<NT),(t+1<NT));       ENDW(t);   RESC(); ROT();
    STEP(pA0,pA1,pB0,pB1,t+1,(t+4<NT),(t+2<NT),(t+2<NT));     ENDW(t+1); RESC(); ROT();
  }
  STEP(pB0,pB1,pA0,pA1,NT-1,false,false,false); RESC();
  { float sacc=pB0[0]+pB0[1]; _Pragma("unroll") for(int r=2;r<16;++r)sacc+=pB0[r]; _Pragma("unroll") for(int r=0;r<16;++r)sacc+=pB1[r]; l_reg+=sacc;
    pw0=(u32x4){PKW(pB0,0),PKW(pB0,2),PKW(pB0,4),PKW(pB0,6)};pw1=(u32x4){PKW(pB0,8),PKW(pB0,10),PKW(pB0,12),PKW(pB0,14)};pw2=(u32x4){PKW(pB1,0),PKW(pB1,2),PKW(pB1,4),PKW(pB1,6)};pw3=(u32x4){PKW(pB1,8),PKW(pB1,10),PKW(pB1,12),PKW(pB1,14)};
    SBAR(); pv(o,vb0+sl_cur,PAF(0),PAF(1),PAF(2),PAF(3)); }
  #undef PKW
  #undef PAF
  #undef VFR
  #undef PIN
  #undef MX3
  #undef GAPA
  #undef GAPB
  #undef EX
  #undef VRD
  #undef KRD
  #undef STEP
  #undef ENDW
  {auto rr=__builtin_amdgcn_permlane32_swap(__float_as_uint(l_reg),__float_as_uint(l_reg),false,false);l_reg=__uint_as_float(rr[0])+__uint_as_float(rr[1]);}
  if(hi==0)wsf[32+r32]=l_reg;asm volatile("s_waitcnt lgkmcnt(0)":::"memory");
  float rli[16];
  #pragma unroll
  for(int r=0;r<16;++r)rli[r]=__builtin_amdgcn_rcpf(wsf[32+crow(r,hi)]);
  bf16*Ow=O+(rowbase+q0+wid*QBLK)*DMO;
  { bf16*stg=(bf16*)(shm+LDS_OST)+wid*2048;
    #pragma unroll
    for(int r=0;r<16;++r){const int orow=crow(r,hi);
      #pragma unroll
      for(int d0=0;d0<2;++d0)stg[orow*64+d0*32+r32]=__float2bfloat16(o[d0][r]*rli[r]);}
    asm volatile("s_waitcnt lgkmcnt(0)":::"memory");
    #pragma unroll
    for(int i=0;i<4;++i){const int row=i*8+(lane>>3),ch=lane&7; const u32x4 v=*(const u32x4*)(stg+row*64+ch*8); ATTN_STORE16(Ow+(long)row*DMO+ch*8,v);} }
  asm volatile("s_waitcnt lgkmcnt(0)\n\ts_barrier":::"memory");
  #undef DMA_K
  #undef DMA_V
  #undef CMASK
  #undef START
  #undef RESC
  #undef ROT
}
constexpr int ATTN_LDS_BYTES=LDS_BYTES;
struct AttnTensors { const bf16* QKV; bf16* O; };
struct AttnUnit { int bvh; int qb; };
struct StaticOrder {
  int vcu;
  __device__ __forceinline__ explicit StaticOrder(int grid,int block):vcu((grid%8==0)?(block%8)*(grid/8)+block/8:block){}
  __device__ __forceinline__ bool next(int i,AttnUnit&u)const{ const int L=vcu; if(i>=16||L>=256)return false; const int s=8*(L&3)+(i>>1); u.bvh=L>>2; u.qb=(i&1)?63-s:s; return true; }
  __device__ __forceinline__ void a_ready(const AttnUnit&)const{}
  __device__ __forceinline__ void done(const AttnUnit&)const{}
};
template<class Sched,int THRL=8> __device__ __forceinline__ void attn_phase(char*lds,const AttnTensors&T,const Sched&S){
  AttnUnit u;
  for(int i=0;S.next(i,u);++i){ S.a_ready(u); const int b=u.bvh>>5,vh=u.bvh&31;
    attn_unit<THRL>(b,u.qb,T.QKV+(vh>>1)*64,T.QKV+1024+(vh>>1)*64,T.QKV+2048+((vh>>2)*2+(vh&1))*64,T.O+vh*64,lds); S.done(u); }
}

constexpr int KSLOT2=8192, VSLOT2=16384;
constexpr int LDS2_K=0, LDS2_V=NSLOT*KSLOT2, LDS2_WS=LDS2_V+NSLOT*VSLOT2, LDS2_OST=LDS2_WS+NW*64*4, LDS2_BYTES=LDS2_OST+NW*4096;
#define WAIT_BAR2(N) asm volatile("s_waitcnt vmcnt(" #N ") lgkmcnt(0)\n\ts_barrier":::"memory")
template<int THRL> __device__ __forceinline__ void attn_unit2(int b,int qb,const bf16*__restrict__ Q,const bf16*__restrict__ K,const bf16*__restrict__ V,bf16*__restrict__ O,char*shm){
  const int tid=pg8::otid(),lane=tid&63,r32=lane&31,hi=lane>>5; const int wid=__builtin_amdgcn_readfirstlane(tid>>6);
  const long rowbase=(long)b*SEQ; const int q0=qb*QB;
  const bf16*Qw=Q+(rowbase+q0+wid*QBLK)*DM;
  const bf16*Kh=K+rowbase*DM,*Vh=V+rowbase*DM;
  const unsigned lds0=(unsigned)(uintptr_t)shm;
  float*wsf=(float*)(shm+LDS2_WS)+wid*64;
  const unsigned kvoff=(unsigned)((lane*DM+wid*8)*2);
  const unsigned vvoff=(unsigned)(((16*(wid&3)+(lane>>2))*DM+(wid>>2)*32+(lane&3)*8)*2);
  const unsigned kdst=lds0+LDS2_K+wid*1024, vdst=lds0+LDS2_V+wid*1024;
  #define DMA_K(t,slot) glds16s(Kh+(long)(t)*KVBLK*DM,kvoff,(unsigned)__builtin_amdgcn_readfirstlane(kdst+(slot)))
  #define DMA_V(t,slot) do{ glds16s(Vh+(long)(t)*KVBLK*DM,vvoff,(unsigned)__builtin_amdgcn_readfirstlane(vdst+2*(slot))); glds16s(Vh+(long)(t)*KVBLK*DM+64,vvoff,(unsigned)__builtin_amdgcn_readfirstlane(vdst+2*(slot)+8192)); }while(0)
  const char*Kbase=shm+LDS2_K; bf16x8 kf[8];
  const lds_cptr shm3=(lds_cptr)shm; const lds_cptr kp0=shm3+LDS2_K+hi*1024+r32*16; const lds_cptr vp0=shm3+LDS2_V+((lane>>4)&1)*32+(lane&3)*8+(4*hi+((lane&15)>>2))*64;
  const int NT=(q0+QB)/KVBLK;
  DMA_K(0,0);DMA_V(0,0);DMA_K(1,KSLOT2);
  bf16x8 qr[4];
  #pragma unroll
  for(int d0=0;d0<4;++d0)qr[d0]=*reinterpret_cast<const bf16x8*>(&Qw[(long)r32*DM+d0*16+hi*8]);
  float mhat=0.f,l_reg=0.f;f32x16 o[4];o[0]=f32x16{};o[1]=f32x16{};o[2]=f32x16{};o[3]=f32x16{};
  f32x16 negm=f32x16{};asm volatile("":"+v"(negm));
  const int qrel=wid*QBLK+r32;
  #define CMASK(P0,P1,t) do{int jb_=(t)-(NT-4); if(jb_>=0)cmask(P0,P1,jb_,qrel,hi);}while(0)
  bool resc=false;
  #define RESC() do{ if(resc){ asm volatile("s_waitcnt lgkmcnt(0)":::"memory"); \
      _Pragma("unroll") for(int d_=0;d_<4;++d_) _Pragma("unroll") for(int r=0;r<16;++r)o[d_][r]*=wsf[crow(r,hi)]; } }while(0)
  f32x16 pA0,pA1,pB0,pB1;
  int sl_prev=0,sl_cur=0,sl_next=KSLOT2;
  #define ROT() do{sl_prev=sl_cur;sl_cur=sl_next;sl_next=(sl_next==(NSLOT-1)*KSLOT2)?0:sl_next+KSLOT2;}while(0)
  DMA_K(2,2*KSLOT2);
  WAIT_BAR2(4);
  qkt(pA0,pA1,Kbase,qr,negm,r32,hi);asm volatile("s_nop 15\n\ts_nop 7":"+v"(pA0),"+v"(pA1));CMASK(pA0,pA1,0);
  { const float rm=rowmax(pA0,pA1); mhat=rm;
    #pragma unroll
    for(int r=0;r<16;++r)negm[r]=-mhat;
    asm volatile("":"+v"(negm));
    #pragma unroll
    for(int r=0;r<16;++r){pA0[r]=__builtin_amdgcn_exp2f(pA0[r]-mhat);pA1[r]=__builtin_amdgcn_exp2f(pA1[r]-mhat);} }
  WAIT_BAR2(0);
  DMA_K(3,0);DMA_V(1,KSLOT2);
  ROT();
  kload8(kf,kp0+sl_cur);
  WAIT_BAR2(3);
  s16x4 vlo[8],vhi[8]; u32x4 pw0,pw1,pw2,pw3;
  #define PKW(P,B) cvtpk_s(P[B],P[B+1])
  #define PAF(k) __builtin_bit_cast(bf16x8,pw##k)
  #define PAFI(k) ((k)==0?PAF(0):(k)==1?PAF(1):(k)==2?PAF(2):PAF(3))
  #define VFR(i) (bf16x8){vlo[i][0],vlo[i][1],vlo[i][2],vlo[i][3],vhi[i][0],vhi[i][1],vhi[i][2],vhi[i][3]}
  #define PIN(x) asm volatile("":"+v"(x))
  #define MX3(a,b,c) __builtin_fmaxf(__builtin_fmaxf((a),(b)),(c))
  #define MFMA(a,b,c) __builtin_amdgcn_mfma_f32_32x32x16_bf16(a,b,c,0,0,0)
  #define GAPA(MF,A0,A1,A2,A3,W0,W1,PW) do{ MF; sacc+=A0; sacc+=A1; sacc+=A2; sacc+=A3; PIN(sacc); W0; W1; PIN(PW); SBAR(); }while(0)
  #define EX(v) __builtin_amdgcn_exp2f(v)
  #define GAPB(MF,X,B) do{ MF; X[B]=EX(X[B]); X[B+1]=EX(X[B+1]); PIN(X); SBAR(); }while(0)
  #define VOFF(j) ((((j)&3)*4096)+(((j)>>2)*1024))
  #define VRD(s_,j) do{ vlo[s_]=vtr(vp_+VOFF(j)); vhi[s_]=vtr(vp_+VOFF(j)+512); }while(0)
  #define KRD(G,j) do{ if(G){ kload2(kf,kp0+sl_next,j); SBAR(); } }while(0)
  #define PVM(j,PA) o[(j)&3]=MFMA(PA,VFR((j)&7),o[(j)&3])
  #define STEP(C0,C1,P0,P1,t,GK,GV,GL) do{ SBAR(); \
    const lds_cptr vp_=vp0+2*sl_prev; \
    VRD(0,0); SBAR(); float sacc=(P0[0]+P0[1]); \
    GAPA(C0=MFMA(kf[0],qr[0],negm), P0[2],P0[3],P0[4],P0[5],     pw0[0]=PKW(P0,0), pw0[1]=PKW(P0,2), pw0); \
    VRD(1,1); SBAR(); GAPA(C1=MFMA(kf[1],qr[0],negm), P0[6],P0[7],P0[8],P0[9],     pw0[2]=PKW(P0,4), pw0[3]=PKW(P0,6), pw0); \
    VRD(2,2); SBAR(); GAPA(C0=MFMA(kf[2],qr[1],C0),   P0[10],P0[11],P0[12],P0[13], pw1[0]=PKW(P0,8), pw1[1]=PKW(P0,10), pw1); \
    VRD(3,3); SBAR(); GAPA(C1=MFMA(kf[3],qr[1],C1),   P0[14],P0[15],P1[0],P1[1],   pw1[2]=PKW(P0,12),pw1[3]=PKW(P0,14), pw1); \
    VRD(4,4); SBAR(); GAPA(C0=MFMA(kf[4],qr[2],C0),   P1[2],P1[3],P1[4],P1[5],     pw2[0]=PKW(P1,0), pw2[1]=PKW(P1,2), pw2); \
    VRD(5,5); SBAR(); GAPA(C1=MFMA(kf[5],qr[2],C1),   P1[6],P1[7],P1[8],P1[9],     pw2[2]=PKW(P1,4), pw2[3]=PKW(P1,6), pw2); \
    VRD(6,6); SBAR(); GAPA(C0=MFMA(kf[6],qr[3],C0),   P1[10],P1[11],P1[12],P1[13], pw3[0]=PKW(P1,8), pw3[1]=PKW(P1,10), pw3); \
    VRD(7,7); SBAR(); GAPA(C1=MFMA(kf[7],qr[3],C1),   P1[14],P1[15],0.f,0.f,       pw3[2]=PKW(P1,12),pw3[3]=PKW(P1,14), pw3); \
    l_reg+=sacc; \
    if(GK){DMA_K((t)+3,sl_cur);} if(GV){DMA_V((t)+1,sl_next);} \
    CMASK(C0,C1,t); \
    { float a=MX3(C0[0],C0[1],C1[0]),b_=MX3(C0[2],C0[3],C1[1]); a=MX3(a,C1[2],C1[3]); \
      _Pragma("unroll") for(int r=4;r<16;r+=4){a=MX3(a,C0[r],C0[r+1]);b_=MX3(b_,C0[r+2],C0[r+3]);a=MX3(a,C1[r],C1[r+1]);b_=MX3(b_,C1[r+2],C1[r+3]);} \
      float rm=__builtin_fmaxf(a,b_); { auto rr=__builtin_amdgcn_permlane32_swap(__float_as_uint(rm),__float_as_uint(rm),false,false); rm=__builtin_fmaxf(__uint_as_float(rr[0]),__uint_as_float(rr[1])); } \
      resc=false; \
      if(__builtin_expect(__any(rm>(float)THRL),0)){ const float dl=__builtin_fmaxf(rm,0.f); mhat+=dl; \
        _Pragma("unroll") for(int r=0;r<16;++r){C0[r]-=dl;C1[r]-=dl;} \
        _Pragma("unroll") for(int r=0;r<16;++r)negm[r]=-mhat; asm volatile("":"+v"(negm)); \
        const float f=__builtin_amdgcn_exp2f(-dl); l_reg*=f; if(hi==0)wsf[r32]=f; resc=true; } } \
    SBAR(); \
    GAPB(PVM(0,PAF(0)),C0,0);  VRD(0,8);  SBAR(); \
    GAPB(PVM(1,PAF(0)),C0,2);  VRD(1,9);  SBAR(); \
    GAPB(PVM(2,PAF(0)),C0,4);  VRD(2,10); SBAR(); \
    GAPB(PVM(3,PAF(0)),C0,6);  VRD(3,11); SBAR(); \
    GAPB(PVM(4,PAF(1)),C0,8);  VRD(4,12); SBAR(); \
    GAPB(PVM(5,PAF(1)),C0,10); VRD(5,13); SBAR(); \
    GAPB(PVM(6,PAF(1)),C0,12); VRD(6,14); SBAR(); \
    GAPB(PVM(7,PAF(1)),C0,14); VRD(7,15); SBAR(); \
    GAPB(PVM(8,PAF(2)),C1,0); \
    GAPB(PVM(9,PAF(2)),C1,2); \
    KRD(GL,0); GAPB(PVM(10,PAF(2)),C1,4); \
    KRD(GL,1); GAPB(PVM(11,PAF(2)),C1,6); \
    KRD(GL,2); GAPB(PVM(12,PAF(3)),C1,8); \
    KRD(GL,3); GAPB(PVM(13,PAF(3)),C1,10); \
    GAPB(PVM(14,PAF(3)),C1,12); \
    GAPB(PVM(15,PAF(3)),C1,14); \
    }while(0)
  int t=1;
  #undef CMASK
  #define CMASK(P0,P1,t) do{}while(0)
  for(;t+5<NT;t+=2){
    STEP(pB0,pB1,pA0,pA1,t,true,true,true);     WAIT_BAR2(3); RESC(); ROT();
    STEP(pA0,pA1,pB0,pB1,t+1,true,true,true);   WAIT_BAR2(3); RESC(); ROT();
  }
  #undef CMASK
  #define CMASK(P0,P1,t) do{int jb_=(t)-(NT-4); if(jb_>=0)cmask(P0,P1,jb_,qrel,hi);}while(0)
  #define ENDW(tt) do{ if((tt)+3<NT){WAIT_BAR2(3);} else if((tt)+2<NT){WAIT_BAR2(2);} else {WAIT_BAR2(0);} }while(0)
  for(;t+1<NT;t+=2){
    STEP(pB0,pB1,pA0,pA1,t,(t+3<NT),(t+1<NT),(t+1<NT));       ENDW(t);   RESC(); ROT();
    STEP(pA0,pA1,pB0,pB1,t+1,(t+4<NT),(t+2<NT),(t+2<NT));     ENDW(t+1); RESC(); ROT();
  }
  STEP(pB0,pB1,pA0,pA1,NT-1,false,false,false); RESC();
  { float sacc=pB0[0]+pB0[1]; _Pragma("unroll") for(int r=2;r<16;++r)sacc+=pB0[r]; _Pragma("unroll") for(int r=0;r<16;++r)sacc+=pB1[r]; l_reg+=sacc;
    pw0=(u32x4){PKW(pB0,0),PKW(pB0,2),PKW(pB0,4),PKW(pB0,6)};pw1=(u32x4){PKW(pB0,8),PKW(pB0,10),PKW(pB0,12),PKW(pB0,14)};pw2=(u32x4){PKW(pB1,0),PKW(pB1,2),PKW(pB1,4),PKW(pB1,6)};pw3=(u32x4){PKW(pB1,8),PKW(pB1,10),PKW(pB1,12),PKW(pB1,14)};
    SBAR(); const lds_cptr vp_=vp0+2*sl_cur;
    #pragma unroll
    for(int d0=0;d0<4;++d0){
      #pragma unroll
      for(int ks=0;ks<4;++ks){ vlo[ks]=vtr(vp_+d0*4096+ks*1024); vhi[ks]=vtr(vp_+d0*4096+ks*1024+512); }
      o[d0]=MFMA(PAF(0),VFR(0),o[d0]); o[d0]=MFMA(PAF(1),VFR(1),o[d0]); o[d0]=MFMA(PAF(2),VFR(2),o[d0]); o[d0]=MFMA(PAF(3),VFR(3),o[d0]); } }
  #undef PKW
  #undef PAF
  #undef PAFI
  #undef VFR
  #undef PIN
  #undef MX3
  #undef MFMA
  #undef GAPA
  #undef GAPB
  #undef EX
  #undef VOFF
  #undef VRD
  #undef KRD
  #undef PVM
  #undef STEP
  #undef ENDW
  {auto rr=__builtin_amdgcn_permlane32_swap(__float_as_uint(l_reg),__float_as_uint(l_reg),false,false);l_reg=__uint_as_float(rr[0])+__uint_as_float(rr[1]);}
  if(hi==0)wsf[32+r32]=l_reg;asm volatile("s_waitcnt lgkmcnt(0)":::"memory");
  float rli[16];
  #pragma unroll
  for(int r=0;r<16;++r)rli[r]=__builtin_amdgcn_rcpf(wsf[32+crow(r,hi)]);
  bf16*Ow=O+(rowbase+q0+wid*QBLK)*DMO;
  { bf16*stg=(bf16*)(shm+LDS2_OST)+wid*2048;
    #pragma unroll
    for(int hh=0;hh<2;++hh){
      #pragma unroll
      for(int r=0;r<16;++r){const int orow=crow(r,hi);
        #pragma unroll
        for(int d0=0;d0<2;++d0)stg[orow*64+d0*32+r32]=__float2bfloat16(o[hh*2+d0][r]*rli[r]);}
      asm volatile("s_waitcnt lgkmcnt(0)":::"memory");
      #pragma unroll
      for(int i=0;i<4;++i){const int row=i*8+(lane>>3),ch=lane&7; const u32x4 v=*(const u32x4*)(stg+row*64+ch*8); ATTN_STORE16(Ow+(long)row*DMO+hh*64+ch*8,v);}
      asm volatile("s_waitcnt lgkmcnt(0)":::"memory"); } }
  asm volatile("s_waitcnt lgkmcnt(0)\n\ts_barrier":::"memory");
  #undef DMA_K
  #undef DMA_V
  #undef CMASK
  #undef RESC
  #undef ROT
}
struct AttnUnit2 { int bhm; int qb; };
struct StaticOrder2 {
  int vcu;
  __device__ __forceinline__ explicit StaticOrder2(int grid,int block):vcu((grid%8==0)?(block%8)*(grid/8)+block/8:block){}
  __device__ __forceinline__ bool next(int i,AttnUnit2&u)const{ const int L=vcu; if(i>=8||L>=256)return false; const int j=L&7; u.bhm=L>>3; u.qb=8*i+((i&1)?7-j:j); return true; }
};
template<class Sched,int THRL=8> __device__ __forceinline__ void attn_phase2(char*lds,const AttnTensors&T,const Sched&S){
  AttnUnit2 u;
  for(int i=0;S.next(i,u);++i){ const int b=u.bhm>>4,hm=u.bhm&15;
    attn_unit2<THRL>(b,u.qb,T.QKV+hm*64,T.QKV+1024+hm*64,T.QKV+2048+(hm>>1)*128,T.O+hm*128,lds); }
}
#undef SBAR
#undef WAIT_BAR
}
#define GAS __attribute__((address_space(1)))
#define LAS __attribute__((address_space(3)))
typedef unsigned short bf16;
typedef unsigned v4u __attribute__((ext_vector_type(4)));
typedef float f32x4 __attribute__((ext_vector_type(4)));
typedef short bf16x8 __attribute__((ext_vector_type(8)));
typedef GAS unsigned gu32;
typedef GAS unsigned long long gu64;
#define RLX_AGENT __ATOMIC_RELAXED, __HIP_MEMORY_SCOPE_AGENT
#define LDS_WAIT() asm volatile("s_waitcnt lgkmcnt(0)" ::: "memory")
#define VM_WAIT() asm volatile("s_waitcnt vmcnt(0)" ::: "memory")
__device__ __forceinline__ unsigned long long rt() { return __builtin_amdgcn_s_memrealtime(); }
__device__ __forceinline__ unsigned f2bf(float f) { unsigned u = __builtin_bit_cast(unsigned, f); return (u + 0x7fffu + ((u >> 16) & 1u)) >> 16; }
__device__ __forceinline__ unsigned pk2(float lo, float hi) { return f2bf(lo) | (f2bf(hi) << 16); }

#define XB_TMO      128
#define XB_XCNT(j)  (256  + 64 * (j))
#define XB_XSUB(j)  (1280 + 64 * (j))
#define XB_XGEN(j)  (2304 + 64 * (j))
#define XB_TOP      3328
#define XB_TOPGEN   3392
#define XCD_BAR_WORDS 3456
#define XB_SPIN_CAP (1u << 18)

__device__ __forceinline__ unsigned xb_ld(unsigned* p)              { return __hip_atomic_load(p, __ATOMIC_RELAXED, __HIP_MEMORY_SCOPE_AGENT); }
__device__ __forceinline__ unsigned xb_add(unsigned* p, unsigned v) { return __hip_atomic_fetch_add(p, v, __ATOMIC_RELAXED, __HIP_MEMORY_SCOPE_AGENT); }
__device__ __forceinline__ unsigned xb_xcc_id() { return (unsigned)__builtin_amdgcn_s_getreg((3 << 11) | 20) & 0xFu; }
#define XB_SPIN(cond, bar) do { unsigned _sp = 0; while (cond) { __builtin_amdgcn_s_sleep(1); \
    if ((++_sp & 255u) == 0u) { if (xb_ld(&(bar)[XB_TMO])) break; if (_sp > XB_SPIN_CAP) { atomicAdd(&(bar)[XB_TMO], 1u); break; } } } } while (0)

struct XcdBarrier {
    unsigned* bar; unsigned x;
    volatile LAS unsigned* st;
};

__device__ __forceinline__ XcdBarrier xcd_barrier_post(unsigned* bar, volatile LAS unsigned* st) {
    XcdBarrier b; b.bar = bar; b.x = xb_xcc_id(); b.st = st;
    if (threadIdx.x == 0) (void)xb_add(&bar[XB_XCNT(b.x)], 1u);
    return b;
}
__device__ __forceinline__ void xcd_barrier_complete(unsigned* bar, unsigned x, unsigned& nloc, unsigned& nx) {
    const unsigned G = gridDim.x * gridDim.y * gridDim.z;
    unsigned sum, cnt, mine, sp = 0u;
    for (;;) {
        sum = 0u; cnt = 0u; mine = 0u;
#pragma unroll
        for (unsigned j = 0; j < 16; ++j) { const unsigned c = xb_ld(&bar[XB_XCNT(j)]); sum += c; cnt += (c > 0u) ? 1u : 0u; mine = (j == x) ? c : mine; }
        if (sum == G) break;
        __builtin_amdgcn_s_sleep(1);
        if ((++sp & 255u) == 0u) { if (xb_ld(&bar[XB_TMO])) break; if (sp > XB_SPIN_CAP) { atomicAdd(&bar[XB_TMO], 1u); break; } }
    }
    nloc = mine > 0u ? mine : 1u; nx = cnt > 0u ? cnt : 1u;
}

__device__ __forceinline__ void xcd_barrier(const XcdBarrier& b) {
    asm volatile("s_waitcnt vmcnt(0)" ::: "memory");
    __syncthreads();
    if (threadIdx.x == 0) {
        unsigned* bar = b.bar;
        __builtin_amdgcn_s_waitcnt(0);
        unsigned nloc = b.st[0], nx = b.st[1];
        if (nloc == 0u) { xcd_barrier_complete(bar, b.x, nloc, nx); b.st[0] = nloc; b.st[1] = nx; }
        const unsigned old = xb_add(&bar[XB_XSUB(b.x)], 1u);
        const unsigned gen = old / nloc;
        if (old + 1u == (gen + 1u) * nloc) {
            __builtin_amdgcn_fence(__ATOMIC_RELEASE, "agent");
            asm volatile("s_waitcnt vmcnt(0)" ::: "memory");
            const unsigned og = xb_add(&bar[XB_TOP], 1u);
            const unsigned tg = og / nx;
            if (og + 1u == (tg + 1u) * nx) xb_add(&bar[XB_TOPGEN], 1u);
            else XB_SPIN(xb_ld(&bar[XB_TOPGEN]) == tg, bar);
            __builtin_amdgcn_fence(__ATOMIC_ACQUIRE, "agent");
            xb_add(&bar[XB_XGEN(b.x)], 1u);
            asm volatile("s_waitcnt vmcnt(0)" ::: "memory");
        } else {
            XB_SPIN(xb_ld(&bar[XB_XGEN(b.x)]) == gen, bar);
            __builtin_amdgcn_fence(__ATOMIC_ACQUIRE, "agent");
            asm volatile("s_waitcnt vmcnt(0)" ::: "memory");
        }
    }
    __syncthreads();
}
constexpr int NWAVES = 8;
constexpr int DMODEL = 2048, NBATCH = 2, SEQ = 16384, DEPTH = 4, MT = NBATCH * SEQ, NMEM = 256, FF = 5632, INW = 4096;
constexpr int UGP = 1152;
constexpr float ALPHA = 1.6817928305074290f, LN_EPS = 1e-5f, RMS_EPS = 1e-5f;
constexpr int NIN = 37;
enum InIdx { I_X = 0, I_MEM, I_F1G, I_F1U, I_F1D, I_LN1G, I_LN1B, I_WIN, I_LQ1, I_LK1, I_LQ2, I_LK2, I_DNG, I_SLRE, I_SLIM, I_SLOG, I_SBRE, I_SBIM, I_SCRE, I_SCIM, I_SD, I_GLUW, I_GLUB,
             I_WOUT, I_LN2G, I_LN2B, I_XQ, I_XK, I_XV, I_XO, I_LN3G, I_LN3B, I_F2G, I_F2U, I_F2D, I_LN4G, I_LN4B };

constexpr size_t MiB = 1u << 20;
constexpr size_t WS_CTL = 0, CTL_ZERO_BYTES = 6 * MiB;
constexpr size_t WS_CS = 1 * MiB;
constexpr int CSL = 57344, CS1 = 0, CB1 = 11264, CS2 = 22528, CB2 = 33792, CSW = 45056, CBW = 49152, CSM = 53248, CBM = 55296;
constexpr size_t WS_ST = 2 * MiB;
constexpr size_t WS_XB = 6 * MiB;
constexpr size_t WS_YLO = WS_XB + 128 * MiB;
constexpr size_t WS_BIG = WS_YLO + 128 * MiB;
constexpr size_t WS_HMID = WS_BIG;
constexpr size_t WS_QKV = WS_BIG;
constexpr size_t WS_UG = WS_BIG + 192 * MiB;
constexpr size_t WS_OV = WS_BIG + 264 * MiB;
constexpr size_t WS_SC = WS_BIG;
constexpr size_t WS_PB = WS_BIG + 128 * MiB;
constexpr size_t WS_MIX = WS_BIG + 392 * MiB;
constexpr size_t WS_YG = WS_MIX + 128 * MiB;
constexpr size_t WS_VS = WS_YG + 64 * MiB;
constexpr size_t WS_W = WS_VS + 16 * MiB;
constexpr size_t WS_W1GU = WS_W, WS_W1D = WS_W1GU + 44 * MiB, WS_W2GU = WS_W1D + 22 * MiB, WS_W2D = WS_W2GU + 44 * MiB, WS_WIN = WS_W2D + 22 * MiB, WS_WGLU = WS_WIN + 16 * MiB,
                 WS_WOUT = WS_WGLU + 2 * MiB, WS_WQN = WS_WOUT + 8 * MiB, WS_WKVT = WS_WQN + 8 * MiB, WS_WOT = WS_WKVT + 16 * MiB, WS_TG = WS_WOT + 8 * MiB, WS_EM = WS_TG + 144 * MiB;
constexpr size_t WS_MEMB = WS_EM + 17 * MiB;
constexpr size_t WS_KVM = WS_MEMB + 2 * MiB;
constexpr size_t WS_MQT = WS_KVM + 4 * MiB;
constexpr size_t WS_VWOT = WS_MQT + 8 * MiB;
constexpr size_t WS_END = WS_VWOT + 8 * MiB;
constexpr int CW_TMO = 0, CW_CODE = 1, CW_BAR = 4096;

constexpr int RING_OFF = 0, RING_BYTES = 131072;
constexpr int LDSCTL_OFF = RING_BYTES, MISC_OFF = LDSCTL_OFF + 320;
constexpr int XCH_OFF = LDSCTL_OFF + 1024;
constexpr int GB_OFF = LDSCTL_OFF + 1024;
constexpr int XST_OFF = GB_OFF + 16384;
static_assert(XST_OFF == GB_OFF + 4096 * 4, "the residual epilogue finds its table right behind the gain | bias image");
constexpr int LDS_BYTES = 163840;
typedef float f32x2v __attribute__((ext_vector_type(2)));
__device__ __forceinline__ float wave_sum(float v) {
    v += pg8::sw_xor<1>(v); v += pg8::sw_xor<2>(v); v += pg8::sw_xor<4>(v); v += pg8::sw_xor<8>(v); v += pg8::sw_xor<16>(v); return pg8::add_xor32(v);
}
__device__ __forceinline__ float wave_max(float v) {
    v = fmaxf(v, pg8::sw_xor<1>(v)); v = fmaxf(v, pg8::sw_xor<2>(v)); v = fmaxf(v, pg8::sw_xor<4>(v)); v = fmaxf(v, pg8::sw_xor<8>(v)); v = fmaxf(v, pg8::sw_xor<16>(v)); return pg8::max_xor32(v);
}
__device__ __forceinline__ unsigned pkbf(float lo, float hi) { return pg8::cvt_pk_bf16(lo, hi); }
struct RmId { __device__ __forceinline__ int operator()(int n0) const { return n0; } };
struct RmGate { int add; __device__ __forceinline__ int operator()(int n0) const { return (n0 >> 7) * 256 + (n0 & 127) + add; } };
template <class RM> __device__ __forceinline__ void conv_T(const float* __restrict__ W, int K, int N, bf16* WT, int ldt, RM rm, const float* gk, const float* bk, float* cs, float* cb, LAS float* scr, int gw, int NGW, int lane, int rot, float wscale = 1.0f) {
    const int nblk = N / 32, nchunks = (K / 512) * nblk, c = lane & 7, r8 = lane >> 3;
    for (int chunk = (gw + NGW - rot % NGW) % NGW; chunk < nchunks; chunk += NGW) {
        const int kc = chunk / nblk, nb = chunk - kc * nblk, n0 = 32 * nb, drow0 = rm(n0);
        const float* wp = W + (size_t)(kc * 512 + r8) * N + n0 + 4 * c;
        float a1[4] = {0.f, 0.f, 0.f, 0.f}, a2[4] = {0.f, 0.f, 0.f, 0.f};
        f32x4 ld[8];
#pragma unroll
        for (int i = 0; i < 8; ++i) ld[i] = __builtin_nontemporal_load((const GAS f32x4*)(wp + (size_t)(8 * i) * N));
#pragma unroll 1
        for (int j = 0; j < 8; ++j) {
            const int k0 = kc * 512 + 64 * j;
#pragma unroll
            for (int i = 0; i < 8; ++i) { LAS float* d = scr + (8 * i + r8) * 33 + 4 * c; d[0] = ld[i][0]; d[1] = ld[i][1]; d[2] = ld[i][2]; d[3] = ld[i][3]; }
            if (j < 7) {
#pragma unroll
                for (int i = 0; i < 8; ++i) ld[i] = __builtin_nontemporal_load((const GAS f32x4*)(wp + (size_t)(64 * (j + 1) + 8 * i) * N)); }
            f32x4 g0, g1, b0, b1;
            if (gk) { g0 = *(const GAS f32x4*)(gk + k0 + 8 * c); g1 = *(const GAS f32x4*)(gk + k0 + 8 * c + 4); b0 = *(const GAS f32x4*)(bk + k0 + 8 * c); b1 = *(const GAS f32x4*)(bk + k0 + 8 * c + 4); }
            LDS_WAIT(); asm volatile("" ::: "memory");
#pragma unroll
            for (int jj = 0; jj < 4; ++jj) { const int n = r8 + 8 * jj; const LAS float* s = scr + (8 * c) * 33 + n;
                float w[8];
#pragma unroll
                for (int e = 0; e < 8; ++e) w[e] = s[e * 33] * wscale;
                v4u o;
                if (gk) {
                    o.x = pkbf(w[0] * g0[0], w[1] * g0[1]); o.y = pkbf(w[2] * g0[2], w[3] * g0[3]); o.z = pkbf(w[4] * g1[0], w[5] * g1[1]); o.w = pkbf(w[6] * g1[2], w[7] * g1[3]);
                    a1[jj] += (pg8::bf_lo(o.x) + pg8::bf_hi(o.x)) + (pg8::bf_lo(o.y) + pg8::bf_hi(o.y)) + (pg8::bf_lo(o.z) + pg8::bf_hi(o.z)) + (pg8::bf_lo(o.w) + pg8::bf_hi(o.w));
                    a2[jj] += (w[0] * b0[0] + w[1] * b0[1]) + (w[2] * b0[2] + w[3] * b0[3]) + (w[4] * b1[0] + w[5] * b1[1]) + (w[6] * b1[2] + w[7] * b1[3]);
                } else { o.x = pkbf(w[0], w[1]); o.y = pkbf(w[2], w[3]); o.z = pkbf(w[4], w[5]); o.w = pkbf(w[6], w[7]); }
                *(GAS v4u*)(WT + (size_t)(drow0 + n) * ldt + k0 + 8 * c) = o; }
            LDS_WAIT(); asm volatile("" ::: "memory");
        }
        if (gk) {
#pragma unroll
            for (int jj = 0; jj < 4; ++jj) { float s1 = a1[jj], s2 = a2[jj];
                s1 += pg8::sw_xor<1>(s1); s1 += pg8::sw_xor<2>(s1); s1 += pg8::sw_xor<4>(s1); s2 += pg8::sw_xor<1>(s2); s2 += pg8::sw_xor<2>(s2); s2 += pg8::sw_xor<4>(s2);
                if (c == 0) { unsafeAtomicAdd(cs + drow0 + r8 + 8 * jj, s1); unsafeAtomicAdd(cb + drow0 + r8 + 8 * jj, s2); } } }
    }
}
__device__ __forceinline__ void conv_copy(const float* __restrict__ W, bf16* O, size_t n, int gw, int NGW, int lane) {
    for (size_t i = ((size_t)gw * 64 + lane) * 8; i < n; i += (size_t)NGW * 64 * 8) {
        const f32x4 a = *(const GAS f32x4*)(W + i), b = *(const GAS f32x4*)(W + i + 4);
        v4u o; o.x = pkbf(a[0], a[1]); o.y = pkbf(a[2], a[3]); o.z = pkbf(b[0], b[1]); o.w = pkbf(b[2], b[3]);
        *(GAS v4u*)(O + i) = o; }
}
__device__ __forceinline__ void ln_rows(const float* Y, const float* __restrict__ g, const float* __restrict__ b, float* X32, bf16* XB, int gw, int NGW, int lane) {
    f32x4 gg[8], bb[8];
#pragma unroll
    for (int j = 0; j < 8; ++j) { gg[j] = *(const GAS f32x4*)(g + 4 * lane + 256 * j); bb[j] = *(const GAS f32x4*)(b + 4 * lane + 256 * j); }
    for (int m = gw; m < MT; m += NGW) {
        const GAS f32x4* yr = (const GAS f32x4*)(Y + (size_t)m * DMODEL) + lane;
        f32x4 v[8]; float s = 0.f;
#pragma unroll
        for (int j = 0; j < 8; ++j) { v[j] = yr[64 * j]; s += (v[j][0] + v[j][1]) + (v[j][2] + v[j][3]); }
        const float mean = wave_sum(s) * (1.f / DMODEL); float s2 = 0.f;
#pragma unroll
        for (int j = 0; j < 8; ++j) { v[j] = v[j] - mean; s2 += (v[j][0] * v[j][0] + v[j][1] * v[j][1]) + (v[j][2] * v[j][2] + v[j][3] * v[j][3]); }
        const float rstd = 1.f / sqrtf(wave_sum(s2) * (1.f / DMODEL) + LN_EPS);
        GAS f32x4* xo = (GAS f32x4*)(X32 + (size_t)m * DMODEL) + lane;
        GAS unsigned long long* o8 = (GAS unsigned long long*)(XB + (size_t)m * DMODEL) + lane;
#pragma unroll
        for (int j = 0; j < 8; ++j) { const f32x4 o = v[j] * rstd * gg[j] + bb[j]; xo[64 * j] = o;
            if (XB) o8[64 * j] = (unsigned long long)pkbf(o[0], o[1]) | ((unsigned long long)pkbf(o[2], o[3]) << 32); }
    }
}
__device__ __forceinline__ void final_ln_planes(const bf16* XB, const pg8::u32x4* LO8, const float* st, const float* g, const float* b, float* out, int gw, int NGW, int lane) {
    const int fq = lane >> 4, fr = lane & 15;
    for (int it = gw; it < 1024 * 64; it += NGW) {
        const int am = it & 7, wv = (it >> 3) & 7, tile = it >> 6, pm = tile >> 3, pn = tile & 7, wr = wv >> 2, wc = wv & 3, ai = am >> 2, mm = am & 3;
        const int r = pm * 256 + ai * 128 + wr * 64 + mm * 16 + fr, col0 = pn * 256 + wc * 32 + 8 * fq;
        const pg8::u32x4 lo = LO8[(size_t)it * 64 + lane];
        const v4u h0 = *(const GAS v4u*)(XB + (size_t)r * DMODEL + col0), h1 = *(const GAS v4u*)(XB + (size_t)r * DMODEL + col0 + 128);
        const f32x2v s = *(const GAS f32x2v*)(st + 2 * (size_t)r);
        const float mu = s.x * (1.0f / 2048.0f), rs = __builtin_amdgcn_rsqf(s.y * (1.0f / 2048.0f) - mu * mu + LN_EPS);
#pragma unroll
        for (int bj = 0; bj < 2; ++bj) { const v4u h = bj ? h1 : h0; const unsigned w0 = bj ? lo.z : lo.x, w1 = bj ? lo.w : lo.y; const int c = col0 + bj * 128;
            const f32x2v a0 = __builtin_amdgcn_cvt_pk_f32_fp8((int)w0, false), a1 = __builtin_amdgcn_cvt_pk_f32_fp8((int)w0, true), a2 = __builtin_amdgcn_cvt_pk_f32_fp8((int)w1, false), a3 = __builtin_amdgcn_cvt_pk_f32_fp8((int)w1, true);
            const f32x4 y0 = {pg8::bf_lo(h[0]) + a0.x * 0.00390625f, pg8::bf_hi(h[0]) + a0.y * 0.00390625f, pg8::bf_lo(h[1]) + a1.x * 0.00390625f, pg8::bf_hi(h[1]) + a1.y * 0.00390625f};
            const f32x4 y1 = {pg8::bf_lo(h[2]) + a2.x * 0.00390625f, pg8::bf_hi(h[2]) + a2.y * 0.00390625f, pg8::bf_lo(h[3]) + a3.x * 0.00390625f, pg8::bf_hi(h[3]) + a3.y * 0.00390625f};
            const f32x4 g0 = *(const GAS f32x4*)(g + c), g1 = *(const GAS f32x4*)(g + c + 4), b0 = *(const GAS f32x4*)(b + c), b1 = *(const GAS f32x4*)(b + c + 4);
            *(GAS f32x4*)(out + (size_t)r * DMODEL + c) = (y0 - mu) * rs * g0 + b0; *(GAS f32x4*)(out + (size_t)r * DMODEL + c + 4) = (y1 - mu) * rs * g1 + b1; }
    }
}
__device__ __forceinline__ void softmax_rows(const float* __restrict__ SC, bf16* PB, int gw, int NGW, int lane) {
    for (int m = gw; m < MT; m += NGW) {
        const GAS f32x4* sr = (const GAS f32x4*)(SC + (size_t)m * 1024) + lane;
        GAS unsigned long long* o8 = (GAS unsigned long long*)(PB + (size_t)m * 1024) + lane;
        f32x4 v[4];
#pragma unroll
        for (int j = 0; j < 4; ++j) v[j] = sr[64 * j];
#pragma unroll
        for (int j = 0; j < 4; ++j) {
            const float mx = wave_max(fmaxf(fmaxf(v[j][0], v[j][1]), fmaxf(v[j][2], v[j][3])));
            f32x4 e;
#pragma unroll
            for (int k = 0; k < 4; ++k) e[k] = __builtin_amdgcn_exp2f((v[j][k] - mx) * 1.4426950408889634f);
            const float inv = 1.0f / wave_sum((e[0] + e[1]) + (e[2] + e[3]));
            o8[64 * j] = (unsigned long long)pkbf(e[0] * inv, e[1] * inv) | ((unsigned long long)pkbf(e[2] * inv, e[3] * inv) << 32);
        }
    }
}
__device__ __forceinline__ void diff_combine(const bf16* __restrict__ OV, bf16* MIX, const float* lq1, const float* lk1, const float* lq2, const float* lk2, const float* ng, float lam_init, int gw, int NGW, int lane) {
    const float s1 = wave_sum(lq1[lane] * lk1[lane]), s2 = wave_sum(lq2[lane] * lk2[lane]);
    const float lam = expf(s1) - expf(s2) + lam_init, osc = 1.0f - lam_init;
    const int h = lane >> 3, d0 = (lane & 7) * 16;
    float gn[16];
#pragma unroll
    for (int e = 0; e < 16; ++e) gn[e] = ng[d0 + e] * osc;
    for (int m0 = gw; m0 < MT; m0 += 2 * NGW) {
        const int m1 = m0 + NGW; const bool has1 = m1 < MT;
        const bf16* o1 = OV + (size_t)m0 * 2048 + h * 256 + d0; const bf16* p1 = OV + (size_t)(has1 ? m1 : m0) * 2048 + h * 256 + d0;
        v4u q[2][4];
        q[0][0] = *(const GAS v4u*)o1; q[0][1] = *(const GAS v4u*)(o1 + 8); q[0][2] = *(const GAS v4u*)(o1 + 128); q[0][3] = *(const GAS v4u*)(o1 + 136);
        q[1][0] = *(const GAS v4u*)p1; q[1][1] = *(const GAS v4u*)(p1 + 8); q[1][2] = *(const GAS v4u*)(p1 + 128); q[1][3] = *(const GAS v4u*)(p1 + 136);
#pragma unroll
        for (int t = 0; t < 2; ++t) { if (t == 1 && !has1) break;
            const v4u a0 = q[t][0], a1 = q[t][1], b0 = q[t][2], b1 = q[t][3]; float x[16];
#pragma unroll
            for (int k = 0; k < 4; ++k) { x[2 * k] = pg8::bf_lo(a0[k]) - lam * pg8::bf_lo(b0[k]); x[2 * k + 1] = pg8::bf_hi(a0[k]) - lam * pg8::bf_hi(b0[k]);
                x[8 + 2 * k] = pg8::bf_lo(a1[k]) - lam * pg8::bf_lo(b1[k]); x[8 + 2 * k + 1] = pg8::bf_hi(a1[k]) - lam * pg8::bf_hi(b1[k]); }
            float ss = 0.f;
#pragma unroll
            for (int e = 0; e < 16; ++e) ss += x[e] * x[e];
            ss += pg8::sw_xor<1>(ss); ss += pg8::sw_xor<2>(ss); ss += pg8::sw_xor<4>(ss);
            const float r = __builtin_amdgcn_rsqf(ss * (1.0f / 128.0f) + RMS_EPS);
            v4u w0, w1;
#pragma unroll
            for (int k = 0; k < 4; ++k) { w0[k] = pkbf(x[2 * k] * r * gn[2 * k], x[2 * k + 1] * r * gn[2 * k + 1]); w1[k] = pkbf(x[8 + 2 * k] * r * gn[8 + 2 * k], x[8 + 2 * k + 1] * r * gn[8 + 2 * k + 1]); }
            bf16* op = MIX + (size_t)(t ? m1 : m0) * 2048 + h * 128 + d0;
            *(GAS v4u*)op = w0; *(GAS v4u*)(op + 8) = w1; }
    }
}
__device__ __forceinline__ void cpow(float rez, float imz, int tau, float& re, float& im) {
    double rev = (double)imz * (double)tau * 0.15915494309189535; rev -= __builtin_rint(rev);
    const float mg = __builtin_amdgcn_exp2f(rez * (float)tau * 1.4426950408889634f), rv = (float)rev;
    re = mg * __builtin_amdgcn_cosf(rv); im = mg * __builtin_amdgcn_sinf(rv);
}
__device__ __forceinline__ void ssm_prep(const float* lam_re, const float* lam_im, const float* log_step, const float* b_re, const float* b_im, const float* c_re, const float* c_im,
                                         bf16* TG, bf16* EM, LAS unsigned char* lds, int vcu, int G, int tid, bool skipz) {
    LAS float* APre = (LAS float*)lds;
    LAS float* APim = APre + 65 * 64;
    LAS float* BBre = APim + 65 * 64;
    LAS float* BBim = BBre + 1024;
    LAS float* CCre = BBim + 1024;
    LAS float* CCim = CCre + 256;
    LAS float* KT = CCim + 256;
    for (int item = vcu; item < 256; item += G) {
        const int g = item >> 2, pb = item & 3;
        const float step = expf(log_step[g]);
        for (int e = tid; e < 65 * 64; e += NWAVES * 64) { const int tau = e >> 6, n = e & 63; const float lr = fminf(lam_re[g * 64 + n], -1e-4f), li = lam_im[g * 64 + n];
            float re, im; cpow(lr * step, li * step, tau, re, im); APre[e] = re; APim[e] = im; }
        for (int e = tid; e < 1024; e += NWAVES * 64) { const int n = e >> 4; const float lr = fminf(lam_re[g * 64 + n], -1e-4f), li = lam_im[g * 64 + n];
            float ar, ai; cpow(lr * step, li * step, 1, ar, ai);
            const float x = ar - 1.0f, y = ai, den = 1.0f / (lr * lr + li * li);
            const float cr = (x * lr + y * li) * den, ci = (y * lr - x * li) * den;
            const float br = b_re[(size_t)g * 1024 + e], bi = b_im[(size_t)g * 1024 + e];
            BBre[e] = cr * br - ci * bi; BBim[e] = cr * bi + ci * br; }
        for (int e = tid; e < 256; e += NWAVES * 64) { const int pl = e >> 6, n = e & 63; CCre[e] = c_re[(size_t)(g * 16 + 4 * pb + pl) * 64 + n]; CCim[e] = c_im[(size_t)(g * 16 + 4 * pb + pl) * 64 + n]; }
        __syncthreads();
        { const int pq = tid & 63, pl = pq >> 4, q = pq & 15, tb = tid >> 6; float acc[8];
#pragma unroll
          for (int k = 0; k < 8; ++k) acc[k] = 0.f;
          for (int n = 0; n < 64; ++n) { const float cr = CCre[pl * 64 + n], ci = CCim[pl * 64 + n], br = BBre[n * 16 + q], bi = BBim[n * 16 + q];
              const float cbr = cr * br - ci * bi, cbi = cr * bi + ci * br;
#pragma unroll
              for (int k = 0; k < 8; ++k) acc[k] += cbr * APre[(tb * 8 + k) * 64 + n] - cbi * APim[(tb * 8 + k) * 64 + n]; }
#pragma unroll
          for (int k = 0; k < 8; ++k) KT[(tb * 8 + k) * 64 + pq] = acc[k]; }
        __syncthreads();
        for (int idx = tid; idx < 256 * 144; idx += NWAVES * 64) {
            const int rowl = idx / 144, ch = idx - rowl * 144, t = rowl >> 2, pl = rowl & 3; float v[8];
            if (ch >= 16) { const int s = (ch - 16) >> 1, q0 = ((ch - 16) & 1) * 8;
                if (s > (t | 15)) continue;
                if (skipz && s > t) continue;
#pragma unroll
                for (int e = 0; e < 8; ++e) v[e] = (s <= t) ? KT[(t - s) * 64 + pl * 16 + q0 + e] : 0.f;
            } else { const int n0 = ch * 8;
#pragma unroll
                for (int e = 0; e < 8; ++e) { const int n = (n0 + e) & 63; const float cr = CCre[pl * 64 + n], ci = CCim[pl * 64 + n], pr = APre[(t + 1) * 64 + n], pi = APim[(t + 1) * 64 + n];
                    v[e] = (n0 < 64) ? (cr * pr - ci * pi) : -(cr * pi + ci * pr); } }
            v4u o; o.x = pkbf(v[0], v[1]); o.y = pkbf(v[2], v[3]); o.z = pkbf(v[4], v[5]); o.w = pkbf(v[6], v[7]);
            *(GAS v4u*)(TG + (size_t)(g * 1024 + t * 16 + 4 * pb + pl) * UGP + ch * 8) = o;
        }
        for (int idx = tid; idx < 32 * 128; idx += NWAVES * 64) {
            const int rl = idx >> 7, ch = idx & 127, part = rl >> 4, n = 16 * pb + (rl & 15), s = ch >> 1, q0 = (ch & 1) * 8; float v[8];
            const float pr = APre[(63 - s) * 64 + n], pi = APim[(63 - s) * 64 + n];
#pragma unroll
            for (int e = 0; e < 8; ++e) { const float br = BBre[n * 16 + q0 + e], bi = BBim[n * 16 + q0 + e]; v[e] = part ? (pr * bi + pi * br) : (pr * br - pi * bi); }
            v4u o; o.x = pkbf(v[0], v[1]); o.y = pkbf(v[2], v[3]); o.z = pkbf(v[4], v[5]); o.w = pkbf(v[6], v[7]);
            *(GAS v4u*)(EM + (size_t)(g * 128 + part * 64 + n) * 1024 + ch * 8) = o;
        }
        __syncthreads();
    }
}
__device__ __forceinline__ void ssm_scan8(const float* lam_re, const float* lam_im, const float* log_step, const float* VS, bf16* UG, int gb, int wave, int lane, LAS float* xl) {
    const int g = gb >> 1, b = gb & 1, n = lane;
    const float step = expf(log_step[g]), lr = fminf(lam_re[g * 64 + n], -1e-4f), li = lam_im[g * 64 + n];
    float ar, ai; cpow(lr * step, li * step, 64, ar, ai);
    const float* vs = VS + (size_t)(g * 512 + b * 256 + 32 * wave) * 128 + n; bf16* ug = UG + (size_t)(g * 512 + b * 256 + 32 * wave) * UGP + n;
    float vr[32], vi[32];
#pragma unroll
    for (int k = 0; k < 32; ++k) { vr[k] = vs[(size_t)k * 128]; vi[k] = vs[(size_t)k * 128 + 64]; }
    float hr = 0.f, hi = 0.f;
#pragma unroll
    for (int k = 0; k < 32; ++k) { const float nr = ar * hr - ai * hi + vr[k], ni = ar * hi + ai * hr + vi[k]; hr = nr; hi = ni; }
    xl[(wave * 64 + n) * 2] = hr; xl[(wave * 64 + n) * 2 + 1] = hi;
    float pr = ar, pi = ai;
#pragma unroll
    for (int q = 0; q < 5; ++q) { const float tr = pr * pr - pi * pi, ti = 2.f * pr * pi; pr = tr; pi = ti; }
    asm volatile("s_waitcnt lgkmcnt(0)" ::: "memory"); __syncthreads();
    hr = 0.f; hi = 0.f;
    for (int v = 0; v < wave; ++v) { const float er = xl[(v * 64 + n) * 2], ei = xl[(v * 64 + n) * 2 + 1]; const float nr = pr * hr - pi * hi + er, ni = pr * hi + pi * hr + ei; hr = nr; hi = ni; }
#pragma unroll
    for (int k = 0; k < 32; ++k) { const unsigned w = pkbf(hr, hi); ug[(size_t)k * UGP] = (bf16)(w & 0xffffu); ug[(size_t)k * UGP + 64] = (bf16)(w >> 16);
        const float nr = ar * hr - ai * hi + vr[k], ni = ar * hi + ai * hr + vi[k]; hr = nr; hi = ni; }
    asm volatile("s_waitcnt lgkmcnt(0)" ::: "memory"); __syncthreads();
}

struct MapSsmV   { __device__ __forceinline__ void operator()(pg8::Unit& u) const { u.aoff = u.pm * 256 * UGP; u.boff = (u.pm >> 1) * 128 * 1024; } };
struct MapSsmY   { __device__ __forceinline__ void operator()(pg8::Unit& u) const { if ((u.pm >> 3) & 1) u.pn = 3 - u.pn;
        u.aoff = u.pm * 256 * UGP; u.boff = ((u.pm >> 1) * 1024 + u.pn * 256) * UGP; u.nt = 6 + 4 * u.pn; } };
struct MapMQT    { __device__ __forceinline__ void operator()(pg8::Unit& u) const { const int b = u.pm >> 2, h = u.pm & 3; u.aoff = b * 256 * 4096 + h * 512; u.boff = u.pn * 256 * 2048 + h * 512; } };
struct MapVWOT   { __device__ __forceinline__ void operator()(pg8::Unit& u) const { const int b = u.pm >> 3, nt = u.pm & 7, h = u.pn; u.aoff = nt * 256 * 2048 + h * 512; u.boff = b * 256 * 4096 + 2048 + h * 512; } };
struct MapScores { __device__ __forceinline__ void operator()(pg8::Unit& u) const { u.aoff = u.pm * 256 * 2048; u.boff = ((u.pm >> 6) * 1024 + u.pn * 256) * 2048; } };
struct MapOut    { __device__ __forceinline__ void operator()(pg8::Unit& u) const { u.aoff = u.pm * 256 * 1024; u.boff = ((u.pm >> 6) * 2048 + u.pn * 256) * 1024; } };

#ifndef WGM_N8
#define WGM_N8 4
#endif
#ifndef WGM_FF
#define WGM_FF 4
#endif
#ifndef STAG_G
#define STAG_G 1
#endif
#ifndef STAG_US
#define STAG_US 0
#endif
__device__ __forceinline__ void stagger(int bx, int us) {
    const int grp = (bx >> 3) % STAG_G;
    if (STAG_G > 1 && grp) { const unsigned long long t0 = __builtin_amdgcn_s_memrealtime(), dt = (unsigned long long)(grp * us) * 100ull;
        while (__builtin_amdgcn_s_memrealtime() - t0 < dt) __builtin_amdgcn_s_sleep(16); }
}
struct Args { const float* in[NIN]; float* out; unsigned char* ws; };
#ifndef PHMASK
#define PHMASK 0xFFFFFFFFu
#endif
#define PH(k) ((PHMASK >> (k)) & 1u)
#ifndef PROBE_DUP
#define PROBE_DUP -1
#endif
#ifndef PROBE_DUP2
#define PROBE_DUP2 -1
#endif
#ifndef PROBE_DUP3
#define PROBE_DUP3 -1
#endif
#ifndef PROBE_DUP4
#define PROBE_DUP4 -1
#endif
#define PD(k) (PROBE_DUP == (k) || PROBE_DUP2 == (k) || PROBE_DUP3 == (k) || PROBE_DUP4 == (k))
#define P_DUMY ((float*)(WSP + WS_END))
#define P_DUMXB ((bf16*)(WSP + WS_END + 256 * MiB))
#define P_DUMST ((float*)(WSP + WS_END + 384 * MiB))
#define LOAD_GB(gp, bp) do { const float* g_ = (gp); const float* b_ = (bp); LAS float* d_ = (LAS float*)(ldsl + GB_OFF); \
        for (int i_ = tid; i_ < DMODEL; i_ += NWAVES * 64) { d_[i_] = g_[i_]; d_[DMODEL + i_] = b_[i_]; } __syncthreads(); } while (0)
#define LGB ((LAS const float*)(ldsl + GB_OFF))
#define GEMM_PHASE(EPI, ORD, g, S, E) pg8::gemm_phase<EPI, ORD, true, true>(ldsl + RING_OFF, g, S, E)
#ifndef SWIGLU_ALIGN
#define SWIGLU_ALIGN true
#endif
#define GEMM_PHASE_SW(EPI, ORD, g, S, E) pg8::gemm_phase<EPI, ORD, SWIGLU_ALIGN, true>(ldsl + RING_OFF, g, S, E)
typedef __attribute__((address_space(4))) const unsigned char* kargp_t;
__device__ __forceinline__ kargp_t kargs() { kargp_t p = (kargp_t)__builtin_amdgcn_kernarg_segment_ptr(); asm volatile("" : "+s"(p)); return p; }
#define INP(i) (*(const float* const __attribute__((address_space(4)))*)(kargs() + 8 * (i)))
#define P_X32 (*(float* const __attribute__((address_space(4)))*)(kargs() + 8 * NIN))
#define WSP (*(unsigned char* const __attribute__((address_space(4)))*)(kargs() + 8 * (NIN + 1)))
#define P_XB ((bf16*)(WSP + WS_XB))
#define P_YLO ((pg8::u32x4*)(WSP + WS_YLO))
#define P_CS(l, off) ((float*)(WSP + WS_CS) + (size_t)(l) * CSL + (off))
#define P_ST(i) ((float*)(WSP + WS_ST) + (size_t)(i) * (2 * MT))
#define P_HMID ((bf16*)(WSP + WS_HMID))
#define P_QKV ((bf16*)(WSP + WS_QKV))
#define P_UG ((bf16*)(WSP + WS_UG))
#define P_OV ((bf16*)(WSP + WS_OV))
#define P_SC ((float*)(WSP + WS_SC))
#define P_PB ((bf16*)(WSP + WS_PB))
#define P_MIX ((bf16*)(WSP + WS_MIX))
#define P_YG ((bf16*)(WSP + WS_YG))
#define P_VS ((float*)(WSP + WS_VS))
#define P_W1GU ((bf16*)(WSP + WS_W1GU))
#define P_W1D ((bf16*)(WSP + WS_W1D))
#define P_W2GU ((bf16*)(WSP + WS_W2GU))
#define P_W2D ((bf16*)(WSP + WS_W2D))
#define P_WIN ((bf16*)(WSP + WS_WIN))
#define P_WGLU ((bf16*)(WSP + WS_WGLU))
#define P_WOUT ((bf16*)(WSP + WS_WOUT))
#define P_WQN ((bf16*)(WSP + WS_WQN))
#define P_WKVT ((bf16*)(WSP + WS_WKVT))
#define P_WOT ((bf16*)(WSP + WS_WOT))
#define P_TG ((bf16*)(WSP + WS_TG))
#define P_EM ((bf16*)(WSP + WS_EM))
#define P_MEMB ((bf16*)(WSP + WS_MEMB))
#define P_KVM ((bf16*)(WSP + WS_KVM))
#define P_MQT ((bf16*)(WSP + WS_MQT))
#define P_VWOT ((bf16*)(WSP + WS_VWOT))
__global__ void __launch_bounds__(NWAVES * 64, 2) fwd_kernel(Args args) {
    extern __shared__ __attribute__((aligned(16))) unsigned char lds[];
    LAS unsigned char* ldsl = (LAS unsigned char*)lds;
    volatile LAS unsigned* MISC = (volatile LAS unsigned*)(ldsl + MISC_OFF);
#define IDS() const int tid = pg8::otid(), lane = tid & 63, wave = __builtin_amdgcn_readfirstlane(tid >> 6); const int G = pg8::osgpr((int)gridDim.x), bx = pg8::osgpr((int)blockIdx.x), \
        vcu = (G % 8 == 0) ? (bx % 8) * (G / 8) + bx / 8 : bx, gw = vcu * NWAVES + wave, NGW = G * NWAVES; LAS float* scr = (LAS float*)(ldsl + RING_OFF + wave * 16384); \
        (void)lane; (void)gw; (void)NGW; (void)scr; (void)vcu
    { const int tid0 = threadIdx.x;
      for (int u = tid0; u < (LDS_BYTES - LDSCTL_OFF) / 4; u += NWAVES * 64) ((LAS unsigned*)(ldsl + LDSCTL_OFF))[u] = 0u; }
    __syncthreads();
    (void)xcd_barrier_post((unsigned*)((gu32*)(WSP + WS_CTL) + CW_BAR), MISC + 8);
#define GRID_BAR() do { XcdBarrier b_; b_.bar = (unsigned*)((gu32*)(WSP + WS_CTL) + CW_BAR); b_.x = xb_xcc_id(); b_.st = (volatile LAS unsigned*)(ldsl + MISC_OFF) + 8; xcd_barrier(b_); } while (0)

#define CONVERT_LAYER(L, MODE) do { const int L_ = (L); IDS();     \
        if ((MODE) != 2) { \
        conv_T(INP(I_F1G) + (size_t)L_ * DMODEL * FF, DMODEL, FF, P_W1GU, DMODEL, RmGate{0}, L_ ? INP(I_LN4G) + (L_ - 1) * DMODEL : nullptr, INP(I_LN4B) + (L_ ? L_ - 1 : 0) * DMODEL, P_CS(L_, CS1), P_CS(L_, CB1), scr, gw, NGW, lane, 0, 1.4426950408889634f); \
        conv_T(INP(I_F1U) + (size_t)L_ * DMODEL * FF, DMODEL, FF, P_W1GU, DMODEL, RmGate{128}, L_ ? INP(I_LN4G) + (L_ - 1) * DMODEL : nullptr, INP(I_LN4B) + (L_ ? L_ - 1 : 0) * DMODEL, P_CS(L_, CS1), P_CS(L_, CB1), scr, gw, NGW, lane, 704, 0.6931471805599453f); \
        conv_T(INP(I_F1D) + (size_t)L_ * DMODEL * FF, FF, DMODEL, P_W1D, FF, RmId{}, nullptr, nullptr, nullptr, nullptr, scr, gw, NGW, lane, 1408); \
        conv_T(INP(I_F2G) + (size_t)L_ * DMODEL * FF, DMODEL, FF, P_W2GU, DMODEL, RmGate{0}, INP(I_LN3G) + L_ * DMODEL, INP(I_LN3B) + L_ * DMODEL, P_CS(L_, CS2), P_CS(L_, CB2), scr, gw, NGW, lane, 2112, 1.4426950408889634f); \
        conv_T(INP(I_F2U) + (size_t)L_ * DMODEL * FF, DMODEL, FF, P_W2GU, DMODEL, RmGate{128}, INP(I_LN3G) + L_ * DMODEL, INP(I_LN3B) + L_ * DMODEL, P_CS(L_, CS2), P_CS(L_, CB2), scr, gw, NGW, lane, 2816, 0.6931471805599453f); \
        } if ((MODE) != 1) { \
        conv_T(INP(I_F2D) + (size_t)L_ * DMODEL * FF, FF, DMODEL, P_W2D, FF, RmId{}, nullptr, nullptr, nullptr, nullptr, scr, gw, NGW, lane, 3520); \
        } if ((MODE) != 2) { \
        conv_T(INP(I_WIN) + (size_t)L_ * DMODEL * INW, DMODEL, INW, P_WIN, DMODEL, RmId{}, INP(I_LN1G) + L_ * DMODEL, INP(I_LN1B) + L_ * DMODEL, P_CS(L_, CSW), P_CS(L_, CBW), scr, gw, NGW, lane, 4224); \
        conv_T(INP(I_GLUW) + (size_t)L_ * 1024 * 1024, 1024, 1024, P_WGLU, 1024, RmId{}, nullptr, nullptr, nullptr, nullptr, scr, gw, NGW, lane, 4736); \
        conv_T(INP(I_WOUT) + (size_t)L_ * DMODEL * DMODEL, DMODEL, DMODEL, P_WOUT, DMODEL, RmId{}, nullptr, nullptr, nullptr, nullptr, scr, gw, NGW, lane, 4800); \
        conv_copy(INP(I_XQ) + (size_t)L_ * DMODEL * DMODEL, P_WQN, (size_t)DMODEL * DMODEL, gw, NGW, lane); \
        conv_T(INP(I_XK) + (size_t)L_ * DMODEL * DMODEL, DMODEL, DMODEL, P_WKVT, DMODEL, RmId{}, nullptr, nullptr, nullptr, nullptr, scr, gw, NGW, lane, 5056); \
        conv_T(INP(I_XV) + (size_t)L_ * DMODEL * DMODEL, DMODEL, DMODEL, P_WKVT + (size_t)DMODEL * DMODEL, DMODEL, RmId{}, nullptr, nullptr, nullptr, nullptr, scr, gw, NGW, lane, 5312); \
        conv_T(INP(I_XO) + (size_t)L_ * DMODEL * DMODEL, DMODEL, DMODEL, P_WOT, DMODEL, RmId{}, nullptr, nullptr, nullptr, nullptr, scr, gw, NGW, lane, 5568); \
        __syncthreads(); \
        ssm_prep(INP(I_SLRE) + L_ * 4096, INP(I_SLIM) + L_ * 4096, INP(I_SLOG) + L_ * 64, INP(I_SBRE) + (size_t)L_ * 65536, INP(I_SBIM) + (size_t)L_ * 65536, \
                 INP(I_SCRE) + (size_t)L_ * 65536, INP(I_SCIM) + (size_t)L_ * 65536, P_TG, P_EM, ldsl + RING_OFF, vcu, G, tid, L_ > 0); \
        } \
    } while (0)
#define CONVERT_DUMMY(L) do { const int L_ = (L); IDS(); \
        conv_T(INP(I_F1G) + (size_t)L_ * DMODEL * FF, DMODEL, FF, ((bf16*)((unsigned char*)P_W1GU + (WS_END - WS_W))), DMODEL, RmGate{0}, L_ ? INP(I_LN4G) + (L_ - 1) * DMODEL : nullptr, INP(I_LN4B) + (L_ ? L_ - 1 : 0) * DMODEL, (P_DUMST + CS1), (P_DUMST + CB1), scr, gw, NGW, lane, 0, 1.4426950408889634f); \
        conv_T(INP(I_F1U) + (size_t)L_ * DMODEL * FF, DMODEL, FF, ((bf16*)((unsigned char*)P_W1GU + (WS_END - WS_W))), DMODEL, RmGate{128}, L_ ? INP(I_LN4G) + (L_ - 1) * DMODEL : nullptr, INP(I_LN4B) + (L_ ? L_ - 1 : 0) * DMODEL, (P_DUMST + CS1), (P_DUMST + CB1), scr, gw, NGW, lane, 704, 0.6931471805599453f); \
        conv_T(INP(I_F1D) + (size_t)L_ * DMODEL * FF, FF, DMODEL, ((bf16*)((unsigned char*)P_W1D + (WS_END - WS_W))), FF, RmId{}, nullptr, nullptr, nullptr, nullptr, scr, gw, NGW, lane, 1408); \
        conv_T(INP(I_F2G) + (size_t)L_ * DMODEL * FF, DMODEL, FF, ((bf16*)((unsigned char*)P_W2GU + (WS_END - WS_W))), DMODEL, RmGate{0}, INP(I_LN3G) + L_ * DMODEL, INP(I_LN3B) + L_ * DMODEL, (P_DUMST + CS2), (P_DUMST + CB2), scr, gw, NGW, lane, 2112, 1.4426950408889634f); \
        conv_T(INP(I_F2U) + (size_t)L_ * DMODEL * FF, DMODEL, FF, ((bf16*)((unsigned char*)P_W2GU + (WS_END - WS_W))), DMODEL, RmGate{128}, INP(I_LN3G) + L_ * DMODEL, INP(I_LN3B) + L_ * DMODEL, (P_DUMST + CS2), (P_DUMST + CB2), scr, gw, NGW, lane, 2816, 0.6931471805599453f); \
        conv_T(INP(I_F2D) + (size_t)L_ * DMODEL * FF, FF, DMODEL, ((bf16*)((unsigned char*)P_W2D + (WS_END - WS_W))), FF, RmId{}, nullptr, nullptr, nullptr, nullptr, scr, gw, NGW, lane, 3520); \
        conv_T(INP(I_WIN) + (size_t)L_ * DMODEL * INW, DMODEL, INW, ((bf16*)((unsigned char*)P_WIN + (WS_END - WS_W))), DMODEL, RmId{}, INP(I_LN1G) + L_ * DMODEL, INP(I_LN1B) + L_ * DMODEL, (P_DUMST + CSW), (P_DUMST + CBW), scr, gw, NGW, lane, 4224); \
        conv_T(INP(I_GLUW) + (size_t)L_ * 1024 * 1024, 1024, 1024, ((bf16*)((unsigned char*)P_WGLU + (WS_END - WS_W))), 1024, RmId{}, nullptr, nullptr, nullptr, nullptr, scr, gw, NGW, lane, 4736); \
        conv_T(INP(I_WOUT) + (size_t)L_ * DMODEL * DMODEL, DMODEL, DMODEL, ((bf16*)((unsigned char*)P_WOUT + (WS_END - WS_W))), DMODEL, RmId{}, nullptr, nullptr, nullptr, nullptr, scr, gw, NGW, lane, 4800); \
        conv_copy(INP(I_XQ) + (size_t)L_ * DMODEL * DMODEL, ((bf16*)((unsigned char*)P_WQN + (WS_END - WS_W))), (size_t)DMODEL * DMODEL, gw, NGW, lane); \
        conv_T(INP(I_XK) + (size_t)L_ * DMODEL * DMODEL, DMODEL, DMODEL, ((bf16*)((unsigned char*)P_WKVT + (WS_END - WS_W))), DMODEL, RmId{}, nullptr, nullptr, nullptr, nullptr, scr, gw, NGW, lane, 5056); \
        conv_T(INP(I_XV) + (size_t)L_ * DMODEL * DMODEL, DMODEL, DMODEL, ((bf16*)((unsigned char*)P_WKVT + (WS_END - WS_W))) + (size_t)DMODEL * DMODEL, DMODEL, RmId{}, nullptr, nullptr, nullptr, nullptr, scr, gw, NGW, lane, 5312); \
        conv_T(INP(I_XO) + (size_t)L_ * DMODEL * DMODEL, DMODEL, DMODEL, ((bf16*)((unsigned char*)P_WOT + (WS_END - WS_W))), DMODEL, RmId{}, nullptr, nullptr, nullptr, nullptr, scr, gw, NGW, lane, 5568); \
        __syncthreads(); \
        ssm_prep(INP(I_SLRE) + L_ * 4096, INP(I_SLIM) + L_ * 4096, INP(I_SLOG) + L_ * 64, INP(I_SBRE) + (size_t)L_ * 65536, INP(I_SBIM) + (size_t)L_ * 65536, \
                 INP(I_SCRE) + (size_t)L_ * 65536, INP(I_SCIM) + (size_t)L_ * 65536, ((bf16*)((unsigned char*)P_TG + (WS_END - WS_W))), ((bf16*)((unsigned char*)P_EM + (WS_END - WS_W))), ldsl + RING_OFF, vcu, G, tid); \
    } while (0)

    { IDS(); conv_copy(INP(I_X), P_XB, (size_t)MT * DMODEL, gw, NGW, lane);
      conv_copy(INP(I_MEM), P_MEMB, (size_t)NBATCH * NMEM * DMODEL, gw, NGW, lane); }
    CONVERT_LAYER(0, 0);
    GRID_BAR();

#pragma unroll 1
    for (int l = 0; l < DEPTH; ++l) {
        if (PH(1)) { IDS();
        { pg8::Gemm g{P_XB, P_W1GU, DMODEL, DMODEL, DMODEL}; pg8::Order<pg8::MapStd> S; S.init(MT / 256, 2 * FF / 256, G, bx, pg8::MapStd{DMODEL, DMODEL}, WGM_FF);
          pg8::EpiSwiGLU E{P_HMID, FF, pg8::Fold{P_ST(l ? 4 * l - 1 : 0), P_CS(l, CS1), P_CS(l, CB1), l == 0}, ldsl + GB_OFF}; GEMM_PHASE_SW(pg8::EpiSwiGLU, pg8::Order<pg8::MapStd>, g, S, E); }
        }
        GRID_BAR();
        if (PH(2)) { IDS(); stagger(bx, STAG_US);
        { pg8::Gemm g{P_HMID, P_W1D, FF, FF, FF}; pg8::Order<pg8::MapStdRev> S; S.init(MT / 256, DMODEL / 256, G, bx, pg8::MapStdRev{FF, FF, MT / 256}, WGM_N8);
          if (l == 0) { pg8::EpiResLn0 E{INP(I_X), nullptr, LGB, P_XB, P_YLO, nullptr, P_ST(0), ALPHA, 0.5f}; GEMM_PHASE(pg8::EpiResLn0, pg8::Order<pg8::MapStdRev>, g, S, E); }
          else { LOAD_GB(INP(I_LN4G) + (l - 1) * DMODEL, INP(I_LN4B) + (l - 1) * DMODEL); pg8::EpiResLn E{nullptr, P_ST(4 * l - 1), LGB, P_XB, P_YLO, nullptr, P_ST(4 * l), ALPHA, 0.5f}; GEMM_PHASE(pg8::EpiResLn, pg8::Order<pg8::MapStdRev>, g, S, E); } }
        }
        GRID_BAR();
        if (PH(4)) { IDS();
        { pg8::Gemm g{P_XB, P_WIN, DMODEL, DMODEL, DMODEL}; pg8::Order<pg8::MapStd> S; S.init(MT / 256, INW / 256, G, bx, pg8::MapStd{DMODEL, DMODEL});
          pg8::EpiWin<UGP> E{P_QKV, P_UG, attn_body::C2, pg8::Fold{P_ST(4 * l), P_CS(l, CSW), P_CS(l, CBW), 0}, ldsl + GB_OFF}; GEMM_PHASE(pg8::EpiWin<UGP>, pg8::Order<pg8::MapStd>, g, S, E); }
        }
        GRID_BAR();
        if (PH(5)) { IDS();
        { pg8::Gemm g{P_UG + 128, P_EM, UGP, 1024, 1024}; pg8::Order<MapSsmV> S; S.init(128, 1, G, bx, MapSsmV{});
          pg8::EpiF32<1> E{P_VS, 128}; GEMM_PHASE(pg8::EpiF32<1>, pg8::Order<MapSsmV>, g, S, E); }
        { pg8::Gemm g{P_MEMB, P_WKVT, DMODEL, DMODEL, DMODEL}; pg8::Order<pg8::MapStd> S; S.init(2, 16, G, bx - 128, pg8::MapStd{DMODEL, DMODEL});
          pg8::EpiBf16 E{P_KVM, 4096, 1.0f}; GEMM_PHASE(pg8::EpiBf16, pg8::Order<pg8::MapStd>, g, S, E); }
        if (l > 0 && bx >= 128 && G == 256) { conv_T(INP(I_F2D) + (size_t)l * DMODEL * FF, FF, DMODEL, P_W2D, FF, RmId{}, nullptr, nullptr, nullptr, nullptr, scr, (bx - 128) * NWAVES + wave, 128 * NWAVES, lane, 0); }
        else if (l > 0 && G != 256) { conv_T(INP(I_F2D) + (size_t)l * DMODEL * FF, FF, DMODEL, P_W2D, FF, RmId{}, nullptr, nullptr, nullptr, nullptr, scr, gw, NGW, lane, 0); }
        __syncthreads();
        }
        if (PH(6)) { IDS();
        { pg8::Order<MapSsmV> S5; S5.init(128, 1, G, bx, MapSsmV{}); pg8::Unit u5; const bool has5 = S5.next(0, u5);
          if (has5) { __builtin_amdgcn_fence(__ATOMIC_ACQUIRE, "agent"); asm volatile("s_waitcnt vmcnt(0)" ::: "memory");
              ssm_scan8(INP(I_SLRE) + l * 4096, INP(I_SLIM) + l * 4096, INP(I_SLOG) + l * 64, P_VS, P_UG, u5.pm, wave, lane, (LAS float*)(ldsl + RING_OFF)); } }
        { const attn_body::AttnTensors AT{(const attn_body::bf16*)P_QKV, (attn_body::bf16*)P_OV};
#if defined(ATTN_V64)
          const attn_body::StaticOrder S((int)G, (int)bx);
          attn_body::attn_phase<attn_body::StaticOrder>((char*)lds + RING_OFF, AT, S); }
#else
          const attn_body::StaticOrder2 S((int)G, (int)bx);
          attn_body::attn_phase2<attn_body::StaticOrder2>((char*)lds + RING_OFF, AT, S); }
#endif
        }
        GRID_BAR();
        if (PH(7)) { IDS();
        diff_combine(P_OV, P_MIX, INP(I_LQ1) + l * 64, INP(I_LK1) + l * 64, INP(I_LQ2) + l * 64, INP(I_LK2) + l * 64, INP(I_DNG) + l * 128, 0.8f - 0.6f * expf(-0.3f * (float)l), gw, NGW, lane);
        __syncthreads();
        { pg8::Gemm g{P_UG, P_TG, UGP, UGP, UGP}; pg8::Order<MapSsmY> S; S.init(128, 4, G, bx, MapSsmY{});
          pg8::EpiSsmY<UGP> E{P_UG, INP(I_SD) + l * 1024, P_YG}; GEMM_PHASE(pg8::EpiSsmY<UGP>, pg8::Order<MapSsmY>, g, S, E); }
        { pg8::Gemm g{P_KVM, P_WQN, 4096, DMODEL, 512}; pg8::Order<MapMQT> S; S.init(8, 8, G, bx, MapMQT{});
          pg8::EpiMqt E{P_MQT, DMODEL, 0.044194173824159216f, INP(I_LN2G) + l * DMODEL, INP(I_LN2B) + l * DMODEL, P_CS(l, CSM), P_CS(l, CBM)}; GEMM_PHASE(pg8::EpiMqt, pg8::Order<MapMQT>, g, S, E); }
        { pg8::Gemm g{P_WOT, P_KVM, DMODEL, 4096, 512}; pg8::Order<MapVWOT> S; S.init(16, 4, G, bx - 64, MapVWOT{});
          pg8::EpiBf16 E{P_VWOT, 1024, 1.0f}; GEMM_PHASE(pg8::EpiBf16, pg8::Order<MapVWOT>, g, S, E); }
        }
        GRID_BAR();
        if (PH(8)) { IDS();
        { pg8::Gemm g{P_YG, P_WGLU, 1024, 1024, 1024}; pg8::Order<pg8::MapStd> S; S.init(MT / 256, 4, G, bx, pg8::MapStd{1024, 1024});
          pg8::EpiGlu E{P_YG, INP(I_GLUB) + l * 1024, P_MIX}; GEMM_PHASE(pg8::EpiGlu, pg8::Order<pg8::MapStd>, g, S, E); }
        }
        GRID_BAR();
        if (PH(9)) { IDS(); stagger(bx, STAG_US);
        { pg8::Gemm g{P_MIX, P_WOUT, DMODEL, DMODEL, DMODEL}; pg8::Order<pg8::MapStd> S; S.init(MT / 256, DMODEL / 256, G, bx, pg8::MapStd{DMODEL, DMODEL}, WGM_N8);
          LOAD_GB(INP(I_LN1G) + l * DMODEL, INP(I_LN1B) + l * DMODEL); pg8::EpiResLn E{nullptr, P_ST(4 * l), LGB, P_XB, P_YLO, nullptr, P_ST(4 * l + 1), ALPHA, 1.0f}; GEMM_PHASE(pg8::EpiResLn, pg8::Order<pg8::MapStd>, g, S, E); }
        }
        GRID_BAR();
        if (PH(11)) { IDS();
        { pg8::Gemm g{P_XB, P_MQT, DMODEL, DMODEL, DMODEL}; pg8::Order<MapScores> S; S.init(MT / 256, 4, G, bx, MapScores{});
          pg8::EpiScoresSm E{P_PB, pg8::Fold{P_ST(4 * l + 1), P_CS(l, CSM), P_CS(l, CBM), 0}, (LAS float*)(ldsl + XCH_OFF)}; GEMM_PHASE(pg8::EpiScoresSm, pg8::Order<MapScores>, g, S, E); }
        }
        GRID_BAR();
        if (PH(13)) { IDS(); stagger(bx, STAG_US);
        { pg8::Gemm g{P_PB, P_VWOT, 1024, 1024, 1024}; pg8::Order<MapOut> S; S.init(MT / 256, DMODEL / 256, G, bx, MapOut{}, WGM_N8);
          LOAD_GB(INP(I_LN2G) + l * DMODEL, INP(I_LN2B) + l * DMODEL); pg8::EpiResLn E{nullptr, P_ST(4 * l + 1), LGB, P_XB, P_YLO, nullptr, P_ST(4 * l + 2), ALPHA, 1.0f}; GEMM_PHASE(pg8::EpiResLn, pg8::Order<MapOut>, g, S, E); }
        }
        GRID_BAR();
        if (PH(15)) { IDS();
        { pg8::Gemm g{P_XB, P_W2GU, DMODEL, DMODEL, DMODEL}; pg8::Order<pg8::MapStd> S; S.init(MT / 256, 2 * FF / 256, G, bx, pg8::MapStd{DMODEL, DMODEL}, WGM_FF);
          pg8::EpiSwiGLU E{P_HMID, FF, pg8::Fold{P_ST(4 * l + 2), P_CS(l, CS2), P_CS(l, CB2), 0}, ldsl + GB_OFF}; GEMM_PHASE_SW(pg8::EpiSwiGLU, pg8::Order<pg8::MapStd>, g, S, E); }
        }
        GRID_BAR();
        if (PH(16)) { IDS(); stagger(bx, STAG_US);
        { pg8::Gemm g{P_HMID, P_W2D, FF, FF, FF}; pg8::Order<pg8::MapStdRev> S; S.init(MT / 256, DMODEL / 256, G, bx, pg8::MapStdRev{FF, FF, MT / 256}, WGM_N8);
          LOAD_GB(INP(I_LN3G) + l * DMODEL, INP(I_LN3B) + l * DMODEL);
          { pg8::EpiResLn E{nullptr, P_ST(4 * l + 2), LGB, P_XB, P_YLO, nullptr, P_ST(4 * l + 3), ALPHA, 0.5f}; GEMM_PHASE(pg8::EpiResLn, pg8::Order<pg8::MapStdRev>, g, S, E); } }
        }
        if (l + 1 < DEPTH) { CONVERT_LAYER(l + 1, 1); GRID_BAR(); }
        else { GRID_BAR(); IDS(); final_ln_planes(P_XB, P_YLO, P_ST(4 * l + 3), INP(I_LN4G) + l * DMODEL, INP(I_LN4B) + l * DMODEL, P_X32, gw, NGW, lane); }
    }
}

extern "C" void kernel_launch(void* const* d_in, const int* in_sizes, int n_in, void* d_out, int out_size, void* d_ws, size_t ws_size, hipStream_t stream) {
    static int grid = 0;
    if (grid == 0) {
        if (n_in != NIN || in_sizes[0] != MT * DMODEL || out_size != MT * DMODEL || ws_size < WS_END) { fprintf(stderr, "kernel_launch: unexpected problem shape (n_in %d, in0 %d, out %d, ws %zu < %zu); nothing launched\n", n_in, n_in > 0 ? in_sizes[0] : -1, out_size, ws_size, (size_t)WS_END); grid = -1; return; }
        int dev = 0, cus = 0, per_cu = 0;
        if (hipGetDevice(&dev) != hipSuccess || hipDeviceGetAttribute(&cus, hipDeviceAttributeMultiprocessorCount, dev) != hipSuccess) { fprintf(stderr, "kernel_launch: device query failed\n"); grid = -1; return; }
        if (hipFuncSetAttribute((const void*)fwd_kernel, hipFuncAttributeMaxDynamicSharedMemorySize, LDS_BYTES) != hipSuccess) { fprintf(stderr, "kernel_launch: hipFuncSetAttribute failed\n"); grid = -1; return; }
        if (hipOccupancyMaxActiveBlocksPerMultiprocessor(&per_cu, (const void*)fwd_kernel, NWAVES * 64, LDS_BYTES) != hipSuccess || per_cu < 1)
            fprintf(stderr, "kernel_launch: note: occupancy query reports %d workgroups per CU\n", per_cu);
        (void)hipGetLastError();
        grid = cus;
    }
    if (grid < 0) return;
    if (hipMemsetAsync((char*)d_ws + WS_CTL, 0, CTL_ZERO_BYTES, stream) != hipSuccess) { fprintf(stderr, "kernel_launch: hipMemsetAsync failed\n"); return; }
    Args a{};
    for (int i = 0; i < NIN; ++i) a.in[i] = (const float*)d_in[i];
    a.out = (float*)d_out; a.ws = (unsigned char*)d_ws;
    hipLaunchKernelGGL(fwd_kernel, dim3(grid), dim3(NWAVES * 64), LDS_BYTES, stream, a);
    const hipError_t le = hipPeekAtLastError();
    if (le != hipSuccess) fprintf(stderr, "kernel_launch: launch failed: %s\n", hipGetErrorName(le));
}
```

```cpp
#pragma clang diagnostic ignored "-Winline-asm"
#include <hip/hip_runtime.h>
#include <hip/hip_bf16.h>
#include <cstdio>
#include <cstdint>
#include <cmath>
namespace pg8 {
#define PG8_LAS __attribute__((address_space(3)))
typedef unsigned short bf16_t;
typedef short bf16x8 __attribute__((ext_vector_type(8)));
typedef float f32x4 __attribute__((ext_vector_type(4)));
typedef float f32x2 __attribute__((ext_vector_type(2)));
typedef unsigned u32x4 __attribute__((ext_vector_type(4)));
constexpr int BM = 256, BK = 64, HALF = 128, HTB = HALF * BK * 2  , STAGE_BYTES = 8 * HTB, NXCD = 8, WGM = 8;

__host__ __device__ __forceinline__ int lds_byte(int r, int c) { const int st = (r >> 4) * 2 + (c >> 5), rr = r & 15, cc = c & 31, ob = rr * 64 + cc * 2; return st * 1024 + (ob ^ (((ob >> 9) & 1) << 5)); }
__host__ __device__ __forceinline__ void stage_rc(int b, int& R, int& C) { const int st = b / 1024, sb = b % 1024, swz = sb ^ (((sb >> 9) & 1) << 5); R = (st >> 1) * 16 + swz / 64; C = (st & 1) * 32 + (swz % 64) / 2; }
__host__ __device__ __forceinline__ int perm32(int rho) { const int n = rho >> 4, i = rho & 15; return 8 * (i >> 2) + 4 * n + (i & 3); }

struct Unit { int aoff, boff, pm, pn, nt; };
struct Gemm { const bf16_t* A; const bf16_t* Bt; int lda, ldb, K; };

template <class Map> struct Order {
    int nM, nN, nwg, G, c, wgm; Map map;
    __device__ __forceinline__ void init(int nM_, int nN_, int G_, int c_, const Map& m, int wgm_ = WGM) { nM = nM_; nN = nN_; nwg = nM * nN; G = G_; c = c_; map = m; wgm = wgm_; }
    __device__ __forceinline__ bool next(int i, Unit& u) const {
        const long L = (long)i * G + c; if (c < 0 || L >= nwg) return false;
        int wgid = (int)L; { const int q = nwg / NXCD, r = nwg % NXCD, xcd = wgid % NXCD, off = wgid / NXCD; wgid = (xcd < r ? xcd * (q + 1) : r * (q + 1) + (xcd - r) * q) + off; }
        const int nig = wgm * nN, gid = wgid / nig, fm = gid * wgm, gsz = (nM - fm) < wgm ? (nM - fm) : wgm;
        u.pm = fm + ((wgid % nig) % gsz); u.pn = (wgid % nig) / gsz; u.nt = 0; map(u); return true;
    }
    __device__ __forceinline__ void a_ready(const Unit&) const {}
    __device__ __forceinline__ void done(const Unit&) const {}
};
struct MapStd { int lda, ldb; __device__ __forceinline__ void operator()(Unit& u) const { u.aoff = u.pm * BM * lda; u.boff = u.pn * BM * ldb; } };

struct MapStdRev { int lda, ldb, nM; __device__ __forceinline__ void operator()(Unit& u) const { u.pm = nM - 1 - u.pm; u.aoff = u.pm * BM * lda; u.boff = u.pn * BM * ldb; } };

__device__ __forceinline__ unsigned cvt_pk_bf16(float lo, float hi) { unsigned r; asm volatile("v_cvt_pk_bf16_f32 %0, %1, %2" : "=v"(r) : "v"(lo), "v"(hi)); return r; }
__device__ __forceinline__ float bf_lo(unsigned w) { return __uint_as_float(w << 16); }
__device__ __forceinline__ float bf_hi(unsigned w) { return __uint_as_float(w & 0xffff0000u); }
__device__ __forceinline__ float sigmoid_f(float z) { return __builtin_amdgcn_rcpf(1.0f + __builtin_amdgcn_exp2f(-1.4426950408889634f * z)); }
__device__ __forceinline__ int otid() { int t = threadIdx.x; asm volatile("" : "+v"(t)); return t; }
__device__ __forceinline__ int osgpr(int v) { asm volatile("" : "+s"(v)); return v; }
template <int K> __device__ __forceinline__ float sw_xor(float v) { return __int_as_float(__builtin_amdgcn_ds_swizzle(__float_as_int(v), (K << 10) | 0x1f)); }
__device__ __forceinline__ float add_xor32(float v) { auto rr = __builtin_amdgcn_permlane32_swap(__float_as_uint(v), __float_as_uint(v), false, false); return __uint_as_float(rr[0]) + __uint_as_float(rr[1]); }
__device__ __forceinline__ float max_xor32(float v) { auto rr = __builtin_amdgcn_permlane32_swap(__float_as_uint(v), __float_as_uint(v), false, false); return fmaxf(__uint_as_float(rr[0]), __uint_as_float(rr[1])); }
__device__ __forceinline__ float red16_32(float v) { v += sw_xor<16>(v); return add_xor32(v); }
template <class T> __device__ __forceinline__ T* at32(const void* base, unsigned byte_off) { return (T*)((char*)const_cast<void*>(base) + byte_off); }
#define PG8_EPI_ARGS const f32x4 (&acc)[2][2][4][2], const Unit& u, int wr, int wc, int fr, int fq
__device__ __forceinline__ u32x4 pack8(const f32x4 v0, const f32x4 v1) { u32x4 w; w.x = cvt_pk_bf16(v0[0], v0[1]); w.y = cvt_pk_bf16(v0[2], v0[3]); w.z = cvt_pk_bf16(v1[0], v1[1]); w.w = cvt_pk_bf16(v1[2], v1[3]); return w; }


struct Fold { const float* stats; const float* cs; const float* cb; int ident; };
__device__ __forceinline__ void fold_row(const Fold& f, int r, float& mu, float& rs) {
    const f32x2 s = *(const f32x2*)(f.stats + 2 * (size_t)r); mu = s.x * (1.0f / 2048.0f); const float var = s.y * (1.0f / 2048.0f) - mu * mu; rs = __builtin_amdgcn_rsqf(var + 1e-5f);
}
__device__ __forceinline__ void fold_rows8(const Fold& f, int row0, float (&mu)[2][4], float (&rs)[2][4]) {
    f32x2 st[2][4];
#pragma unroll
    for (int ai = 0; ai < 2; ++ai)
#pragma unroll
        for (int m = 0; m < 4; ++m) st[ai][m] = *at32<const f32x2>(f.stats, 8u * (unsigned)(row0 + ai * HALF + m * 16));
#pragma unroll
    for (int ai = 0; ai < 2; ++ai)
#pragma unroll
        for (int m = 0; m < 4; ++m) { mu[ai][m] = st[ai][m].x * (1.0f / 2048.0f); rs[ai][m] = __builtin_amdgcn_rsqf(st[ai][m].y * (1.0f / 2048.0f) - mu[ai][m] * mu[ai][m] + 1e-5f); }
}
__device__ __forceinline__ f32x4 fold4(const f32x4 a, float mu, float rs, const f32x4 cs, const f32x4 cb) { return (a - cs * mu) * rs + cb; }

__device__ __forceinline__ void fold_prefetch(const Fold& f, const Unit& u, PG8_LAS unsigned char* pf) {
    const int tid = otid(), wid = __builtin_amdgcn_readfirstlane(tid >> 6), L = tid & 63, wr = wid >> 2, wc = wid & 3, q = (L >> 3) & 3;
    PG8_LAS unsigned char* slot = pf + wid * 2048;
    __builtin_amdgcn_global_load_lds((const unsigned*)(f.stats + 2 * (u.pm * BM + (L >> 5) * HALF + wr * 64 + (L & 31) * 2)), (PG8_LAS unsigned*)slot, 16, 0, 0);
    __builtin_amdgcn_global_load_lds((const unsigned*)(((q & 2) ? f.cb : f.cs) + u.pn * BM + (q & 1) * HALF + wc * 32 + (L & 7) * 4), (PG8_LAS unsigned*)(slot + 1024), 16, 0, 0);
}
__device__ __forceinline__ void fold_from_lds(PG8_LAS const unsigned char* pf, int wr, int wc, int fr, int fq, f32x4 (&cs)[2][2], f32x4 (&cb)[2][2], float (&mu)[2][4], float (&rs)[2][4]) {
    PG8_LAS const unsigned char* slot = pf + (wr * 4 + wc) * 2048;
    f32x2 st[2][4];
#pragma unroll
    for (int ai = 0; ai < 2; ++ai)
#pragma unroll
        for (int m = 0; m < 4; ++m) st[ai][m] = *(const PG8_LAS f32x2*)(slot + (ai * 64 + m * 16 + fr) * 8);
#pragma unroll
    for (int bj = 0; bj < 2; ++bj)
#pragma unroll
        for (int n = 0; n < 2; ++n) { cs[bj][n] = *(const PG8_LAS f32x4*)(slot + 1024 + (bj * 8 + 2 * fq + n) * 16); cb[bj][n] = *(const PG8_LAS f32x4*)(slot + 1024 + ((2 + bj) * 8 + 2 * fq + n) * 16); }
#pragma unroll
    for (int ai = 0; ai < 2; ++ai)
#pragma unroll
        for (int m = 0; m < 4; ++m) { mu[ai][m] = st[ai][m].x * (1.0f / 2048.0f); rs[ai][m] = __builtin_amdgcn_rsqf(st[ai][m].y * (1.0f / 2048.0f) - mu[ai][m] * mu[ai][m] + 1e-5f); }
}

struct EpiBf16 {
    static constexpr bool PERM = true, AFTER_DRAIN = false, PREF = false;
    bf16_t* O; int ldc; float scale;
    __device__ __forceinline__ void operator()(PG8_EPI_ARGS) const {
        const int row0 = u.pm * BM + wr * 64 + fr, col0 = u.pn * BM + wc * 32 + 8 * fq;
#pragma unroll
        for (int ai = 0; ai < 2; ++ai)
#pragma unroll
            for (int m = 0; m < 4; ++m) { const unsigned bo = 2u * (unsigned)((row0 + ai * HALF + m * 16) * ldc + col0);
#pragma unroll
                for (int bj = 0; bj < 2; ++bj) *at32<u32x4>(O, bo + 2u * bj * HALF) = pack8(acc[ai][bj][m][0] * scale, acc[ai][bj][m][1] * scale); }
    }
};
template <int NBJ> struct EpiF32 {
    static constexpr bool PERM = false, AFTER_DRAIN = false, PREF = false;
    float* O; int ldc;
    __device__ __forceinline__ void operator()(PG8_EPI_ARGS) const {
        const int row0 = u.pm * BM + wr * 64 + fr, col0 = u.pn * (NBJ == 2 ? BM : HALF) + wc * 32 + 4 * fq;
#pragma unroll
        for (int ai = 0; ai < 2; ++ai)
#pragma unroll
            for (int m = 0; m < 4; ++m) { float* rowp = O + (size_t)(row0 + ai * HALF + m * 16) * ldc + col0;
#pragma unroll
                for (int bj = 0; bj < NBJ; ++bj)
#pragma unroll
                    for (int n = 0; n < 2; ++n) *(f32x4*)(rowp + bj * HALF + n * 16) = acc[ai][bj][m][n]; }
    }
};

struct EpiScoresSm {
    static constexpr bool PERM = true, AFTER_DRAIN = false, PREF = false;
    bf16_t* PB; Fold f; PG8_LAS float* xch;
    __device__ __forceinline__ void operator()(PG8_EPI_ARGS) const {
        f32x4 (&s)[2][2][4][2] = const_cast<f32x4 (&)[2][2][4][2]>(acc);
        const int row0 = u.pm * BM + wr * 64 + fr, col0 = u.pn * BM + wc * 32 + 8 * fq, vb = (u.pm >> 6) * 1024, rl0 = wr * 64 + fr;
        { f32x4 cs[2][2], cb[2][2]; float mus[2][4], rss[2][4]; fold_rows8(f, row0, mus, rss);
#pragma unroll
          for (int bj = 0; bj < 2; ++bj)
#pragma unroll
            for (int n = 0; n < 2; ++n) { cs[bj][n] = *(const f32x4*)(f.cs + vb + col0 + bj * HALF + 4 * n); cb[bj][n] = *(const f32x4*)(f.cb + vb + col0 + bj * HALF + 4 * n); }
#pragma unroll
          for (int ai = 0; ai < 2; ++ai)
#pragma unroll
            for (int m = 0; m < 4; ++m) { const float mu = mus[ai][m], rs = rss[ai][m]; float mx = -3.0e38f;
#pragma unroll
                for (int bj = 0; bj < 2; ++bj)
#pragma unroll
                    for (int n = 0; n < 2; ++n) { const f32x4 v = fold4(s[ai][bj][m][n], mu, rs, cs[bj][n], cb[bj][n]) * 1.4426950408889634f; s[ai][bj][m][n] = v;
                        mx = fmaxf(fmaxf(mx, fmaxf(v[0], v[1])), fmaxf(v[2], v[3])); }
                mx = fmaxf(mx, sw_xor<16>(mx)); mx = max_xor32(mx);
                if (fq == 0) xch[(ai * HALF + m * 16 + rl0) * 4 + wc] = mx; } }
        asm volatile("s_waitcnt lgkmcnt(0)" ::: "memory"); __builtin_amdgcn_s_barrier(); asm volatile("" ::: "memory");
#pragma unroll
        for (int ai = 0; ai < 2; ++ai)
#pragma unroll
            for (int m = 0; m < 4; ++m) { const f32x4 q = *(const PG8_LAS f32x4*)(xch + (ai * HALF + m * 16 + rl0) * 4); const float M = fmaxf(fmaxf(q[0], q[1]), fmaxf(q[2], q[3])); float sm = 0.f;
#pragma unroll
                for (int bj = 0; bj < 2; ++bj)
#pragma unroll
                    for (int n = 0; n < 2; ++n) { f32x4 v = s[ai][bj][m][n];
#pragma unroll
                        for (int e = 0; e < 4; ++e) v[e] = __builtin_amdgcn_exp2f(v[e] - M);
                        s[ai][bj][m][n] = v; sm += (v[0] + v[1]) + (v[2] + v[3]); }
                sm = red16_32(sm);
                if (fq == 0) xch[1024 + (ai * HALF + m * 16 + rl0) * 4 + wc] = sm; }
        asm volatile("s_waitcnt lgkmcnt(0)" ::: "memory"); __builtin_amdgcn_s_barrier(); asm volatile("" ::: "memory");
#pragma unroll
        for (int ai = 0; ai < 2; ++ai)
#pragma unroll
            for (int m = 0; m < 4; ++m) { const f32x4 q = *(const PG8_LAS f32x4*)(xch + 1024 + (ai * HALF + m * 16 + rl0) * 4); const float inv = __builtin_amdgcn_rcpf((q[0] + q[1]) + (q[2] + q[3]));
                const unsigned bo = 2u * (unsigned)((row0 + ai * HALF + m * 16) * 1024 + col0);
#pragma unroll
                for (int bj = 0; bj < 2; ++bj) *at32<u32x4>(PB, bo + 2u * bj * HALF) = pack8(s[ai][bj][m][0] * inv, s[ai][bj][m][1] * inv); }
        asm volatile("s_waitcnt lgkmcnt(0)" ::: "memory");
    }
};
struct EpiSwiGLU {
    static constexpr bool PERM = true, AFTER_DRAIN = false, PREF = true;
    bf16_t* O; int ldc; Fold f; PG8_LAS unsigned char* pf;
    __device__ __forceinline__ void pref(const Unit& u) const { if (!f.ident) fold_prefetch(f, u, pf); }
    __device__ __forceinline__ void operator()(PG8_EPI_ARGS) const {
        const int row0 = u.pm * BM + wr * 64 + fr, col0 = u.pn * HALF + wc * 32 + 8 * fq;
        f32x4 cs[2][2], cb[2][2]; float mus[2][4], rss[2][4];
        if (!f.ident) {
            fold_from_lds(pf, wr, wc, fr, fq, cs, cb, mus, rss);
        } else {
#pragma unroll
            for (int ai = 0; ai < 2; ++ai)
#pragma unroll
                for (int m = 0; m < 4; ++m) { mus[ai][m] = 0.f; rss[ai][m] = 1.f; }
        }
#pragma unroll
        for (int ai = 0; ai < 2; ++ai)
#pragma unroll
            for (int m = 0; m < 4; ++m) { const int r = row0 + ai * HALF + m * 16; f32x4 v[2]; const float mu = mus[ai][m], rs = rss[ai][m];
#pragma unroll
                for (int n = 0; n < 2; ++n) { f32x4 g = acc[ai][0][m][n], up = acc[ai][1][m][n];
                    if (!f.ident) { g = fold4(g, mu, rs, cs[0][n], cb[0][n]); up = fold4(up, mu, rs, cs[1][n], cb[1][n]); }
#pragma unroll
                    for (int e = 0; e < 4; ++e) v[n][e] = (g[e] * up[e]) * __builtin_amdgcn_rcpf(1.0f + __builtin_amdgcn_exp2f(-g[e])); }
                *at32<u32x4>(O, 2u * (unsigned)(r * ldc + col0)) = pack8(v[0], v[1]); }
    }
};
template <bool IDENT, bool WF32 = false, int SKIP = 0> struct EpiResLnT {
    static constexpr bool PERM = true, AFTER_DRAIN = false, PREF = false; static constexpr int RB = 4;
    const float* xin; const float* st_old; PG8_LAS const float* lgb; bf16_t* XB; u32x4* LO8; float* yf32; float* st_new; float alpha, scale;
    __device__ __forceinline__ void operator()(PG8_EPI_ARGS) const {
        const int row0 = u.pm * BM + wr * 64 + fr, col0 = u.pn * BM + wc * 32 + 8 * fq;
        PG8_LAS float* xst = const_cast<PG8_LAS float*>(lgb) + 4096;
        u32x4* lop = LO8 + ((size_t)((u.pm * 8 + u.pn) * 8 + wr * 4 + wc) * 8) * 64 + fq * 16 + fr;
#pragma unroll
        for (int ab = 0; ab < 8 / RB; ++ab) { const int ai = (ab * RB) >> 2, m0 = (ab * RB) & 3; float mu[RB], rs[RB], s1[RB], s2[RB]; u32x4 hi[RB][2], lo[RB];
            u32x4 xi[RB][2];
            { f32x2 st[RB];
              if (!IDENT) {
#pragma unroll
                for (int m = 0; m < RB; ++m) st[m] = *at32<const f32x2>(st_old, 8u * (unsigned)(row0 + ai * HALF + (m0 + m) * 16)); }
#pragma unroll
              for (int m = 0; m < RB; ++m) {
                if (!IDENT) lo[m] = (SKIP & 1) ? (u32x4){0u, 0u, 0u, 0u} : __builtin_nontemporal_load(lop + (ai * 4 + m0 + m) * 64);
#pragma unroll
                for (int bj = 0; bj < 2; ++bj) { const unsigned off = (unsigned)((row0 + ai * HALF + (m0 + m) * 16) * 2048 + col0 + bj * HALF);
                    if (IDENT) { hi[m][bj] = *at32<const u32x4>(xin, 4u * off); xi[m][bj] = *at32<const u32x4>(xin, 4u * off + 16u); }
                    else hi[m][bj] = (SKIP & 1) ? (u32x4){0u, 0u, 0u, 0u} : *at32<const u32x4>(XB, 2u * off); } }
              asm volatile("" ::: "memory");
#pragma unroll
              for (int m = 0; m < RB; ++m) { s1[m] = 0.f; s2[m] = 0.f; mu[m] = 0.f; rs[m] = 1.f;
                  if (!IDENT) { mu[m] = st[m].x * (1.0f / 2048.0f); rs[m] = __builtin_amdgcn_rsqf(st[m].y * (1.0f / 2048.0f) - mu[m] * mu[m] + 1e-5f); } } }
            u32x4 lon[RB];
#pragma unroll
            for (int bj = 0; bj < 2; ++bj) { f32x4 gg[2], bb[2];
                if (!IDENT) {
#pragma unroll
                    for (int n = 0; n < 2; ++n) { gg[n] = *(const PG8_LAS f32x4*)(lgb + col0 + bj * HALF + 4 * n); bb[n] = *(const PG8_LAS f32x4*)(lgb + 2048 + col0 + bj * HALF + 4 * n); } }
#pragma unroll
                for (int m = 0; m < RB; ++m) { const unsigned off = (unsigned)((row0 + ai * HALF + (m0 + m) * 16) * 2048 + col0 + bj * HALF); f32x4 v[2]; const u32x4 h0 = hi[m][bj];
                    if (IDENT) { const u32x4 l0 = xi[m][bj]; v[0] = (f32x4){__uint_as_float(h0.x), __uint_as_float(h0.y), __uint_as_float(h0.z), __uint_as_float(h0.w)}; v[1] = (f32x4){__uint_as_float(l0.x), __uint_as_float(l0.y), __uint_as_float(l0.z), __uint_as_float(l0.w)}; }
                    else { const unsigned w0 = bj ? lo[m].z : lo[m].x, w1 = bj ? lo[m].w : lo[m].y;
                           const f32x2 a0 = __builtin_amdgcn_cvt_pk_f32_fp8((int)w0, false), a1 = __builtin_amdgcn_cvt_pk_f32_fp8((int)w0, true), a2 = __builtin_amdgcn_cvt_pk_f32_fp8((int)w1, false), a3 = __builtin_amdgcn_cvt_pk_f32_fp8((int)w1, true);
                           v[0] = (f32x4){bf_lo(h0.x) + a0.x * 0.00390625f, bf_hi(h0.x) + a0.y * 0.00390625f, bf_lo(h0.y) + a1.x * 0.00390625f, bf_hi(h0.y) + a1.y * 0.00390625f};
                           v[1] = (f32x4){bf_lo(h0.z) + a2.x * 0.00390625f, bf_hi(h0.z) + a2.y * 0.00390625f, bf_lo(h0.w) + a3.x * 0.00390625f, bf_hi(h0.w) + a3.y * 0.00390625f}; }
#pragma unroll
                    for (int n = 0; n < 2; ++n) { f32x4 x = v[n];
                        if (!IDENT) x = (x - mu[m]) * rs[m] * gg[n] + bb[n];
                        v[n] = x * alpha + acc[ai][bj][m0 + m][n] * scale;
                        if (WF32) *at32<f32x4>(yf32, 4u * off + 16u * n) = v[n];
                        s1[m] += (v[n][0] + v[n][1]) + (v[n][2] + v[n][3]); s2[m] += (v[n][0] * v[n][0] + v[n][1] * v[n][1]) + (v[n][2] * v[n][2] + v[n][3] * v[n][3]); }
                    const u32x4 h = pack8(v[0], v[1]);
                    const f32x4 d0 = {(v[0][0] - bf_lo(h.x)) * 256.0f, (v[0][1] - bf_hi(h.x)) * 256.0f, (v[0][2] - bf_lo(h.y)) * 256.0f, (v[0][3] - bf_hi(h.y)) * 256.0f},
                                d1 = {(v[1][0] - bf_lo(h.z)) * 256.0f, (v[1][1] - bf_hi(h.z)) * 256.0f, (v[1][2] - bf_lo(h.w)) * 256.0f, (v[1][3] - bf_hi(h.w)) * 256.0f};
                    int e0 = __builtin_amdgcn_cvt_pk_fp8_f32(d0[0], d0[1], 0, false); e0 = __builtin_amdgcn_cvt_pk_fp8_f32(d0[2], d0[3], e0, true);
                    int e1 = __builtin_amdgcn_cvt_pk_fp8_f32(d1[0], d1[1], 0, false); e1 = __builtin_amdgcn_cvt_pk_fp8_f32(d1[2], d1[3], e1, true);
                    if (bj == 0) { lon[m].x = (unsigned)e0; lon[m].y = (unsigned)e1; } else { lon[m].z = (unsigned)e0; lon[m].w = (unsigned)e1; }
                    if (!(SKIP & 2)) *at32<u32x4>(XB, 2u * off) = h; } }
#pragma unroll
            for (int m = 0; m < RB; ++m) { if (!(SKIP & 2)) __builtin_nontemporal_store(lon[m], lop + (ai * 4 + m0 + m) * 64);
                const float a = red16_32(s1[m]), b = red16_32(s2[m]);
                if (fq == 0) { const int rl = ai * HALF + wr * 64 + (m0 + m) * 16 + fr; xst[rl * 8 + wc] = a; xst[rl * 8 + 4 + wc] = b; } }
            asm volatile("" ::: "memory"); }
        asm volatile("s_waitcnt lgkmcnt(0)" ::: "memory"); __builtin_amdgcn_s_barrier(); asm volatile("" ::: "memory");
        { const int t = (wr * 4 + wc) * 64 + fq * 16 + fr;
          if (t < 256 && st_new && !(SKIP & 4)) { const PG8_LAS float* p = xst + t * 8; const float sa = (p[0] + p[1]) + (p[2] + p[3]), sb = (p[4] + p[5]) + (p[6] + p[7]); float* dst = st_new + 2 * (size_t)(row0 - wr * 64 - fr + t);
              unsafeAtomicAdd(dst, sa); unsafeAtomicAdd(dst + 1, sb); }
          asm volatile("s_waitcnt lgkmcnt(0)" ::: "memory"); }
    }
};
typedef EpiResLnT<false> EpiResLn; typedef EpiResLnT<true> EpiResLn0; typedef EpiResLnT<false, true> EpiResLnF;
struct EpiMqt {
    static constexpr bool PERM = true, AFTER_DRAIN = false, PREF = false;
    bf16_t* O; int ldc; float scale; const float* gk; const float* bk; float* cs; float* cb;
    __device__ __forceinline__ void operator()(PG8_EPI_ARGS) const {
        const int row0 = u.pm * BM + wr * 64 + fr, col0 = u.pn * BM + wc * 32 + 8 * fq;
        f32x4 gg[2][2], bb[2][2];
#pragma unroll
        for (int bj = 0; bj < 2; ++bj)
#pragma unroll
            for (int n = 0; n < 2; ++n) { gg[bj][n] = *(const f32x4*)(gk + col0 + bj * HALF + 4 * n); bb[bj][n] = *(const f32x4*)(bk + col0 + bj * HALF + 4 * n); }
#pragma unroll
        for (int ai = 0; ai < 2; ++ai)
#pragma unroll
            for (int m = 0; m < 4; ++m) { const int r = row0 + ai * HALF + m * 16; float s1 = 0.f, s2 = 0.f;
#pragma unroll
                for (int bj = 0; bj < 2; ++bj) { const f32x4 v0 = acc[ai][bj][m][0] * scale, v1 = acc[ai][bj][m][1] * scale;
                    const u32x4 w = pack8(v0 * gg[bj][0], v1 * gg[bj][1]);
                    *(u32x4*)(O + (size_t)r * ldc + col0 + bj * HALF) = w;
                    s1 += (bf_lo(w.x) + bf_hi(w.x)) + (bf_lo(w.y) + bf_hi(w.y)) + (bf_lo(w.z) + bf_hi(w.z)) + (bf_lo(w.w) + bf_hi(w.w));
                    const f32x4 t0 = v0 * bb[bj][0], t1 = v1 * bb[bj][1]; s2 += (t0[0] + t0[1]) + (t0[2] + t0[3]) + (t1[0] + t1[1]) + (t1[2] + t1[3]); }
                s1 = red16_32(s1); s2 = red16_32(s2);
                if (fq == 0) { unsafeAtomicAdd(cs + r, s1); unsafeAtomicAdd(cb + r, s2); } }
    }
};
template <int UGP> struct EpiWin {
    static constexpr bool PERM = true, AFTER_DRAIN = false, PREF = true;
    bf16_t* QKV; bf16_t* UG; float qscale; Fold f; PG8_LAS unsigned char* pf;
    __device__ __forceinline__ void pref(const Unit& u) const { fold_prefetch(f, u, pf); }
    __device__ __forceinline__ void operator()(PG8_EPI_ARGS) const {
        const int row0 = u.pm * BM + wr * 64 + fr;
        f32x4 cs[2][2], cb[2][2]; float mus[2][4], rss[2][4]; fold_from_lds(pf, wr, wc, fr, fq, cs, cb, mus, rss);
        if (u.pn < 12) {
            const float sc = u.pn < 4 ? qscale : 1.0f; const int col0 = u.pn * BM + wc * 32 + 8 * fq;
#pragma unroll
            for (int ai = 0; ai < 2; ++ai)
#pragma unroll
                for (int m = 0; m < 4; ++m) { const int r = row0 + ai * HALF + m * 16; const float mu = mus[ai][m], rs = rss[ai][m]; const unsigned bo = 2u * (unsigned)(r * 3072 + col0);
#pragma unroll
                    for (int bj = 0; bj < 2; ++bj) *at32<u32x4>(QKV, bo + 2u * bj * HALF) = pack8(fold4(acc[ai][bj][m][0], mu, rs, cs[bj][0], cb[bj][0]) * sc, fold4(acc[ai][bj][m][1], mu, rs, cs[bj][1], cb[bj][1]) * sc); }
        } else {
#pragma unroll
            for (int ai = 0; ai < 2; ++ai)
#pragma unroll
                for (int m = 0; m < 4; ++m) { const int r = row0 + ai * HALF + m * 16, b = r >> 14, c = (r >> 6) & 255, s = r & 63; const float mu = mus[ai][m], rs = rss[ai][m];
#pragma unroll
                    for (int bj = 0; bj < 2; ++bj) { const int j0 = (u.pn - 12) * BM + bj * HALF + wc * 32 + 8 * fq, g = j0 >> 4, q0 = j0 & 15;
                        *at32<u32x4>(UG, 2u * (unsigned)((g * 512 + b * 256 + c) * UGP + 128 + s * 16 + q0)) = pack8(fold4(acc[ai][bj][m][0], mu, rs, cs[bj][0], cb[bj][0]), fold4(acc[ai][bj][m][1], mu, rs, cs[bj][1], cb[bj][1])); } }
        }
    }
};
template <int UGP> struct EpiSsmY {
    static constexpr bool PERM = true, AFTER_DRAIN = false, PREF = false;
    const bf16_t* UG; const float* dskip; bf16_t* YG;
    __device__ __forceinline__ void operator()(PG8_EPI_ARGS) const {
        const int R0 = u.pm * BM + wr * 64 + fr, g = R0 >> 9, b = (R0 >> 8) & 1;
        f32x4 d0[2], d1[2];
#pragma unroll
        for (int bj = 0; bj < 2; ++bj) { const int p0 = (bj * HALF + wc * 32 + 8 * fq) & 15; d0[bj] = *(const f32x4*)(dskip + g * 16 + p0); d1[bj] = *(const f32x4*)(dskip + g * 16 + p0 + 4); }
#pragma unroll
        for (int ai = 0; ai < 2; ++ai) { u32x4 uu[4][2];
#pragma unroll
            for (int m = 0; m < 4; ++m)
#pragma unroll
                for (int bj = 0; bj < 2; ++bj) uu[m][bj] = *at32<const u32x4>(UG, 2u * (unsigned)((R0 + ai * HALF + m * 16) * UGP + 128 + u.pn * BM + bj * HALF + wc * 32 + 8 * fq));
            asm volatile("" ::: "memory");
#pragma unroll
            for (int m = 0; m < 4; ++m) { const int c = (R0 + ai * HALF + m * 16) & 255;
#pragma unroll
                for (int bj = 0; bj < 2; ++bj) { const int col = u.pn * BM + bj * HALF + wc * 32 + 8 * fq, t = col >> 4, p0 = col & 15; const u32x4 w = uu[m][bj];
                    f32x4 y0 = acc[ai][bj][m][0], y1 = acc[ai][bj][m][1];
                    y0[0] += d0[bj][0] * bf_lo(w.x); y0[1] += d0[bj][1] * bf_hi(w.x); y0[2] += d0[bj][2] * bf_lo(w.y); y0[3] += d0[bj][3] * bf_hi(w.y);
                    y1[0] += d1[bj][0] * bf_lo(w.z); y1[1] += d1[bj][1] * bf_hi(w.z); y1[2] += d1[bj][2] * bf_lo(w.w); y1[3] += d1[bj][3] * bf_hi(w.w);
#pragma unroll
                    for (int e = 0; e < 4; ++e) { const float a = y0[e], bq = y1[e];
                        y0[e] = a * __builtin_amdgcn_rcpf(1.0f + __builtin_amdgcn_exp2f(-2.3022081983f * (a + 0.044715f * a * a * a))); y1[e] = bq * __builtin_amdgcn_rcpf(1.0f + __builtin_amdgcn_exp2f(-2.3022081983f * (bq + 0.044715f * bq * bq * bq))); }
                    *at32<u32x4>(YG, 2u * (unsigned)((b * 16384 + c * 64 + t) * 1024 + g * 16 + p0)) = pack8(y0, y1); } }
            asm volatile("" ::: "memory"); }
    }
};
struct EpiGlu {
    static constexpr bool PERM = true, AFTER_DRAIN = false, PREF = false;
    const bf16_t* YG; const float* bias; bf16_t* MIX;
    __device__ __forceinline__ void operator()(PG8_EPI_ARGS) const {
        const int row0 = u.pm * BM + wr * 64 + fr, col0 = u.pn * BM + wc * 32 + 8 * fq;
        f32x4 b0[2], b1[2];
#pragma unroll
        for (int bj = 0; bj < 2; ++bj) { b0[bj] = *(const f32x4*)(bias + col0 + bj * HALF); b1[bj] = *(const f32x4*)(bias + col0 + bj * HALF + 4); }
#pragma unroll
        for (int ai = 0; ai < 2; ++ai) { u32x4 yy[4][2];
#pragma unroll
            for (int m = 0; m < 4; ++m)
#pragma unroll
                for (int bj = 0; bj < 2; ++bj) yy[m][bj] = *at32<const u32x4>(YG, 2u * (unsigned)((row0 + ai * HALF + m * 16) * 1024 + col0 + bj * HALF));
            asm volatile("" ::: "memory");
#pragma unroll
            for (int m = 0; m < 4; ++m) { const int r = row0 + ai * HALF + m * 16;
#pragma unroll
                for (int bj = 0; bj < 2; ++bj) { const u32x4 w = yy[m][bj];
                    const f32x4 z0 = acc[ai][bj][m][0] + b0[bj], z1 = acc[ai][bj][m][1] + b1[bj]; f32x4 o0, o1;
                    o0[0] = bf_lo(w.x) * sigmoid_f(z0[0]); o0[1] = bf_hi(w.x) * sigmoid_f(z0[1]); o0[2] = bf_lo(w.y) * sigmoid_f(z0[2]); o0[3] = bf_hi(w.y) * sigmoid_f(z0[3]);
                    o1[0] = bf_lo(w.z) * sigmoid_f(z1[0]); o1[1] = bf_hi(w.z) * sigmoid_f(z1[1]); o1[2] = bf_lo(w.w) * sigmoid_f(z1[2]); o1[3] = bf_hi(w.w) * sigmoid_f(z1[3]);
                    *at32<u32x4>(MIX, 2u * (unsigned)(r * 2048 + 1024 + col0 + bj * HALF)) = pack8(o0, o1); } }
            asm volatile("" ::: "memory"); }
    }
};
#ifndef PG8_ASMDMA
#define PG8_ASMDMA 1
#endif
#ifndef PG8_BAL
#define PG8_BAL 1
#endif
template <class Epi, class Sched, bool ALIGN_EPI = false, bool SP2 = false>
__device__ __forceinline__ void gemm_phase(PG8_LAS unsigned char* lds, const Gemm g, const Sched& S, const Epi& E) {
    const int tid = otid(), wid = __builtin_amdgcn_readfirstlane(tid >> 6), lane = tid & 63, wr = wid >> 2, wc = wid & 3, fr = lane & 15, fq = lane >> 4;
    const int K = g.K, nt_def = K / BK;
    unsigned voffA[2], voffB[2];
#pragma unroll
    for (int i = 0; i < 2; ++i) { int R, C; stage_rc(tid * 16 + i * 8192, R, C); const int Rb = Epi::PERM ? ((R & ~31) + perm32(R & 31)) : R;
        voffA[i] = (unsigned)(R * g.lda + C) * 2u; voffB[i] = (unsigned)(Rb * g.ldb + C) * 2u; }
    const size_t kstep = (size_t)(BK * 2);
    const size_t hstepA = (size_t)HALF * g.lda * 2, hstepB = (size_t)HALF * g.ldb * 2;
    const unsigned ldsbase = (unsigned)(__UINTPTR_TYPE__)lds;
    const unsigned ldsw = (unsigned)wid * 1024u;
    const int aoff = lds_byte(wr * 64 + fr, fq * 8), boff = lds_byte(wc * 32 + fr, fq * 8);
#define PG8_SA(b, h) (((b) * 2 + (h)) * HTB)
#define PG8_SB(b, h) ((4 + (b) * 2 + (h)) * HTB)
#if PG8_ASMDMA
#define PG8_STAGE(bufoff, gbase, voff) do { _Pragma("unroll") for (int _i = 0; _i < 2; ++_i) { \
        const unsigned la_ = (unsigned)__builtin_amdgcn_readfirstlane((int)(ldsbase + (unsigned)(bufoff) + ldsw + (unsigned)(_i * 8192))); const char* gb_ = (const char*)(gbase); \
        asm volatile("s_mov_b32 m0, %2\n\ts_nop 0\n\tglobal_load_lds_dwordx4 %0, %1" :: "v"((voff)[_i]), "s"(gb_), "s"(la_) : "memory", "m0"); } } while (0)
#else
#define PG8_STAGE(bufoff, gbase, voff) do { _Pragma("unroll") for (int _i = 0; _i < 2; ++_i) \
        __builtin_amdgcn_global_load_lds((const unsigned*)((const char*)(gbase) + (voff)[_i]), (PG8_LAS unsigned*)(lds + (bufoff) + ldsw + _i * 8192), 16, 0, 0); } while (0)
#endif
#define PG8_LDA(dst, b, h) do { _Pragma("unroll") for (int m = 0; m < 4; ++m) _Pragma("unroll") for (int k = 0; k < 2; ++k) dst[m][k] = *(const PG8_LAS bf16x8*)(lds + PG8_SA(b, h) + aoff + m * 2048 + k * 1024); } while (0)
#define PG8_LDB(dst, b, h) do { _Pragma("unroll") for (int n = 0; n < 2; ++n) _Pragma("unroll") for (int k = 0; k < 2; ++k) dst[n][k] = *(const PG8_LAS bf16x8*)(lds + PG8_SB(b, h) + boff + n * 2048 + k * 1024); } while (0)
#define PG8_MMA(ai, bj, At, Bt) do { _Pragma("unroll") for (int m = 0; m < 4; ++m) _Pragma("unroll") for (int n = 0; n < 2; ++n) _Pragma("unroll") for (int k = 0; k < 2; ++k) \
        acc[ai][bj][m][n] = __builtin_amdgcn_mfma_f32_16x16x32_bf16(Bt[n][k], At[m][k], acc[ai][bj][m][n], 0, 0, 0); } while (0)
#define PG8_WAIT_V(n) asm volatile("s_waitcnt vmcnt(" #n ")" ::: "memory")
#define PG8_WAIT_L(n) asm volatile("s_waitcnt lgkmcnt(" #n ")" ::: "memory")
#define PG8_BAR __builtin_amdgcn_s_barrier()
#define PG8_SCHED __builtin_amdgcn_sched_barrier(0)
    Unit cur, nxt; int ui = 0;
    if (!S.next(0, cur)) return;
    f32x4 acc[2][2][4][2];
#pragma unroll
    for (int a = 0; a < 2; ++a)
#pragma unroll
        for (int b = 0; b < 2; ++b)
#pragma unroll
            for (int m = 0; m < 4; ++m)
#pragma unroll
                for (int n = 0; n < 2; ++n) acc[a][b][m][n] = (f32x4){0.f, 0.f, 0.f, 0.f};
    bf16x8 At[4][2], B0[2][2], B1[2][2];
    const char* cA = (const char*)g.A + (size_t)cur.aoff * 2; const char* cB = (const char*)g.Bt + (size_t)cur.boff * 2;
    S.a_ready(cur);
    if constexpr (SP2) {
        PG8_STAGE(PG8_SB(0, 0), cB, voffB); PG8_STAGE(PG8_SB(0, 1), cB + hstepB, voffB); PG8_STAGE(PG8_SA(0, 0), cA, voffA); PG8_STAGE(PG8_SA(0, 1), cA + hstepA, voffA);
        if (wr == 1) PG8_BAR;
        PG8_WAIT_V(2); PG8_BAR;
#if PG8_BAL
        PG8_STAGE(PG8_SB(1, 0), cB + kstep, voffB); PG8_STAGE(PG8_SB(1, 1), cB + hstepB + kstep, voffB);
        PG8_WAIT_V(4); PG8_BAR;
#else
        PG8_STAGE(PG8_SB(1, 0), cB + kstep, voffB); PG8_STAGE(PG8_SA(1, 0), cA + kstep, voffA); PG8_STAGE(PG8_SB(1, 1), cB + hstepB + kstep, voffB);
        PG8_WAIT_V(6); PG8_BAR;
#endif
    } else {
        PG8_STAGE(PG8_SB(0, 0), cB, voffB); PG8_STAGE(PG8_SA(0, 0), cA, voffA); PG8_STAGE(PG8_SB(0, 1), cB + hstepB, voffB); PG8_STAGE(PG8_SA(0, 1), cA + hstepA, voffA);
        if (wr == 1) PG8_BAR;
        PG8_WAIT_V(4); PG8_BAR;
        PG8_STAGE(PG8_SB(1, 0), cB + kstep, voffB); PG8_STAGE(PG8_SA(1, 0), cA + kstep, voffA); PG8_STAGE(PG8_SB(1, 1), cB + hstepB + kstep, voffB);
        PG8_WAIT_V(6); PG8_BAR;
    }
    for (;;) {
        const bool has_next = S.next(ui + 1, nxt);
        const char* nA = has_next ? (const char*)g.A + (size_t)nxt.aoff * 2 : cA; const char* nB = has_next ? (const char*)g.Bt + (size_t)nxt.boff * 2 : cB;
        const int nt = cur.nt ? cur.nt : nt_def;
        for (int t = 0; t < nt; t += 2) {
            const bool last = (t == nt - 2);
            const char* a1 = cA + (size_t)(t + 1) * kstep;
            const char* a2 = last ? nA : cA + (size_t)(t + 2) * kstep; const char* b2 = last ? nB : cB + (size_t)(t + 2) * kstep;
            const char* a3 = a2 + kstep; const char* b3 = b2 + kstep;
            if (last && has_next) S.a_ready(nxt);
            if constexpr (Epi::PREF) { if (last) E.pref(cur); }
            if constexpr (SP2) {
#if PG8_BAL
            PG8_LDB(B0, 0, 0); PG8_LDB(B1, 0, 1); PG8_SCHED; PG8_LDA(At, 0, 0); PG8_STAGE(PG8_SA(1, 0), a1, voffA); PG8_STAGE(PG8_SA(1, 1), a1 + hstepA, voffA);
            PG8_WAIT_V(8); PG8_WAIT_L(0); __builtin_amdgcn_s_setprio(1); PG8_BAR; PG8_MMA(0, 0, At, B0); PG8_MMA(0, 1, At, B1); __builtin_amdgcn_s_setprio(0); PG8_BAR; PG8_SCHED;
            PG8_LDA(At, 0, 1); PG8_STAGE(PG8_SB(0, 0), b2, voffB); PG8_STAGE(PG8_SB(0, 1), b2 + hstepB, voffB);
            PG8_WAIT_V(6); PG8_WAIT_L(0); __builtin_amdgcn_s_setprio(1); PG8_BAR; PG8_MMA(1, 0, At, B0); PG8_MMA(1, 1, At, B1); __builtin_amdgcn_s_setprio(0); PG8_BAR; PG8_SCHED;
            PG8_LDB(B0, 1, 0); PG8_LDB(B1, 1, 1); PG8_SCHED; PG8_LDA(At, 1, 0); PG8_STAGE(PG8_SA(0, 0), a2, voffA); PG8_STAGE(PG8_SA(0, 1), a2 + hstepA, voffA);
            PG8_WAIT_V(8); PG8_WAIT_L(0); __builtin_amdgcn_s_setprio(1); PG8_BAR; PG8_MMA(0, 0, At, B0); PG8_MMA(0, 1, At, B1); __builtin_amdgcn_s_setprio(0); PG8_BAR; PG8_SCHED;
            PG8_LDA(At, 1, 1); PG8_STAGE(PG8_SB(1, 0), b3, voffB); PG8_STAGE(PG8_SB(1, 1), b3 + hstepB, voffB);
            PG8_WAIT_V(6); PG8_WAIT_L(0); __builtin_amdgcn_s_setprio(1); PG8_BAR; PG8_MMA(1, 0, At, B0); PG8_MMA(1, 1, At, B1); __builtin_amdgcn_s_setprio(0); PG8_BAR; PG8_SCHED;
            (void)a3;
#else
            PG8_LDB(B0, 0, 0); PG8_LDB(B1, 0, 1); PG8_SCHED; PG8_LDA(At, 0, 0); PG8_STAGE(PG8_SA(1, 1), a1 + hstepA, voffA);
            PG8_WAIT_V(8); PG8_WAIT_L(0); __builtin_amdgcn_s_setprio(1); PG8_BAR; PG8_MMA(0, 0, At, B0); PG8_MMA(0, 1, At, B1); __builtin_amdgcn_s_setprio(0); PG8_BAR; PG8_SCHED;
            PG8_LDA(At, 0, 1); PG8_STAGE(PG8_SB(0, 0), b2, voffB); PG8_STAGE(PG8_SB(0, 1), b2 + hstepB, voffB); PG8_STAGE(PG8_SA(0, 0), a2, voffA);
            PG8_WAIT_V(8); PG8_WAIT_L(0); __builtin_amdgcn_s_setprio(1); PG8_BAR; PG8_MMA(1, 0, At, B0); PG8_MMA(1, 1, At, B1); __builtin_amdgcn_s_setprio(0); PG8_BAR; PG8_SCHED;
            PG8_LDB(B0, 1, 0); PG8_LDB(B1, 1, 1); PG8_SCHED; PG8_LDA(At, 1, 0); PG8_STAGE(PG8_SA(0, 1), a2 + hstepA, voffA);
            PG8_WAIT_V(8); PG8_WAIT_L(0); __builtin_amdgcn_s_setprio(1); PG8_BAR; PG8_MMA(0, 0, At, B0); PG8_MMA(0, 1, At, B1); __builtin_amdgcn_s_setprio(0); PG8_BAR; PG8_SCHED;
            PG8_LDA(At, 1, 1); PG8_STAGE(PG8_SB(1, 0), b3, voffB); PG8_STAGE(PG8_SB(1, 1), b3 + hstepB, voffB); PG8_STAGE(PG8_SA(1, 0), a3, voffA);
            PG8_WAIT_V(8); PG8_WAIT_L(0); __builtin_amdgcn_s_setprio(1); PG8_BAR; PG8_MMA(1, 0, At, B0); PG8_MMA(1, 1, At, B1); __builtin_amdgcn_s_setprio(0); PG8_BAR; PG8_SCHED;
#endif
            } else {
            PG8_LDB(B0, 0, 0); PG8_SCHED; PG8_LDA(At, 0, 0); PG8_STAGE(PG8_SA(1, 1), a1 + hstepA, voffA);
            PG8_WAIT_L(8); PG8_BAR; PG8_WAIT_L(0); __builtin_amdgcn_s_setprio(1); PG8_MMA(0, 0, At, B0); __builtin_amdgcn_s_setprio(0); PG8_BAR; PG8_SCHED;
            PG8_LDB(B1, 0, 1); PG8_STAGE(PG8_SB(0, 0), b2, voffB);
            PG8_BAR; PG8_WAIT_L(0); __builtin_amdgcn_s_setprio(1); PG8_MMA(0, 1, At, B1); __builtin_amdgcn_s_setprio(0); PG8_BAR;
            PG8_LDA(At, 0, 1); PG8_STAGE(PG8_SA(0, 0), a2, voffA);
            PG8_BAR; PG8_WAIT_L(0); __builtin_amdgcn_s_setprio(1); PG8_MMA(1, 0, At, B0); __builtin_amdgcn_s_setprio(0); PG8_BAR; PG8_SCHED;
            PG8_STAGE(PG8_SB(0, 1), b2 + hstepB, voffB);
            PG8_WAIT_V(6); PG8_BAR; __builtin_amdgcn_s_setprio(1); PG8_MMA(1, 1, At, B1); __builtin_amdgcn_s_setprio(0); PG8_BAR;
            PG8_LDB(B0, 1, 0); PG8_SCHED; PG8_LDA(At, 1, 0); PG8_STAGE(PG8_SA(0, 1), a2 + hstepA, voffA);
            PG8_WAIT_L(8); PG8_BAR; PG8_WAIT_L(0); __builtin_amdgcn_s_setprio(1); PG8_MMA(0, 0, At, B0); __builtin_amdgcn_s_setprio(0); PG8_BAR; PG8_SCHED;
            PG8_LDB(B1, 1, 1); PG8_STAGE(PG8_SB(1, 0), b3, voffB);
            PG8_BAR; PG8_WAIT_L(0); __builtin_amdgcn_s_setprio(1); PG8_MMA(0, 1, At, B1); __builtin_amdgcn_s_setprio(0); PG8_BAR;
            PG8_LDA(At, 1, 1); PG8_STAGE(PG8_SA(1, 0), a3, voffA);
            PG8_BAR; PG8_WAIT_L(0); __builtin_amdgcn_s_setprio(1); PG8_MMA(1, 0, At, B0); __builtin_amdgcn_s_setprio(0); PG8_BAR; PG8_SCHED;
            PG8_STAGE(PG8_SB(1, 1), b3 + hstepB, voffB);
            PG8_WAIT_V(6); PG8_BAR; __builtin_amdgcn_s_setprio(1); PG8_MMA(1, 1, At, B1); __builtin_amdgcn_s_setprio(0); PG8_BAR;
            }
        }
        if constexpr (ALIGN_EPI) { if (wr == 0) PG8_BAR; }
        if constexpr (!Epi::AFTER_DRAIN) { E(acc, cur, wr, wc, fr, fq); S.done(cur); }
        if (!has_next) break;
#pragma unroll
        for (int a = 0; a < 2; ++a)
#pragma unroll
            for (int b = 0; b < 2; ++b)
#pragma unroll
                for (int m = 0; m < 4; ++m)
#pragma unroll
                    for (int n = 0; n < 2; ++n) acc[a][b][m][n] = (f32x4){0.f, 0.f, 0.f, 0.f};
        cur = nxt; cA = nA; cB = nB; ++ui;
        if constexpr (ALIGN_EPI) { if (wr == 1) PG8_BAR; }
    }
    PG8_WAIT_V(0);
    if constexpr (!ALIGN_EPI) { if (wr == 0) PG8_BAR; }
    PG8_BAR;
    if constexpr (Epi::AFTER_DRAIN) { E.fused(acc, cur, wr, wc, fr, fq, lds, wid, lane); S.done(cur); }
#undef PG8_SA
#undef PG8_SB
#undef PG8_STAGE
#undef PG8_LDA
#undef PG8_LDB
#undef PG8_MMA
#undef PG8_WAIT_V
#undef PG8_WAIT_L
#undef PG8_BAR
#undef PG8_SCHED
}
}
#include <hip/hip_bf16.h>
#include <cmath>
namespace attn_body {
using bf16=__hip_bfloat16;
using bf16x8=__attribute__((ext_vector_type(8)))short;
using s16x4=__attribute__((ext_vector_type(4)))short;
using f32x16=__attribute__((ext_vector_type(16)))float;
using u32x4=__attribute__((ext_vector_type(4)))unsigned;
constexpr int BATCH=2,NVH=32,SEQ=16384,D=64,DM=3072,DMO=2048;
constexpr int NW=8,QBLK=32,QB=QBLK*NW,KVBLK=64,NQB=SEQ/QB;
constexpr int ATTN_PITCH=DM, ATTN_UNIT_ROWS=QB;
__device__ __forceinline__ int crow(int r,int hi){return (r&3)+8*(r>>2)+4*hi;}
#define SBAR() __builtin_amdgcn_sched_barrier(0)
__device__ __forceinline__ void cmask(f32x16&p0,f32x16&p1,int jb,int qrel,int hi){
  const float NEG=-INFINITY; (void)hi;
  if(jb>(qrel>>6)){
  #pragma unroll
  for(int r=0;r<16;++r){p0[r]=NEG;p1[r]=NEG;}}
}

constexpr int NSLOT=3, SLOTB=8192;
constexpr int LDS_K=0, LDS_V=NSLOT*SLOTB, LDS_WS=2*NSLOT*SLOTB, LDS_OST=LDS_WS+NW*64*4, LDS_BYTES=LDS_OST+NW*4096;
constexpr float C2=0.125f*1.4426950408889634f;
__device__ __forceinline__ void glds16(const void*gsrc,unsigned lds_dst){unsigned keep;
  asm volatile("s_mov_b32 %0, m0\n\ts_mov_b32 m0, %2\n\ts_nop 0\n\tglobal_load_lds_dwordx4 %1, off\n\ts_mov_b32 m0, %0":"=&s"(keep):"v"(gsrc),"s"(lds_dst):"memory");}
__device__ __forceinline__ void glds16s(const void*gbase,unsigned voff,unsigned lds_dst){
  asm volatile("s_mov_b32 m0, %2\n\ts_nop 0\n\tglobal_load_lds_dwordx4 %0, %1"::"v"(voff),"s"(gbase),"s"(lds_dst):"memory","m0");}
__device__ __forceinline__ float max3f(float a,float b,float c){float r;asm("v_max3_f32 %0, %1, %2, %3":"=v"(r):"v"(a),"v"(b),"v"(c));return r;}
__device__ __forceinline__ float max2f(float a,float b){float r;asm("v_max_f32_e32 %0, %1, %2":"=v"(r):"v"(a),"v"(b));return r;}
__device__ __forceinline__ float fadd_s(float a,float b){float r;asm("v_add_f32_e32 %0, %1, %2":"=v"(r):"v"(a),"v"(b));return r;}
__device__ __forceinline__ float fsub_s(float a,float b){float r;asm("v_sub_f32_e32 %0, %1, %2":"=v"(r):"v"(a),"v"(b));return r;}
typedef float f32x2_t __attribute__((ext_vector_type(2))); typedef __bf16 bf16x2_t __attribute__((ext_vector_type(2)));
__device__ __forceinline__ unsigned cvtpk_s(float lo,float hi){f32x2_t v={lo,hi};bf16x2_t b=__builtin_convertvector(v,bf16x2_t);return __builtin_bit_cast(unsigned,b);}
#define WAIT_BAR(N) asm volatile("s_waitcnt vmcnt(" #N ") lgkmcnt(0)\n\ts_barrier":::"memory")

__device__ __forceinline__ void qkt(f32x16&p0,f32x16&p1,const char*Kslot,const bf16x8*qr,const f32x16&negm,int r32,int hi){
  const char*kb=Kslot+hi*1024+r32*16;
  #pragma unroll
  for(int d0=0;d0<4;++d0){
    const bf16x8 b0=*reinterpret_cast<const bf16x8*>(kb+d0*2048);
    const bf16x8 b1=*reinterpret_cast<const bf16x8*>(kb+d0*2048+512);
    if(d0==0){p0=__builtin_amdgcn_mfma_f32_32x32x16_bf16(b0,qr[0],negm,0,0,0);p1=__builtin_amdgcn_mfma_f32_32x32x16_bf16(b1,qr[0],negm,0,0,0);}
    else{p0=__builtin_amdgcn_mfma_f32_32x32x16_bf16(b0,qr[d0],p0,0,0,0);p1=__builtin_amdgcn_mfma_f32_32x32x16_bf16(b1,qr[d0],p1,0,0,0);}}
}
typedef __attribute__((address_space(3))) const char* lds_cptr;
typedef short v4i16_t __attribute__((ext_vector_type(4)));
__device__ __forceinline__ void kload8(bf16x8*kf,lds_cptr kp){
  kf[0]=*(const __attribute__((address_space(3))) bf16x8*)(kp);      kf[1]=*(const __attribute__((address_space(3))) bf16x8*)(kp+512);
  kf[2]=*(const __attribute__((address_space(3))) bf16x8*)(kp+2048); kf[3]=*(const __attribute__((address_space(3))) bf16x8*)(kp+2560);
  kf[4]=*(const __attribute__((address_space(3))) bf16x8*)(kp+4096); kf[5]=*(const __attribute__((address_space(3))) bf16x8*)(kp+4608);
  kf[6]=*(const __attribute__((address_space(3))) bf16x8*)(kp+6144); kf[7]=*(const __attribute__((address_space(3))) bf16x8*)(kp+6656);
}
__device__ __forceinline__ void kload2(bf16x8*kf,lds_cptr kp,int j){ kf[2*j]=*(const __attribute__((address_space(3))) bf16x8*)(kp+j*2048); kf[2*j+1]=*(const __attribute__((address_space(3))) bf16x8*)(kp+j*2048+512); }
__device__ __forceinline__ s16x4 vtr(lds_cptr p){ return __builtin_bit_cast(s16x4,__builtin_amdgcn_ds_read_tr16_b64_v4i16((__attribute__((address_space(3))) v4i16_t*)p)); }
__device__ __forceinline__ float rowmax(const f32x16&p0,const f32x16&p1){
  float a=max3f(p0[0],p0[1],p1[0]),b=max3f(p0[2],p0[3],p1[1]);a=max3f(a,p1[2],p1[3]);
  #pragma unroll
  for(int r=4;r<16;r+=4){a=max3f(a,p0[r],p0[r+1]);b=max3f(b,p0[r+2],p0[r+3]);a=max3f(a,p1[r],p1[r+1]);b=max3f(b,p1[r+2],p1[r+3]);}
  const float m=max2f(a,b);
  auto rr=__builtin_amdgcn_permlane32_swap(__float_as_uint(m),__float_as_uint(m),false,false);
  return max2f(__uint_as_float(rr[0]),__uint_as_float(rr[1]));
}
__device__ __forceinline__ void pv(f32x16*o,int vb,bf16x8 pa0,bf16x8 pa1,bf16x8 pa2,bf16x8 pa3){
  #pragma unroll
  for(int d0=0;d0<2;++d0){s16x4 lo[4],hi[4];
    #pragma unroll
    for(int ks=0;ks<4;++ks){
      asm volatile("ds_read_b64_tr_b16 %0,%1 offset:%c2":"=&v"(lo[ks]):"v"(vb),"i"(d0*4096+ks*1024):"memory");
      asm volatile("ds_read_b64_tr_b16 %0,%1 offset:%c2":"=&v"(hi[ks]):"v"(vb),"i"(d0*4096+ks*1024+512):"memory");}
    asm volatile("s_waitcnt lgkmcnt(0)":::"memory");SBAR();
    #define PK(k) (bf16x8){lo[k][0],lo[k][1],lo[k][2],lo[k][3],hi[k][0],hi[k][1],hi[k][2],hi[k][3]}
    o[d0]=__builtin_amdgcn_mfma_f32_32x32x16_bf16(pa0,PK(0),o[d0],0,0,0);
    o[d0]=__builtin_amdgcn_mfma_f32_32x32x16_bf16(pa1,PK(1),o[d0],0,0,0);
    o[d0]=__builtin_amdgcn_mfma_f32_32x32x16_bf16(pa2,PK(2),o[d0],0,0,0);
    o[d0]=__builtin_amdgcn_mfma_f32_32x32x16_bf16(pa3,PK(3),o[d0],0,0,0);
    #undef PK
  }
}

#ifndef ATTN_STORE16
#define ATTN_STORE16(p,v) __builtin_nontemporal_store((v),(u32x4*)(p))
#endif
template<int THRL> __device__ __forceinline__ void attn_unit(int b,int qb,const bf16*__restrict__ Q,const bf16*__restrict__ K,const bf16*__restrict__ V,bf16*__restrict__ O,char*shm){
  const int tid=pg8::otid(),lane=tid&63,r32=lane&31,hi=lane>>5; const int wid=__builtin_amdgcn_readfirstlane(tid>>6);
  const long rowbase=(long)b*SEQ; const int q0=qb*QB;
  const bf16*Qw=Q+(rowbase+q0+wid*QBLK)*DM;
  const bf16*Kh=K+rowbase*DM,*Vh=V+rowbase*DM;
  const unsigned lds0=(unsigned)(uintptr_t)shm;
  float*wsf=(float*)(shm+LDS_WS)+wid*64;
  const bf16*ksrc=Kh+(long)lane*DM+wid*8;
  const bf16*vsrc=Vh+(long)(16*(wid&3)+(lane>>2))*DM+(wid>>2)*32+(lane&3)*8;
  const unsigned kdst=lds0+LDS_K+wid*1024, vdst=lds0+LDS_V+wid*1024;
  #define DMA_K(t,slot) glds16(ksrc+(long)(t)*KVBLK*DM,(unsigned)__builtin_amdgcn_readfirstlane(kdst+(slot)))
  #define DMA_V(t,slot) glds16(vsrc+(long)(t)*KVBLK*DM,(unsigned)__builtin_amdgcn_readfirstlane(vdst+(slot)))
  const int vb0=(int)(lds0+LDS_V)+((lane>>4)&1)*32+(lane&3)*8+(4*hi+((lane&15)>>2))*64;
  const char*Kbase=shm+LDS_K; bf16x8 kf[8];
  const lds_cptr shm3=(lds_cptr)shm; const lds_cptr kp0=shm3+LDS_K+hi*1024+r32*16; const lds_cptr vp0=shm3+LDS_V+((lane>>4)&1)*32+(lane&3)*8+(4*hi+((lane&15)>>2))*64;
  const int NT=(q0+QB)/KVBLK;
  DMA_K(0,0);DMA_V(0,0);DMA_K(1,SLOTB);
  bf16x8 qr[4];
  #pragma unroll
  for(int d0=0;d0<4;++d0)qr[d0]=*reinterpret_cast<const bf16x8*>(&Qw[(long)r32*DM+d0*16+hi*8]);
  float mhat=0.f,l_reg=0.f;f32x16 o[2];o[0]=f32x16{};o[1]=f32x16{};f32x16 negm=f32x16{};asm volatile("":"+v"(negm));
  const int qrel=wid*QBLK+r32;
  #define CMASK(P0,P1,t) do{int jb_=(t)-(NT-4); if(jb_>=0)cmask(P0,P1,jb_,qrel,hi);}while(0)
  bool resc=false;
  #define START(P0,P1) do{ const float rm=rowmax(P0,P1); resc=false; \
    { const float dl=rm; mhat=fadd_s(mhat,dl); \
      _Pragma("unroll") for(int r=0;r<16;++r){P0[r]=fsub_s(P0[r],dl);P1[r]=fsub_s(P1[r],dl);} \
      _Pragma("unroll") for(int r=0;r<16;++r)negm[r]=-mhat; asm volatile("":"+v"(negm)); } \
    _Pragma("unroll") for(int r=0;r<16;++r)P0[r]=__builtin_amdgcn_exp2f(P0[r]); }while(0)
  #define RESC() do{ if(resc){ asm volatile("s_waitcnt lgkmcnt(0)":::"memory"); \
      _Pragma("unroll") for(int d_=0;d_<2;++d_) _Pragma("unroll") for(int r=0;r<16;++r)o[d_][r]*=wsf[crow(r,hi)]; } }while(0)
  f32x16 pA0,pA1,pB0,pB1;
  int sl_prev=0,sl_cur=0,sl_next=SLOTB;
  #define ROT() do{sl_prev=sl_cur;sl_cur=sl_next;sl_next=(sl_next==(NSLOT-1)*SLOTB)?0:sl_next+SLOTB;}while(0)
  DMA_K(2,2*SLOTB);
  WAIT_BAR(3);
  qkt(pA0,pA1,Kbase,qr,negm,r32,hi);asm volatile("s_nop 15\n\ts_nop 7":"+v"(pA0),"+v"(pA1));CMASK(pA0,pA1,0);
  START(pA0,pA1);
  _Pragma("unroll") for(int r=0;r<16;++r)pA1[r]=__builtin_amdgcn_exp2f(pA1[r]);
  WAIT_BAR(0);
  DMA_K(3,0);DMA_V(1,SLOTB);
  ROT();
  kload8(kf,kp0+sl_cur);
  WAIT_BAR(2);
  s16x4 vlo[8],vhi[8]; u32x4 pw0,pw1,pw2,pw3;
  #define PKW(P,B) cvtpk_s(P[B],P[B+1])
  #define PAF(k) __builtin_bit_cast(bf16x8,pw##k)
  #define VFR(i) (bf16x8){vlo[i][0],vlo[i][1],vlo[i][2],vlo[i][3],vhi[i][0],vhi[i][1],vhi[i][2],vhi[i][3]}
  #define PIN(x) asm volatile("":"+v"(x))
  #define MX3(a,b,c) __builtin_fmaxf(__builtin_fmaxf((a),(b)),(c))
  #define GAPA(MF,A0,A1,A2,A3,W0,W1,PW) do{ MF; sacc+=A0; sacc+=A1; sacc+=A2; sacc+=A3; PIN(sacc); W0; W1; PIN(PW); SBAR(); }while(0)
  #define EX(v) __builtin_amdgcn_exp2f(v)
  #define GAPB(MF,X,B) do{ MF; X[B]=EX(X[B]); X[B+1]=EX(X[B+1]); X[B+2]=EX(X[B+2]); X[B+3]=EX(X[B+3]); PIN(X); SBAR(); }while(0)
  #define VRD(i) do{ vlo[i]=vtr(vp_+(((i)>>2)*4096+((i)&3)*1024)); vhi[i]=vtr(vp_+(((i)>>2)*4096+((i)&3)*1024+512)); }while(0)
  #define KRD(G,j) do{ if(G){ kload2(kf,kp0+sl_next,j); SBAR(); } }while(0)
  #define STEP(C0,C1,P0,P1,t,GK,GV,GL) do{ SBAR(); \
    const lds_cptr vp_=vp0+sl_prev; \
    VRD(0); SBAR(); float sacc=(P0[0]+P0[1]); \
    GAPA(C0=__builtin_amdgcn_mfma_f32_32x32x16_bf16(kf[0],qr[0],negm,0,0,0), P0[2],P0[3],P0[4],P0[5],     pw0[0]=PKW(P0,0), pw0[1]=PKW(P0,2), pw0); \
    VRD(4); SBAR(); GAPA(C1=__builtin_amdgcn_mfma_f32_32x32x16_bf16(kf[1],qr[0],negm,0,0,0), P0[6],P0[7],P0[8],P0[9],     pw0[2]=PKW(P0,4), pw0[3]=PKW(P0,6), pw0); \
    VRD(1); SBAR(); GAPA(C0=__builtin_amdgcn_mfma_f32_32x32x16_bf16(kf[2],qr[1],C0,0,0,0),   P0[10],P0[11],P0[12],P0[13], pw1[0]=PKW(P0,8), pw1[1]=PKW(P0,10), pw1); \
    VRD(5); SBAR(); GAPA(C1=__builtin_amdgcn_mfma_f32_32x32x16_bf16(kf[3],qr[1],C1,0,0,0),   P0[14],P0[15],P1[0],P1[1],   pw1[2]=PKW(P0,12),pw1[3]=PKW(P0,14), pw1); \
    VRD(2); SBAR(); GAPA(C0=__builtin_amdgcn_mfma_f32_32x32x16_bf16(kf[4],qr[2],C0,0,0,0),   P1[2],P1[3],P1[4],P1[5],     pw2[0]=PKW(P1,0), pw2[1]=PKW(P1,2), pw2); \
    VRD(6); SBAR(); GAPA(C1=__builtin_amdgcn_mfma_f32_32x32x16_bf16(kf[5],qr[2],C1,0,0,0),   P1[6],P1[7],P1[8],P1[9],     pw2[2]=PKW(P1,4), pw2[3]=PKW(P1,6), pw2); \
    VRD(3); SBAR(); GAPA(C0=__builtin_amdgcn_mfma_f32_32x32x16_bf16(kf[6],qr[3],C0,0,0,0),   P1[10],P1[11],P1[12],P1[13], pw3[0]=PKW(P1,8), pw3[1]=PKW(P1,10), pw3); \
    VRD(7); SBAR(); GAPA(C1=__builtin_amdgcn_mfma_f32_32x32x16_bf16(kf[7],qr[3],C1,0,0,0),   P1[14],P1[15],0.f,0.f,       pw3[2]=PKW(P1,12),pw3[3]=PKW(P1,14), pw3); \
    l_reg+=sacc; \
    if(GK){DMA_K((t)+3,sl_cur);} if(GV){DMA_V((t)+1,sl_next);} \
    CMASK(C0,C1,t); \
    { float a=MX3(C0[0],C0[1],C1[0]),b=MX3(C0[2],C0[3],C1[1]); a=MX3(a,C1[2],C1[3]); \
      _Pragma("unroll") for(int r=4;r<16;r+=4){a=MX3(a,C0[r],C0[r+1]);b=MX3(b,C0[r+2],C0[r+3]);a=MX3(a,C1[r],C1[r+1]);b=MX3(b,C1[r+2],C1[r+3]);} \
      float rm=__builtin_fmaxf(a,b); { auto rr=__builtin_amdgcn_permlane32_swap(__float_as_uint(rm),__float_as_uint(rm),false,false); rm=__builtin_fmaxf(__uint_as_float(rr[0]),__uint_as_float(rr[1])); } \
      resc=false; \
      if(__builtin_expect(__any(rm>(float)THRL),0)){ const float dl=__builtin_fmaxf(rm,0.f); mhat+=dl; \
        _Pragma("unroll") for(int r=0;r<16;++r){C0[r]-=dl;C1[r]-=dl;} \
        _Pragma("unroll") for(int r=0;r<16;++r)negm[r]=-mhat; asm volatile("":"+v"(negm)); \
        const float f=__builtin_amdgcn_exp2f(-dl); l_reg*=f; if(hi==0)wsf[r32]=f; resc=true; } } \
    SBAR(); \
    GAPB(o[0]=__builtin_amdgcn_mfma_f32_32x32x16_bf16(PAF(0),VFR(0),o[0],0,0,0), C0,0); \
    GAPB(o[1]=__builtin_amdgcn_mfma_f32_32x32x16_bf16(PAF(0),VFR(4),o[1],0,0,0), C0,4); \
    KRD(GL,0); GAPB(o[0]=__builtin_amdgcn_mfma_f32_32x32x16_bf16(PAF(1),VFR(1),o[0],0,0,0), C0,8); \
    KRD(GL,1); GAPB(o[1]=__builtin_amdgcn_mfma_f32_32x32x16_bf16(PAF(1),VFR(5),o[1],0,0,0), C0,12); \
    KRD(GL,2); GAPB(o[0]=__builtin_amdgcn_mfma_f32_32x32x16_bf16(PAF(2),VFR(2),o[0],0,0,0), C1,0); \
    KRD(GL,3); GAPB(o[1]=__builtin_amdgcn_mfma_f32_32x32x16_bf16(PAF(2),VFR(6),o[1],0,0,0), C1,4); \
    GAPB(o[0]=__builtin_amdgcn_mfma_f32_32x32x16_bf16(PAF(3),VFR(3),o[0],0,0,0), C1,8); \
    GAPB(o[1]=__builtin_amdgcn_mfma_f32_32x32x16_bf16(PAF(3),VFR(7),o[1],0,0,0), C1,12); \
    }while(0)
  int t=1;
  #undef CMASK
  #define CMASK(P0,P1,t) do{}while(0)
  for(;t+5<NT;t+=2){
    STEP(pB0,pB1,pA0,pA1,t,true,true,true);     WAIT_BAR(2); RESC(); ROT();
    STEP(pA0,pA1,pB0,pB1,t+1,true,true,true);   WAIT_BAR(2); RESC(); ROT();
  }
  #undef CMASK
  #define CMASK(P0,P1,t) do{int jb_=(t)-(NT-4); if(jb_>=0)cmask(P0,P1,jb_,qrel,hi);}while(0)
  #define ENDW(tt) do{ if((tt)+3<NT){WAIT_BAR(2);} else if((tt)+2<NT){WAIT_BAR(1);} else {WAIT_BAR(0);} }while(0)
  for(;t+1<NT;t+=2){
    STEP(pB0,pB1,pA0,pA1,t,(t+3<NT),(t+1<NT),(t+1<NT));       ENDW(t);   RESC(); ROT();
    STEP(pA0,pA1,pB0,pB1,t+1,(t+4<NT),(t+2<NT),(t+2<NT));     ENDW(t+1); RESC(); ROT();
  }
  STEP(pB0,pB1,pA0,pA1,NT-1,false,false,false); RESC();
  { float sacc=pB0[0]+pB0[1]; _Pragma("unroll") for(int r=2;r<16;++r)sacc+=pB0[r]; _Pragma("unroll") for(int r=0;r<16;++r)sacc+=pB1[r]; l_reg+=sacc;
    pw0=(u32x4){PKW(pB0,0),PKW(pB0,2),PKW(pB0,4),PKW(pB0,6)};pw1=(u32x4){PKW(pB0,8),PKW(pB0,10),PKW(pB0,12),PKW(pB0,14)};pw2=(u32x4){PKW(pB1,0),PKW(pB1,2),PKW(pB1,4),PKW(pB1,6)};pw3=(u32x4){PKW(pB1,8),PKW(pB1,10),PKW(pB1,12),PKW(pB1,14)};
    SBAR(); pv(o,vb0+sl_cur,PAF(0),PAF(1),PAF(2),PAF(3)); }
  #undef PKW
  #undef PAF
  #undef VFR
  #undef PIN
  #undef MX3
  #undef GAPA
  #undef GAPB
  #undef EX
  #undef VRD
  #undef KRD
  #undef STEP
  #undef ENDW
  {auto rr=__builtin_amdgcn_permlane32_swap(__float_as_uint(l_reg),__float_as_uint(l_reg),false,false);l_reg=__uint_as_float(rr[0])+__uint_as_float(rr[1]);}
  if(hi==0)wsf[32+r32]=l_reg;asm volatile("s_waitcnt lgkmcnt(0)":::"memory");
  float rli[16];
  #pragma unroll
  for(int r=0;r<16;++r)rli[r]=__builtin_amdgcn_rcpf(wsf[32+crow(r,hi)]);
  bf16*Ow=O+(rowbase+q0+wid*QBLK)*DMO;
  { bf16*stg=(bf16*)(shm+LDS_OST)+wid*2048;
    #pragma unroll
    for(int r=0;r<16;++r){const int orow=crow(r,hi);
      #pragma unroll
      for(int d0=0;d0<2;++d0)stg[orow*64+d0*32+r32]=__float2bfloat16(o[d0][r]*rli[r]);}
    asm volatile("s_waitcnt lgkmcnt(0)":::"memory");
    #pragma unroll
    for(int i=0;i<4;++i){const int row=i*8+(lane>>3),ch=lane&7; const u32x4 v=*(const u32x4*)(stg+row*64+ch*8); ATTN_STORE16(Ow+(long)row*DMO+ch*8,v);} }
  asm volatile("s_waitcnt lgkmcnt(0)\n\ts_barrier":::"memory");
  #undef DMA_K
  #undef DMA_V
  #undef CMASK
  #undef START
  #undef RESC
  #undef ROT
}
constexpr int ATTN_LDS_BYTES=LDS_BYTES;
struct AttnTensors { const bf16* QKV; bf16* O; };
struct AttnUnit { int bvh; int qb; };
struct StaticOrder {
  int vcu;
  __device__ __forceinline__ explicit StaticOrder(int grid,int block):vcu((grid%8==0)?(block%8)*(grid/8)+block/8:block){}
  __device__ __forceinline__ bool next(int i,AttnUnit&u)const{ const int L=vcu; if(i>=16||L>=256)return false; const int s=8*(L&3)+(i>>1); u.bvh=L>>2; u.qb=(i&1)?63-s:s; return true; }
  __device__ __forceinline__ void a_ready(const AttnUnit&)const{}
  __device__ __forceinline__ void done(const AttnUnit&)const{}
};
template<class Sched,int THRL=8> __device__ __forceinline__ void attn_phase(char*lds,const AttnTensors&T,const Sched&S){
  AttnUnit u;
  for(int i=0;S.next(i,u);++i){ S.a_ready(u); const int b=u.bvh>>5,vh=u.bvh&31;
    attn_unit<THRL>(b,u.qb,T.QKV+(vh>>1)*64,T.QKV+1024+(vh>>1)*64,T.QKV+2048+((vh>>2)*2+(vh&1))*64,T.O+vh*64,lds); S.done(u); }
}

constexpr int KSLOT2=8192, VSLOT2=16384;
constexpr int LDS2_K=0, LDS2_V=NSLOT*KSLOT2, LDS2_WS=LDS2_V+NSLOT*VSLOT2, LDS2_OST=LDS2_WS+NW*64*4, LDS2_BYTES=LDS2_OST+NW*4096;
#define WAIT_BAR2(N) asm volatile("s_waitcnt vmcnt(" #N ") lgkmcnt(0)\n\ts_barrier":::"memory")
template<int THRL> __device__ __forceinline__ void attn_unit2(int b,int qb,const bf16*__restrict__ Q,const bf16*__restrict__ K,const bf16*__restrict__ V,bf16*__restrict__ O,char*shm){
  const int tid=pg8::otid(),lane=tid&63,r32=lane&31,hi=lane>>5; const int wid=__builtin_amdgcn_readfirstlane(tid>>6);
  const long rowbase=(long)b*SEQ; const int q0=qb*QB;
  const bf16*Qw=Q+(rowbase+q0+wid*QBLK)*DM;
  const bf16*Kh=K+rowbase*DM,*Vh=V+rowbase*DM;
  const unsigned lds0=(unsigned)(uintptr_t)shm;
  float*wsf=(float*)(shm+LDS2_WS)+wid*64;
  const unsigned kvoff=(unsigned)((lane*DM+wid*8)*2);
  const unsigned vvoff=(unsigned)(((16*(wid&3)+(lane>>2))*DM+(wid>>2)*32+(lane&3)*8)*2);
  const unsigned kdst=lds0+LDS2_K+wid*1024, vdst=lds0+LDS2_V+wid*1024;
  #define DMA_K(t,slot) glds16s(Kh+(long)(t)*KVBLK*DM,kvoff,(unsigned)__builtin_amdgcn_readfirstlane(kdst+(slot)))
  #define DMA_V(t,slot) do{ glds16s(Vh+(long)(t)*KVBLK*DM,vvoff,(unsigned)__builtin_amdgcn_readfirstlane(vdst+2*(slot))); glds16s(Vh+(long)(t)*KVBLK*DM+64,vvoff,(unsigned)__builtin_amdgcn_readfirstlane(vdst+2*(slot)+8192)); }while(0)
  const char*Kbase=shm+LDS2_K; bf16x8 kf[8];
  const lds_cptr shm3=(lds_cptr)shm; const lds_cptr kp0=shm3+LDS2_K+hi*1024+r32*16; const lds_cptr vp0=shm3+LDS2_V+((lane>>4)&1)*32+(lane&3)*8+(4*hi+((lane&15)>>2))*64;
  const int NT=(q0+QB)/KVBLK;
  DMA_K(0,0);DMA_V(0,0);DMA_K(1,KSLOT2);
  bf16x8 qr[4];
  #pragma unroll
  for(int d0=0;d0<4;++d0)qr[d0]=*reinterpret_cast<const bf16x8*>(&Qw[(long)r32*DM+d0*16+hi*8]);
  float mhat=0.f,l_reg=0.f;f32x16 o[4];o[0]=f32x16{};o[1]=f32x16{};o[2]=f32x16{};o[3]=f32x16{};
  f32x16 negm=f32x16{};asm volatile("":"+v"(negm));
  const int qrel=wid*QBLK+r32;
  #define CMASK(P0,P1,t) do{int jb_=(t)-(NT-4); if(jb_>=0)cmask(P0,P1,jb_,qrel,hi);}while(0)
  bool resc=false;
  #define RESC() do{ if(resc){ asm volatile("s_waitcnt lgkmcnt(0)":::"memory"); \
      _Pragma("unroll") for(int d_=0;d_<4;++d_) _Pragma("unroll") for(int r=0;r<16;++r)o[d_][r]*=wsf[crow(r,hi)]; } }while(0)
  f32x16 pA0,pA1,pB0,pB1;
  int sl_prev=0,sl_cur=0,sl_next=KSLOT2;
  #define ROT() do{sl_prev=sl_cur;sl_cur=sl_next;sl_next=(sl_next==(NSLOT-1)*KSLOT2)?0:sl_next+KSLOT2;}while(0)
  DMA_K(2,2*KSLOT2);
  WAIT_BAR2(4);
  qkt(pA0,pA1,Kbase,qr,negm,r32,hi);asm volatile("s_nop 15\n\ts_nop 7":"+v"(pA0),"+v"(pA1));CMASK(pA0,pA1,0);
  { const float rm=rowmax(pA0,pA1); mhat=rm;
    #pragma unroll
    for(int r=0;r<16;++r)negm[r]=-mhat;
    asm volatile("":"+v"(negm));
    #pragma unroll
    for(int r=0;r<16;++r){pA0[r]=__builtin_amdgcn_exp2f(pA0[r]-mhat);pA1[r]=__builtin_amdgcn_exp2f(pA1[r]-mhat);} }
  WAIT_BAR2(0);
  DMA_K(3,0);DMA_V(1,KSLOT2);
  ROT();
  kload8(kf,kp0+sl_cur);
  WAIT_BAR2(3);
  s16x4 vlo[8],vhi[8]; u32x4 pw0,pw1,pw2,pw3;
  #define PKW(P,B) cvtpk_s(P[B],P[B+1])
  #define PAF(k) __builtin_bit_cast(bf16x8,pw##k)
  #define PAFI(k) ((k)==0?PAF(0):(k)==1?PAF(1):(k)==2?PAF(2):PAF(3))
  #define VFR(i) (bf16x8){vlo[i][0],vlo[i][1],vlo[i][2],vlo[i][3],vhi[i][0],vhi[i][1],vhi[i][2],vhi[i][3]}
  #define PIN(x) asm volatile("":"+v"(x))
  #define MX3(a,b,c) __builtin_fmaxf(__builtin_fmaxf((a),(b)),(c))
  #define MFMA(a,b,c) __builtin_amdgcn_mfma_f32_32x32x16_bf16(a,b,c,0,0,0)
  #define GAPA(MF,A0,A1,A2,A3,W0,W1,PW) do{ MF; sacc+=A0; sacc+=A1; sacc+=A2; sacc+=A3; PIN(sacc); W0; W1; PIN(PW); SBAR(); }while(0)
  #define EX(v) __builtin_amdgcn_exp2f(v)
  #define GAPB(MF,X,B) do{ MF; X[B]=EX(X[B]); X[B+1]=EX(X[B+1]); PIN(X); SBAR(); }while(0)
  #define VOFF(j) ((((j)&3)*4096)+(((j)>>2)*1024))
  #define VRD(s_,j) do{ vlo[s_]=vtr(vp_+VOFF(j)); vhi[s_]=vtr(vp_+VOFF(j)+512); }while(0)
  #define KRD(G,j) do{ if(G){ kload2(kf,kp0+sl_next,j); SBAR(); } }while(0)
  #define PVM(j,PA) o[(j)&3]=MFMA(PA,VFR((j)&7),o[(j)&3])
  #define STEP(C0,C1,P0,P1,t,GK,GV,GL) do{ SBAR(); \
    const lds_cptr vp_=vp0+2*sl_prev; \
    VRD(0,0); SBAR(); float sacc=(P0[0]+P0[1]); \
    GAPA(C0=MFMA(kf[0],qr[0],negm), P0[2],P0[3],P0[4],P0[5],     pw0[0]=PKW(P0,0), pw0[1]=PKW(P0,2), pw0); \
    VRD(1,1); SBAR(); GAPA(C1=MFMA(kf[1],qr[0],negm), P0[6],P0[7],P0[8],P0[9],     pw0[2]=PKW(P0,4), pw0[3]=PKW(P0,6), pw0); \
    VRD(2,2); SBAR(); GAPA(C0=MFMA(kf[2],qr[1],C0),   P0[10],P0[11],P0[12],P0[13], pw1[0]=PKW(P0,8), pw1[1]=PKW(P0,10), pw1); \
    VRD(3,3); SBAR(); GAPA(C1=MFMA(kf[3],qr[1],C1),   P0[14],P0[15],P1[0],P1[1],   pw1[2]=PKW(P0,12),pw1[3]=PKW(P0,14), pw1); \
    VRD(4,4); SBAR(); GAPA(C0=MFMA(kf[4],qr[2],C0),   P1[2],P1[3],P1[4],P1[5],     pw2[0]=PKW(P1,0), pw2[1]=PKW(P1,2), pw2); \
    VRD(5,5); SBAR(); GAPA(C1=MFMA(kf[5],qr[2],C1),   P1[6],P1[7],P1[8],P1[9],     pw2[2]=PKW(P1,4), pw2[3]=PKW(P1,6), pw2); \
    VRD(6,6); SBAR(); GAPA(C0=MFMA(kf[6],qr[3],C0),   P1[10],P1[11],P1[12],P1[13], pw3[0]=PKW(P1,8), pw3[1]=PKW(P1,10), pw3); \
    VRD(7,7); SBAR(); GAPA(C1=MFMA(kf[7],qr[3],C1),   P1[14],P1[15],0.f,0.f,       pw3[2]=PKW(P1,12),pw3[3]=PKW(P1,14), pw3); \
    l_reg+=sacc; \
    if(GK){DMA_K((t)+3,sl_cur);} if(GV){DMA_V((t)+1,sl_next);} \
    CMASK(C0,C1,t); \
    { float a=MX3(C0[0],C0[1],C1[0]),b_=MX3(C0[2],C0[3],C1[1]); a=MX3(a,C1[2],C1[3]); \
      _Pragma("unroll") for(int r=4;r<16;r+=4){a=MX3(a,C0[r],C0[r+1]);b_=MX3(b_,C0[r+2],C0[r+3]);a=MX3(a,C1[r],C1[r+1]);b_=MX3(b_,C1[r+2],C1[r+3]);} \
      float rm=__builtin_fmaxf(a,b_); { auto rr=__builtin_amdgcn_permlane32_swap(__float_as_uint(rm),__float_as_uint(rm),false,false); rm=__builtin_fmaxf(__uint_as_float(rr[0]),__uint_as_float(rr[1])); } \
      resc=false; \
      if(__builtin_expect(__any(rm>(float)THRL),0)){ const float dl=__builtin_fmaxf(rm,0.f); mhat+=dl; \
        _Pragma("unroll") for(int r=0;r<16;++r){C0[r]-=dl;C1[r]-=dl;} \
        _Pragma("unroll") for(int r=0;r<16;++r)negm[r]=-mhat; asm volatile("":"+v"(negm)); \
        const float f=__builtin_amdgcn_exp2f(-dl); l_reg*=f; if(hi==0)wsf[r32]=f; resc=true; } } \
    SBAR(); \
    GAPB(PVM(0,PAF(0)),C0,0);  VRD(0,8);  SBAR(); \
    GAPB(PVM(1,PAF(0)),C0,2);  VRD(1,9);  SBAR(); \
    GAPB(PVM(2,PAF(0)),C0,4);  VRD(2,10); SBAR(); \
    GAPB(PVM(3,PAF(0)),C0,6);  VRD(3,11); SBAR(); \
    GAPB(PVM(4,PAF(1)),C0,8);  VRD(4,12); SBAR(); \
    GAPB(PVM(5,PAF(1)),C0,10); VRD(5,13); SBAR(); \
    GAPB(PVM(6,PAF(1)),C0,12); VRD(6,14); SBAR(); \
    GAPB(PVM(7,PAF(1)),C0,14); VRD(7,15); SBAR(); \
    GAPB(PVM(8,PAF(2)),C1,0); \
    GAPB(PVM(9,PAF(2)),C1,2); \
    KRD(GL,0); GAPB(PVM(10,PAF(2)),C1,4); \
    KRD(GL,1); GAPB(PVM(11,PAF(2)),C1,6); \
    KRD(GL,2); GAPB(PVM(12,PAF(3)),C1,8); \
    KRD(GL,3); GAPB(PVM(13,PAF(3)),C1,10); \
    GAPB(PVM(14,PAF(3)),C1,12); \
    GAPB(PVM(15,PAF(3)),C1,14); \
    }while(0)
  int t=1;
  #undef CMASK
  #define CMASK(P0,P1,t) do{}while(0)
  for(;t+5<NT;t+=2){
    STEP(pB0,pB1,pA0,pA1,t,true,true,true);     WAIT_BAR2(3); RESC(); ROT();
    STEP(pA0,pA1,pB0,pB1,t+1,true,true,true);   WAIT_BAR2(3); RESC(); ROT();
  }
  #undef CMASK
  #define CMASK(P0,P1,t) do{int jb_=(t)-(NT-4); if(jb_>=0)cmask(P0,P1,jb_,qrel,hi);}while(0)
  #define ENDW(tt) do{ if((tt)+3<NT){WAIT_BAR2(3);} else if((tt)+2<NT){WAIT_BAR2(2);} else {WAIT_BAR2(0);} }while(0)
  for(;t+1<NT;t+=2){
    STEP(pB0,pB1,pA0,pA1,t,(t+3<NT),(t+1<NT),(t+1<NT));       ENDW(t);   RESC(); ROT();
    STEP(pA0,pA1,pB0,pB1,t+1,(t+4<NT),(t+2<NT),(t+2<NT));     ENDW(t+1); RESC(); ROT();
  }
  STEP(pB0,pB1,pA0,pA1,NT-1,false,false,false); RESC();
  { float sacc=pB0[0]+pB0[1]; _Pragma("unroll") for(int r=2;r<16;++r)sacc+=pB0[r]; _Pragma("unroll") for(int r=0;r<16;++r)sacc+=pB1[r]; l_reg+=sacc;
    pw0=(u32x4){PKW(pB0,0),PKW(pB0,2),PKW(pB0,4),PKW(pB0,6)};pw1=(u32x4){PKW(pB0,8),PKW(pB0,10),PKW(pB0,12),PKW(pB0,14)};pw2=(u32x4){PKW(pB1,0),PKW(pB1,2),PKW(pB1,4),PKW(pB1,6)};pw3=(u32x4){PKW(pB1,8),PKW(pB1,10),PKW(pB1,12),PKW(pB1,14)};
    SBAR(); const lds_cptr vp_=vp0+2*sl_cur;
    #pragma unroll
    for(int d0=0;d0<4;++d0){
      #pragma unroll
      for(int ks=0;ks<4;++ks){ vlo[ks]=vtr(vp_+d0*4096+ks*1024); vhi[ks]=vtr(vp_+d0*4096+ks*1024+512); }
      o[d0]=MFMA(PAF(0),VFR(0),o[d0]); o[d0]=MFMA(PAF(1),VFR(1),o[d0]); o[d0]=MFMA(PAF(2),VFR(2),o[d0]); o[d0]=MFMA(PAF(3),VFR(3),o[d0]); } }
  #undef PKW
  #undef PAF
  #undef PAFI
  #undef VFR
  #undef PIN
  #undef MX3
  #undef MFMA
  #undef GAPA
  #undef GAPB
  #undef EX
  #undef VOFF
  #undef VRD
  #undef KRD
  #undef PVM
  #undef STEP
  #undef ENDW
  {auto rr=__builtin_amdgcn_permlane32_swap(__float_as_uint(l_reg),__float_as_uint(l_reg),false,false);l_reg=__uint_as_float(rr[0])+__uint_as_float(rr[1]);}
  if(hi==0)wsf[32+r32]=l_reg;asm volatile("s_waitcnt lgkmcnt(0)":::"memory");
  float rli[16];
  #pragma unroll
  for(int r=0;r<16;++r)rli[r]=__builtin_amdgcn_rcpf(wsf[32+crow(r,hi)]);
  bf16*Ow=O+(rowbase+q0+wid*QBLK)*DMO;
  { bf16*stg=(bf16*)(shm+LDS2_OST)+wid*2048;
    #pragma unroll
    for(int hh=0;hh<2;++hh){
      #pragma unroll
      for(int r=0;r<16;++r){const int orow=crow(r,hi);
        #pragma unroll
        for(int d0=0;d0<2;++d0)stg[orow*64+d0*32+r32]=__float2bfloat16(o[hh*2+d0][r]*rli[r]);}
      asm volatile("s_waitcnt lgkmcnt(0)":::"memory");
      #pragma unroll
      for(int i=0;i<4;++i){const int row=i*8+(lane>>3),ch=lane&7; const u32x4 v=*(const u32x4*)(stg+row*64+ch*8); ATTN_STORE16(Ow+(long)row*DMO+hh*64+ch*8,v);}
      asm volatile("s_waitcnt lgkmcnt(0)":::"memory"); } }
  asm volatile("s_waitcnt lgkmcnt(0)\n\ts_barrier":::"memory");
  #undef DMA_K
  #undef DMA_V
  #undef CMASK
  #undef RESC
  #undef ROT
}
struct AttnUnit2 { int bhm; int qb; };
struct StaticOrder2 {
  int vcu;
  __device__ __forceinline__ explicit StaticOrder2(int grid,int block):vcu((grid%8==0)?(block%8)*(grid/8)+block/8:block){}
  __device__ __forceinline__ bool next(int i,AttnUnit2&u)const{ const int L=vcu; if(i>=8||L>=256)return false; const int j=L&7; u.bhm=L>>3; u.qb=8*i+((i&1)?7-j:j); return true; }
};
template<class Sched,int THRL=8> __device__ __forceinline__ void attn_phase2(char*lds,const AttnTensors&T,const Sched&S){
  AttnUnit2 u;
  for(int i=0;S.next(i,u);++i){ const int b=u.bhm>>4,hm=u.bhm&15;
    attn_unit2<THRL>(b,u.qb,T.QKV+hm*64,T.QKV+1024+hm*64,T.QKV+2048+(hm>>1)*128,T.O+hm*128,lds); }
}
#undef SBAR
#undef WAIT_BAR
}
#define GAS __attribute__((address_space(1)))
#define LAS __attribute__((address_space(3)))
typedef unsigned short bf16;
typedef unsigned v4u __attribute__((ext_vector_type(4)));
typedef float f32x4 __attribute__((ext_vector_type(4)));
typedef short bf16x8 __attribute__((ext_vector_type(8)));
typedef GAS unsigned gu32;
typedef GAS unsigned long long gu64;
#define RLX_AGENT __ATOMIC_RELAXED, __HIP_MEMORY_SCOPE_AGENT
#define LDS_WAIT() asm volatile("s_waitcnt lgkmcnt(0)" ::: "memory")
#define VM_WAIT() asm volatile("s_waitcnt vmcnt(0)" ::: "memory")
__device__ __forceinline__ unsigned long long rt() { return __builtin_amdgcn_s_memrealtime(); }
__device__ __forceinline__ unsigned f2bf(float f) { unsigned u = __builtin_bit_cast(unsigned, f); return (u + 0x7fffu + ((u >> 16) & 1u)) >> 16; }
__device__ __forceinline__ unsigned pk2(float lo, float hi) { return f2bf(lo) | (f2bf(hi) << 16); }

#define XB_TMO      128
#define XB_XCNT(j)  (256  + 64 * (j))
#define XB_XSUB(j)  (1280 + 64 * (j))
#define XB_XGEN(j)  (2304 + 64 * (j))
#define XB_TOP      3328
#define XB_TOPGEN   3392
#define XCD_BAR_WORDS 3456
#define XB_SPIN_CAP (1u << 18)

__device__ __forceinline__ unsigned xb_ld(unsigned* p)              { return __hip_atomic_load(p, __ATOMIC_RELAXED, __HIP_MEMORY_SCOPE_AGENT); }
__device__ __forceinline__ unsigned xb_add(unsigned* p, unsigned v) { return __hip_atomic_fetch_add(p, v, __ATOMIC_RELAXED, __HIP_MEMORY_SCOPE_AGENT); }
__device__ __forceinline__ unsigned xb_xcc_id() { return (unsigned)__builtin_amdgcn_s_getreg((3 << 11) | 20) & 0xFu; }
#define XB_SPIN(cond, bar) do { unsigned _sp = 0; while (cond) { __builtin_amdgcn_s_sleep(1); \
    if ((++_sp & 255u) == 0u) { if (xb_ld(&(bar)[XB_TMO])) break; if (_sp > XB_SPIN_CAP) { atomicAdd(&(bar)[XB_TMO], 1u); break; } } } } while (0)

struct XcdBarrier {
    unsigned* bar; unsigned x;
    volatile LAS unsigned* st;
};

__device__ __forceinline__ XcdBarrier xcd_barrier_post(unsigned* bar, volatile LAS unsigned* st) {
    XcdBarrier b; b.bar = bar; b.x = xb_xcc_id(); b.st = st;
    if (threadIdx.x == 0) (void)xb_add(&bar[XB_XCNT(b.x)], 1u);
    return b;
}
__device__ __forceinline__ void xcd_barrier_complete(unsigned* bar, unsigned x, unsigned& nloc, unsigned& nx) {
    const unsigned G = gridDim.x * gridDim.y * gridDim.z;
    unsigned sum, cnt, mine, sp = 0u;
    for (;;) {
        sum = 0u; cnt = 0u; mine = 0u;
#pragma unroll
        for (unsigned j = 0; j < 16; ++j) { const unsigned c = xb_ld(&bar[XB_XCNT(j)]); sum += c; cnt += (c > 0u) ? 1u : 0u; mine = (j == x) ? c : mine; }
        if (sum == G) break;
        __builtin_amdgcn_s_sleep(1);
        if ((++sp & 255u) == 0u) { if (xb_ld(&bar[XB_TMO])) break; if (sp > XB_SPIN_CAP) { atomicAdd(&bar[XB_TMO], 1u); break; } }
    }
    nloc = mine > 0u ? mine : 1u; nx = cnt > 0u ? cnt : 1u;
}

__device__ __forceinline__ void xcd_barrier(const XcdBarrier& b) {
    asm volatile("s_waitcnt vmcnt(0)" ::: "memory");
    __syncthreads();
    if (threadIdx.x == 0) {
        unsigned* bar = b.bar;
        __builtin_amdgcn_s_waitcnt(0);
        unsigned nloc = b.st[0], nx = b.st[1];
        if (nloc == 0u) { xcd_barrier_complete(bar, b.x, nloc, nx); b.st[0] = nloc; b.st[1] = nx; }
        const unsigned old = xb_add(&bar[XB_XSUB(b.x)], 1u);
        const unsigned gen = old / nloc;
        if (old + 1u == (gen + 1u) * nloc) {
            __builtin_amdgcn_fence(__ATOMIC_RELEASE, "agent");
            asm volatile("s_waitcnt vmcnt(0)" ::: "memory");
            const unsigned og = xb_add(&bar[XB_TOP], 1u);
            const unsigned tg = og / nx;
            if (og + 1u == (tg + 1u) * nx) xb_add(&bar[XB_TOPGEN], 1u);
            else XB_SPIN(xb_ld(&bar[XB_TOPGEN]) == tg, bar);
            __builtin_amdgcn_fence(__ATOMIC_ACQUIRE, "agent");
            xb_add(&bar[XB_XGEN(b.x)], 1u);
            asm volatile("s_waitcnt vmcnt(0)" ::: "memory");
        } else {
            XB_SPIN(xb_ld(&bar[XB_XGEN(b.x)]) == gen, bar);
            __builtin_amdgcn_fence(__ATOMIC_ACQUIRE, "agent");
            asm volatile("s_waitcnt vmcnt(0)" ::: "memory");
        }
    }
    __syncthreads();
}
constexpr int NWAVES = 8;
constexpr int DMODEL = 2048, NBATCH = 2, SEQ = 16384, DEPTH = 4, MT = NBATCH * SEQ, NMEM = 256, FF = 5632, INW = 4096;
constexpr int UGP = 1152;
constexpr float ALPHA = 1.6817928305074290f, LN_EPS = 1e-5f, RMS_EPS = 1e-5f;
constexpr int NIN = 37;
enum InIdx { I_X = 0, I_MEM, I_F1G, I_F1U, I_F1D, I_LN1G, I_LN1B, I_WIN, I_LQ1, I_LK1, I_LQ2, I_LK2, I_DNG, I_SLRE, I_SLIM, I_SLOG, I_SBRE, I_SBIM, I_SCRE, I_SCIM, I_SD, I_GLUW, I_GLUB,
             I_WOUT, I_LN2G, I_LN2B, I_XQ, I_XK, I_XV, I_XO, I_LN3G, I_LN3B, I_F2G, I_F2U, I_F2D, I_LN4G, I_LN4B };

constexpr size_t MiB = 1u << 20;
constexpr size_t WS_CTL = 0, CTL_ZERO_BYTES = 6 * MiB;
constexpr size_t WS_CS = 1 * MiB;
constexpr int CSL = 57344, CS1 = 0, CB1 = 11264, CS2 = 22528, CB2 = 33792, CSW = 45056, CBW = 49152, CSM = 53248, CBM = 55296;
constexpr size_t WS_ST = 2 * MiB;
constexpr size_t WS_XB = 6 * MiB;
constexpr size_t WS_YLO = WS_XB + 128 * MiB;
constexpr size_t WS_BIG = WS_YLO + 128 * MiB;
constexpr size_t WS_HMID = WS_BIG;
constexpr size_t WS_QKV = WS_BIG;
constexpr size_t WS_UG = WS_BIG + 192 * MiB;
constexpr size_t WS_OV = WS_BIG + 264 * MiB;
constexpr size_t WS_SC = WS_BIG;
constexpr size_t WS_PB = WS_BIG + 128 * MiB;
constexpr size_t WS_MIX = WS_BIG + 392 * MiB;
constexpr size_t WS_YG = WS_MIX + 128 * MiB;
constexpr size_t WS_VS = WS_YG + 64 * MiB;
constexpr size_t WS_W = WS_VS + 16 * MiB;
constexpr size_t WS_W1GU = WS_W, WS_W1D = WS_W1GU + 44 * MiB, WS_W2GU = WS_W1D + 22 * MiB, WS_W2D = WS_W2GU + 44 * MiB, WS_WIN = WS_W2D + 22 * MiB, WS_WGLU = WS_WIN + 16 * MiB,
                 WS_WOUT = WS_WGLU + 2 * MiB, WS_WQN = WS_WOUT + 8 * MiB, WS_WKVT = WS_WQN + 8 * MiB, WS_WOT = WS_WKVT + 16 * MiB, WS_TG = WS_WOT + 8 * MiB, WS_EM = WS_TG + 144 * MiB;
constexpr size_t WS_MEMB = WS_EM + 17 * MiB;
constexpr size_t WS_KVM = WS_MEMB + 2 * MiB;
constexpr size_t WS_MQT = WS_KVM + 4 * MiB;
constexpr size_t WS_VWOT = WS_MQT + 8 * MiB;
constexpr size_t WS_END = WS_VWOT + 8 * MiB;
constexpr int CW_TMO = 0, CW_CODE = 1, CW_BAR = 4096;

constexpr int RING_OFF = 0, RING_BYTES = 131072;
constexpr int LDSCTL_OFF = RING_BYTES, MISC_OFF = LDSCTL_OFF + 320;
constexpr int XCH_OFF = LDSCTL_OFF + 1024;
constexpr int GB_OFF = LDSCTL_OFF + 1024;
constexpr int XST_OFF = GB_OFF + 16384;
static_assert(XST_OFF == GB_OFF + 4096 * 4, "the residual epilogue finds its table right behind the gain | bias image");
constexpr int LDS_BYTES = 163840;
typedef float f32x2v __attribute__((ext_vector_type(2)));
__device__ __forceinline__ float wave_sum(float v) {
    v += pg8::sw_xor<1>(v); v += pg8::sw_xor<2>(v); v += pg8::sw_xor<4>(v); v += pg8::sw_xor<8>(v); v += pg8::sw_xor<16>(v); return pg8::add_xor32(v);
}
__device__ __forceinline__ float wave_max(float v) {
    v = fmaxf(v, pg8::sw_xor<1>(v)); v = fmaxf(v, pg8::sw_xor<2>(v)); v = fmaxf(v, pg8::sw_xor<4>(v)); v = fmaxf(v, pg8::sw_xor<8>(v)); v = fmaxf(v, pg8::sw_xor<16>(v)); return pg8::max_xor32(v);
}
__device__ __forceinline__ unsigned pkbf(float lo, float hi) { return pg8::cvt_pk_bf16(lo, hi); }
struct RmId { __device__ __forceinline__ int operator()(int n0) const { return n0; } };
struct RmGate { int add; __device__ __forceinline__ int operator()(int n0) const { return (n0 >> 7) * 256 + (n0 & 127) + add; } };
template <class RM> __device__ __forceinline__ void conv_T(const float* __restrict__ W, int K, int N, bf16* WT, int ldt, RM rm, const float* gk, const float* bk, float* cs, float* cb, LAS float* scr, int gw, int NGW, int lane, int rot, float wscale = 1.0f) {
    const int nblk = N / 32, nchunks = (K / 512) * nblk, c = lane & 7, r8 = lane >> 3;
    for (int chunk = (gw + NGW - rot % NGW) % NGW; chunk < nchunks; chunk += NGW) {
        const int kc = chunk / nblk, nb = chunk - kc * nblk, n0 = 32 * nb, drow0 = rm(n0);
        const float* wp = W + (size_t)(kc * 512 + r8) * N + n0 + 4 * c;
        float a1[4] = {0.f, 0.f, 0.f, 0.f}, a2[4] = {0.f, 0.f, 0.f, 0.f};
        f32x4 ld[8];
#pragma unroll
        for (int i = 0; i < 8; ++i) ld[i] = __builtin_nontemporal_load((const GAS f32x4*)(wp + (size_t)(8 * i) * N));
#pragma unroll 1
        for (int j = 0; j < 8; ++j) {
            const int k0 = kc * 512 + 64 * j;
#pragma unroll
            for (int i = 0; i < 8; ++i) { LAS float* d = scr + (8 * i + r8) * 33 + 4 * c; d[0] = ld[i][0]; d[1] = ld[i][1]; d[2] = ld[i][2]; d[3] = ld[i][3]; }
            if (j < 7) {
#pragma unroll
                for (int i = 0; i < 8; ++i) ld[i] = __builtin_nontemporal_load((const GAS f32x4*)(wp + (size_t)(64 * (j + 1) + 8 * i) * N)); }
            f32x4 g0, g1, b0, b1;
            if (gk) { g0 = *(const GAS f32x4*)(gk + k0 + 8 * c); g1 = *(const GAS f32x4*)(gk + k0 + 8 * c + 4); b0 = *(const GAS f32x4*)(bk + k0 + 8 * c); b1 = *(const GAS f32x4*)(bk + k0 + 8 * c + 4); }
            LDS_WAIT(); asm volatile("" ::: "memory");
#pragma unroll
            for (int jj = 0; jj < 4; ++jj) { const int n = r8 + 8 * jj; const LAS float* s = scr + (8 * c) * 33 + n;
                float w[8];
#pragma unroll
                for (int e = 0; e < 8; ++e) w[e] = s[e * 33] * wscale;
                v4u o;
                if (gk) {
                    o.x = pkbf(w[0] * g0[0], w[1] * g0[1]); o.y = pkbf(w[2] * g0[2], w[3] * g0[3]); o.z = pkbf(w[4] * g1[0], w[5] * g1[1]); o.w = pkbf(w[6] * g1[2], w[7] * g1[3]);
                    a1[jj] += (pg8::bf_lo(o.x) + pg8::bf_hi(o.x)) + (pg8::bf_lo(o.y) + pg8::bf_hi(o.y)) + (pg8::bf_lo(o.z) + pg8::bf_hi(o.z)) + (pg8::bf_lo(o.w) + pg8::bf_hi(o.w));
                    a2[jj] += (w[0] * b0[0] + w[1] * b0[1]) + (w[2] * b0[2] + w[3] * b0[3]) + (w[4] * b1[0] + w[5] * b1[1]) + (w[6] * b1[2] + w[7] * b1[3]);
                } else { o.x = pkbf(w[0], w[1]); o.y = pkbf(w[2], w[3]); o.z = pkbf(w[4], w[5]); o.w = pkbf(w[6], w[7]); }
                *(GAS v4u*)(WT + (size_t)(drow0 + n) * ldt + k0 + 8 * c) = o; }
            LDS_WAIT(); asm volatile("" ::: "memory");
        }
        if (gk) {
#pragma unroll
            for (int jj = 0; jj < 4; ++jj) { float s1 = a1[jj], s2 = a2[jj];
                s1 += pg8::sw_xor<1>(s1); s1 += pg8::sw_xor<2>(s1); s1 += pg8::sw_xor<4>(s1); s2 += pg8::sw_xor<1>(s2); s2 += pg8::sw_xor<2>(s2); s2 += pg8::sw_xor<4>(s2);
                if (c == 0) { unsafeAtomicAdd(cs + drow0 + r8 + 8 * jj, s1); unsafeAtomicAdd(cb + drow0 + r8 + 8 * jj, s2); } } }
    }
}
__device__ __forceinline__ void conv_copy(const float* __restrict__ W, bf16* O, size_t n, int gw, int NGW, int lane) {
    for (size_t i = ((size_t)gw * 64 + lane) * 8; i < n; i += (size_t)NGW * 64 * 8) {
        const f32x4 a = *(const GAS f32x4*)(W + i), b = *(const GAS f32x4*)(W + i + 4);
        v4u o; o.x = pkbf(a[0], a[1]); o.y = pkbf(a[2], a[3]); o.z = pkbf(b[0], b[1]); o.w = pkbf(b[2], b[3]);
        *(GAS v4u*)(O + i) = o; }
}
__device__ __forceinline__ void ln_rows(const float* Y, const float* __restrict__ g, const float* __restrict__ b, float* X32, bf16* XB, int gw, int NGW, int lane) {
    f32x4 gg[8], bb[8];
#pragma unroll
    for (int j = 0; j < 8; ++j) { gg[j] = *(const GAS f32x4*)(g + 4 * lane + 256 * j); bb[j] = *(const GAS f32x4*)(b + 4 * lane + 256 * j); }
    for (int m = gw; m < MT; m += NGW) {
        const GAS f32x4* yr = (const GAS f32x4*)(Y + (size_t)m * DMODEL) + lane;
        f32x4 v[8]; float s = 0.f;
#pragma unroll
        for (int j = 0; j < 8; ++j) { v[j] = yr[64 * j]; s += (v[j][0] + v[j][1]) + (v[j][2] + v[j][3]); }
        const float mean = wave_sum(s) * (1.f / DMODEL); float s2 = 0.f;
#pragma unroll
        for (int j = 0; j < 8; ++j) { v[j] = v[j] - mean; s2 += (v[j][0] * v[j][0] + v[j][1] * v[j][1]) + (v[j][2] * v[j][2] + v[j][3] * v[j][3]); }
        const float rstd = 1.f / sqrtf(wave_sum(s2) * (1.f / DMODEL) + LN_EPS);
        GAS f32x4* xo = (GAS f32x4*)(X32 + (size_t)m * DMODEL) + lane;
        GAS unsigned long long* o8 = (GAS unsigned long long*)(XB + (size_t)m * DMODEL) + lane;
#pragma unroll
        for (int j = 0; j < 8; ++j) { const f32x4 o = v[j] * rstd * gg[j] + bb[j]; xo[64 * j] = o;
            if (XB) o8[64 * j] = (unsigned long long)pkbf(o[0], o[1]) | ((unsigned long long)pkbf(o[2], o[3]) << 32); }
    }
}
__device__ __forceinline__ void final_ln_planes(const bf16* XB, const pg8::u32x4* LO8, const float* st, const float* g, const float* b, float* out, int gw, int NGW, int lane) {
    const int fq = lane >> 4, fr = lane & 15;
    for (int it = gw; it < 1024 * 64; it += NGW) {
        const int am = it & 7, wv = (it >> 3) & 7, tile = it >> 6, pm = tile >> 3, pn = tile & 7, wr = wv >> 2, wc = wv & 3, ai = am >> 2, mm = am & 3;
        const int r = pm * 256 + ai * 128 + wr * 64 + mm * 16 + fr, col0 = pn * 256 + wc * 32 + 8 * fq;
        const pg8::u32x4 lo = LO8[(size_t)it * 64 + lane];
        const v4u h0 = *(const GAS v4u*)(XB + (size_t)r * DMODEL + col0), h1 = *(const GAS v4u*)(XB + (size_t)r * DMODEL + col0 + 128);
        const f32x2v s = *(const GAS f32x2v*)(st + 2 * (size_t)r);
        const float mu = s.x * (1.0f / 2048.0f), rs = __builtin_amdgcn_rsqf(s.y * (1.0f / 2048.0f) - mu * mu + LN_EPS);
#pragma unroll
        for (int bj = 0; bj < 2; ++bj) { const v4u h = bj ? h1 : h0; const unsigned w0 = bj ? lo.z : lo.x, w1 = bj ? lo.w : lo.y; const int c = col0 + bj * 128;
            const f32x2v a0 = __builtin_amdgcn_cvt_pk_f32_fp8((int)w0, false), a1 = __builtin_amdgcn_cvt_pk_f32_fp8((int)w0, true), a2 = __builtin_amdgcn_cvt_pk_f32_fp8((int)w1, false), a3 = __builtin_amdgcn_cvt_pk_f32_fp8((int)w1, true);
            const f32x4 y0 = {pg8::bf_lo(h[0]) + a0.x * 0.00390625f, pg8::bf_hi(h[0]) + a0.y * 0.00390625f, pg8::bf_lo(h[1]) + a1.x * 0.00390625f, pg8::bf_hi(h[1]) + a1.y * 0.00390625f};
            const f32x4 y1 = {pg8::bf_lo(h[2]) + a2.x * 0.00390625f, pg8::bf_hi(h[2]) + a2.y * 0.00390625f, pg8::bf_lo(h[3]) + a3.x * 0.00390625f, pg8::bf_hi(h[3]) + a3.y * 0.00390625f};
            const f32x4 g0 = *(const GAS f32x4*)(g + c), g1 = *(const GAS f32x4*)(g + c + 4), b0 = *(const GAS f32x4*)(b + c), b1 = *(const GAS f32x4*)(b + c + 4);
            *(GAS f32x4*)(out + (size_t)r * DMODEL + c) = (y0 - mu) * rs * g0 + b0; *(GAS f32x4*)(out + (size_t)r * DMODEL + c + 4) = (y1 - mu) * rs * g1 + b1; }
    }
}
__device__ __forceinline__ void softmax_rows(const float* __restrict__ SC, bf16* PB, int gw, int NGW, int lane) {
    for (int m = gw; m < MT; m += NGW) {
        const GAS f32x4* sr = (const GAS f32x4*)(SC + (size_t)m * 1024) + lane;
        GAS unsigned long long* o8 = (GAS unsigned long long*)(PB + (size_t)m * 1024) + lane;
        f32x4 v[4];
#pragma unroll
        for (int j = 0; j < 4; ++j) v[j] = sr[64 * j];
#pragma unroll
        for (int j = 0; j < 4; ++j) {
            const float mx = wave_max(fmaxf(fmaxf(v[j][0], v[j][1]), fmaxf(v[j][2], v[j][3])));
            f32x4 e;
#pragma unroll
            for (int k = 0; k < 4; ++k) e[k] = __builtin_amdgcn_exp2f((v[j][k] - mx) * 1.4426950408889634f);
            const float inv = 1.0f / wave_sum((e[0] + e[1]) + (e[2] + e[3]));
            o8[64 * j] = (unsigned long long)pkbf(e[0] * inv, e[1] * inv) | ((unsigned long long)pkbf(e[2] * inv, e[3] * inv) << 32);
        }
    }
}
__device__ __forceinline__ void diff_combine(const bf16* __restrict__ OV, bf16* MIX, const float* lq1, const float* lk1, const float* lq2, const float* lk2, const float* ng, float lam_init, int gw, int NGW, int lane) {
    const float s1 = wave_sum(lq1[lane] * lk1[lane]), s2 = wave_sum(lq2[lane] * lk2[lane]);
    const float lam = expf(s1) - expf(s2) + lam_init, osc = 1.0f - lam_init;
    const int h = lane >> 3, d0 = (lane & 7) * 16;
    float gn[16];
#pragma unroll
    for (int e = 0; e < 16; ++e) gn[e] = ng[d0 + e] * osc;
    for (int m0 = gw; m0 < MT; m0 += 2 * NGW) {
        const int m1 = m0 + NGW; const bool has1 = m1 < MT;
        const bf16* o1 = OV + (size_t)m0 * 2048 + h * 256 + d0; const bf16* p1 = OV + (size_t)(has1 ? m1 : m0) * 2048 + h * 256 + d0;
        v4u q[2][4];
        q[0][0] = *(const GAS v4u*)o1; q[0][1] = *(const GAS v4u*)(o1 + 8); q[0][2] = *(const GAS v4u*)(o1 + 128); q[0][3] = *(const GAS v4u*)(o1 + 136);
        q[1][0] = *(const GAS v4u*)p1; q[1][1] = *(const GAS v4u*)(p1 + 8); q[1][2] = *(const GAS v4u*)(p1 + 128); q[1][3] = *(const GAS v4u*)(p1 + 136);
#pragma unroll
        for (int t = 0; t < 2; ++t) { if (t == 1 && !has1) break;
            const v4u a0 = q[t][0], a1 = q[t][1], b0 = q[t][2], b1 = q[t][3]; float x[16];
#pragma unroll
            for (int k = 0; k < 4; ++k) { x[2 * k] = pg8::bf_lo(a0[k]) - lam * pg8::bf_lo(b0[k]); x[2 * k + 1] = pg8::bf_hi(a0[k]) - lam * pg8::bf_hi(b0[k]);
                x[8 + 2 * k] = pg8::bf_lo(a1[k]) - lam * pg8::bf_lo(b1[k]); x[8 + 2 * k + 1] = pg8::bf_hi(a1[k]) - lam * pg8::bf_hi(b1[k]); }
            float ss = 0.f;
#pragma unroll
            for (int e = 0; e < 16; ++e) ss += x[e] * x[e];
            ss += pg8::sw_xor<1>(ss); ss += pg8::sw_xor<2>(ss); ss += pg8::sw_xor<4>(ss);
            const float r = __builtin_amdgcn_rsqf(ss * (1.0f / 128.0f) + RMS_EPS);
            v4u w0, w1;
#pragma unroll
            for (int k = 0; k < 4; ++k) { w0[k] = pkbf(x[2 * k] * r * gn[2 * k], x[2 * k + 1] * r * gn[2 * k + 1]); w1[k] = pkbf(x[8 + 2 * k] * r * gn[8 + 2 * k], x[8 + 2 * k + 1] * r * gn[8 + 2 * k + 1]); }
            bf16* op = MIX + (size_t)(t ? m1 : m0) * 2048 + h * 128 + d0;
            *(GAS v4u*)op = w0; *(GAS v4u*)(op + 8) = w1; }
    }
}
__device__ __forceinline__ void cpow(float rez, float imz, int tau, float& re, float& im) {
    double rev = (double)imz * (double)tau * 0.15915494309189535; rev -= __builtin_rint(rev);
    const float mg = __builtin_amdgcn_exp2f(rez * (float)tau * 1.4426950408889634f), rv = (float)rev;
    re = mg * __builtin_amdgcn_cosf(rv); im = mg * __builtin_amdgcn_sinf(rv);
}
__device__ __forceinline__ void ssm_prep(const float* lam_re, const float* lam_im, const float* log_step, const float* b_re, const float* b_im, const float* c_re, const float* c_im,
                                         bf16* TG, bf16* EM, LAS unsigned char* lds, int vcu, int G, int tid, bool skipz) {
    LAS float* APre = (LAS float*)lds;
    LAS float* APim = APre + 65 * 64;
    LAS float* BBre = APim + 65 * 64;
    LAS float* BBim = BBre + 1024;
    LAS float* CCre = BBim + 1024;
    LAS float* CCim = CCre + 256;
    LAS float* KT = CCim + 256;
    for (int item = vcu; item < 256; item += G) {
        const int g = item >> 2, pb = item & 3;
        const float step = expf(log_step[g]);
        for (int e = tid; e < 65 * 64; e += NWAVES * 64) { const int tau = e >> 6, n = e & 63; const float lr = fminf(lam_re[g * 64 + n], -1e-4f), li = lam_im[g * 64 + n];
            float re, im; cpow(lr * step, li * step, tau, re, im); APre[e] = re; APim[e] = im; }
        for (int e = tid; e < 1024; e += NWAVES * 64) { const int n = e >> 4; const float lr = fminf(lam_re[g * 64 + n], -1e-4f), li = lam_im[g * 64 + n];
            float ar, ai; cpow(lr * step, li * step, 1, ar, ai);
            const float x = ar - 1.0f, y = ai, den = 1.0f / (lr * lr + li * li);
            const float cr = (x * lr + y * li) * den, ci = (y * lr - x * li) * den;
            const float br = b_re[(size_t)g * 1024 + e], bi = b_im[(size_t)g * 1024 + e];
            BBre[e] = cr * br - ci * bi; BBim[e] = cr * bi + ci * br; }
        for (int e = tid; e < 256; e += NWAVES * 64) { const int pl = e >> 6, n = e & 63; CCre[e] = c_re[(size_t)(g * 16 + 4 * pb + pl) * 64 + n]; CCim[e] = c_im[(size_t)(g * 16 + 4 * pb + pl) * 64 + n]; }
        __syncthreads();
        { const int pq = tid & 63, pl = pq >> 4, q = pq & 15, tb = tid >> 6; float acc[8];
#pragma unroll
          for (int k = 0; k < 8; ++k) acc[k] = 0.f;
          for (int n = 0; n < 64; ++n) { const float cr = CCre[pl * 64 + n], ci = CCim[pl * 64 + n], br = BBre[n * 16 + q], bi = BBim[n * 16 + q];
              const float cbr = cr * br - ci * bi, cbi = cr * bi + ci * br;
#pragma unroll
              for (int k = 0; k < 8; ++k) acc[k] += cbr * APre[(tb * 8 + k) * 64 + n] - cbi * APim[(tb * 8 + k) * 64 + n]; }
#pragma unroll
          for (int k = 0; k < 8; ++k) KT[(tb * 8 + k) * 64 + pq] = acc[k]; }
        __syncthreads();
        for (int idx = tid; idx < 256 * 144; idx += NWAVES * 64) {
            const int rowl = idx / 144, ch = idx - rowl * 144, t = rowl >> 2, pl = rowl & 3; float v[8];
            if (ch >= 16) { const int s = (ch - 16) >> 1, q0 = ((ch - 16) & 1) * 8;
                if (s > (t | 15)) continue;
                if (skipz && s > t) continue;
#pragma unroll
                for (int e = 0; e < 8; ++e) v[e] = (s <= t) ? KT[(t - s) * 64 + pl * 16 + q0 + e] : 0.f;
            } else { const int n0 = ch * 8;
#pragma unroll
                for (int e = 0; e < 8; ++e) { const int n = (n0 + e) & 63; const float cr = CCre[pl * 64 + n], ci = CCim[pl * 64 + n], pr = APre[(t + 1) * 64 + n], pi = APim[(t + 1) * 64 + n];
                    v[e] = (n0 < 64) ? (cr * pr - ci * pi) : -(cr * pi + ci * pr); } }
            v4u o; o.x = pkbf(v[0], v[1]); o.y = pkbf(v[2], v[3]); o.z = pkbf(v[4], v[5]); o.w = pkbf(v[6], v[7]);
            *(GAS v4u*)(TG + (size_t)(g * 1024 + t * 16 + 4 * pb + pl) * UGP + ch * 8) = o;
        }
        for (int idx = tid; idx < 32 * 128; idx += NWAVES * 64) {
            const int rl = idx >> 7, ch = idx & 127, part = rl >> 4, n = 16 * pb + (rl & 15), s = ch >> 1, q0 = (ch & 1) * 8; float v[8];
            const float pr = APre[(63 - s) * 64 + n], pi = APim[(63 - s) * 64 + n];
#pragma unroll
            for (int e = 0; e < 8; ++e) { const float br = BBre[n * 16 + q0 + e], bi = BBim[n * 16 + q0 + e]; v[e] = part ? (pr * bi + pi * br) : (pr * br - pi * bi); }
            v4u o; o.x = pkbf(v[0], v[1]); o.y = pkbf(v[2], v[3]); o.z = pkbf(v[4], v[5]); o.w = pkbf(v[6], v[7]);
            *(GAS v4u*)(EM + (size_t)(g * 128 + part * 64 + n) * 1024 + ch * 8) = o;
        }
        __syncthreads();
    }
}
__device__ __forceinline__ void ssm_scan8(const float* lam_re, const float* lam_im, const float* log_step, const float* VS, bf16* UG, int gb, int wave, int lane, LAS float* xl) {
    const int g = gb >> 1, b = gb & 1, n = lane;
    const float step = expf(log_step[g]), lr = fminf(lam_re[g * 64 + n], -1e-4f), li = lam_im[g * 64 + n];
    float ar, ai; cpow(lr * step, li * step, 64, ar, ai);
    const float* vs = VS + (size_t)(g * 512 + b * 256 + 32 * wave) * 128 + n; bf16* ug = UG + (size_t)(g * 512 + b * 256 + 32 * wave) * UGP + n;
    float vr[32], vi[32];
#pragma unroll
    for (int k = 0; k < 32; ++k) { vr[k] = vs[(size_t)k * 128]; vi[k] = vs[(size_t)k * 128 + 64]; }
    float hr = 0.f, hi = 0.f;
#pragma unroll
    for (int k = 0; k < 32; ++k) { const float nr = ar * hr - ai * hi + vr[k], ni = ar * hi + ai * hr + vi[k]; hr = nr; hi = ni; }
    xl[(wave * 64 + n) * 2] = hr; xl[(wave * 64 + n) * 2 + 1] = hi;
    float pr = ar, pi = ai;
#pragma unroll
    for (int q = 0; q < 5; ++q) { const float tr = pr * pr - pi * pi, ti = 2.f * pr * pi; pr = tr; pi = ti; }
    asm volatile("s_waitcnt lgkmcnt(0)" ::: "memory"); __syncthreads();
    hr = 0.f; hi = 0.f;
    for (int v = 0; v < wave; ++v) { const float er = xl[(v * 64 + n) * 2], ei = xl[(v * 64 + n) * 2 + 1]; const float nr = pr * hr - pi * hi + er, ni = pr * hi + pi * hr + ei; hr = nr; hi = ni; }
#pragma unroll
    for (int k = 0; k < 32; ++k) { const unsigned w = pkbf(hr, hi); ug[(size_t)k * UGP] = (bf16)(w & 0xffffu); ug[(size_t)k * UGP + 64] = (bf16)(w >> 16);
        const float nr = ar * hr - ai * hi + vr[k], ni = ar * hi + ai * hr + vi[k]; hr = nr; hi = ni; }
    asm volatile("s_waitcnt lgkmcnt(0)" ::: "memory"); __syncthreads();
}

struct MapSsmV   { __device__ __forceinline__ void operator()(pg8::Unit& u) const { u.aoff = u.pm * 256 * UGP; u.boff = (u.pm >> 1) * 128 * 1024; } };
struct MapSsmY   { __device__ __forceinline__ void operator()(pg8::Unit& u) const { if ((u.pm >> 3) & 1) u.pn = 3 - u.pn;
        u.aoff = u.pm * 256 * UGP; u.boff = ((u.pm >> 1) * 1024 + u.pn * 256) * UGP; u.nt = 6 + 4 * u.pn; } };
struct MapMQT    { __device__ __forceinline__ void operator()(pg8::Unit& u) const { const int b = u.pm >> 2, h = u.pm & 3; u.aoff = b * 256 * 4096 + h * 512; u.boff = u.pn * 256 * 2048 + h * 512; } };
struct MapVWOT   { __device__ __forceinline__ void operator()(pg8::Unit& u) const { const int b = u.pm >> 3, nt = u.pm & 7, h = u.pn; u.aoff = nt * 256 * 2048 + h * 512; u.boff = b * 256 * 4096 + 2048 + h * 512; } };
struct MapScores { __device__ __forceinline__ void operator()(pg8::Unit& u) const { u.aoff = u.pm * 256 * 2048; u.boff = ((u.pm >> 6) * 1024 + u.pn * 256) * 2048; } };
struct MapOut    { __device__ __forceinline__ void operator()(pg8::Unit& u) const { u.aoff = u.pm * 256 * 1024; u.boff = ((u.pm >> 6) * 2048 + u.pn * 256) * 1024; } };

#ifndef WGM_N8
#define WGM_N8 4
#endif
#ifndef WGM_FF
#define WGM_FF 4
#endif
#ifndef STAG_G
#define STAG_G 1
#endif
#ifndef STAG_US
#define STAG_US 0
#endif
__device__ __forceinline__ void stagger(int bx, int us) {
    const int grp = (bx >> 3) % STAG_G;
    if (STAG_G > 1 && grp) { const unsigned long long t0 = __builtin_amdgcn_s_memrealtime(), dt = (unsigned long long)(grp * us) * 100ull;
        while (__builtin_amdgcn_s_memrealtime() - t0 < dt) __builtin_amdgcn_s_sleep(16); }
}
struct Args { const float* in[NIN]; float* out; unsigned char* ws; };
#ifndef PHMASK
#define PHMASK 0xFFFFFFFFu
#endif
#define PH(k) ((PHMASK >> (k)) & 1u)
#ifndef PROBE_DUP
#define PROBE_DUP -1
#endif
#ifndef PROBE_DUP2
#define PROBE_DUP2 -1
#endif
#ifndef PROBE_DUP3
#define PROBE_DUP3 -1
#endif
#ifndef PROBE_DUP4
#define PROBE_DUP4 -1
#endif
#define PD(k) (PROBE_DUP == (k) || PROBE_DUP2 == (k) || PROBE_DUP3 == (k) || PROBE_DUP4 == (k))
#define P_DUMY ((float*)(WSP + WS_END))
#define P_DUMXB ((bf16*)(WSP + WS_END + 256 * MiB))
#define P_DUMST ((float*)(WSP + WS_END + 384 * MiB))
#define LOAD_GB(gp, bp) do { const float* g_ = (gp); const float* b_ = (bp); LAS float* d_ = (LAS float*)(ldsl + GB_OFF); \
        for (int i_ = tid; i_ < DMODEL; i_ += NWAVES * 64) { d_[i_] = g_[i_]; d_[DMODEL + i_] = b_[i_]; } __syncthreads(); } while (0)
#define LGB ((LAS const float*)(ldsl + GB_OFF))
#define GEMM_PHASE(EPI, ORD, g, S, E) pg8::gemm_phase<EPI, ORD, true, true>(ldsl + RING_OFF, g, S, E)
#ifndef SWIGLU_ALIGN
#define SWIGLU_ALIGN true
#endif
#define GEMM_PHASE_SW(EPI, ORD, g, S, E) pg8::gemm_phase<EPI, ORD, SWIGLU_ALIGN, true>(ldsl + RING_OFF, g, S, E)
typedef __attribute__((address_space(4))) const unsigned char* kargp_t;
__device__ __forceinline__ kargp_t kargs() { kargp_t p = (kargp_t)__builtin_amdgcn_kernarg_segment_ptr(); asm volatile("" : "+s"(p)); return p; }
#define INP(i) (*(const float* const __attribute__((address_space(4)))*)(kargs() + 8 * (i)))
#define P_X32 (*(float* const __attribute__((address_space(4)))*)(kargs() + 8 * NIN))
#define WSP (*(unsigned char* const __attribute__((address_space(4)))*)(kargs() + 8 * (NIN + 1)))
#define P_XB ((bf16*)(WSP + WS_XB))
#define P_YLO ((pg8::u32x4*)(WSP + WS_YLO))
#define P_CS(l, off) ((float*)(WSP + WS_CS) + (size_t)(l) * CSL + (off))
#define P_ST(i) ((float*)(WSP + WS_ST) + (size_t)(i) * (2 * MT))
#define P_HMID ((bf16*)(WSP + WS_HMID))
#define P_QKV ((bf16*)(WSP + WS_QKV))
#define P_UG ((bf16*)(WSP + WS_UG))
#define P_OV ((bf16*)(WSP + WS_OV))
#define P_SC ((float*)(WSP + WS_SC))
#define P_PB ((bf16*)(WSP + WS_PB))
#define P_MIX ((bf16*)(WSP + WS_MIX))
#define P_YG ((bf16*)(WSP + WS_YG))
#define P_VS ((float*)(WSP + WS_VS))
#define P_W1GU ((bf16*)(WSP + WS_W1GU))
#define P_W1D ((bf16*)(WSP + WS_W1D))
#define P_W2GU ((bf16*)(WSP + WS_W2GU))
#define P_W2D ((bf16*)(WSP + WS_W2D))
#define P_WIN ((bf16*)(WSP + WS_WIN))
#define P_WGLU ((bf16*)(WSP + WS_WGLU))
#define P_WOUT ((bf16*)(WSP + WS_WOUT))
#define P_WQN ((bf16*)(WSP + WS_WQN))
#define P_WKVT ((bf16*)(WSP + WS_WKVT))
#define P_WOT ((bf16*)(WSP + WS_WOT))
#define P_TG ((bf16*)(WSP + WS_TG))
#define P_EM ((bf16*)(WSP + WS_EM))
#define P_MEMB ((bf16*)(WSP + WS_MEMB))
#define P_KVM ((bf16*)(WSP + WS_KVM))
#define P_MQT ((bf16*)(WSP + WS_MQT))
#define P_VWOT ((bf16*)(WSP + WS_VWOT))
__global__ void __launch_bounds__(NWAVES * 64, 2) fwd_kernel(Args args) {
    extern __shared__ __attribute__((aligned(16))) unsigned char lds[];
    LAS unsigned char* ldsl = (LAS unsigned char*)lds;
    volatile LAS unsigned* MISC = (volatile LAS unsigned*)(ldsl + MISC_OFF);
#define IDS() const int tid = pg8::otid(), lane = tid & 63, wave = __builtin_amdgcn_readfirstlane(tid >> 6); const int G = pg8::osgpr((int)gridDim.x), bx = pg8::osgpr((int)blockIdx.x), \
        vcu = (G % 8 == 0) ? (bx % 8) * (G / 8) + bx / 8 : bx, gw = vcu * NWAVES + wave, NGW = G * NWAVES; LAS float* scr = (LAS float*)(ldsl + RING_OFF + wave * 16384); \
        (void)lane; (void)gw; (void)NGW; (void)scr; (void)vcu
    { const int tid0 = threadIdx.x;
      for (int u = tid0; u < (LDS_BYTES - LDSCTL_OFF) / 4; u += NWAVES * 64) ((LAS unsigned*)(ldsl + LDSCTL_OFF))[u] = 0u; }
    __syncthreads();
    (void)xcd_barrier_post((unsigned*)((gu32*)(WSP + WS_CTL) + CW_BAR), MISC + 8);
#define GRID_BAR() do { XcdBarrier b_; b_.bar = (unsigned*)((gu32*)(WSP + WS_CTL) + CW_BAR); b_.x = xb_xcc_id(); b_.st = (volatile LAS unsigned*)(ldsl + MISC_OFF) + 8; xcd_barrier(b_); } while (0)

#define CONVERT_LAYER(L, MODE) do { const int L_ = (L); IDS();     \
        if ((MODE) != 2) { \
        conv_T(INP(I_F1G) + (size_t)L_ * DMODEL * FF, DMODEL, FF, P_W1GU, DMODEL, RmGate{0}, L_ ? INP(I_LN4G) + (L_ - 1) * DMODEL : nullptr, INP(I_LN4B) + (L_ ? L_ - 1 : 0) * DMODEL, P_CS(L_, CS1), P_CS(L_, CB1), scr, gw, NGW, lane, 0, 1.4426950408889634f); \
        conv_T(INP(I_F1U) + (size_t)L_ * DMODEL * FF, DMODEL, FF, P_W1GU, DMODEL, RmGate{128}, L_ ? INP(I_LN4G) + (L_ - 1) * DMODEL : nullptr, INP(I_LN4B) + (L_ ? L_ - 1 : 0) * DMODEL, P_CS(L_, CS1), P_CS(L_, CB1), scr, gw, NGW, lane, 704, 0.6931471805599453f); \
        conv_T(INP(I_F1D) + (size_t)L_ * DMODEL * FF, FF, DMODEL, P_W1D, FF, RmId{}, nullptr, nullptr, nullptr, nullptr, scr, gw, NGW, lane, 1408); \
        conv_T(INP(I_F2G) + (size_t)L_ * DMODEL * FF, DMODEL, FF, P_W2GU, DMODEL, RmGate{0}, INP(I_LN3G) + L_ * DMODEL, INP(I_LN3B) + L_ * DMODEL, P_CS(L_, CS2), P_CS(L_, CB2), scr, gw, NGW, lane, 2112, 1.4426950408889634f); \
        conv_T(INP(I_F2U) + (size_t)L_ * DMODEL * FF, DMODEL, FF, P_W2GU, DMODEL, RmGate{128}, INP(I_LN3G) + L_ * DMODEL, INP(I_LN3B) + L_ * DMODEL, P_CS(L_, CS2), P_CS(L_, CB2), scr, gw, NGW, lane, 2816, 0.6931471805599453f); \
        } if ((MODE) != 1) { \
        conv_T(INP(I_F2D) + (size_t)L_ * DMODEL * FF, FF, DMODEL, P_W2D, FF, RmId{}, nullptr, nullptr, nullptr, nullptr, scr, gw, NGW, lane, 3520); \
        } if ((MODE) != 2) { \
        conv_T(INP(I_WIN) + (size_t)L_ * DMODEL * INW, DMODEL, INW, P_WIN, DMODEL, RmId{}, INP(I_LN1G) + L_ * DMODEL, INP(I_LN1B) + L_ * DMODEL, P_CS(L_, CSW), P_CS(L_, CBW), scr, gw, NGW, lane, 4224); \
        conv_T(INP(I_GLUW) + (size_t)L_ * 1024 * 1024, 1024, 1024, P_WGLU, 1024, RmId{}, nullptr, nullptr, nullptr, nullptr, scr, gw, NGW, lane, 4736); \
        conv_T(INP(I_WOUT) + (size_t)L_ * DMODEL * DMODEL, DMODEL, DMODEL, P_WOUT, DMODEL, RmId{}, nullptr, nullptr, nullptr, nullptr, scr, gw, NGW, lane, 4800); \
        conv_copy(INP(I_XQ) + (size_t)L_ * DMODEL * DMODEL, P_WQN, (size_t)DMODEL * DMODEL, gw, NGW, lane); \
        conv_T(INP(I_XK) + (size_t)L_ * DMODEL * DMODEL, DMODEL, DMODEL, P_WKVT, DMODEL, RmId{}, nullptr, nullptr, nullptr, nullptr, scr, gw, NGW, lane, 5056); \
        conv_T(INP(I_XV) + (size_t)L_ * DMODEL * DMODEL, DMODEL, DMODEL, P_WKVT + (size_t)DMODEL * DMODEL, DMODEL, RmId{}, nullptr, nullptr, nullptr, nullptr, scr, gw, NGW, lane, 5312); \
        conv_T(INP(I_XO) + (size_t)L_ * DMODEL * DMODEL, DMODEL, DMODEL, P_WOT, DMODEL, RmId{}, nullptr, nullptr, nullptr, nullptr, scr, gw, NGW, lane, 5568); \
        __syncthreads(); \
        ssm_prep(INP(I_SLRE) + L_ * 4096, INP(I_SLIM) + L_ * 4096, INP(I_SLOG) + L_ * 64, INP(I_SBRE) + (size_t)L_ * 65536, INP(I_SBIM) + (size_t)L_ * 65536, \
                 INP(I_SCRE) + (size_t)L_ * 65536, INP(I_SCIM) + (size_t)L_ * 65536, P_TG, P_EM, ldsl + RING_OFF, vcu, G, tid, L_ > 0); \
        } \
    } while (0)
#define CONVERT_DUMMY(L) do { const int L_ = (L); IDS(); \
        conv_T(INP(I_F1G) + (size_t)L_ * DMODEL * FF, DMODEL, FF, ((bf16*)((unsigned char*)P_W1GU + (WS_END - WS_W))), DMODEL, RmGate{0}, L_ ? INP(I_LN4G) + (L_ - 1) * DMODEL : nullptr, INP(I_LN4B) + (L_ ? L_ - 1 : 0) * DMODEL, (P_DUMST + CS1), (P_DUMST + CB1), scr, gw, NGW, lane, 0, 1.4426950408889634f); \
        conv_T(INP(I_F1U) + (size_t)L_ * DMODEL * FF, DMODEL, FF, ((bf16*)((unsigned char*)P_W1GU + (WS_END - WS_W))), DMODEL, RmGate{128}, L_ ? INP(I_LN4G) + (L_ - 1) * DMODEL : nullptr, INP(I_LN4B) + (L_ ? L_ - 1 : 0) * DMODEL, (P_DUMST + CS1), (P_DUMST + CB1), scr, gw, NGW, lane, 704, 0.6931471805599453f); \
        conv_T(INP(I_F1D) + (size_t)L_ * DMODEL * FF, FF, DMODEL, ((bf16*)((unsigned char*)P_W1D + (WS_END - WS_W))), FF, RmId{}, nullptr, nullptr, nullptr, nullptr, scr, gw, NGW, lane, 1408); \
        conv_T(INP(I_F2G) + (size_t)L_ * DMODEL * FF, DMODEL, FF, ((bf16*)((unsigned char*)P_W2GU + (WS_END - WS_W))), DMODEL, RmGate{0}, INP(I_LN3G) + L_ * DMODEL, INP(I_LN3B) + L_ * DMODEL, (P_DUMST + CS2), (P_DUMST + CB2), scr, gw, NGW, lane, 2112, 1.4426950408889634f); \
        conv_T(INP(I_F2U) + (size_t)L_ * DMODEL * FF, DMODEL, FF, ((bf16*)((unsigned char*)P_W2GU + (WS_END - WS_W))), DMODEL, RmGate{128}, INP(I_LN3G) + L_ * DMODEL, INP(I_LN3B) + L_ * DMODEL, (P_DUMST + CS2), (P_DUMST + CB2), scr, gw, NGW, lane, 2816, 0.6931471805599453f); \
        conv_T(INP(I_F2D) + (size_t)L_ * DMODEL * FF, FF, DMODEL, ((bf16*)((unsigned char*)P_W2D + (WS_END - WS_W))), FF, RmId{}, nullptr, nullptr, nullptr, nullptr, scr, gw, NGW, lane, 3520); \
        conv_T(INP(I_WIN) + (size_t)L_ * DMODEL * INW, DMODEL, INW, ((bf16*)((unsigned char*)P_WIN + (WS_END - WS_W))), DMODEL, RmId{}, INP(I_LN1G) + L_ * DMODEL, INP(I_LN1B) + L_ * DMODEL, (P_DUMST + CSW), (P_DUMST + CBW), scr, gw, NGW, lane, 4224); \
        conv_T(INP(I_GLUW) + (size_t)L_ * 1024 * 1024, 1024, 1024, ((bf16*)((unsigned char*)P_WGLU + (WS_END - WS_W))), 1024, RmId{}, nullptr, nullptr, nullptr, nullptr, scr, gw, NGW, lane, 4736); \
        conv_T(INP(I_WOUT) + (size_t)L_ * DMODEL * DMODEL, DMODEL, DMODEL, ((bf16*)((unsigned char*)P_WOUT + (WS_END - WS_W))), DMODEL, RmId{}, nullptr, nullptr, nullptr, nullptr, scr, gw, NGW, lane, 4800); \
        conv_copy(INP(I_XQ) + (size_t)L_ * DMODEL * DMODEL, ((bf16*)((unsigned char*)P_WQN + (WS_END - WS_W))), (size_t)DMODEL * DMODEL, gw, NGW, lane); \
        conv_T(INP(I_XK) + (size_t)L_ * DMODEL * DMODEL, DMODEL, DMODEL, ((bf16*)((unsigned char*)P_WKVT + (WS_END - WS_W))), DMODEL, RmId{}, nullptr, nullptr, nullptr, nullptr, scr, gw, NGW, lane, 5056); \
        conv_T(INP(I_XV) + (size_t)L_ * DMODEL * DMODEL, DMODEL, DMODEL, ((bf16*)((unsigned char*)P_WKVT + (WS_END - WS_W))) + (size_t)DMODEL * DMODEL, DMODEL, RmId{}, nullptr, nullptr, nullptr, nullptr, scr, gw, NGW, lane, 5312); \
        conv_T(INP(I_XO) + (size_t)L_ * DMODEL * DMODEL, DMODEL, DMODEL, ((bf16*)((unsigned char*)P_WOT + (WS_END - WS_W))), DMODEL, RmId{}, nullptr, nullptr, nullptr, nullptr, scr, gw, NGW, lane, 5568); \
        __syncthreads(); \
        ssm_prep(INP(I_SLRE) + L_ * 4096, INP(I_SLIM) + L_ * 4096, INP(I_SLOG) + L_ * 64, INP(I_SBRE) + (size_t)L_ * 65536, INP(I_SBIM) + (size_t)L_ * 65536, \
                 INP(I_SCRE) + (size_t)L_ * 65536, INP(I_SCIM) + (size_t)L_ * 65536, ((bf16*)((unsigned char*)P_TG + (WS_END - WS_W))), ((bf16*)((unsigned char*)P_EM + (WS_END - WS_W))), ldsl + RING_OFF, vcu, G, tid); \
    } while (0)

    { IDS(); conv_copy(INP(I_X), P_XB, (size_t)MT * DMODEL, gw, NGW, lane);
      conv_copy(INP(I_MEM), P_MEMB, (size_t)NBATCH * NMEM * DMODEL, gw, NGW, lane); }
    CONVERT_LAYER(0, 0);
    GRID_BAR();

#pragma unroll 1
    for (int l = 0; l < DEPTH; ++l) {
        if (PH(1)) { IDS();
        { pg8::Gemm g{P_XB, P_W1GU, DMODEL, DMODEL, DMODEL}; pg8::Order<pg8::MapStd> S; S.init(MT / 256, 2 * FF / 256, G, bx, pg8::MapStd{DMODEL, DMODEL}, WGM_FF);
          pg8::EpiSwiGLU E{P_HMID, FF, pg8::Fold{P_ST(l ? 4 * l - 1 : 0), P_CS(l, CS1), P_CS(l, CB1), l == 0}, ldsl + GB_OFF}; GEMM_PHASE_SW(pg8::EpiSwiGLU, pg8::Order<pg8::MapStd>, g, S, E); }
        }
        GRID_BAR();
        if (PH(2)) { IDS(); stagger(bx, STAG_US);
        { pg8::Gemm g{P_HMID, P_W1D, FF, FF, FF}; pg8::Order<pg8::MapStdRev> S; S.init(MT / 256, DMODEL / 256, G, bx, pg8::MapStdRev{FF, FF, MT / 256}, WGM_N8);
          if (l == 0) { pg8::EpiResLn0 E{INP(I_X), nullptr, LGB, P_XB, P_YLO, nullptr, P_ST(0), ALPHA, 0.5f}; GEMM_PHASE(pg8::EpiResLn0, pg8::Order<pg8::MapStdRev>, g, S, E); }
          else { LOAD_GB(INP(I_LN4G) + (l - 1) * DMODEL, INP(I_LN4B) + (l - 1) * DMODEL); pg8::EpiResLn E{nullptr, P_ST(4 * l - 1), LGB, P_XB, P_YLO, nullptr, P_ST(4 * l), ALPHA, 0.5f}; GEMM_PHASE(pg8::EpiResLn, pg8::Order<pg8::MapStdRev>, g, S, E); } }
        }
        GRID_BAR();
        if (PH(4)) { IDS();
        { pg8::Gemm g{P_XB, P_WIN, DMODEL, DMODEL, DMODEL}; pg8::Order<pg8::MapStd> S; S.init(MT / 256, INW / 256, G, bx, pg8::MapStd{DMODEL, DMODEL});
          pg8::EpiWin<UGP> E{P_QKV, P_UG, attn_body::C2, pg8::Fold{P_ST(4 * l), P_CS(l, CSW), P_CS(l, CBW), 0}, ldsl + GB_OFF}; GEMM_PHASE(pg8::EpiWin<UGP>, pg8::Order<pg8::MapStd>, g, S, E); }
        }
        GRID_BAR();
        if (PH(5)) { IDS();
        { pg8::Gemm g{P_UG + 128, P_EM, UGP, 1024, 1024}; pg8::Order<MapSsmV> S; S.init(128, 1, G, bx, MapSsmV{});
          pg8::EpiF32<1> E{P_VS, 128}; GEMM_PHASE(pg8::EpiF32<1>, pg8::Order<MapSsmV>, g, S, E); }
        { pg8::Gemm g{P_MEMB, P_WKVT, DMODEL, DMODEL, DMODEL}; pg8::Order<pg8::MapStd> S; S.init(2, 16, G, bx - 128, pg8::MapStd{DMODEL, DMODEL});
          pg8::EpiBf16 E{P_KVM, 4096, 1.0f}; GEMM_PHASE(pg8::EpiBf16, pg8::Order<pg8::MapStd>, g, S, E); }
        if (l > 0 && bx >= 128 && G == 256) { conv_T(INP(I_F2D) + (size_t)l * DMODEL * FF, FF, DMODEL, P_W2D, FF, RmId{}, nullptr, nullptr, nullptr, nullptr, scr, (bx - 128) * NWAVES + wave, 128 * NWAVES, lane, 0); }
        else if (l > 0 && G != 256) { conv_T(INP(I_F2D) + (size_t)l * DMODEL * FF, FF, DMODEL, P_W2D, FF, RmId{}, nullptr, nullptr, nullptr, nullptr, scr, gw, NGW, lane, 0); }
        __syncthreads();
        }
        if (PH(6)) { IDS();
        { pg8::Order<MapSsmV> S5; S5.init(128, 1, G, bx, MapSsmV{}); pg8::Unit u5; const bool has5 = S5.next(0, u5);
          if (has5) { __builtin_amdgcn_fence(__ATOMIC_ACQUIRE, "agent"); asm volatile("s_waitcnt vmcnt(0)" ::: "memory");
              ssm_scan8(INP(I_SLRE) + l * 4096, INP(I_SLIM) + l * 4096, INP(I_SLOG) + l * 64, P_VS, P_UG, u5.pm, wave, lane, (LAS float*)(ldsl + RING_OFF)); } }
        { const attn_body::AttnTensors AT{(const attn_body::bf16*)P_QKV, (attn_body::bf16*)P_OV};
#if defined(ATTN_V64)
          const attn_body::StaticOrder S((int)G, (int)bx);
          attn_body::attn_phase<attn_body::StaticOrder>((char*)lds + RING_OFF, AT, S); }
#else
          const attn_body::StaticOrder2 S((int)G, (int)bx);
          attn_body::attn_phase2<attn_body::StaticOrder2>((char*)lds + RING_OFF, AT, S); }
#endif
        }
        GRID_BAR();
        if (PH(7)) { IDS();
        diff_combine(P_OV, P_MIX, INP(I_LQ1) + l * 64, INP(I_LK1) + l * 64, INP(I_LQ2) + l * 64, INP(I_LK2) + l * 64, INP(I_DNG) + l * 128, 0.8f - 0.6f * expf(-0.3f * (float)l), gw, NGW, lane);
        __syncthreads();
        { pg8::Gemm g{P_UG, P_TG, UGP, UGP, UGP}; pg8::Order<MapSsmY> S; S.init(128, 4, G, bx, MapSsmY{});
          pg8::EpiSsmY<UGP> E{P_UG, INP(I_SD) + l * 1024, P_YG}; GEMM_PHASE(pg8::EpiSsmY<UGP>, pg8::Order<MapSsmY>, g, S, E); }
        { pg8::Gemm g{P_KVM, P_WQN, 4096, DMODEL, 512}; pg8::Order<MapMQT> S; S.init(8, 8, G, bx, MapMQT{});
          pg8::EpiMqt E{P_MQT, DMODEL, 0.044194173824159216f, INP(I_LN2G) + l * DMODEL, INP(I_LN2B) + l * DMODEL, P_CS(l, CSM), P_CS(l, CBM)}; GEMM_PHASE(pg8::EpiMqt, pg8::Order<MapMQT>, g, S, E); }
        { pg8::Gemm g{P_WOT, P_KVM, DMODEL, 4096, 512}; pg8::Order<MapVWOT> S; S.init(16, 4, G, bx - 64, MapVWOT{});
          pg8::EpiBf16 E{P_VWOT, 1024, 1.0f}; GEMM_PHASE(pg8::EpiBf16, pg8::Order<MapVWOT>, g, S, E); }
        }
        GRID_BAR();
        if (PH(8)) { IDS();
        { pg8::Gemm g{P_YG, P_WGLU, 1024, 1024, 1024}; pg8::Order<pg8::MapStd> S; S.init(MT / 256, 4, G, bx, pg8::MapStd{1024, 1024});
          pg8::EpiGlu E{P_YG, INP(I_GLUB) + l * 1024, P_MIX}; GEMM_PHASE(pg8::EpiGlu, pg8::Order<pg8::MapStd>, g, S, E); }
        }
        GRID_BAR();
        if (PH(9)) { IDS(); stagger(bx, STAG_US);
        { pg8::Gemm g{P_MIX, P_WOUT, DMODEL, DMODEL, DMODEL}; pg8::Order<pg8::MapStd> S; S.init(MT / 256, DMODEL / 256, G, bx, pg8::MapStd{DMODEL, DMODEL}, WGM_N8);
          LOAD_GB(INP(I_LN1G) + l * DMODEL, INP(I_LN1B) + l * DMODEL); pg8::EpiResLn E{nullptr, P_ST(4 * l), LGB, P_XB, P_YLO, nullptr, P_ST(4 * l + 1), ALPHA, 1.0f}; GEMM_PHASE(pg8::EpiResLn, pg8::Order<pg8::MapStd>, g, S, E); }
        }
        GRID_BAR();
        if (PH(11)) { IDS();
        { pg8::Gemm g{P_XB, P_MQT, DMODEL, DMODEL, DMODEL}; pg8::Order<MapScores> S; S.init(MT / 256, 4, G, bx, MapScores{});
          pg8::EpiScoresSm E{P_PB, pg8::Fold{P_ST(4 * l + 1), P_CS(l, CSM), P_CS(l, CBM), 0}, (LAS float*)(ldsl + XCH_OFF)}; GEMM_PHASE(pg8::EpiScoresSm, pg8::Order<MapScores>, g, S, E); }
        }
        GRID_BAR();
        if (PH(13)) { IDS(); stagger(bx, STAG_US);
        { pg8::Gemm g{P_PB, P_VWOT, 1024, 1024, 1024}; pg8::Order<MapOut> S; S.init(MT / 256, DMODEL / 256, G, bx, MapOut{}, WGM_N8);
          LOAD_GB(INP(I_LN2G) + l * DMODEL, INP(I_LN2B) + l * DMODEL); pg8::EpiResLn E{nullptr, P_ST(4 * l + 1), LGB, P_XB, P_YLO, nullptr, P_ST(4 * l + 2), ALPHA, 1.0f}; GEMM_PHASE(pg8::EpiResLn, pg8::Order<MapOut>, g, S, E); }
        }
        GRID_BAR();
        if (PH(15)) { IDS();
        { pg8::Gemm g{P_XB, P_W2GU, DMODEL, DMODEL, DMODEL}; pg8::Order<pg8::MapStd> S; S.init(MT / 256, 2 * FF / 256, G, bx, pg8::MapStd{DMODEL, DMODEL}, WGM_FF);
          pg8::EpiSwiGLU E{P_HMID, FF, pg8::Fold{P_ST(4 * l + 2), P_CS(l, CS2), P_CS(l, CB2), 0}, ldsl + GB_OFF}; GEMM_PHASE_SW(pg8::EpiSwiGLU, pg8::Order<pg8::MapStd>, g, S, E); }
        }
        GRID_BAR();
        if (PH(16)) { IDS(); stagger(bx, STAG_US);
        { pg8::Gemm g{P_HMID, P_W2D, FF, FF, FF}; pg8::Order<pg8::MapStdRev> S; S.init(MT / 256, DMODEL / 256, G, bx, pg8::MapStdRev{FF, FF, MT / 256}, WGM_N8);
          LOAD_GB(INP(I_LN3G) + l * DMODEL, INP(I_LN3B) + l * DMODEL);
          { pg8::EpiResLn E{nullptr, P_ST(4 * l + 2), LGB, P_XB, P_YLO, nullptr, P_ST(4 * l + 3), ALPHA, 0.5f}; GEMM_PHASE(pg8::EpiResLn, pg8::Order<pg8::MapStdRev>, g, S, E); } }
        }
        if (l + 1 < DEPTH) { CONVERT_LAYER(l + 1, 1); GRID_BAR(); }
        else { GRID_BAR(); IDS(); final_ln_planes(P_XB, P_YLO, P_ST(4 * l + 3), INP(I_LN4G) + l * DMODEL, INP(I_LN4B) + l * DMODEL, P_X32, gw, NGW, lane); }
    }
}

extern "C" void kernel_launch(void* const* d_in, const int* in_sizes, int n_in, void* d_out, int out_size, void* d_ws, size_t ws_size, hipStream_t stream) {
    static int grid = 0;
    if (grid == 0) {
        if (n_in != NIN || in_sizes[0] != MT * DMODEL || out_size != MT * DMODEL || ws_size < WS_END) { fprintf(stderr, "kernel_launch: unexpected problem shape (n_in %d, in0 %d, out %d, ws %zu < %zu); nothing launched\n", n_in, n_in > 0 ? in_sizes[0] : -1, out_size, ws_size, (size_t)WS_END); grid = -1; return; }
        int dev = 0, cus = 0, per_cu = 0;
        if (hipGetDevice(&dev) != hipSuccess || hipDeviceGetAttribute(&cus, hipDeviceAttributeMultiprocessorCount, dev) != hipSuccess) { fprintf(stderr, "kernel_launch: device query failed\n"); grid = -1; return; }
        if (hipFuncSetAttribute((const void*)fwd_kernel, hipFuncAttributeMaxDynamicSharedMemorySize, LDS_BYTES) != hipSuccess) { fprintf(stderr, "kernel_launch: hipFuncSetAttribute failed\n"); grid = -1; return; }
        if (hipOccupancyMaxActiveBlocksPerMultiprocessor(&per_cu, (const void*)fwd_kernel, NWAVES * 64, LDS_BYTES) != hipSuccess || per_cu < 1)
            fprintf(stderr, "kernel_launch: note: occupancy query reports %d workgroups per CU\n", per_cu);
        (void)hipGetLastError();
        grid = cus;
    }
    if (grid < 0) return;
    if (hipMemsetAsync((char*)d_ws + WS_CTL, 0, CTL_ZERO_BYTES, stream) != hipSuccess) { fprintf(stderr, "kernel_launch: hipMemsetAsync failed\n"); return; }
    Args a{};
    for (int i = 0; i < NIN; ++i) a.in[i] = (const float*)d_in[i];
    a.out = (float*)d_out; a.ws = (unsigned char*)d_ws;
    hipLaunchKernelGGL(fwd_kernel, dim3(grid), dim3(NWAVES * 64), LDS_BYTES, stream, a);
    const hipError_t le = hipPeekAtLastError();
    if (le != hipSuccess) fprintf(stderr, "kernel_launch: launch failed: %s\n", hipGetErrorName(le));
}
```

```cpp
#pragma clang diagnostic ignored "-Winline-asm"
#include <hip/hip_runtime.h>
#include <hip/hip_bf16.h>
#include <cstdio>
#include <cstdint>
#include <cmath>
namespace pg8 {
#define PG8_LAS __attribute__((address_space(3)))
typedef unsigned short bf16_t;
typedef short bf16x8 __attribute__((ext_vector_type(8)));
typedef float f32x4 __attribute__((ext_vector_type(4)));
typedef float f32x2 __attribute__((ext_vector_type(2)));
typedef unsigned u32x4 __attribute__((ext_vector_type(4)));
constexpr int BM = 256, BK = 64, HALF = 128, HTB = HALF * BK * 2  , STAGE_BYTES = 8 * HTB, NXCD = 8, WGM = 8;

__host__ __device__ __forceinline__ int lds_byte(int r, int c) { const int st = (r >> 4) * 2 + (c >> 5), rr = r & 15, cc = c & 31, ob = rr * 64 + cc * 2; return st * 1024 + (ob ^ (((ob >> 9) & 1) << 5)); }
__host__ __device__ __forceinline__ void stage_rc(int b, int& R, int& C) { const int st = b / 1024, sb = b % 1024, swz = sb ^ (((sb >> 9) & 1) << 5); R = (st >> 1) * 16 + swz / 64; C = (st & 1) * 32 + (swz % 64) / 2; }
__host__ __device__ __forceinline__ int perm32(int rho) { const int n = rho >> 4, i = rho & 15; return 8 * (i >> 2) + 4 * n + (i & 3); }

struct Unit { int aoff, boff, pm, pn, nt; };
struct Gemm { const bf16_t* A; const bf16_t* Bt; int lda, ldb, K; };

template <class Map> struct Order {
    int nM, nN, nwg, G, c, wgm; Map map;
    __device__ __forceinline__ void init(int nM_, int nN_, int G_, int c_, const Map& m, int wgm_ = WGM) { nM = nM_; nN = nN_; nwg = nM * nN; G = G_; c = c_; map = m; wgm = wgm_; }
    __device__ __forceinline__ bool next(int i, Unit& u) const {
        const long L = (long)i * G + c; if (c < 0 || L >= nwg) return false;
        int wgid = (int)L; { const int q = nwg / NXCD, r = nwg % NXCD, xcd = wgid % NXCD, off = wgid / NXCD; wgid = (xcd < r ? xcd * (q + 1) : r * (q + 1) + (xcd - r) * q) + off; }
        const int nig = wgm * nN, gid = wgid / nig, fm = gid * wgm, gsz = (nM - fm) < wgm ? (nM - fm) : wgm;
        u.pm = fm + ((wgid % nig) % gsz); u.pn = (wgid % nig) / gsz; u.nt = 0; map(u); return true;
    }
    __device__ __forceinline__ void a_ready(const Unit&) const {}
    __device__ __forceinline__ void done(const Unit&) const {}
};
struct MapStd { int lda, ldb; __device__ __forceinline__ void operator()(Unit& u) const { u.aoff = u.pm * BM * lda; u.boff = u.pn * BM * ldb; } };

struct MapStdRev { int lda, ldb, nM; __device__ __forceinline__ void operator()(Unit& u) const { u.pm = nM - 1 - u.pm; u.aoff = u.pm * BM * lda; u.boff = u.pn * BM * ldb; } };

__device__ __forceinline__ unsigned cvt_pk_bf16(float lo, float hi) { unsigned r; asm volatile("v_cvt_pk_bf16_f32 %0, %1, %2" : "=v"(r) : "v"(lo), "v"(hi)); return r; }
__device__ __forceinline__ float bf_lo(unsigned w) { return __uint_as_float(w << 16); }
__device__ __forceinline__ float bf_hi(unsigned w) { return __uint_as_float(w & 0xffff0000u); }
__device__ __forceinline__ float sigmoid_f(float z) { return __builtin_amdgcn_rcpf(1.0f + __builtin_amdgcn_exp2f(-1.4426950408889634f * z)); }
__device__ __forceinline__ int otid() { int t = threadIdx.x; asm volatile("" : "+v"(t)); return t; }
__device__ __forceinline__ int osgpr(int v) { asm volatile("" : "+s"(v)); return v; }
template <int K> __device__ __forceinline__ float sw_xor(float v) { return __int_as_float(__builtin_amdgcn_ds_swizzle(__float_as_int(v), (K << 10) | 0x1f)); }
__device__ __forceinline__ float add_xor32(float v) { auto rr = __builtin_amdgcn_permlane32_swap(__float_as_uint(v), __float_as_uint(v), false, false); return __uint_as_float(rr[0]) + __uint_as_float(rr[1]); }
__device__ __forceinline__ float max_xor32(float v) { auto rr = __builtin_amdgcn_permlane32_swap(__float_as_uint(v), __float_as_uint(v), false, false); return fmaxf(__uint_as_float(rr[0]), __uint_as_float(rr[1])); }
__device__ __forceinline__ float red16_32(float v) { v += sw_xor<16>(v); return add_xor32(v); }
template <class T> __device__ __forceinline__ T* at32(const void* base, unsigned byte_off) { return (T*)((char*)const_cast<void*>(base) + byte_off); }
#define PG8_EPI_ARGS const f32x4 (&acc)[2][2][4][2], const Unit& u, int wr, int wc, int fr, int fq
__device__ __forceinline__ u32x4 pack8(const f32x4 v0, const f32x4 v1) { u32x4 w; w.x = cvt_pk_bf16(v0[0], v0[1]); w.y = cvt_pk_bf16(v0[2], v0[3]); w.z = cvt_pk_bf16(v1[0], v1[1]); w.w = cvt_pk_bf16(v1[2], v1[3]); return w; }


struct Fold { const float* stats; const float* cs; const float* cb; int ident; };
__device__ __forceinline__ void fold_row(const Fold& f, int r, float& mu, float& rs) {
    const f32x2 s = *(const f32x2*)(f.stats + 2 * (size_t)r); mu = s.x * (1.0f / 2048.0f); const float var = s.y * (1.0f / 2048.0f) - mu * mu; rs = __builtin_amdgcn_rsqf(var + 1e-5f);
}
__device__ __forceinline__ void fold_rows8(const Fold& f, int row0, float (&mu)[2][4], float (&rs)[2][4]) {
    f32x2 st[2][4];
#pragma unroll
    for (int ai = 0; ai < 2; ++ai)
#pragma unroll
        for (int m = 0; m < 4; ++m) st[ai][m] = *at32<const f32x2>(f.stats, 8u * (unsigned)(row0 + ai * HALF + m * 16));
#pragma unroll
    for (int ai = 0; ai < 2; ++ai)
#pragma unroll
        for (int m = 0; m < 4; ++m) { mu[ai][m] = st[ai][m].x * (1.0f / 2048.0f); rs[ai][m] = __builtin_amdgcn_rsqf(st[ai][m].y * (1.0f / 2048.0f) - mu[ai][m] * mu[ai][m] + 1e-5f); }
}
__device__ __forceinline__ f32x4 fold4(const f32x4 a, float mu, float rs, const f32x4 cs, const f32x4 cb) { return (a - cs * mu) * rs + cb; }

__device__ __forceinline__ void fold_prefetch(const Fold& f, const Unit& u, PG8_LAS unsigned char* pf) {
    const int tid = otid(), wid = __builtin_amdgcn_readfirstlane(tid >> 6), L = tid & 63, wr = wid >> 2, wc = wid & 3, q = (L >> 3) & 3;
    PG8_LAS unsigned char* slot = pf + wid * 2048;
    __builtin_amdgcn_global_load_lds((const unsigned*)(f.stats + 2 * (u.pm * BM + (L >> 5) * HALF + wr * 64 + (L & 31) * 2)), (PG8_LAS unsigned*)slot, 16, 0, 0);
    __builtin_amdgcn_global_load_lds((const unsigned*)(((q & 2) ? f.cb : f.cs) + u.pn * BM + (q & 1) * HALF + wc * 32 + (L & 7) * 4), (PG8_LAS unsigned*)(slot + 1024), 16, 0, 0);
}
__device__ __forceinline__ void fold_from_lds(PG8_LAS const unsigned char* pf, int wr, int wc, int fr, int fq, f32x4 (&cs)[2][2], f32x4 (&cb)[2][2], float (&mu)[2][4], float (&rs)[2][4]) {
    PG8_LAS const unsigned char* slot = pf + (wr * 4 + wc) * 2048;
    f32x2 st[2][4];
#pragma unroll
    for (int ai = 0; ai < 2; ++ai)
#pragma unroll
        for (int m = 0; m < 4; ++m) st[ai][m] = *(const PG8_LAS f32x2*)(slot + (ai * 64 + m * 16 + fr) * 8);
#pragma unroll
    for (int bj = 0; bj < 2; ++bj)
#pragma unroll
        for (int n = 0; n < 2; ++n) { cs[bj][n] = *(const PG8_LAS f32x4*)(slot + 1024 + (bj * 8 + 2 * fq + n) * 16); cb[bj][n] = *(const PG8_LAS f32x4*)(slot + 1024 + ((2 + bj) * 8 + 2 * fq + n) * 16); }
#pragma unroll
    for (int ai = 0; ai < 2; ++ai)
#pragma unroll
        for (int m = 0; m < 4; ++m) { mu[ai][m] = st[ai][m].x * (1.0f / 2048.0f); rs[ai][m] = __builtin_amdgcn_rsqf(st[ai][m].y * (1.0f / 2048.0f) - mu[ai][m] * mu[ai][m] + 1e-5f); }
}

struct EpiBf16 {
    static constexpr bool PERM = true, AFTER_DRAIN = false, PREF = false;
    bf16_t* O; int ldc; float scale;
    __device__ __forceinline__ void operator()(PG8_EPI_ARGS) const {
        const int row0 = u.pm * BM + wr * 64 + fr, col0 = u.pn * BM + wc * 32 + 8 * fq;
#pragma unroll
        for (int ai = 0; ai < 2; ++ai)
#pragma unroll
            for (int m = 0; m < 4; ++m) { const unsigned bo = 2u * (unsigned)((row0 + ai * HALF + m * 16) * ldc + col0);
#pragma unroll
                for (int bj = 0; bj < 2; ++bj) *at32<u32x4>(O, bo + 2u * bj * HALF) = pack8(acc[ai][bj][m][0] * scale, acc[ai][bj][m][1] * scale); }
    }
};
template <int NBJ> struct EpiF32 {
    static constexpr bool PERM = false, AFTER_DRAIN = false, PREF = false;
    float* O; int ldc;
    __device__ __forceinline__ void operator()(PG8_EPI_ARGS) const {
        const int row0 = u.pm * BM + wr * 64 + fr, col0 = u.pn * (NBJ == 2 ? BM : HALF) + wc * 32 + 4 * fq;
#pragma unroll
        for (int ai = 0; ai < 2; ++ai)
#pragma unroll
            for (int m = 0; m < 4; ++m) { float* rowp = O + (size_t)(row0 + ai * HALF + m * 16) * ldc + col0;
#pragma unroll
                for (int bj = 0; bj < NBJ; ++bj)
#pragma unroll
                    for (int n = 0; n < 2; ++n) *(f32x4*)(rowp + bj * HALF + n * 16) = acc[ai][bj][m][n]; }
    }
};

struct EpiScoresSm {
    static constexpr bool PERM = true, AFTER_DRAIN = false, PREF = false;
    bf16_t* PB; Fold f; PG8_LAS float* xch;
    __device__ __forceinline__ void operator()(PG8_EPI_ARGS) const {
        f32x4 (&s)[2][2][4][2] = const_cast<f32x4 (&)[2][2][4][2]>(acc);
        const int row0 = u.pm * BM + wr * 64 + fr, col0 = u.pn * BM + wc * 32 + 8 * fq, vb = (u.pm >> 6) * 1024, rl0 = wr * 64 + fr;
        { f32x4 cs[2][2], cb[2][2]; float mus[2][4], rss[2][4]; fold_rows8(f, row0, mus, rss);
#pragma unroll
          for (int bj = 0; bj < 2; ++bj)
#pragma unroll
            for (int n = 0; n < 2; ++n) { cs[bj][n] = *(const f32x4*)(f.cs + vb + col0 + bj * HALF + 4 * n); cb[bj][n] = *(const f32x4*)(f.cb + vb + col0 + bj * HALF + 4 * n); }
#pragma unroll
          for (int ai = 0; ai < 2; ++ai)
#pragma unroll
            for (int m = 0; m < 4; ++m) { const float mu = mus[ai][m], rs = rss[ai][m]; float mx = -3.0e38f;
#pragma unroll
                for (int bj = 0; bj < 2; ++bj)
#pragma unroll
                    for (int n = 0; n < 2; ++n) { const f32x4 v = fold4(s[ai][bj][m][n], mu, rs, cs[bj][n], cb[bj][n]) * 1.4426950408889634f; s[ai][bj][m][n] = v;
                        mx = fmaxf(fmaxf(mx, fmaxf(v[0], v[1])), fmaxf(v[2], v[3])); }
                mx = fmaxf(mx, sw_xor<16>(mx)); mx = max_xor32(mx);
                if (fq == 0) xch[(ai * HALF + m * 16 + rl0) * 4 + wc] = mx; } }
        asm volatile("s_waitcnt lgkmcnt(0)" ::: "memory"); __builtin_amdgcn_s_barrier(); asm volatile("" ::: "memory");
#pragma unroll
        for (int ai = 0; ai < 2; ++ai)
#pragma unroll
            for (int m = 0; m < 4; ++m) { const f32x4 q = *(const PG8_LAS f32x4*)(xch + (ai * HALF + m * 16 + rl0) * 4); const float M = fmaxf(fmaxf(q[0], q[1]), fmaxf(q[2], q[3])); float sm = 0.f;
#pragma unroll
                for (int bj = 0; bj < 2; ++bj)
#pragma unroll
                    for (int n = 0; n < 2; ++n) { f32x4 v = s[ai][bj][m][n];
#pragma unroll
                        for (int e = 0; e < 4; ++e) v[e] = __builtin_amdgcn_exp2f(v[e] - M);
                        s[ai][bj][m][n] = v; sm += (v[0] + v[1]) + (v[2] + v[3]); }
                sm = red16_32(sm);
                if (fq == 0) xch[1024 + (ai * HALF + m * 16 + rl0) * 4 + wc] = sm; }
        asm volatile("s_waitcnt lgkmcnt(0)" ::: "memory"); __builtin_amdgcn_s_barrier(); asm volatile("" ::: "memory");
#pragma unroll
        for (int ai = 0; ai < 2; ++ai)
#pragma unroll
            for (int m = 0; m < 4; ++m) { const f32x4 q = *(const PG8_LAS f32x4*)(xch + 1024 + (ai * HALF + m * 16 + rl0) * 4); const float inv = __builtin_amdgcn_rcpf((q[0] + q[1]) + (q[2] + q[3]));
                const unsigned bo = 2u * (unsigned)((row0 + ai * HALF + m * 16) * 1024 + col0);
#pragma unroll
                for (int bj = 0; bj < 2; ++bj) *at32<u32x4>(PB, bo + 2u * bj * HALF) = pack8(s[ai][bj][m][0] * inv, s[ai][bj][m][1] * inv); }
        asm volatile("s_waitcnt lgkmcnt(0)" ::: "memory");
    }
};
struct EpiSwiGLU {
    static constexpr bool PERM = true, AFTER_DRAIN = false, PREF = true;
    bf16_t* O; int ldc; Fold f; PG8_LAS unsigned char* pf;
    __device__ __forceinline__ void pref(const Unit& u) const { if (!f.ident) fold_prefetch(f, u, pf); }
    __device__ __forceinline__ void operator()(PG8_EPI_ARGS) const {
        const int row0 = u.pm * BM + wr * 64 + fr, col0 = u.pn * HALF + wc * 32 + 8 * fq;
        f32x4 cs[2][2], cb[2][2]; float mus[2][4], rss[2][4];
        if (!f.ident) {
            fold_from_lds(pf, wr, wc, fr, fq, cs, cb, mus, rss);
        } else {
#pragma unroll
            for (int ai = 0; ai < 2; ++ai)
#pragma unroll
                for (int m = 0; m < 4; ++m) { mus[ai][m] = 0.f; rss[ai][m] = 1.f; }
        }
#pragma unroll
        for (int ai = 0; ai < 2; ++ai)
#pragma unroll
            for (int m = 0; m < 4; ++m) { const int r = row0 + ai * HALF + m * 16; f32x4 v[2]; const float mu = mus[ai][m], rs = rss[ai][m];
#pragma unroll
                for (int n = 0; n < 2; ++n) { f32x4 g = acc[ai][0][m][n], up = acc[ai][1][m][n];
                    if (!f.ident) { g = fold4(g, mu, rs, cs[0][n], cb[0][n]); up = fold4(up, mu, rs, cs[1][n], cb[1][n]); }
#pragma unroll
                    for (int e = 0; e < 4; ++e) v[n][e] = (g[e] * up[e]) * __builtin_amdgcn_rcpf(1.0f + __builtin_amdgcn_exp2f(-g[e])); }
                *at32<u32x4>(O, 2u * (unsigned)(r * ldc + col0)) = pack8(v[0], v[1]); }
    }
};
template <bool IDENT, bool WF32 = false, int SKIP = 0> struct EpiResLnT {
    static constexpr bool PERM = true, AFTER_DRAIN = false, PREF = false; static constexpr int RB = 4;
    const float* xin; const float* st_old; PG8_LAS const float* lgb; bf16_t* XB; u32x4* LO8; float* yf32; float* st_new; float alpha, scale;
    __device__ __forceinline__ void operator()(PG8_EPI_ARGS) const {
        const int row0 = u.pm * BM + wr * 64 + fr, col0 = u.pn * BM + wc * 32 + 8 * fq;
        PG8_LAS float* xst = const_cast<PG8_LAS float*>(lgb) + 4096;
        u32x4* lop = LO8 + ((size_t)((u.pm * 8 + u.pn) * 8 + wr * 4 + wc) * 8) * 64 + fq * 16 + fr;
#pragma unroll
        for (int ab = 0; ab < 8 / RB; ++ab) { const int ai = (ab * RB) >> 2, m0 = (ab * RB) & 3; float mu[RB], rs[RB], s1[RB], s2[RB]; u32x4 hi[RB][2], lo[RB];
            u32x4 xi[RB][2];
            { f32x2 st[RB];
              if (!IDENT) {
#pragma unroll
                for (int m = 0; m < RB; ++m) st[m] = *at32<const f32x2>(st_old, 8u * (unsigned)(row0 + ai * HALF + (m0 + m) * 16)); }
#pragma unroll
              for (int m = 0; m < RB; ++m) {
                if (!IDENT) lo[m] = (SKIP & 1) ? (u32x4){0u, 0u, 0u, 0u} : __builtin_nontemporal_load(lop + (ai * 4 + m0 + m) * 64);
#pragma unroll
                for (int bj = 0; bj < 2; ++bj) { const unsigned off = (unsigned)((row0 + ai * HALF + (m0 + m) * 16) * 2048 + col0 + bj * HALF);
                    if (IDENT) { hi[m][bj] = *at32<const u32x4>(xin, 4u * off); xi[m][bj] = *at32<const u32x4>(xin, 4u * off + 16u); }
                    else hi[m][bj] = (SKIP & 1) ? (u32x4){0u, 0u, 0u, 0u} : *at32<const u32x4>(XB, 2u * off); } }
              asm volatile("" ::: "memory");
#pragma unroll
              for (int m = 0; m < RB; ++m) { s1[m] = 0.f; s2[m] = 0.f; mu[m] = 0.f; rs[m] = 1.f;
                  if (!IDENT) { mu[m] = st[m].x * (1.0f / 2048.0f); rs[m] = __builtin_amdgcn_rsqf(st[m].y * (1.0f / 2048.0f) - mu[m] * mu[m] + 1e-5f); } } }
            u32x4 lon[RB];
#pragma unroll
            for (int bj = 0; bj < 2; ++bj) { f32x4 gg[2], bb[2];
                if (!IDENT) {
#pragma unroll
                    for (int n = 0; n < 2; ++n) { gg[n] = *(const PG8_LAS f32x4*)(lgb + col0 + bj * HALF + 4 * n); bb[n] = *(const PG8_LAS f32x4*)(lgb + 2048 + col0 + bj * HALF + 4 * n); } }
#pragma unroll
                for (int m = 0; m < RB; ++m) { const unsigned off = (unsigned)((row0 + ai * HALF + (m0 + m) * 16) * 2048 + col0 + bj * HALF); f32x4 v[2]; const u32x4 h0 = hi[m][bj];
                    if (IDENT) { const u32x4 l0 = xi[m][bj]; v[0] = (f32x4){__uint_as_float(h0.x), __uint_as_float(h0.y), __uint_as_float(h0.z), __uint_as_float(h0.w)}; v[1] = (f32x4){__uint_as_float(l0.x), __uint_as_float(l0.y), __uint_as_float(l0.z), __uint_as_float(l0.w)}; }
                    else { const unsigned w0 = bj ? lo[m].z : lo[m].x, w1 = bj ? lo[m].w : lo[m].y;
                           const f32x2 a0 = __builtin_amdgcn_cvt_pk_f32_fp8((int)w0, false), a1 = __builtin_amdgcn_cvt_pk_f32_fp8((int)w0, true), a2 = __builtin_amdgcn_cvt_pk_f32_fp8((int)w1, false), a3 = __builtin_amdgcn_cvt_pk_f32_fp8((int)w1, true);
                           v[0] = (f32x4){bf_lo(h0.x) + a0.x * 0.00390625f, bf_hi(h0.x) + a0.y * 0.00390625f, bf_lo(h0.y) + a1.x * 0.00390625f, bf_hi(h0.y) + a1.y * 0.00390625f};
                           v[1] = (f32x4){bf_lo(h0.z) + a2.x * 0.00390625f, bf_hi(h0.z) + a2.y * 0.00390625f, bf_lo(h0.w) + a3.x * 0.00390625f, bf_hi(h0.w) + a3.y * 0.00390625f}; }
#pragma unroll
                    for (int n = 0; n < 2; ++n) { f32x4 x = v[n];
                        if (!IDENT) x = (x - mu[m]) * rs[m] * gg[n] + bb[n];
                        v[n] = x * alpha + acc[ai][bj][m0 + m][n] * scale;
                        if (WF32) *at32<f32x4>(yf32, 4u * off + 16u * n) = v[n];
                        s1[m] += (v[n][0] + v[n][1]) + (v[n][2] + v[n][3]); s2[m] += (v[n][0] * v[n][0] + v[n][1] * v[n][1]) + (v[n][2] * v[n][2] + v[n][3] * v[n][3]); }
                    const u32x4 h = pack8(v[0], v[1]);
                    const f32x4 d0 = {(v[0][0] - bf_lo(h.x)) * 256.0f, (v[0][1] - bf_hi(h.x)) * 256.0f, (v[0][2] - bf_lo(h.y)) * 256.0f, (v[0][3] - bf_hi(h.y)) * 256.0f},
                                d1 = {(v[1][0] - bf_lo(h.z)) * 256.0f, (v[1][1] - bf_hi(h.z)) * 256.0f, (v[1][2] - bf_lo(h.w)) * 256.0f, (v[1][3] - bf_hi(h.w)) * 256.0f};
                    int e0 = __builtin_amdgcn_cvt_pk_fp8_f32(d0[0], d0[1], 0, false); e0 = __builtin_amdgcn_cvt_pk_fp8_f32(d0[2], d0[3], e0, true);
                    int e1 = __builtin_amdgcn_cvt_pk_fp8_f32(d1[0], d1[1], 0, false); e1 = __builtin_amdgcn_cvt_pk_fp8_f32(d1[2], d1[3], e1, true);
                    if (bj == 0) { lon[m].x = (unsigned)e0; lon[m].y = (unsigned)e1; } else { lon[m].z = (unsigned)e0; lon[m].w = (unsigned)e1; }
                    if (!(SKIP & 2)) *at32<u32x4>(XB, 2u * off) = h; } }
#pragma unroll
            for (int m = 0; m < RB; ++m) { if (!(SKIP & 2)) __builtin_nontemporal_store(lon[m], lop + (ai * 4 + m0 + m) * 64);
                const float a = red16_32(s1[m]), b = red16_32(s2[m]);
                if (fq == 0) { const int rl = ai * HALF + wr * 64 + (m0 + m) * 16 + fr; xst[rl * 8 + wc] = a; xst[rl * 8 + 4 + wc] = b; } }
            asm volatile("" ::: "memory"); }
        asm volatile("s_waitcnt lgkmcnt(0)" ::: "memory"); __builtin_amdgcn_s_barrier(); asm volatile("" ::: "memory");
        { const int t = (wr * 4 + wc) * 64 + fq * 16 + fr;
          if (t < 256 && st_new && !(SKIP & 4)) { const PG8_LAS float* p = xst + t * 8; const float sa = (p[0] + p[1]) + (p[2] + p[3]), sb = (p[4] + p[5]) + (p[6] + p[7]); float* dst = st_new + 2 * (size_t)(row0 - wr * 64 - fr + t);
              unsafeAtomicAdd(dst, sa); unsafeAtomicAdd(dst + 1, sb); }
          asm volatile("s_waitcnt lgkmcnt(0)" ::: "memory"); }
    }
};
typedef EpiResLnT<false> EpiResLn; typedef EpiResLnT<true> EpiResLn0; typedef EpiResLnT<false, true> EpiResLnF;
struct EpiMqt {
    static constexpr bool PERM = true, AFTER_DRAIN = false, PREF = false;
    bf16_t* O; int ldc; float scale; const float* gk; const float* bk; float* cs; float* cb;
    __device__ __forceinline__ void operator()(PG8_EPI_ARGS) const {
        const int row0 = u.pm * BM + wr * 64 + fr, col0 = u.pn * BM + wc * 32 + 8 * fq;
        f32x4 gg[2][2], bb[2][2];
#pragma unroll
        for (int bj = 0; bj < 2; ++bj)
#pragma unroll
            for (int n = 0; n < 2; ++n) { gg[bj][n] = *(const f32x4*)(gk + col0 + bj * HALF + 4 * n); bb[bj][n] = *(const f32x4*)(bk + col0 + bj * HALF + 4 * n); }
#pragma unroll
        for (int ai = 0; ai < 2; ++ai)
#pragma unroll
            for (int m = 0; m < 4; ++m) { const int r = row0 + ai * HALF + m * 16; float s1 = 0.f, s2 = 0.f;
#pragma unroll
                for (int bj = 0; bj < 2; ++bj) { const f32x4 v0 = acc[ai][bj][m][0] * scale, v1 = acc[ai][bj][m][1] * scale;
                    const u32x4 w = pack8(v0 * gg[bj][0], v1 * gg[bj][1]);
                    *(u32x4*)(O + (size_t)r * ldc + col0 + bj * HALF) = w;
                    s1 += (bf_lo(w.x) + bf_hi(w.x)) + (bf_lo(w.y) + bf_hi(w.y)) + (bf_lo(w.z) + bf_hi(w.z)) + (bf_lo(w.w) + bf_hi(w.w));
                    const f32x4 t0 = v0 * bb[bj][0], t1 = v1 * bb[bj][1]; s2 += (t0[0] + t0[1]) + (t0[2] + t0[3]) + (t1[0] + t1[1]) + (t1[2] + t1[3]); }
                s1 = red16_32(s1); s2 = red16_32(s2);
                if (fq == 0) { unsafeAtomicAdd(cs + r, s1); unsafeAtomicAdd(cb + r, s2); } }
    }
};
template <int UGP> struct EpiWin {
    static constexpr bool PERM = true, AFTER_DRAIN = false, PREF = true;
    bf16_t* QKV; bf16_t* UG; float qscale; Fold f; PG8_LAS unsigned char* pf;
    __device__ __forceinline__ void pref(const Unit& u) const { fold_prefetch(f, u, pf); }
    __device__ __forceinline__ void operator()(PG8_EPI_ARGS) const {
        const int row0 = u.pm * BM + wr * 64 + fr;
        f32x4 cs[2][2], cb[2][2]; float mus[2][4], rss[2][4]; fold_from_lds(pf, wr, wc, fr, fq, cs, cb, mus, rss);
        if (u.pn < 12) {
            const float sc = u.pn < 4 ? qscale : 1.0f; const int col0 = u.pn * BM + wc * 32 + 8 * fq;
#pragma unroll
            for (int ai = 0; ai < 2; ++ai)
#pragma unroll
                for (int m = 0; m < 4; ++m) { const int r = row0 + ai * HALF + m * 16; const float mu = mus[ai][m], rs = rss[ai][m]; const unsigned bo = 2u * (unsigned)(r * 3072 + col0);
#pragma unroll
                    for (int bj = 0; bj < 2; ++bj) *at32<u32x4>(QKV, bo + 2u * bj * HALF) = pack8(fold4(acc[ai][bj][m][0], mu, rs, cs[bj][0], cb[bj][0]) * sc, fold4(acc[ai][bj][m][1], mu, rs, cs[bj][1], cb[bj][1]) * sc); }
        } else {
#pragma unroll
            for (int ai = 0; ai < 2; ++ai)
#pragma unroll
                for (int m = 0; m < 4; ++m) { const int r = row0 + ai * HALF + m * 16, b = r >> 14, c = (r >> 6) & 255, s = r & 63; const float mu = mus[ai][m], rs = rss[ai][m];
#pragma unroll
                    for (int bj = 0; bj < 2; ++bj) { const int j0 = (u.pn - 12) * BM + bj * HALF + wc * 32 + 8 * fq, g = j0 >> 4, q0 = j0 & 15;
                        *at32<u32x4>(UG, 2u * (unsigned)((g * 512 + b * 256 + c) * UGP + 128 + s * 16 + q0)) = pack8(fold4(acc[ai][bj][m][0], mu, rs, cs[bj][0], cb[bj][0]), fold4(acc[ai][bj][m][1], mu, rs, cs[bj][1], cb[bj][1])); } }
        }
    }
};
template <int UGP> struct EpiSsmY {
    static constexpr bool PERM = true, AFTER_DRAIN = false, PREF = false;
    const bf16_t* UG; const float* dskip; bf16_t* YG;
    __device__ __forceinline__ void operator()(PG8_EPI_ARGS) const {
        const int R0 = u.pm * BM + wr * 64 + fr, g = R0 >> 9, b = (R0 >> 8) & 1;
        f32x4 d0[2], d1[2];
#pragma unroll
        for (int bj = 0; bj < 2; ++bj) { const int p0 = (bj * HALF + wc * 32 + 8 * fq) & 15; d0[bj] = *(const f32x4*)(dskip + g * 16 + p0); d1[bj] = *(const f32x4*)(dskip + g * 16 + p0 + 4); }
#pragma unroll
        for (int ai = 0; ai < 2; ++ai) { u32x4 uu[4][2];
#pragma unroll
            for (int m = 0; m < 4; ++m)
#pragma unroll
                for (int bj = 0; bj < 2; ++bj) uu[m][bj] = *at32<const u32x4>(UG, 2u * (unsigned)((R0 + ai * HALF + m * 16) * UGP + 128 + u.pn * BM + bj * HALF + wc * 32 + 8 * fq));
            asm volatile("" ::: "memory");
#pragma unroll
            for (int m = 0; m < 4; ++m) { const int c = (R0 + ai * HALF + m * 16) & 255;
#pragma unroll
                for (int bj = 0; bj < 2; ++bj) { const int col = u.pn * BM + bj * HALF + wc * 32 + 8 * fq, t = col >> 4, p0 = col & 15; const u32x4 w = uu[m][bj];
                    f32x4 y0 = acc[ai][bj][m][0], y1 = acc[ai][bj][m][1];
                    y0[0] += d0[bj][0] * bf_lo(w.x); y0[1] += d0[bj][1] * bf_hi(w.x); y0[2] += d0[bj][2] * bf_lo(w.y); y0[3] += d0[bj][3] * bf_hi(w.y);
                    y1[0] += d1[bj][0] * bf_lo(w.z); y1[1] += d1[bj][1] * bf_hi(w.z); y1[2] += d1[bj][2] * bf_lo(w.w); y1[3] += d1[bj][3] * bf_hi(w.w);
#pragma unroll
                    for (int e = 0; e < 4; ++e) { const float a = y0[e], bq = y1[e];
                        y0[e] = a * __builtin_amdgcn_rcpf(1.0f + __builtin_amdgcn_exp2f(-2.3022081983f * (a + 0.044715f * a * a * a))); y1[e] = bq * __builtin_amdgcn_rcpf(1.0f + __builtin_amdgcn_exp2f(-2.3022081983f * (bq + 0.044715f * bq * bq * bq))); }
                    *at32<u32x4>(YG, 2u * (unsigned)((b * 16384 + c * 64 + t) * 1024 + g * 16 + p0)) = pack8(y0, y1); } }
            asm volatile("" ::: "memory"); }
    }
};
struct EpiGlu {
    static constexpr bool PERM = true, AFTER_DRAIN = false, PREF = false;
    const bf16_t* YG; const float* bias; bf16_t* MIX;
    __device__ __forceinline__ void operator()(PG8_EPI_ARGS) const {
        const int row0 = u.pm * BM + wr * 64 + fr, col0 = u.pn * BM + wc * 32 + 8 * fq;
        f32x4 b0[2], b1[2];
#pragma unroll
        for (int bj = 0; bj < 2; ++bj) { b0[bj] = *(const f32x4*)(bias + col0 + bj * HALF); b1[bj] = *(const f32x4*)(bias + col0 + bj * HALF + 4); }
#pragma unroll
        for (int ai = 0; ai < 2; ++ai) { u32x4 yy[4][2];
#pragma unroll
            for (int m = 0; m < 4; ++m)
#pragma unroll
                for (int bj = 0; bj < 2; ++bj) yy[m][bj] = *at32<const u32x4>(YG, 2u * (unsigned)((row0 + ai * HALF + m * 16) * 1024 + col0 + bj * HALF));
            asm volatile("" ::: "memory");
#pragma unroll
            for (int m = 0; m < 4; ++m) { const int r = row0 + ai * HALF + m * 16;
#pragma unroll
                for (int bj = 0; bj < 2; ++bj) { const u32x4 w = yy[m][bj];
                    const f32x4 z0 = acc[ai][bj][m][0] + b0[bj], z1 = acc[ai][bj][m][1] + b1[bj]; f32x4 o0, o1;
                    o0[0] = bf_lo(w.x) * sigmoid_f(z0[0]); o0[1] = bf_hi(w.x) * sigmoid_f(z0[1]); o0[2] = bf_lo(w.y) * sigmoid_f(z0[2]); o0[3] = bf_hi(w.y) * sigmoid_f(z0[3]);
                    o1[0] = bf_lo(w.z) * sigmoid_f(z1[0]); o1[1] = bf_hi(w.z) * sigmoid_f(z1[1]); o1[2] = bf_lo(w.w) * sigmoid_f(z1[2]); o1[3] = bf_hi(w.w) * sigmoid_f(z1[3]);
                    *at32<u32x4>(MIX, 2u * (unsigned)(r * 2048 + 1024 + col0 + bj * HALF)) = pack8(o0, o1); } }
            asm volatile("" ::: "memory"); }
    }
};
#ifndef PG8_ASMDMA
#define PG8_ASMDMA 1
#endif
#ifndef PG8_BAL
#define PG8_BAL 1
#endif
template <class Epi, class Sched, bool ALIGN_EPI = false, bool SP2 = false>
__device__ __forceinline__ void gemm_phase(PG8_LAS unsigned char* lds, const Gemm g, const Sched& S, const Epi& E) {
    const int tid = otid(), wid = __builtin_amdgcn_readfirstlane(tid >> 6), lane = tid & 63, wr = wid >> 2, wc = wid & 3, fr = lane & 15, fq = lane >> 4;
    const int K = g.K, nt_def = K / BK;
    unsigned voffA[2], voffB[2];
#pragma unroll
    for (int i = 0; i < 2; ++i) { int R, C; stage_rc(tid * 16 + i * 8192, R, C); const int Rb = Epi::PERM ? ((R & ~31) + perm32(R & 31)) : R;
        voffA[i] = (unsigned)(R * g.lda + C) * 2u; voffB[i] = (unsigned)(Rb * g.ldb + C) * 2u; }
    const size_t kstep = (size_t)(BK * 2);
    const size_t hstepA = (size_t)HALF * g.lda * 2, hstepB = (size_t)HALF * g.ldb * 2;
    const unsigned ldsbase = (unsigned)(__UINTPTR_TYPE__)lds;
    const unsigned ldsw = (unsigned)wid * 1024u;
    const int aoff = lds_byte(wr * 64 + fr, fq * 8), boff = lds_byte(wc * 32 + fr, fq * 8);
#define PG8_SA(b, h) (((b) * 2 + (h)) * HTB)
#define PG8_SB(b, h) ((4 + (b) * 2 + (h)) * HTB)
#if PG8_ASMDMA
#define PG8_STAGE(bufoff, gbase, voff) do { _Pragma("unroll") for (int _i = 0; _i < 2; ++_i) { \
        const unsigned la_ = (unsigned)__builtin_amdgcn_readfirstlane((int)(ldsbase + (unsigned)(bufoff) + ldsw + (unsigned)(_i * 8192))); const char* gb_ = (const char*)(gbase); \
        asm volatile("s_mov_b32 m0, %2\n\ts_nop 0\n\tglobal_load_lds_dwordx4 %0, %1" :: "v"((voff)[_i]), "s"(gb_), "s"(la_) : "memory", "m0"); } } while (0)
#else
#define PG8_STAGE(bufoff, gbase, voff) do { _Pragma("unroll") for (int _i = 0; _i < 2; ++_i) \
        __builtin_amdgcn_global_load_lds((const unsigned*)((const char*)(gbase) + (voff)[_i]), (PG8_LAS unsigned*)(lds + (bufoff) + ldsw + _i * 8192), 16, 0, 0); } while (0)
#endif
#define PG8_LDA(dst, b, h) do { _Pragma("unroll") for (int m = 0; m < 4; ++m) _Pragma("unroll") for (int k = 0; k < 2; ++k) dst[m][k] = *(const PG8_LAS bf16x8*)(lds + PG8_SA(b, h) + aoff + m * 2048 + k * 1024); } while (0)
#define PG8_LDB(dst, b, h) do { _Pragma("unroll") for (int n = 0; n < 2; ++n) _Pragma("unroll") for (int k = 0; k < 2; ++k) dst[n][k] = *(const PG8_LAS bf16x8*)(lds + PG8_SB(b, h) + boff + n * 2048 + k * 1024); } while (0)
#define PG8_MMA(ai, bj, At, Bt) do { _Pragma("unroll") for (int m = 0; m < 4; ++m) _Pragma("unroll") for (int n = 0; n < 2; ++n) _Pragma("unroll") for (int k = 0; k < 2; ++k) \
        acc[ai][bj][m][n] = __builtin_amdgcn_mfma_f32_16x16x32_bf16(Bt[n][k], At[m][k], acc[ai][bj][m][n], 0, 0, 0); } while (0)
#define PG8_WAIT_V(n) asm volatile("s_waitcnt vmcnt(" #n ")" ::: "memory")
#define PG8_WAIT_L(n) asm volatile("s_waitcnt lgkmcnt(" #n ")" ::: "memory")
#define PG8_BAR __builtin_amdgcn_s_barrier()
#define PG8_SCHED __builtin_amdgcn_sched_barrier(0)
    Unit cur, nxt; int ui = 0;
    if (!S.next(0, cur)) return;
    f32x4 acc[2][2][4][2];
#pragma unroll
    for (int a = 0; a < 2; ++a)
#pragma unroll
        for (int b = 0; b < 2; ++b)
#pragma unroll
            for (int m = 0; m < 4; ++m)
#pragma unroll
                for (int n = 0; n < 2; ++n) acc[a][b][m][n] = (f32x4){0.f, 0.f, 0.f, 0.f};
    bf16x8 At[4][2], B0[2][2], B1[2][2];
    const char* cA = (const char*)g.A + (size_t)cur.aoff * 2; const char* cB = (const char*)g.Bt + (size_t)cur.boff * 2;
    S.a_ready(cur);
    if constexpr (SP2) {
        PG8_STAGE(PG8_SB(0, 0), cB, voffB); PG8_STAGE(PG8_SB(0, 1), cB + hstepB, voffB); PG8_STAGE(PG8_SA(0, 0), cA, voffA); PG8_STAGE(PG8_SA(0, 1), cA + hstepA, voffA);
        if (wr == 1) PG8_BAR;
        PG8_WAIT_V(2); PG8_BAR;
#if PG8_BAL
        PG8_STAGE(PG8_SB(1, 0), cB + kstep, voffB); PG8_STAGE(PG8_SB(1, 1), cB + hstepB + kstep, voffB);
        PG8_WAIT_V(4); PG8_BAR;
#else
        PG8_STAGE(PG8_SB(1, 0), cB + kstep, voffB); PG8_STAGE(PG8_SA(1, 0), cA + kstep, voffA); PG8_STAGE(PG8_SB(1, 1), cB + hstepB + kstep, voffB);
        PG8_WAIT_V(6); PG8_BAR;
#endif
    } else {
        PG8_STAGE(PG8_SB(0, 0), cB, voffB); PG8_STAGE(PG8_SA(0, 0), cA, voffA); PG8_STAGE(PG8_SB(0, 1), cB + hstepB, voffB); PG8_STAGE(PG8_SA(0, 1), cA + hstepA, voffA);
        if (wr == 1) PG8_BAR;
        PG8_WAIT_V(4); PG8_BAR;
        PG8_STAGE(PG8_SB(1, 0), cB + kstep, voffB); PG8_STAGE(PG8_SA(1, 0), cA + kstep, voffA); PG8_STAGE(PG8_SB(1, 1), cB + hstepB + kstep, voffB);
        PG8_WAIT_V(6); PG8_BAR;
    }
    for (;;) {
        const bool has_next = S.next(ui + 1, nxt);
        const char* nA = has_next ? (const char*)g.A + (size_t)nxt.aoff * 2 : cA; const char* nB = has_next ? (const char*)g.Bt + (size_t)nxt.boff * 2 : cB;
        const int nt = cur.nt ? cur.nt : nt_def;
        for (int t = 0; t < nt; t += 2) {
            const bool last = (t == nt - 2);
            const char* a1 = cA + (size_t)(t + 1) * kstep;
            const char* a2 = last ? nA : cA + (size_t)(t + 2) * kstep; const char* b2 = last ? nB : cB + (size_t)(t + 2) * kstep;
            const char* a3 = a2 + kstep; const char* b3 = b2 + kstep;
            if (last && has_next) S.a_ready(nxt);
            if constexpr (Epi::PREF) { if (last) E.pref(cur); }
            if constexpr (SP2) {
#if PG8_BAL
            PG8_LDB(B0, 0, 0); PG8_LDB(B1, 0, 1); PG8_SCHED; PG8_LDA(At, 0, 0); PG8_STAGE(PG8_SA(1, 0), a1, voffA); PG8_STAGE(PG8_SA(1, 1), a1 + hstepA, voffA);
            PG8_WAIT_V(8); PG8_WAIT_L(0); __builtin_amdgcn_s_setprio(1); PG8_BAR; PG8_MMA(0, 0, At, B0); PG8_MMA(0, 1, At, B1); __builtin_amdgcn_s_setprio(0); PG8_BAR; PG8_SCHED;
            PG8_LDA(At, 0, 1); PG8_STAGE(PG8_SB(0, 0), b2, voffB); PG8_STAGE(PG8_SB(0, 1), b2 + hstepB, voffB);
            PG8_WAIT_V(6); PG8_WAIT_L(0); __builtin_amdgcn_s_setprio(1); PG8_BAR; PG8_MMA(1, 0, At, B0); PG8_MMA(1, 1, At, B1); __builtin_amdgcn_s_setprio(0); PG8_BAR; PG8_SCHED;
            PG8_LDB(B0, 1, 0); PG8_LDB(B1, 1, 1); PG8_SCHED; PG8_LDA(At, 1, 0); PG8_STAGE(PG8_SA(0, 0), a2, voffA); PG8_STAGE(PG8_SA(0, 1), a2 + hstepA, voffA);
            PG8_WAIT_V(8); PG8_WAIT_L(0); __builtin_amdgcn_s_setprio(1); PG8_BAR; PG8_MMA(0, 0, At, B0); PG8_MMA(0, 1, At, B1); __builtin_amdgcn_s_setprio(0); PG8_BAR; PG8_SCHED;
            PG8_LDA(At, 1, 1); PG8_STAGE(PG8_SB(1, 0), b3, voffB); PG8_STAGE(PG8_SB(1, 1), b3 + hstepB, voffB);
            PG8_WAIT_V(6); PG8_WAIT_L(0); __builtin_amdgcn_s_setprio(1); PG8_BAR; PG8_MMA(1, 0, At, B0); PG8_MMA(1, 1, At, B1); __builtin_amdgcn_s_setprio(0); PG8_BAR; PG8_SCHED;
            (void)a3;
#else
            PG8_LDB(B0, 0, 0); PG8_LDB(B1, 0, 1); PG8_SCHED; PG8_LDA(At, 0, 0); PG8_STAGE(PG8_SA(1, 1), a1 + hstepA, voffA);
            PG8_WAIT_V(8); PG8_WAIT_L(0); __builtin_amdgcn_s_setprio(1); PG8_BAR; PG8_MMA(0, 0, At, B0); PG8_MMA(0, 1, At, B1); __builtin_amdgcn_s_setprio(0); PG8_BAR; PG8_SCHED;
            PG8_LDA(At, 0, 1); PG8_STAGE(PG8_SB(0, 0), b2, voffB); PG8_STAGE(PG8_SB(0, 1), b2 + hstepB, voffB); PG8_STAGE(PG8_SA(0, 0), a2, voffA);
            PG8_WAIT_V(8); PG8_WAIT_L(0); __builtin_amdgcn_s_setprio(1); PG8_BAR; PG8_MMA(1, 0, At, B0); PG8_MMA(1, 1, At, B1); __builtin_amdgcn_s_setprio(0); PG8_BAR; PG8_SCHED;
            PG8_LDB(B0, 1, 0); PG8_LDB(B1, 1, 1); PG8_SCHED; PG8_LDA(At, 1, 0); PG8_STAGE(PG8_SA(0, 1), a2 + hstepA, voffA);
            PG8_WAIT_V(8); PG8_WAIT_L(0); __builtin_amdgcn_s_setprio(1); PG8_BAR; PG8_MMA(0, 0, At, B0); PG8_MMA(0, 1, At, B1); __builtin_amdgcn_s_setprio(0); PG8_BAR; PG8_SCHED;
            PG8_LDA(At, 1, 1); PG8_STAGE(PG8_SB(1, 0), b3, voffB); PG8_STAGE(PG8_SB(1, 1), b3 + hstepB, voffB); PG8_STAGE(PG8_SA(1, 0), a3, voffA);
            PG8_WAIT_V(8); PG8_WAIT_L(0); __builtin_amdgcn_s_setprio(1); PG8_BAR; PG8_MMA(1, 0, At, B0); PG8_MMA(1, 1, At, B1); __builtin_amdgcn_s_setprio(0); PG8_BAR; PG8_SCHED;
#endif
            } else {
            PG8_LDB(B0, 0, 0); PG8_SCHED; PG8_LDA(At, 0, 0); PG8_STAGE(PG8_SA(1, 1), a1 + hstepA, voffA);
            PG8_WAIT_L(8); PG8_BAR; PG8_WAIT_L(0); __builtin_amdgcn_s_setprio(1); PG8_MMA(0, 0, At, B0); __builtin_amdgcn_s_setprio(0); PG8_BAR; PG8_SCHED;
            PG8_LDB(B1, 0, 1); PG8_STAGE(PG8_SB(0, 0), b2, voffB);
            PG8_BAR; PG8_WAIT_L(0); __builtin_amdgcn_s_setprio(1); PG8_MMA(0, 1, At, B1); __builtin_amdgcn_s_setprio(0); PG8_BAR;
            PG8_LDA(At, 0, 1); PG8_STAGE(PG8_SA(0, 0), a2, voffA);
            PG8_BAR; PG8_WAIT_L(0); __builtin_amdgcn_s_setprio(1); PG8_MMA(1, 0, At, B0); __builtin_amdgcn_s_setprio(0); PG8_BAR; PG8_SCHED;
            PG8_STAGE(PG8_SB(0, 1), b2 + hstepB, voffB);
            PG8_WAIT_V(6); PG8_BAR; __builtin_amdgcn_s_setprio(1); PG8_MMA(1, 1, At, B1); __builtin_amdgcn_s_setprio(0); PG8_BAR;
            PG8_LDB(B0, 1, 0); PG8_SCHED; PG8_LDA(At, 1, 0); PG8_STAGE(PG8_SA(0, 1), a2 + hstepA, voffA);
            PG8_WAIT_L(8); PG8_BAR; PG8_WAIT_L(0); __builtin_amdgcn_s_setprio(1); PG8_MMA(0, 0, At, B0); __builtin_amdgcn_s_setprio(0); PG8_BAR; PG8_SCHED;
            PG8_LDB(B1, 1, 1); PG8_STAGE(PG8_SB(1, 0), b3, voffB);
            PG8_BAR; PG8_WAIT_L(0); __builtin_amdgcn_s_setprio(1); PG8_MMA(0, 1, At, B1); __builtin_amdgcn_s_setprio(0); PG8_BAR;
            PG8_LDA(At, 1, 1); PG8_STAGE(PG8_SA(1, 0), a3, voffA);
            PG8_BAR; PG8_WAIT_L(0); __builtin_amdgcn_s_setprio(1); PG8_MMA(1, 0, At, B0); __builtin_amdgcn_s_setprio(0); PG8_BAR; PG8_SCHED;
            PG8_STAGE(PG8_SB(1, 1), b3 + hstepB, voffB);
            PG8_WAIT_V(6); PG8_BAR; __builtin_amdgcn_s_setprio(1); PG8_MMA(1, 1, At, B1); __builtin_amdgcn_s_setprio(0); PG8_BAR;
            }
        }
        if constexpr (ALIGN_EPI) { if (wr == 0) PG8_BAR; }
        if constexpr (!Epi::AFTER_DRAIN) { E(acc, cur, wr, wc, fr, fq); S.done(cur); }
        if (!has_next) break;
#pragma unroll
        for (int a = 0; a < 2; ++a)
#pragma unroll
            for (int b = 0; b < 2; ++b)
#pragma unroll
                for (int m = 0; m < 4; ++m)
#pragma unroll
                    for (int n = 0; n < 2; ++n) acc[a][b][m][n] = (f32x4){0.f, 0.f, 0.f, 0.f};
        cur = nxt; cA = nA; cB = nB; ++ui;
        if constexpr (ALIGN_EPI) { if (wr == 1) PG8_BAR; }
    }
    PG8_WAIT_V(0);
    if constexpr (!ALIGN_EPI) { if (wr == 0) PG8_BAR; }
    PG8_BAR;
    if constexpr (Epi::AFTER_DRAIN) { E.fused(acc, cur, wr, wc, fr, fq, lds, wid, lane); S.done(cur); }
#undef PG8_SA
#undef PG8_SB
#undef PG8_STAGE
#undef PG8_LDA
#undef PG8_LDB
#undef PG8_MMA
#undef PG8_WAIT_V
#undef PG8_WAIT_L
#undef PG8_BAR
#undef PG8_SCHED
}
}
#include <hip/hip_bf16.h>
#include <cmath>
namespace attn_body {
using bf16=__hip_bfloat16;
using bf16x8=__attribute__((ext_vector_type(8)))short;
using s16x4=__attribute__((ext_vector_type(4)))short;
using f32x16=__attribute__((ext_vector_type(16)))float;
using u32x4=__attribute__((ext_vector_type(4)))unsigned;
constexpr int BATCH=2,NVH=32,SEQ=16384,D=64,DM=3072,DMO=2048;
constexpr int NW=8,QBLK=32,QB=QBLK*NW,KVBLK=64,NQB=SEQ/QB;
constexpr int ATTN_PITCH=DM, ATTN_UNIT_ROWS=QB;
__device__ __forceinline__ int crow(int r,int hi){return (r&3)+8*(r>>2)+4*hi;}
#define SBAR() __builtin_amdgcn_sched_barrier(0)
__device__ __forceinline__ void cmask(f32x16&p0,f32x16&p1,int jb,int qrel,int hi){
  const float NEG=-INFINITY; (void)hi;
  if(jb>(qrel>>6)){
  #pragma unroll
  for(int r=0;r<16;++r){p0[r]=NEG;p1[r]=NEG;}}
}

constexpr int NSLOT=3, SLOTB=8192;
constexpr int LDS_K=0, LDS_V=NSLOT*SLOTB, LDS_WS=2*NSLOT*SLOTB, LDS_OST=LDS_WS+NW*64*4, LDS_BYTES=LDS_OST+NW*4096;
constexpr float C2=0.125f*1.4426950408889634f;
__device__ __forceinline__ void glds16(const void*gsrc,unsigned lds_dst){unsigned keep;
  asm volatile("s_mov_b32 %0, m0\n\ts_mov_b32 m0, %2\n\ts_nop 0\n\tglobal_load_lds_dwordx4 %1, off\n\ts_mov_b32 m0, %0":"=&s"(keep):"v"(gsrc),"s"(lds_dst):"memory");}
__device__ __forceinline__ void glds16s(const void*gbase,unsigned voff,unsigned lds_dst){
  asm volatile("s_mov_b32 m0, %2\n\ts_nop 0\n\tglobal_load_lds_dwordx4 %0, %1"::"v"(voff),"s"(gbase),"s"(lds_dst):"memory","m0");}
__device__ __forceinline__ float max3f(float a,float b,float c){float r;asm("v_max3_f32 %0, %1, %2, %3":"=v"(r):"v"(a),"v"(b),"v"(c));return r;}
__device__ __forceinline__ float max2f(float a,float b){float r;asm("v_max_f32_e32 %0, %1, %2":"=v"(r):"v"(a),"v"(b));return r;}
__device__ __forceinline__ float fadd_s(float a,float b){float r;asm("v_add_f32_e32 %0, %1, %2":"=v"(r):"v"(a),"v"(b));return r;}
__device__ __forceinline__ float fsub_s(float a,float b){float r;asm("v_sub_f32_e32 %0, %1, %2":"=v"(r):"v"(a),"v"(b));return r;}
typedef float f32x2_t __attribute__((ext_vector_type(2))); typedef __bf16 bf16x2_t __attribute__((ext_vector_type(2)));
__device__ __forceinline__ unsigned cvtpk_s(float lo,float hi){f32x2_t v={lo,hi};bf16x2_t b=__builtin_convertvector(v,bf16x2_t);return __builtin_bit_cast(unsigned,b);}
#define WAIT_BAR(N) asm volatile("s_waitcnt vmcnt(" #N ") lgkmcnt(0)\n\ts_barrier":::"memory")

__device__ __forceinline__ void qkt(f32x16&p0,f32x16&p1,const char*Kslot,const bf16x8*qr,const f32x16&negm,int r32,int hi){
  const char*kb=Kslot+hi*1024+r32*16;
  #pragma unroll
  for(int d0=0;d0<4;++d0){
    const bf16x8 b0=*reinterpret_cast<const bf16x8*>(kb+d0*2048);
    const bf16x8 b1=*reinterpret_cast<const bf16x8*>(kb+d0*2048+512);
    if(d0==0){p0=__builtin_amdgcn_mfma_f32_32x32x16_bf16(b0,qr[0],negm,0,0,0);p1=__builtin_amdgcn_mfma_f32_32x32x16_bf16(b1,qr[0],negm,0,0,0);}
    else{p0=__builtin_amdgcn_mfma_f32_32x32x16_bf16(b0,qr[d0],p0,0,0,0);p1=__builtin_amdgcn_mfma_f32_32x32x16_bf16(b1,qr[d0],p1,0,0,0);}}
}
typedef __attribute__((address_space(3))) const char* lds_cptr;
typedef short v4i16_t __attribute__((ext_vector_type(4)));
__device__ __forceinline__ void kload8(bf16x8*kf,lds_cptr kp){
  kf[0]=*(const __attribute__((address_space(3))) bf16x8*)(kp);      kf[1]=*(const __attribute__((address_space(3))) bf16x8*)(kp+512);
  kf[2]=*(const __attribute__((address_space(3))) bf16x8*)(kp+2048); kf[3]=*(const __attribute__((address_space(3))) bf16x8*)(kp+2560);
  kf[4]=*(const __attribute__((address_space(3))) bf16x8*)(kp+4096); kf[5]=*(const __attribute__((address_space(3))) bf16x8*)(kp+4608);
  kf[6]=*(const __attribute__((address_space(3))) bf16x8*)(kp+6144); kf[7]=*(const __attribute__((address_space(3))) bf16x8*)(kp+6656);
}
__device__ __forceinline__ void kload2(bf16x8*kf,lds_cptr kp,int j){ kf[2*j]=*(const __attribute__((address_space(3))) bf16x8*)(kp+j*2048); kf[2*j+1]=*(const __attribute__((address_space(3))) bf16x8*)(kp+j*2048+512); }
__device__ __forceinline__ s16x4 vtr(lds_cptr p){ return __builtin_bit_cast(s16x4,__builtin_amdgcn_ds_read_tr16_b64_v4i16((__attribute__((address_space(3))) v4i16_t*)p)); }
__device__ __forceinline__ float rowmax(const f32x16&p0,const f32x16&p1){
  float a=max3f(p0[0],p0[1],p1[0]),b=max3f(p0[2],p0[3],p1[1]);a=max3f(a,p1[2],p1[3]);
  #pragma unroll
  for(int r=4;r<16;r+=4){a=max3f(a,p0[r],p0[r+1]);b=max3f(b,p0[r+2],p0[r+3]);a=max3f(a,p1[r],p1[r+1]);b=max3f(b,p1[r+2],p1[r+3]);}
  const float m=max2f(a,b);
  auto rr=__builtin_amdgcn_permlane32_swap(__float_as_uint(m),__float_as_uint(m),false,false);
  return max2f(__uint_as_float(rr[0]),__uint_as_float(rr[1]));
}
__device__ __forceinline__ void pv(f32x16*o,int vb,bf16x8 pa0,bf16x8 pa1,bf16x8 pa2,bf16x8 pa3){
  #pragma unroll
  for(int d0=0;d0<2;++d0){s16x4 lo[4],hi[4];
    #pragma unroll
    for(int ks=0;ks<4;++ks){
      asm volatile("ds_read_b64_tr_b16 %0,%1 offset:%c2":"=&v"(lo[ks]):"v"(vb),"i"(d0*4096+ks*1024):"memory");
      asm volatile("ds_read_b64_tr_b16 %0,%1 offset:%c2":"=&v"(hi[ks]):"v"(vb),"i"(d0*4096+ks*1024+512):"memory");}
    asm volatile("s_waitcnt lgkmcnt(0)":::"memory");SBAR();
    #define PK(k) (bf16x8){lo[k][0],lo[k][1],lo[k][2],lo[k][3],hi[k][0],hi[k][1],hi[k][2],hi[k][3]}
    o[d0]=__builtin_amdgcn_mfma_f32_32x32x16_bf16(pa0,PK(0),o[d0],0,0,0);
    o[d0]=__builtin_amdgcn_mfma_f32_32x32x16_bf16(pa1,PK(1),o[d0],0,0,0);
    o[d0]=__builtin_amdgcn_mfma_f32_32x32x16_bf16(pa2,PK(2),o[d0],0,0,0);
    o[d0]=__builtin_amdgcn_mfma_f32_32x32x16_bf16(pa3,PK(3),o[d0],0,0,0);
    #undef PK
  }
}

#ifndef ATTN_STORE16
#define ATTN_STORE16(p,v) __builtin_nontemporal_store((v),(u32x4*)(p))
#endif
template<int THRL> __device__ __forceinline__ void attn_unit(int b,int qb,const bf16*__restrict__ Q,const bf16*__restrict__ K,const bf16*__restrict__ V,bf16*__restrict__ O,char*shm){
  const int tid=pg8::otid(),lane=tid&63,r32=lane&31,hi=lane>>5; const int wid=__builtin_amdgcn_readfirstlane(tid>>6);
  const long rowbase=(long)b*SEQ; const int q0=qb*QB;
  const bf16*Qw=Q+(rowbase+q0+wid*QBLK)*DM;
  const bf16*Kh=K+rowbase*DM,*Vh=V+rowbase*DM;
  const unsigned lds0=(unsigned)(uintptr_t)shm;
  float*wsf=(float*)(shm+LDS_WS)+wid*64;
  const bf16*ksrc=Kh+(long)lane*DM+wid*8;
  const bf16*vsrc=Vh+(long)(16*(wid&3)+(lane>>2))*DM+(wid>>2)*32+(lane&3)*8;
  const unsigned kdst=lds0+LDS_K+wid*1024, vdst=lds0+LDS_V+wid*1024;
  #define DMA_K(t,slot) glds16(ksrc+(long)(t)*KVBLK*DM,(unsigned)__builtin_amdgcn_readfirstlane(kdst+(slot)))
  #define DMA_V(t,slot) glds16(vsrc+(long)(t)*KVBLK*DM,(unsigned)__builtin_amdgcn_readfirstlane(vdst+(slot)))
  const int vb0=(int)(lds0+LDS_V)+((lane>>4)&1)*32+(lane&3)*8+(4*hi+((lane&15)>>2))*64;
  const char*Kbase=shm+LDS_K; bf16x8 kf[8];
  const lds_cptr shm3=(lds_cptr)shm; const lds_cptr kp0=shm3+LDS_K+hi*1024+r32*16; const lds_cptr vp0=shm3+LDS_V+((lane>>4)&1)*32+(lane&3)*8+(4*hi+((lane&15)>>2))*64;
  const int NT=(q0+QB)/KVBLK;
  DMA_K(0,0);DMA_V(0,0);DMA_K(1,SLOTB);
  bf16x8 qr[4];
  #pragma unroll
  for(int d0=0;d0<4;++d0)qr[d0]=*reinterpret_cast<const bf16x8*>(&Qw[(long)r32*DM+d0*16+hi*8]);
  float mhat=0.f,l_reg=0.f;f32x16 o[2];o[0]=f32x16{};o[1]=f32x16{};f32x16 negm=f32x16{};asm volatile("":"+v"(negm));
  const int qrel=wid*QBLK+r32;
  #define CMASK(P0,P1,t) do{int jb_=(t)-(NT-4); if(jb_>=0)cmask(P0,P1,jb_,qrel,hi);}while(0)
  bool resc=false;
  #define START(P0,P1) do{ const float rm=rowmax(P0,P1); resc=false; \
    { const float dl=rm; mhat=fadd_s(mhat,dl); \
      _Pragma("unroll") for(int r=0;r<16;++r){P0[r]=fsub_s(P0[r],dl);P1[r]=fsub_s(P1[r],dl);} \
      _Pragma("unroll") for(int r=0;r<16;++r)negm[r]=-mhat; asm volatile("":"+v"(negm)); } \
    _Pragma("unroll") for(int r=0;r<16;++r)P0[r]=__builtin_amdgcn_exp2f(P0[r]); }while(0)
  #define RESC() do{ if(resc){ asm volatile("s_waitcnt lgkmcnt(0)":::"memory"); \
      _Pragma("unroll") for(int d_=0;d_<2;++d_) _Pragma("unroll") for(int r=0;r<16;++r)o[d_][r]*=wsf[crow(r,hi)]; } }while(0)
  f32x16 pA0,pA1,pB0,pB1;
  int sl_prev=0,sl_cur=0,sl_next=SLOTB;
  #define ROT() do{sl_prev=sl_cur;sl_cur=sl_next;sl_next=(sl_next==(NSLOT-1)*SLOTB)?0:sl_next+SLOTB;}while(0)
  DMA_K(2,2*SLOTB);
  WAIT_BAR(3);
  qkt(pA0,pA1,Kbase,qr,negm,r32,hi);asm volatile("s_nop 15\n\ts_nop 7":"+v"(pA0),"+v"(pA1));CMASK(pA0,pA1,0);
  START(pA0,pA1);
  _Pragma("unroll") for(int r=0;r<16;++r)pA1[r]=__builtin_amdgcn_exp2f(pA1[r]);
  WAIT_BAR(0);
  DMA_K(3,0);DMA_V(1,SLOTB);
  ROT();
  kload8(kf,kp0+sl_cur);
  WAIT_BAR(2);
  s16x4 vlo[8],vhi[8]; u32x4 pw0,pw1,pw2,pw3;
  #define PKW(P,B) cvtpk_s(P[B],P[B+1])
  #define PAF(k) __builtin_bit_cast(bf16x8,pw##k)
  #define VFR(i) (bf16x8){vlo[i][0],vlo[i][1],vlo[i][2],vlo[i][3],vhi[i][0],vhi[i][1],vhi[i][2],vhi[i][3]}
  #define PIN(x) asm volatile("":"+v"(x))
  #define MX3(a,b,c) __builtin_fmaxf(__builtin_fmaxf((a),(b)),(c))
  #define GAPA(MF,A0,A1,A2,A3,W0,W1,PW) do{ MF; sacc+=A0; sacc+=A1; sacc+=A2; sacc+=A3; PIN(sacc); W0; W1; PIN(PW); SBAR(); }while(0)
  #define EX(v) __builtin_amdgcn_exp2f(v)
  #define GAPB(MF,X,B) do{ MF; X[B]=EX(X[B]); X[B+1]=EX(X[B+1]); X[B+2]=EX(X[B+2]); X[B+3]=EX(X[B+3]); PIN(X); SBAR(); }while(0)
  #define VRD(i) do{ vlo[i]=vtr(vp_+(((i)>>2)*4096+((i)&3)*1024)); vhi[i]=vtr(vp_+(((i)>>2)*4096+((i)&3)*1024+512)); }while(0)
  #define KRD(G,j) do{ if(G){ kload2(kf,kp0+sl_next,j); SBAR(); } }while(0)
  #define STEP(C0,C1,P0,P1,t,GK,GV,GL) do{ SBAR(); \
    const lds_cptr vp_=vp0+sl_prev; \
    VRD(0); SBAR(); float sacc=(P0[0]+P0[1]); \
    GAPA(C0=__builtin_amdgcn_mfma_f32_32x32x16_bf16(kf[0],qr[0],negm,0,0,0), P0[2],P0[3],P0[4],P0[5],     pw0[0]=PKW(P0,0), pw0[1]=PKW(P0,2), pw0); \
    VRD(4); SBAR(); GAPA(C1=__builtin_amdgcn_mfma_f32_32x32x16_bf16(kf[1],qr[0],negm,0,0,0), P0[6],P0[7],P0[8],P0[9],     pw0[2]=PKW(P0,4), pw0[3]=PKW(P0,6), pw0); \
    VRD(1); SBAR(); GAPA(C0=__builtin_amdgcn_mfma_f32_32x32x16_bf16(kf[2],qr[1],C0,0,0,0),   P0[10],P0[11],P0[12],P0[13], pw1[0]=PKW(P0,8), pw1[1]=PKW(P0,10), pw1); \
    VRD(5); SBAR(); GAPA(C1=__builtin_amdgcn_mfma_f32_32x32x16_bf16(kf[3],qr[1],C1,0,0,0),   P0[14],P0[15],P1[0],P1[1],   pw1[2]=PKW(P0,12),pw1[3]=PKW(P0,14), pw1); \
    VRD(2); SBAR(); GAPA(C0=__builtin_amdgcn_mfma_f32_32x32x16_bf16(kf[4],qr[2],C0,0,0,0),   P1[2],P1[3],P1[4],P1[5],     pw2[0]=PKW(P1,0), pw2[1]=PKW(P1,2), pw2); \
    VRD(6); SBAR(); GAPA(C1=__builtin_amdgcn_mfma_f32_32x32x16_bf16(kf[5],qr[2],C1,0,0,0),   P1[6],P1[7],P1[8],P1[9],     pw2[2]=PKW(P1,4), pw2[3]=PKW(P1,6), pw2); \
    VRD(3); SBAR(); GAPA(C0=__builtin_amdgcn_mfma_f32_32x32x16_bf16(kf[6],qr[3],C0,0,0,0),   P1[10],P1[11],P1[12],P1[13], pw3[0]=PKW(P1,8), pw3[1]=PKW(P1,10), pw3); \
    VRD(7); SBAR(); GAPA(C1=__builtin_amdgcn_mfma_f32_32x32x16_bf16(kf[7],qr[3],C1,0,0,0),   P1[14],P1[15],0.f,0.f,       pw3[2]=PKW(P1,12),pw3[3]=PKW(P1,14), pw3); \
    l_reg+=sacc; \
    if(GK){DMA_K((t)+3,sl_cur);} if(GV){DMA_V((t)+1,sl_next);} \
    CMASK(C0,C1,t); \
    { float a=MX3(C0[0],C0[1],C1[0]),b=MX3(C0[2],C0[3],C1[1]); a=MX3(a,C1[2],C1[3]); \
      _Pragma("unroll") for(int r=4;r<16;r+=4){a=MX3(a,C0[r],C0[r+1]);b=MX3(b,C0[r+2],C0[r+3]);a=MX3(a,C1[r],C1[r+1]);b=MX3(b,C1[r+2],C1[r+3]);} \
      float rm=__builtin_fmaxf(a,b); { auto rr=__builtin_amdgcn_permlane32_swap(__float_as_uint(rm),__float_as_uint(rm),false,false); rm=__builtin_fmaxf(__uint_as_float(rr[0]),__uint_as_float(rr[1])); } \
      resc=false; \
      if(__builtin_expect(__any(rm>(float)THRL),0)){ const float dl=__builtin_fmaxf(rm,0.f); mhat+=dl; \
        _Pragma("unroll") for(int r=0;r<16;++r){C0[r]-=dl;C1[r]-=dl;} \
        _Pragma("unroll") for(int r=0;r<16;++r)negm[r]=-mhat; asm volatile("":"+v"(negm)); \
        const float f=__builtin_amdgcn_exp2f(-dl); l_reg*=f; if(hi==0)wsf[r32]=f; resc=true; } } \
    SBAR(); \
    GAPB(o[0]=__builtin_amdgcn_mfma_f32_32x32x16_bf16(PAF(0),VFR(0),o[0],0,0,0), C0,0); \
    GAPB(o[1]=__builtin_amdgcn_mfma_f32_32x32x16_bf16(PAF(0),VFR(4),o[1],0,0,0), C0,4); \
    KRD(GL,0); GAPB(o[0]=__builtin_amdgcn_mfma_f32_32x32x16_bf16(PAF(1),VFR(1),o[0],0,0,0), C0,8); \
    KRD(GL,1); GAPB(o[1]=__builtin_amdgcn_mfma_f32_32x32x16_bf16(PAF(1),VFR(5),o[1],0,0,0), C0,12); \
    KRD(GL,2); GAPB(o[0]=__builtin_amdgcn_mfma_f32_32x32x16_bf16(PAF(2),VFR(2),o[0],0,0,0), C1,0); \
    KRD(GL,3); GAPB(o[1]=__builtin_amdgcn_mfma_f32_32x32x16_bf16(PAF(2),VFR(6),o[1],0,0,0), C1,4); \
    GAPB(o[0]=__builtin_amdgcn_mfma_f32_32x32x16_bf16(PAF(3),VFR(3),o[0],0,0,0), C1,8); \
    GAPB(o[1]=__builtin_amdgcn_mfma_f32_32x32x16_bf16(PAF(3),VFR(7),o[1],0,0,0), C1,12); \
    }while(0)
  int t=1;
  #undef CMASK
  #define CMASK(P0,P1,t) do{}while(0)
  for(;t+5<NT;t+=2){
    STEP(pB0,pB1,pA0,pA1,t,true,true,true);     WAIT_BAR(2); RESC(); ROT();
    STEP(pA0,pA1,pB0,pB1,t+1,true,true,true);   WAIT_BAR(2); RESC(); ROT();
  }
  #undef CMASK
  #define CMASK(P0,P1,t) do{int jb_=(t)-(NT-4); if(jb_>=0)cmask(P0,P1,jb_,qrel,hi);}while(0)
  #define ENDW(tt) do{ if((tt)+3<NT){WAIT_BAR(2);} else if((tt)+2<NT){WAIT_BAR(1);} else {WAIT_BAR(0);} }while(0)
  for(;t+1<NT;t+=2){
    STEP(pB0,pB1,pA0,pA1,t,(t+3<NT),(t+1<NT),(t+1<NT));       ENDW(t);   RESC(); ROT();
    STEP(pA0,pA1,pB0,pB1,t+1,(t+4<NT),(t+2<NT),(t+2<NT));     ENDW(t+1); RESC(); ROT();
  }
  STEP(pB0,pB1,pA0,pA1,NT-1,false,false,false); RESC();
  { float sacc=pB0[0]+pB0[1]; _Pragma("unroll") for(int r=2;r<16;++r)sacc+=pB0[r]; _Pragma("unroll") for(int r=0;r<16;++r)sacc+=pB1[r]; l_reg+=sacc;
    pw0=(u32x4){PKW(pB0,0),PKW(pB0,2),PKW(pB0,4),PKW(pB0,6)};pw1=(u32x4){PKW(pB0,8),PKW(pB0,10),PKW(pB0,12),PKW(pB0,14)};pw2=(u32x4){PKW(pB1,0),PKW(pB1,2),PKW(pB1,4),PKW(pB1,6)};pw3=(u32x4){PKW(pB1,8),PKW(pB1,10),PKW(pB1,12),PKW(pB1,14)};
    SBAR(); pv(o,vb0+sl_cur,PAF(0),PAF(1),PAF(2),PAF(3)); }
  #undef PKW
  #undef PAF
  #undef VFR
  #undef PIN
  #undef MX3
  #undef GAPA
  #undef GAPB
  #undef EX
  #undef VRD
  #undef KRD
  #undef STEP
  #undef ENDW
  {auto rr=__builtin_amdgcn_permlane32_swap(__float_as_uint(l_reg),__float_as_uint(l_reg),false,false);l_reg=__uint_as_float(rr[0])+__uint_as_float(rr[1]);}
  if(hi==0)wsf[32+r32]=l_reg;asm volatile("s_waitcnt lgkmcnt(0)":::"memory");
  float rli[16];
  #pragma unroll
  for(int r=0;r<16;++r)rli[r]=__builtin_amdgcn_rcpf(wsf[32+crow(r,hi)]);
  bf16*Ow=O+(rowbase+q0+wid*QBLK)*DMO;
  { bf16*stg=(bf16*)(shm+LDS_OST)+wid*2048;
    #pragma unroll
    for(int r=0;r<16;++r){const int orow=crow(r,hi);
      #pragma unroll
      for(int d0=0;d0<2;++d0)stg[orow*64+d0*32+r32]=__float2bfloat16(o[d0][r]*rli[r]);}
    asm volatile("s_waitcnt lgkmcnt(0)":::"memory");
    #pragma unroll
    for(int i=0;i<4;++i){const int row=i*8+(lane>>3),ch=lane&7; const u32x4 v=*(const u32x4*)(stg+row*64+ch*8); ATTN_STORE16(Ow+(long)row*DMO+ch*8,v);} }
  asm volatile("s_waitcnt lgkmcnt(0)\n\ts_barrier":::"memory");
  #undef DMA_K
  #undef DMA_V
  #undef CMASK
  #undef START
  #undef RESC
  #undef ROT
}
constexpr int ATTN_LDS_BYTES=LDS_BYTES;
struct AttnTensors { const bf16* QKV; bf16* O; };
struct AttnUnit { int bvh; int qb; };
struct StaticOrder {
  int vcu;
  __device__ __forceinline__ explicit StaticOrder(int grid,int block):vcu((grid%8==0)?(block%8)*(grid/8)+block/8:block){}
  __device__ __forceinline__ bool next(int i,AttnUnit&u)const{ const int L=vcu; if(i>=16||L>=256)return false; const int s=8*(L&3)+(i>>1); u.bvh=L>>2; u.qb=(i&1)?63-s:s; return true; }
  __device__ __forceinline__ void a_ready(const AttnUnit&)const{}
  __device__ __forceinline__ void done(const AttnUnit&)const{}
};
template<class Sched,int THRL=8> __device__ __forceinline__ void attn_phase(char*lds,const AttnTensors&T,const Sched&S){
  AttnUnit u;
  for(int i=0;S.next(i,u);++i){ S.a_ready(u); const int b=u.bvh>>5,vh=u.bvh&31;
    attn_unit<THRL>(b,u.qb,T.QKV+(vh>>1)*64,T.QKV+1024+(vh>>1)*64,T.QKV+2048+((vh>>2)*2+(vh&1))*64,T.O+vh*64,lds); S.done(u); }
}

constexpr int KSLOT2=8192, VSLOT2=16384;
constexpr int LDS2_K=0, LDS2_V=NSLOT*KSLOT2, LDS2_WS=LDS2_V+NSLOT*VSLOT2, LDS2_OST=LDS2_WS+NW*64*4, LDS2_BYTES=LDS2_OST+NW*4096;
#define WAIT_BAR2(N) asm volatile("s_waitcnt vmcnt(" #N ") lgkmcnt(0)\n\ts_barrier":::"memory")
template<int THRL> __device__ __forceinline__ void attn_unit2(int b,int qb,const bf16*__restrict__ Q,const bf16*__restrict__ K,const bf16*__restrict__ V,bf16*__restrict__ O,char*shm){
  const int tid=pg8::otid(),lane=tid&63,r32=lane&31,hi=lane>>5; const int wid=__builtin_amdgcn_readfirstlane(tid>>6);
  const long rowbase=(long)b*SEQ; const int q0=qb*QB;
  const bf16*Qw=Q+(rowbase+q0+wid*QBLK)*DM;
  const bf16*Kh=K+rowbase*DM,*Vh=V+rowbase*DM;
  const unsigned lds0=(unsigned)(uintptr_t)shm;
  float*wsf=(float*)(shm+LDS2_WS)+wid*64;
  const unsigned kvoff=(unsigned)((lane*DM+wid*8)*2);
  const unsigned vvoff=(unsigned)(((16*(wid&3)+(lane>>2))*DM+(wid>>2)*32+(lane&3)*8)*2);
  const unsigned kdst=lds0+LDS2_K+wid*1024, vdst=lds0+LDS2_V+wid*1024;
  #define DMA_K(t,slot) glds16s(Kh+(long)(t)*KVBLK*DM,kvoff,(unsigned)__builtin_amdgcn_readfirstlane(kdst+(slot)))
  #define DMA_V(t,slot) do{ glds16s(Vh+(long)(t)*KVBLK*DM,vvoff,(unsigned)__builtin_amdgcn_readfirstlane(vdst+2*(slot))); glds16s(Vh+(long)(t)*KVBLK*DM+64,vvoff,(unsigned)__builtin_amdgcn_readfirstlane(vdst+2*(slot)+8192)); }while(0)
  const char*Kbase=shm+LDS2_K; bf16x8 kf[8];
  const lds_cptr shm3=(lds_cptr)shm; const lds_cptr kp0=shm3+LDS2_K+hi*1024+r32*16; const lds_cptr vp0=shm3+LDS2_V+((lane>>4)&1)*32+(lane&3)*8+(4*hi+((lane&15)>>2))*64;
  const int NT=(q0+QB)/KVBLK;
  DMA_K(0,0);DMA_V(0,0);DMA_K(1,KSLOT2);
  bf16x8 qr[4];
  #pragma unroll
  for(int d0=0;d0<4;++d0)qr[d0]=*reinterpret_cast<const bf16x8*>(&Qw[(long)r32*DM+d0*16+hi*8]);
  float mhat=0.f,l_reg=0.f;f32x16 o[4];o[0]=f32x16{};o[1]=f32x16{};o[2]=f32x16{};o[3]=f32x16{};
  f32x16 negm=f32x16{};asm volatile("":"+v"(negm));
  const int qrel=wid*QBLK+r32;
  #define CMASK(P0,P1,t) do{int jb_=(t)-(NT-4); if(jb_>=0)cmask(P0,P1,jb_,qrel,hi);}while(0)
  bool resc=false;
  #define RESC() do{ if(resc){ asm volatile("s_waitcnt lgkmcnt(0)":::"memory"); \
      _Pragma("unroll") for(int d_=0;d_<4;++d_) _Pragma("unroll") for(int r=0;r<16;++r)o[d_][r]*=wsf[crow(r,hi)]; } }while(0)
  f32x16 pA0,pA1,pB0,pB1;
  int sl_prev=0,sl_cur=0,sl_next=KSLOT2;
  #define ROT() do{sl_prev=sl_cur;sl_cur=sl_next;sl_next=(sl_next==(NSLOT-1)*KSLOT2)?0:sl_next+KSLOT2;}while(0)
  DMA_K(2,2*KSLOT2);
  WAIT_BAR2(4);
  qkt(pA0,pA1,Kbase,qr,negm,r32,hi);asm volatile("s_nop 15\n\ts_nop 7":"+v"(pA0),"+v"(pA1));CMASK(pA0,pA1,0);
  { const float rm=rowmax(pA0,pA1); mhat=rm;
    #pragma unroll
    for(int r=0;r<16;++r)negm[r]=-mhat;
    asm volatile("":"+v"(negm));
    #pragma unroll
    for(int r=0;r<16;++r){pA0[r]=__builtin_amdgcn_exp2f(pA0[r]-mhat);pA1[r]=__builtin_amdgcn_exp2f(pA1[r]-mhat);} }
  WAIT_BAR2(0);
  DMA_K(3,0);DMA_V(1,KSLOT2);
  ROT();
  kload8(kf,kp0+sl_cur);
  WAIT_BAR2(3);
  s16x4 vlo[8],vhi[8]; u32x4 pw0,pw1,pw2,pw3;
  #define PKW(P,B) cvtpk_s(P[B],P[B+1])
  #define PAF(k) __builtin_bit_cast(bf16x8,pw##k)
  #define PAFI(k) ((k)==0?PAF(0):(k)==1?PAF(1):(k)==2?PAF(2):PAF(3))
  #define VFR(i) (bf16x8){vlo[i][0],vlo[i][1],vlo[i][2],vlo[i][3],vhi[i][0],vhi[i][1],vhi[i][2],vhi[i][3]}
  #define PIN(x) asm volatile("":"+v"(x))
  #define MX3(a,b,c) __builtin_fmaxf(__builtin_fmaxf((a),(b)),(c))
  #define MFMA(a,b,c) __builtin_amdgcn_mfma_f32_32x32x16_bf16(a,b,c,0,0,0)
  #define GAPA(MF,A0,A1,A2,A3,W0,W1,PW) do{ MF; sacc+=A0; sacc+=A1; sacc+=A2; sacc+=A3; PIN(sacc); W0; W1; PIN(PW); SBAR(); }while(0)
  #define EX(v) __builtin_amdgcn_exp2f(v)
  #define GAPB(MF,X,B) do{ MF; X[B]=EX(X[B]); X[B+1]=EX(X[B+1]); PIN(X); SBAR(); }while(0)
  #define VOFF(j) ((((j)&3)*4096)+(((j)>>2)*1024))
  #define VRD(s_,j) do{ vlo[s_]=vtr(vp_+VOFF(j)); vhi[s_]=vtr(vp_+VOFF(j)+512); }while(0)
  #define KRD(G,j) do{ if(G){ kload2(kf,kp0+sl_next,j); SBAR(); } }while(0)
  #define PVM(j,PA) o[(j)&3]=MFMA(PA,VFR((j)&7),o[(j)&3])
  #define STEP(C0,C1,P0,P1,t,GK,GV,GL) do{ SBAR(); \
    const lds_cptr vp_=vp0+2*sl_prev; \
    VRD(0,0); SBAR(); float sacc=(P0[0]+P0[1]); \
    GAPA(C0=MFMA(kf[0],qr[0],negm), P0[2],P0[3],P0[4],P0[5],     pw0[0]=PKW(P0,0), pw0[1]=PKW(P0,2), pw0); \
    VRD(1,1); SBAR(); GAPA(C1=MFMA(kf[1],qr[0],negm), P0[6],P0[7],P0[8],P0[9],     pw0[2]=PKW(P0,4), pw0[3]=PKW(P0,6), pw0); \
    VRD(2,2); SBAR(); GAPA(C0=MFMA(kf[2],qr[1],C0),   P0[10],P0[11],P0[12],P0[13], pw1[0]=PKW(P0,8), pw1[1]=PKW(P0,10), pw1); \
    VRD(3,3); SBAR(); GAPA(C1=MFMA(kf[3],qr[1],C1),   P0[14],P0[15],P1[0],P1[1],   pw1[2]=PKW(P0,12),pw1[3]=PKW(P0,14), pw1); \
    VRD(4,4); SBAR(); GAPA(C0=MFMA(kf[4],qr[2],C0),   P1[2],P1[3],P1[4],P1[5],     pw2[0]=PKW(P1,0), pw2[1]=PKW(P1,2), pw2); \
    VRD(5,5); SBAR(); GAPA(C1=MFMA(kf[5],qr[2],C1),   P1[6],P1[7],P1[8],P1[9],     pw2[2]=PKW(P1,4), pw2[3]=PKW(P1,6), pw2); \
    VRD(6,6); SBAR(); GAPA(C0=MFMA(kf[6],qr[3],C0),   P1[10],P1[11],P1[12],P1[13], pw3[0]=PKW(P1,8), pw3[1]=PKW(P1,10), pw3); \
    VRD(7,7); SBAR(); GAPA(C1=MFMA(kf[7],qr[3],C1),   P1[14],P1[15],0.f,0.f,       pw3[2]=PKW(P1,12),pw3[3]=PKW(P1,14), pw3); \
    l_reg+=sacc; \
    if(GK){DMA_K((t)+3,sl_cur);} if(GV){DMA_V((t)+1,sl_next);} \
    CMASK(C0,C1,t); \
    { float a=MX3(C0[0],C0[1],C1[0]),b_=MX3(C0[2],C0[3],C1[1]); a=MX3(a,C1[2],C1[3]); \
      _Pragma("unroll") for(int r=4;r<16;r+=4){a=MX3(a,C0[r],C0[r+1]);b_=MX3(b_,C0[r+2],C0[r+3]);a=MX3(a,C1[r],C1[r+1]);b_=MX3(b_,C1[r+2],C1[r+3]);} \
      float rm=__builtin_fmaxf(a,b_); { auto rr=__builtin_amdgcn_permlane32_swap(__float_as_uint(rm),__float_as_uint(rm),false,false); rm=__builtin_fmaxf(__uint_as_float(rr[0]),__uint_as_float(rr[1])); } \
      resc=false; \
      if(__builtin_expect(__any(rm>(float)THRL),0)){ const float dl=__builtin_fmaxf(rm,0.f); mhat+=dl; \
        _Pragma("unroll") for(int r=0;r<16;++r){C0[r]-=dl;C1[r]-=dl;} \
        _Pragma("unroll") for(int r=0;r<16;++r)negm[r]=-mhat; asm volatile("":"+v"(negm)); \
        const float f=__builtin_amdgcn_exp2f(-dl); l_reg*=f; if(hi==0)wsf[r32]=f; resc=true; } } \
    SBAR(); \
    GAPB(PVM(0,PAF(0)),C0,0);  VRD(0,8);  SBAR(); \
    GAPB(PVM(1,PAF(0)),C0,2);  VRD(1,9);  SBAR(); \
    GAPB(PVM(2,PAF(0)),C0,4);  VRD(2,10); SBAR(); \
    GAPB(PVM(3,PAF(0)),C0,6);  VRD(3,11); SBAR(); \
    GAPB(PVM(4,PAF(1)),C0,8);  VRD(4,12); SBAR(); \
    GAPB(PVM(5,PAF(1)),C0,10); VRD(5,13); SBAR(); \
    GAPB(PVM(6,PAF(1)),C0,12); VRD(6,14); SBAR(); \
    GAPB(PVM(7,PAF(1)),C0,14); VRD(7,15); SBAR(); \
    GAPB(PVM(8,PAF(2)),C1,0); \
    GAPB(PVM(9,PAF(2)),C1,2); \
    KRD(GL,0); GAPB(PVM(10,PAF(2)),C1,4); \
    KRD(GL,1); GAPB(PVM(11,PAF(2)),C1,6); \
    KRD(GL,2); GAPB(PVM(12,PAF(3)),C1,8); \
    KRD(GL,3); GAPB(PVM(13,PAF(3)),C1,10); \
    GAPB(PVM(14,PAF(3)),C1,12); \
    GAPB(PVM(15,PAF(3)),C1,14); \
    }while(0)
  int t=1;
  #undef CMASK
  #define CMASK(P0,P1,t) do{}while(0)
  for(;t+5<NT;t+=2){
    STEP(pB0,pB1,pA0,pA1,t,true,true,true);     WAIT_BAR2(3); RESC(); ROT();
    STEP(pA0,pA1,pB0,pB1,t+1,true,true,true);   WAIT_BAR2(3); RESC(); ROT();
  }
  #undef CMASK
  #define CMASK(P0,P1,t) do{int jb_=(t)-(NT-4); if(jb_>=0)cmask(P0,P1,jb_,qrel,hi);}while(0)
  #define ENDW(tt) do{ if((tt)+3<NT){WAIT_BAR2(3);} else if((tt)+2<NT){WAIT_BAR2(2);} else {WAIT_BAR2(0);} }while(0)
  for(;t+1<NT;t+=2){
    STEP(pB0,pB1,pA0,pA1,t,(t+3<NT),(t+1<NT),(t+1<NT));       ENDW(t);   RESC(); ROT();
    STEP(pA0,pA1,pB0,pB1,t+1,(t+4<NT),(t+2<NT),(t+2<NT));     ENDW(t+1); RESC(); ROT();
  }
  STEP(pB0,pB1,pA0,pA1,NT-1,false,false,false); RESC();
  { float sacc=pB0[0]+pB0[1]; _Pragma("unroll") for(int r=2;r<16;++r)sacc+=pB0[r]; _Pragma("unroll") for(int r=0;r<16;++r)sacc+=pB1[r]; l_reg+=sacc;
    pw0=(u32x4){PKW(pB0,0),PKW(pB0,2),PKW(pB0,4),PKW(pB0,6)};pw1=(u32x4){PKW(pB0,8),PKW(pB0,10),PKW(pB0,12),PKW(pB0,14)};pw2=(u32x4){PKW(pB1,0),PKW(pB1,2),PKW(pB1,4),PKW(pB1,6)};pw3=(u32x4){PKW(pB1,8),PKW(pB1,10),PKW(pB1,12),PKW(pB1,14)};
    SBAR(); const lds_cptr vp_=vp0+2*sl_cur;
    #pragma unroll
    for(int d0=0;d0<4;++d0){
      #pragma unroll
      for(int ks=0;ks<4;++ks){ vlo[ks]=vtr(vp_+d0*4096+ks*1024); vhi[ks]=vtr(vp_+d0*4096+ks*1024+512); }
      o[d0]=MFMA(PAF(0),VFR(0),o[d0]); o[d0]=MFMA(PAF(1),VFR(1),o[d0]); o[d0]=MFMA(PAF(2),VFR(2),o[d0]); o[d0]=MFMA(PAF(3),VFR(3),o[d0]); } }
  #undef PKW
  #undef PAF
  #undef PAFI
  #undef VFR
  #undef PIN
  #undef MX3
  #undef MFMA
  #undef GAPA
  #undef GAPB
  #undef EX
  #undef VOFF
  #undef VRD
  #undef KRD
  #undef PVM
  #undef STEP
  #undef ENDW
  {auto rr=__builtin_amdgcn_permlane32_swap(__float_as_uint(l_reg),__float_as_uint(l_reg),false,false);l_reg=__uint_as_float(rr[0])+__uint_as_float(rr[1]);}
  if(hi==0)wsf[32+r32]=l_reg;asm volatile("s_waitcnt lgkmcnt(0)":::"memory");
  float rli[16];
  #pragma unroll
  for(int r=0;r<16;++r)rli[r]=__builtin_amdgcn_rcpf(wsf[32+crow(r,hi)]);
  bf16*Ow=O+(rowbase+q0+wid*QBLK)*DMO;
  { bf16*stg=(bf16*)(shm+LDS2_OST)+wid*2048;
    #pragma unroll
    for(int hh=0;hh<2;++hh){
      #pragma unroll
      for(int r=0;r<16;++r){const int orow=crow(r,hi);
        #pragma unroll
        for(int d0=0;d0<2;++d0)stg[orow*64+d0*32+r32]=__float2bfloat16(o[hh*2+d0][r]*rli[r]);}
      asm volatile("s_waitcnt lgkmcnt(0)":::"memory");
      #pragma unroll
      for(int i=0;i<4;++i){const int row=i*8+(lane>>3),ch=lane&7; const u32x4 v=*(const u32x4*)(stg+row*64+ch*8); ATTN_STORE16(Ow+(long)row*DMO+hh*64+ch*8,v);}
      asm volatile("s_waitcnt lgkmcnt(0)":::"memory"); } }
  asm volatile("s_waitcnt lgkmcnt(0)\n\ts_barrier":::"memory");
  #undef DMA_K
  #undef DMA_V
  #undef CMASK
  #undef RESC
  #undef ROT
}
struct AttnUnit2 { int bhm; int qb; };
struct StaticOrder2 {
  int vcu;
  __device__ __forceinline__ explicit StaticOrder2(int grid,int block):vcu((grid%8==0)?(block%8)*(grid/8)+block/8:block){}
  __device__ __forceinline__ bool next(int i,AttnUnit2&u)const{ const int L=vcu; if(i>=8||L>=256)return false; const int j=L&7; u.bhm=L>>3; u.qb=8*i+((i&1)?7-j:j); return true; }
};
template<class Sched,int THRL=8> __device__ __forceinline__ void attn_phase2(char*lds,const AttnTensors&T,const Sched&S){
  AttnUnit2 u;
  for(int i=0;S.next(i,u);++i){ const int b=u.bhm>>4,hm=u.bhm&15;
    attn_unit2<THRL>(b,u.qb,T.QKV+hm*64,T.QKV+1024+hm*64,T.QKV+2048+(hm>>1)*128,T.O+hm*128,lds); }
}
#undef SBAR
#undef WAIT_BAR
}
#define GAS __attribute__((address_space(1)))
#define LAS __attribute__((address_space(3)))
typedef unsigned short bf16;
typedef unsigned v4u __attribute__((ext_vector_type(4)));
typedef float f32x4 __attribute__((ext_vector_type(4)));
typedef short bf16x8 __attribute__((ext_vector_type(8)));
typedef GAS unsigned gu32;
typedef GAS unsigned long long gu64;
#define RLX_AGENT __ATOMIC_RELAXED, __HIP_MEMORY_SCOPE_AGENT
#define LDS_WAIT() asm volatile("s_waitcnt lgkmcnt(0)" ::: "memory")
#define VM_WAIT() asm volatile("s_waitcnt vmcnt(0)" ::: "memory")
__device__ __forceinline__ unsigned long long rt() { return __builtin_amdgcn_s_memrealtime(); }
__device__ __forceinline__ unsigned f2bf(float f) { unsigned u = __builtin_bit_cast(unsigned, f); return (u + 0x7fffu + ((u >> 16) & 1u)) >> 16; }
__device__ __forceinline__ unsigned pk2(float lo, float hi) { return f2bf(lo) | (f2bf(hi) << 16); }

#define XB_TMO      128
#define XB_XCNT(j)  (256  + 64 * (j))
#define XB_XSUB(j)  (1280 + 64 * (j))
#define XB_XGEN(j)  (2304 + 64 * (j))
#define XB_TOP      3328
#define XB_TOPGEN   3392
#define XCD_BAR_WORDS 3456
#define XB_SPIN_CAP (1u << 18)

__device__ __forceinline__ unsigned xb_ld(unsigned* p)              { return __hip_atomic_load(p, __ATOMIC_RELAXED, __HIP_MEMORY_SCOPE_AGENT); }
__device__ __forceinline__ unsigned xb_add(unsigned* p, unsigned v) { return __hip_atomic_fetch_add(p, v, __ATOMIC_RELAXED, __HIP_MEMORY_SCOPE_AGENT); }
__device__ __forceinline__ unsigned xb_xcc_id() { return (unsigned)__builtin_amdgcn_s_getreg((3 << 11) | 20) & 0xFu; }
#define XB_SPIN(cond, bar) do { unsigned _sp = 0; while (cond) { __builtin_amdgcn_s_sleep(1); \
    if ((++_sp & 255u) == 0u) { if (xb_ld(&(bar)[XB_TMO])) break; if (_sp > XB_SPIN_CAP) { atomicAdd(&(bar)[XB_TMO], 1u); break; } } } } while (0)

struct XcdBarrier {
    unsigned* bar; unsigned x;
    volatile LAS unsigned* st;
};

__device__ __forceinline__ XcdBarrier xcd_barrier_post(unsigned* bar, volatile LAS unsigned* st) {
    XcdBarrier b; b.bar = bar; b.x = xb_xcc_id(); b.st = st;
    if (threadIdx.x == 0) (void)xb_add(&bar[XB_XCNT(b.x)], 1u);
    return b;
}
__device__ __forceinline__ void xcd_barrier_complete(unsigned* bar, unsigned x, unsigned& nloc, unsigned& nx) {
    const unsigned G = gridDim.x * gridDim.y * gridDim.z;
    unsigned sum, cnt, mine, sp = 0u;
    for (;;) {
        sum = 0u; cnt = 0u; mine = 0u;
#pragma unroll
        for (unsigned j = 0; j < 16; ++j) { const unsigned c = xb_ld(&bar[XB_XCNT(j)]); sum += c; cnt += (c > 0u) ? 1u : 0u; mine = (j == x) ? c : mine; }
        if (sum == G) break;
        __builtin_amdgcn_s_sleep(1);
        if ((++sp & 255u) == 0u) { if (xb_ld(&bar[XB_TMO])) break; if (sp > XB_SPIN_CAP) { atomicAdd(&bar[XB_TMO], 1u); break; } }
    }
    nloc = mine > 0u ? mine : 1u; nx = cnt > 0u ? cnt : 1u;
}

__device__ __forceinline__ void xcd_barrier(const XcdBarrier& b) {
    asm volatile("s_waitcnt vmcnt(0)" ::: "memory");
    __syncthreads();
    if (threadIdx.x == 0) {
        unsigned* bar = b.bar;
        __builtin_amdgcn_s_waitcnt(0);
        unsigned nloc = b.st[0], nx = b.st[1];
        if (nloc == 0u) { xcd_barrier_complete(bar, b.x, nloc, nx); b.st[0] = nloc; b.st[1] = nx; }
        const unsigned old = xb_add(&bar[XB_XSUB(b.x)], 1u);
        const unsigned gen = old / nloc;
        if (old + 1u == (gen + 1u) * nloc) {
            __builtin_amdgcn_fence(__ATOMIC_RELEASE, "agent");
            asm volatile("s_waitcnt vmcnt(0)" ::: "memory");
            const unsigned og = xb_add(&bar[XB_TOP], 1u);
            const unsigned tg = og / nx;
            if (og + 1u == (tg + 1u) * nx) xb_add(&bar[XB_TOPGEN], 1u);
            else XB_SPIN(xb_ld(&bar[XB_TOPGEN]) == tg, bar);
            __builtin_amdgcn_fence(__ATOMIC_ACQUIRE, "agent");
            xb_add(&bar[XB_XGEN(b.x)], 1u);
            asm volatile("s_waitcnt vmcnt(0)" ::: "memory");
        } else {
            XB_SPIN(xb_ld(&bar[XB_XGEN(b.x)]) == gen, bar);
            __builtin_amdgcn_fence(__ATOMIC_ACQUIRE, "agent");
            asm volatile("s_waitcnt vmcnt(0)" ::: "memory");
        }
    }
    __syncthreads();
}
constexpr int NWAVES = 8;
constexpr int DMODEL = 2048, NBATCH = 2, SEQ = 16384, DEPTH = 4, MT = NBATCH * SEQ, NMEM = 256, FF = 5632, INW = 4096;
constexpr int UGP = 1152;
constexpr float ALPHA = 1.6817928305074290f, LN_EPS = 1e-5f, RMS_EPS = 1e-5f;
constexpr int NIN = 37;
enum InIdx { I_X = 0, I_MEM, I_F1G, I_F1U, I_F1D, I_LN1G, I_LN1B, I_WIN, I_LQ1, I_LK1, I_LQ2, I_LK2, I_DNG, I_SLRE, I_SLIM, I_SLOG, I_SBRE, I_SBIM, I_SCRE, I_SCIM, I_SD, I_GLUW, I_GLUB,
             I_WOUT, I_LN2G, I_LN2B, I_XQ, I_XK, I_XV, I_XO, I_LN3G, I_LN3B, I_F2G, I_F2U, I_F2D, I_LN4G, I_LN4B };

constexpr size_t MiB = 1u << 20;
constexpr size_t WS_CTL = 0, CTL_ZERO_BYTES = 6 * MiB;
constexpr size_t WS_CS = 1 * MiB;
constexpr int CSL = 57344, CS1 = 0, CB1 = 11264, CS2 = 22528, CB2 = 33792, CSW = 45056, CBW = 49152, CSM = 53248, CBM = 55296;
constexpr size_t WS_ST = 2 * MiB;
constexpr size_t WS_XB = 6 * MiB;
constexpr size_t WS_YLO = WS_XB + 128 * MiB;
constexpr size_t WS_BIG = WS_YLO + 128 * MiB;
constexpr size_t WS_HMID = WS_BIG;
constexpr size_t WS_QKV = WS_BIG;
constexpr size_t WS_UG = WS_BIG + 192 * MiB;
constexpr size_t WS_OV = WS_BIG + 264 * MiB;
constexpr size_t WS_SC = WS_BIG;
constexpr size_t WS_PB = WS_BIG + 128 * MiB;
constexpr size_t WS_MIX = WS_BIG + 392 * MiB;
constexpr size_t WS_YG = WS_MIX + 128 * MiB;
constexpr size_t WS_VS = WS_YG + 64 * MiB;
constexpr size_t WS_W = WS_VS + 16 * MiB;
constexpr size_t WS_W1GU = WS_W, WS_W1D = WS_W1GU + 44 * MiB, WS_W2GU = WS_W1D + 22 * MiB, WS_W2D = WS_W2GU + 44 * MiB, WS_WIN = WS_W2D + 22 * MiB, WS_WGLU = WS_WIN + 16 * MiB,
                 WS_WOUT = WS_WGLU + 2 * MiB, WS_WQN = WS_WOUT + 8 * MiB, WS_WKVT = WS_WQN + 8 * MiB, WS_WOT = WS_WKVT + 16 * MiB, WS_TG = WS_WOT + 8 * MiB, WS_EM = WS_TG + 144 * MiB;
constexpr size_t WS_MEMB = WS_EM + 17 * MiB;
constexpr size_t WS_KVM = WS_MEMB + 2 * MiB;
constexpr size_t WS_MQT = WS_KVM + 4 * MiB;
constexpr size_t WS_VWOT = WS_MQT + 8 * MiB;
constexpr size_t WS_END = WS_VWOT + 8 * MiB;
constexpr int CW_TMO = 0, CW_CODE = 1, CW_BAR = 4096;

constexpr int RING_OFF = 0, RING_BYTES = 131072;
constexpr int LDSCTL_OFF = RING_BYTES, MISC_OFF = LDSCTL_OFF + 320;
constexpr int XCH_OFF = LDSCTL_OFF + 1024;
constexpr int GB_OFF = LDSCTL_OFF + 1024;
constexpr int XST_OFF = GB_OFF + 16384;
static_assert(XST_OFF == GB_OFF + 4096 * 4, "the residual epilogue finds its table right behind the gain | bias image");
constexpr int LDS_BYTES = 163840;
typedef float f32x2v __attribute__((ext_vector_type(2)));
__device__ __forceinline__ float wave_sum(float v) {
    v += pg8::sw_xor<1>(v); v += pg8::sw_xor<2>(v); v += pg8::sw_xor<4>(v); v += pg8::sw_xor<8>(v); v += pg8::sw_xor<16>(v); return pg8::add_xor32(v);
}
__device__ __forceinline__ float wave_max(float v) {
    v = fmaxf(v, pg8::sw_xor<1>(v)); v = fmaxf(v, pg8::sw_xor<2>(v)); v = fmaxf(v, pg8::sw_xor<4>(v)); v = fmaxf(v, pg8::sw_xor<8>(v)); v = fmaxf(v, pg8::sw_xor<16>(v)); return pg8::max_xor32(v);
}
__device__ __forceinline__ unsigned pkbf(float lo, float hi) { return pg8::cvt_pk_bf16(lo, hi); }
struct RmId { __device__ __forceinline__ int operator()(int n0) const { return n0; } };
struct RmGate { int add; __device__ __forceinline__ int operator()(int n0) const { return (n0 >> 7) * 256 + (n0 & 127) + add; } };
template <class RM> __device__ __forceinline__ void conv_T(const float* __restrict__ W, int K, int N, bf16* WT, int ldt, RM rm, const float* gk, const float* bk, float* cs, float* cb, LAS float* scr, int gw, int NGW, int lane, int rot, float wscale = 1.0f) {
    const int nblk = N / 32, nchunks = (K / 512) * nblk, c = lane & 7, r8 = lane >> 3;
    for (int chunk = (gw + NGW - rot % NGW) % NGW; chunk < nchunks; chunk += NGW) {
        const int kc = chunk / nblk, nb = chunk - kc * nblk, n0 = 32 * nb, drow0 = rm(n0);
        const float* wp = W + (size_t)(kc * 512 + r8) * N + n0 + 4 * c;
        float a1[4] = {0.f, 0.f, 0.f, 0.f}, a2[4] = {0.f, 0.f, 0.f, 0.f};
        f32x4 ld[8];
#pragma unroll
        for (int i = 0; i < 8; ++i) ld[i] = __builtin_nontemporal_load((const GAS f32x4*)(wp + (size_t)(8 * i) * N));
#pragma unroll 1
        for (int j = 0; j < 8; ++j) {
            const int k0 = kc * 512 + 64 * j;
#pragma unroll
            for (int i = 0; i < 8; ++i) { LAS float* d = scr + (8 * i + r8) * 33 + 4 * c; d[0] = ld[i][0]; d[1] = ld[i][1]; d[2] = ld[i][2]; d[3] = ld[i][3]; }
            if (j < 7) {
#pragma unroll
                for (int i = 0; i < 8; ++i) ld[i] = __builtin_nontemporal_load((const GAS f32x4*)(wp + (size_t)(64 * (j + 1) + 8 * i) * N)); }
            f32x4 g0, g1, b0, b1;
            if (gk) { g0 = *(const GAS f32x4*)(gk + k0 + 8 * c); g1 = *(const GAS f32x4*)(gk + k0 + 8 * c + 4); b0 = *(const GAS f32x4*)(bk + k0 + 8 * c); b1 = *(const GAS f32x4*)(bk + k0 + 8 * c + 4); }
            LDS_WAIT(); asm volatile("" ::: "memory");
#pragma unroll
            for (int jj = 0; jj < 4; ++jj) { const int n = r8 + 8 * jj; const LAS float* s = scr + (8 * c) * 33 + n;
                float w[8];
#pragma unroll
                for (int e = 0; e < 8; ++e) w[e] = s[e * 33] * wscale;
                v4u o;
                if (gk) {
                    o.x = pkbf(w[0] * g0[0], w[1] * g0[1]); o.y = pkbf(w[2] * g0[2], w[3] * g0[3]); o.z = pkbf(w[4] * g1[0], w[5] * g1[1]); o.w = pkbf(w[6] * g1[2], w[7] * g1[3]);
                    a1[jj] += (pg8::bf_lo(o.x) + pg8::bf_hi(o.x)) + (pg8::bf_lo(o.y) + pg8::bf_hi(o.y)) + (pg8::bf_lo(o.z) + pg8::bf_hi(o.z)) + (pg8::bf_lo(o.w) + pg8::bf_hi(o.w));
                    a2[jj] += (w[0] * b0[0] + w[1] * b0[1]) + (w[2] * b0[2] + w[3] * b0[3]) + (w[4] * b1[0] + w[5] * b1[1]) + (w[6] * b1[2] + w[7] * b1[3]);
                } else { o.x = pkbf(w[0], w[1]); o.y = pkbf(w[2], w[3]); o.z = pkbf(w[4], w[5]); o.w = pkbf(w[6], w[7]); }
                *(GAS v4u*)(WT + (size_t)(drow0 + n) * ldt + k0 + 8 * c) = o; }
            LDS_WAIT(); asm volatile("" ::: "memory");
        }
        if (gk) {
#pragma unroll
            for (int jj = 0; jj < 4; ++jj) { float s1 = a1[jj], s2 = a2[jj];
                s1 += pg8::sw_xor<1>(s1); s1 += pg8::sw_xor<2>(s1); s1 += pg8::sw_xor<4>(s1); s2 += pg8::sw_xor<1>(s2); s2 += pg8::sw_xor<2>(s2); s2 += pg8::sw_xor<4>(s2);
                if (c == 0) { unsafeAtomicAdd(cs + drow0 + r8 + 8 * jj, s1); unsafeAtomicAdd(cb + drow0 + r8 + 8 * jj, s2); } } }
    }
}
__device__ __forceinline__ void conv_copy(const float* __restrict__ W, bf16* O, size_t n, int gw, int NGW, int lane) {
    for (size_t i = ((size_t)gw * 64 + lane) * 8; i < n; i += (size_t)NGW * 64 * 8) {
        const f32x4 a = *(const GAS f32x4*)(W + i), b = *(const GAS f32x4*)(W + i + 4);
        v4u o; o.x = pkbf(a[0], a[1]); o.y = pkbf(a[2], a[3]); o.z = pkbf(b[0], b[1]); o.w = pkbf(b[2], b[3]);
        *(GAS v4u*)(O + i) = o; }
}
__device__ __forceinline__ void ln_rows(const float* Y, const float* __restrict__ g, const float* __restrict__ b, float* X32, bf16* XB, int gw, int NGW, int lane) {
    f32x4 gg[8], bb[8];
#pragma unroll
    for (int j = 0; j < 8; ++j) { gg[j] = *(const GAS f32x4*)(g + 4 * lane + 256 * j); bb[j] = *(const GAS f32x4*)(b + 4 * lane + 256 * j); }
    for (int m = gw; m < MT; m += NGW) {
        const GAS f32x4* yr = (const GAS f32x4*)(Y + (size_t)m * DMODEL) + lane;
        f32x4 v[8]; float s = 0.f;
#pragma unroll
        for (int j = 0; j < 8; ++j) { v[j] = yr[64 * j]; s += (v[j][0] + v[j][1]) + (v[j][2] + v[j][3]); }
        const float mean = wave_sum(s) * (1.f / DMODEL); float s2 = 0.f;
#pragma unroll
        for (int j = 0; j < 8; ++j) { v[j] = v[j] - mean; s2 += (v[j][0] * v[j][0] + v[j][1] * v[j][1]) + (v[j][2] * v[j][2] + v[j][3] * v[j][3]); }
        const float rstd = 1.f / sqrtf(wave_sum(s2) * (1.f / DMODEL) + LN_EPS);
        GAS f32x4* xo = (GAS f32x4*)(X32 + (size_t)m * DMODEL) + lane;
        GAS unsigned long long* o8 = (GAS unsigned long long*)(XB + (size_t)m * DMODEL) + lane;
#pragma unroll
        for (int j = 0; j < 8; ++j) { const f32x4 o = v[j] * rstd * gg[j] + bb[j]; xo[64 * j] = o;
            if (XB) o8[64 * j] = (unsigned long long)pkbf(o[0], o[1]) | ((unsigned long long)pkbf(o[2], o[3]) << 32); }
    }
}
__device__ __forceinline__ void final_ln_planes(const bf16* XB, const pg8::u32x4* LO8, const float* st, const float* g, const float* b, float* out, int gw, int NGW, int lane) {
    const int fq = lane >> 4, fr = lane & 15;
    for (int it = gw; it < 1024 * 64; it += NGW) {
        const int am = it & 7, wv = (it >> 3) & 7, tile = it >> 6, pm = tile >> 3, pn = tile & 7, wr = wv >> 2, wc = wv & 3, ai = am >> 2, mm = am & 3;
        const int r = pm * 256 + ai * 128 + wr * 64 + mm * 16 + fr, col0 = pn * 256 + wc * 32 + 8 * fq;
        const pg8::u32x4 lo = LO8[(size_t)it * 64 + lane];
        const v4u h0 = *(const GAS v4u*)(XB + (size_t)r * DMODEL + col0), h1 = *(const GAS v4u*)(XB + (size_t)r * DMODEL + col0 + 128);
        const f32x2v s = *(const GAS f32x2v*)(st + 2 * (size_t)r);
        const float mu = s.x * (1.0f / 2048.0f), rs = __builtin_amdgcn_rsqf(s.y * (1.0f / 2048.0f) - mu * mu + LN_EPS);
#pragma unroll
        for (int bj = 0; bj < 2; ++bj) { const v4u h = bj ? h1 : h0; const unsigned w0 = bj ? lo.z : lo.x, w1 = bj ? lo.w : lo.y; const int c = col0 + bj * 128;
            const f32x2v a0 = __builtin_amdgcn_cvt_pk_f32_fp8((int)w0, false), a1 = __builtin_amdgcn_cvt_pk_f32_fp8((int)w0, true), a2 = __builtin_amdgcn_cvt_pk_f32_fp8((int)w1, false), a3 = __builtin_amdgcn_cvt_pk_f32_fp8((int)w1, true);
            const f32x4 y0 = {pg8::bf_lo(h[0]) + a0.x * 0.00390625f, pg8::bf_hi(h[0]) + a0.y * 0.00390625f, pg8::bf_lo(h[1]) + a1.x * 0.00390625f, pg8::bf_hi(h[1]) + a1.y * 0.00390625f};
            const f32x4 y1 = {pg8::bf_lo(h[2]) + a2.x * 0.00390625f, pg8::bf_hi(h[2]) + a2.y * 0.00390625f, pg8::bf_lo(h[3]) + a3.x * 0.00390625f, pg8::bf_hi(h[3]) + a3.y * 0.00390625f};
            const f32x4 g0 = *(const GAS f32x4*)(g + c), g1 = *(const GAS f32x4*)(g + c + 4), b0 = *(const GAS f32x4*)(b + c), b1 = *(const GAS f32x4*)(b + c + 4);
            *(GAS f32x4*)(out + (size_t)r * DMODEL + c) = (y0 - mu) * rs * g0 + b0; *(GAS f32x4*)(out + (size_t)r * DMODEL + c + 4) = (y1 - mu) * rs * g1 + b1; }
    }
}
__device__ __forceinline__ void softmax_rows(const float* __restrict__ SC, bf16* PB, int gw, int NGW, int lane) {
    for (int m = gw; m < MT; m += NGW) {
        const GAS f32x4* sr = (const GAS f32x4*)(SC + (size_t)m * 1024) + lane;
        GAS unsigned long long* o8 = (GAS unsigned long long*)(PB + (size_t)m * 1024) + lane;
        f32x4 v[4];
#pragma unroll
        for (int j = 0; j < 4; ++j) v[j] = sr[64 * j];
#pragma unroll
        for (int j = 0; j < 4; ++j) {
            const float mx = wave_max(fmaxf(fmaxf(v[j][0], v[j][1]), fmaxf(v[j][2], v[j][3])));
            f32x4 e;
#pragma unroll
            for (int k = 0; k < 4; ++k) e[k] = __builtin_amdgcn_exp2f((v[j][k] - mx) * 1.4426950408889634f);
            const float inv = 1.0f / wave_sum((e[0] + e[1]) + (e[2] + e[3]));
            o8[64 * j] = (unsigned long long)pkbf(e[0] * inv, e[1] * inv) | ((unsigned long long)pkbf(e[2] * inv, e[3] * inv) << 32);
        }
    }
}
__device__ __forceinline__ void diff_combine(const bf16* __restrict__ OV, bf16* MIX, const float* lq1, const float* lk1, const float* lq2, const float* lk2, const float* ng, float lam_init, int gw, int NGW, int lane) {
    const float s1 = wave_sum(lq1[lane] * lk1[lane]), s2 = wave_sum(lq2[lane] * lk2[lane]);
    const float lam = expf(s1) - expf(s2) + lam_init, osc = 1.0f - lam_init;
    const int h = lane >> 3, d0 = (lane & 7) * 16;
    float gn[16];
#pragma unroll
    for (int e = 0; e < 16; ++e) gn[e] = ng[d0 + e] * osc;
    for (int m0 = gw; m0 < MT; m0 += 2 * NGW) {
        const int m1 = m0 + NGW; const bool has1 = m1 < MT;
        const bf16* o1 = OV + (size_t)m0 * 2048 + h * 256 + d0; const bf16* p1 = OV + (size_t)(has1 ? m1 : m0) * 2048 + h * 256 + d0;
        v4u q[2][4];
        q[0][0] = *(const GAS v4u*)o1; q[0][1] = *(const GAS v4u*)(o1 + 8); q[0][2] = *(const GAS v4u*)(o1 + 128); q[0][3] = *(const GAS v4u*)(o1 + 136);
        q[1][0] = *(const GAS v4u*)p1; q[1][1] = *(const GAS v4u*)(p1 + 8); q[1][2] = *(const GAS v4u*)(p1 + 128); q[1][3] = *(const GAS v4u*)(p1 + 136);
#pragma unroll
        for (int t = 0; t < 2; ++t) { if (t == 1 && !has1) break;
            const v4u a0 = q[t][0], a1 = q[t][1], b0 = q[t][2], b1 = q[t][3]; float x[16];
#pragma unroll
            for (int k = 0; k < 4; ++k) { x[2 * k] = pg8::bf_lo(a0[k]) - lam * pg8::bf_lo(b0[k]); x[2 * k + 1] = pg8::bf_hi(a0[k]) - lam * pg8::bf_hi(b0[k]);
                x[8 + 2 * k] = pg8::bf_lo(a1[k]) - lam * pg8::bf_lo(b1[k]); x[8 + 2 * k + 1] = pg8::bf_hi(a1[k]) - lam * pg8::bf_hi(b1[k]); }
            float ss = 0.f;
#pragma unroll
            for (int e = 0; e < 16; ++e) ss += x[e] * x[e];
            ss += pg8::sw_xor<1>(ss); ss += pg8::sw_xor<2>(ss); ss += pg8::sw_xor<4>(ss);
            const float r = __builtin_amdgcn_rsqf(ss * (1.0f / 128.0f) + RMS_EPS);
            v4u w0, w1;
#pragma unroll
            for (int k = 0; k < 4; ++k) { w0[k] = pkbf(x[2 * k] * r * gn[2 * k], x[2 * k + 1] * r * gn[2 * k + 1]); w1[k] = pkbf(x[8 + 2 * k] * r * gn[8 + 2 * k], x[8 + 2 * k + 1] * r * gn[8 + 2 * k + 1]); }
            bf16* op = MIX + (size_t)(t ? m1 : m0) * 2048 + h * 128 + d0;
            *(GAS v4u*)op = w0; *(GAS v4u*)(op + 8) = w1; }
    }
}
__device__ __forceinline__ void cpow(float rez, float imz, int tau, float& re, float& im) {
    double rev = (double)imz * (double)tau * 0.15915494309189535; rev -= __builtin_rint(rev);
    const float mg = __builtin_amdgcn_exp2f(rez * (float)tau * 1.4426950408889634f), rv = (float)rev;
    re = mg * __builtin_amdgcn_cosf(rv); im = mg * __builtin_amdgcn_sinf(rv);
}
__device__ __forceinline__ void ssm_prep(const float* lam_re, const float* lam_im, const float* log_step, const float* b_re, const float* b_im, const float* c_re, const float* c_im,
                                         bf16* TG, bf16* EM, LAS unsigned char* lds, int vcu, int G, int tid, bool skipz) {
    LAS float* APre = (LAS float*)lds;
    LAS float* APim = APre + 65 * 64;
    LAS float* BBre = APim + 65 * 64;
    LAS float* BBim = BBre + 1024;
    LAS float* CCre = BBim + 1024;
    LAS float* CCim = CCre + 256;
    LAS float* KT = CCim + 256;
    for (int item = vcu; item < 256; item += G) {
        const int g = item >> 2, pb = item & 3;
        const float step = expf(log_step[g]);
        for (int e = tid; e < 65 * 64; e += NWAVES * 64) { const int tau = e >> 6, n = e & 63; const float lr = fminf(lam_re[g * 64 + n], -1e-4f), li = lam_im[g * 64 + n];
            float re, im; cpow(lr * step, li * step, tau, re, im); APre[e] = re; APim[e] = im; }
        for (int e = tid; e < 1024; e += NWAVES * 64) { const int n = e >> 4; const float lr = fminf(lam_re[g * 64 + n], -1e-4f), li = lam_im[g * 64 + n];
            float ar, ai; cpow(lr * step, li * step, 1, ar, ai);
            const float x = ar - 1.0f, y = ai, den = 1.0f / (lr * lr + li * li);
            const float cr = (x * lr + y * li) * den, ci = (y * lr - x * li) * den;
            const float br = b_re[(size_t)g * 1024 + e], bi = b_im[(size_t)g * 1024 + e];
            BBre[e] = cr * br - ci * bi; BBim[e] = cr * bi + ci * br; }
        for (int e = tid; e < 256; e += NWAVES * 64) { const int pl = e >> 6, n = e & 63; CCre[e] = c_re[(size_t)(g * 16 + 4 * pb + pl) * 64 + n]; CCim[e] = c_im[(size_t)(g * 16 + 4 * pb + pl) * 64 + n]; }
        __syncthreads();
        { const int pq = tid & 63, pl = pq >> 4, q = pq & 15, tb = tid >> 6; float acc[8];
#pragma unroll
          for (int k = 0; k < 8; ++k) acc[k] = 0.f;
          for (int n = 0; n < 64; ++n) { const float cr = CCre[pl * 64 + n], ci = CCim[pl * 64 + n], br = BBre[n * 16 + q], bi = BBim[n * 16 + q];
              const float cbr = cr * br - ci * bi, cbi = cr * bi + ci * br;
#pragma unroll
              for (int k = 0; k < 8; ++k) acc[k] += cbr * APre[(tb * 8 + k) * 64 + n] - cbi * APim[(tb * 8 + k) * 64 + n]; }
#pragma unroll
          for (int k = 0; k < 8; ++k) KT[(tb * 8 + k) * 64 + pq] = acc[k]; }
        __syncthreads();
        for (int idx = tid; idx < 256 * 144; idx += NWAVES * 64) {
            const int rowl = idx / 144, ch = idx - rowl * 144, t = rowl >> 2, pl = rowl & 3; float v[8];
            if (ch >= 16) { const int s = (ch - 16) >> 1, q0 = ((ch - 16) & 1) * 8;
                if (s > (t | 15)) continue;
                if (skipz && s > t) continue;
#pragma unroll
                for (int e = 0; e < 8; ++e) v[e] = (s <= t) ? KT[(t - s) * 64 + pl * 16 + q0 + e] : 0.f;
            } else { const int n0 = ch * 8;
#pragma unroll
                for (int e = 0; e < 8; ++e) { const int n = (n0 + e) & 63; const float cr = CCre[pl * 64 + n], ci = CCim[pl * 64 + n], pr = APre[(t + 1) * 64 + n], pi = APim[(t + 1) * 64 + n];
                    v[e] = (n0 < 64) ? (cr * pr - ci * pi) : -(cr * pi + ci * pr); } }
            v4u o; o.x = pkbf(v[0], v[1]); o.y = pkbf(v[2], v[3]); o.z = pkbf(v[4], v[5]); o.w = pkbf(v[6], v[7]);
            *(GAS v4u*)(TG + (size_t)(g * 1024 + t * 16 + 4 * pb + pl) * UGP + ch * 8) = o;
        }
        for (int idx = tid; idx < 32 * 128; idx += NWAVES * 64) {
            const int rl = idx >> 7, ch = idx & 127, part = rl >> 4, n = 16 * pb + (rl & 15), s = ch >> 1, q0 = (ch & 1) * 8; float v[8];
            const float pr = APre[(63 - s) * 64 + n], pi = APim[(63 - s) * 64 + n];
#pragma unroll
            for (int e = 0; e < 8; ++e) { const float br = BBre[n * 16 + q0 + e], bi = BBim[n * 16 + q0 + e]; v[e] = part ? (pr * bi + pi * br) : (pr * br - pi * bi); }
            v4u o; o.x = pkbf(v[0], v[1]); o.y = pkbf(v[2], v[3]); o.z = pkbf(v[4], v[5]); o.w = pkbf(v[6], v[7]);
            *(GAS v4u*)(EM + (size_t)(g * 128 + part * 64 + n) * 1024 + ch * 8) = o;
        }
        __syncthreads();
    }
}
__device__ __forceinline__ void ssm_scan8(const float* lam_re, const float* lam_im, const float* log_step, const float* VS, bf16* UG, int gb, int wave, int lane, LAS float* xl) {
    const int g = gb >> 1, b = gb & 1, n = lane;
    const float step = expf(log_step[g]), lr = fminf(lam_re[g * 64 + n], -1e-4f), li = lam_im[g * 64 + n];
    float ar, ai; cpow(lr * step, li * step, 64, ar, ai);
    const float* vs = VS + (size_t)(g * 512 + b * 256 + 32 * wave) * 128 + n; bf16* ug = UG + (size_t)(g * 512 + b * 256 + 32 * wave) * UGP + n;
    float vr[32], vi[32];
#pragma unroll
    for (int k = 0; k < 32; ++k) { vr[k] = vs[(size_t)k * 128]; vi[k] = vs[(size_t)k * 128 + 64]; }
    float hr = 0.f, hi = 0.f;
#pragma unroll
    for (int k = 0; k < 32; ++k) { const float nr = ar * hr - ai * hi + vr[k], ni = ar * hi + ai * hr + vi[k]; hr = nr; hi = ni; }
    xl[(wave * 64 + n) * 2] = hr; xl[(wave * 64 + n) * 2 + 1] = hi;
    float pr = ar, pi = ai;
#pragma unroll
    for (int q = 0; q < 5; ++q) { const float tr = pr * pr - pi * pi, ti = 2.f * pr * pi; pr = tr; pi = ti; }
    asm volatile("s_waitcnt lgkmcnt(0)" ::: "memory"); __syncthreads();
    hr = 0.f; hi = 0.f;
    for (int v = 0; v < wave; ++v) { const float er = xl[(v * 64 + n) * 2], ei = xl[(v * 64 + n) * 2 + 1]; const float nr = pr * hr - pi * hi + er, ni = pr * hi + pi * hr + ei; hr = nr; hi = ni; }
#pragma unroll
    for (int k = 0; k < 32; ++k) { const unsigned w = pkbf(hr, hi); ug[(size_t)k * UGP] = (bf16)(w & 0xffffu); ug[(size_t)k * UGP + 64] = (bf16)(w >> 16);
        const float nr = ar * hr - ai * hi + vr[k], ni = ar * hi + ai * hr + vi[k]; hr = nr; hi = ni; }
    asm volatile("s_waitcnt lgkmcnt(0)" ::: "memory"); __syncthreads();
}

struct MapSsmV   { __device__ __forceinline__ void operator()(pg8::Unit& u) const { u.aoff = u.pm * 256 * UGP; u.boff = (u.pm >> 1) * 128 * 1024; } };
struct MapSsmY   { __device__ __forceinline__ void operator()(pg8::Unit& u) const { if ((u.pm >> 3) & 1) u.pn = 3 - u.pn;
        u.aoff = u.pm * 256 * UGP; u.boff = ((u.pm >> 1) * 1024 + u.pn * 256) * UGP; u.nt = 6 + 4 * u.pn; } };
struct MapMQT    { __device__ __forceinline__ void operator()(pg8::Unit& u) const { const int b = u.pm >> 2, h = u.pm & 3; u.aoff = b * 256 * 4096 + h * 512; u.boff = u.pn * 256 * 2048 + h * 512; } };
struct MapVWOT   { __device__ __forceinline__ void operator()(pg8::Unit& u) const { const int b = u.pm >> 3, nt = u.pm & 7, h = u.pn; u.aoff = nt * 256 * 2048 + h * 512; u.boff = b * 256 * 4096 + 2048 + h * 512; } };
struct MapScores { __device__ __forceinline__ void operator()(pg8::Unit& u) const { u.aoff = u.pm * 256 * 2048; u.boff = ((u.pm >> 6) * 1024 + u.pn * 256) * 2048; } };
struct MapOut    { __device__ __forceinline__ void operator()(pg8::Unit& u) const { u.aoff = u.pm * 256 * 1024; u.boff = ((u.pm >> 6) * 2048 + u.pn * 256) * 1024; } };

#ifndef WGM_N8
#define WGM_N8 4
#endif
#ifndef WGM_FF
#define WGM_FF 4
#endif
#ifndef STAG_G
#define STAG_G 1
#endif
#ifndef STAG_US
#define STAG_US 0
#endif
__device__ __forceinline__ void stagger(int bx, int us) {
    const int grp = (bx >> 3) % STAG_G;
    if (STAG_G > 1 && grp) { const unsigned long long t0 = __builtin_amdgcn_s_memrealtime(), dt = (unsigned long long)(grp * us) * 100ull;
        while (__builtin_amdgcn_s_memrealtime() - t0 < dt) __builtin_amdgcn_s_sleep(16); }
}
struct Args { const float* in[NIN]; float* out; unsigned char* ws; };
#ifndef PHMASK
#define PHMASK 0xFFFFFFFFu
#endif
#define PH(k) ((PHMASK >> (k)) & 1u)
#ifndef PROBE_DUP
#define PROBE_DUP -1
#endif
#ifndef PROBE_DUP2
#define PROBE_DUP2 -1
#endif
#ifndef PROBE_DUP3
#define PROBE_DUP3 -1
#endif
#ifndef PROBE_DUP4
#define PROBE_DUP4 -1
#endif
#define PD(k) (PROBE_DUP == (k) || PROBE_DUP2 == (k) || PROBE_DUP3 == (k) || PROBE_DUP4 == (k))
#define P_DUMY ((float*)(WSP + WS_END))
#define P_DUMXB ((bf16*)(WSP + WS_END + 256 * MiB))
#define P_DUMST ((float*)(WSP + WS_END + 384 * MiB))
#define LOAD_GB(gp, bp) do { const float* g_ = (gp); const float* b_ = (bp); LAS float* d_ = (LAS float*)(ldsl + GB_OFF); \
        for (int i_ = tid; i_ < DMODEL; i_ += NWAVES * 64) { d_[i_] = g_[i_]; d_[DMODEL + i_] = b_[i_]; } __syncthreads(); } while (0)
#define LGB ((LAS const float*)(ldsl + GB_OFF))
#define GEMM_PHASE(EPI, ORD, g, S, E) pg8::gemm_phase<EPI, ORD, true, true>(ldsl + RING_OFF, g, S, E)
#ifndef SWIGLU_ALIGN
#define SWIGLU_ALIGN true
#endif
#define GEMM_PHASE_SW(EPI, ORD, g, S, E) pg8::gemm_phase<EPI, ORD, SWIGLU_ALIGN, true>(ldsl + RING_OFF, g, S, E)
typedef __attribute__((address_space(4))) const unsigned char* kargp_t;
__device__ __forceinline__ kargp_t kargs() { kargp_t p = (kargp_t)__builtin_amdgcn_kernarg_segment_ptr(); asm volatile("" : "+s"(p)); return p; }
#define INP(i) (*(const float* const __attribute__((address_space(4)))*)(kargs() + 8 * (i)))
#define P_X32 (*(float* const __attribute__((address_space(4)))*)(kargs() + 8 * NIN))
#define WSP (*(unsigned char* const __attribute__((address_space(4)))*)(kargs() + 8 * (NIN + 1)))
#define P_XB ((bf16*)(WSP + WS_XB))
#define P_YLO ((pg8::u32x4*)(WSP + WS_YLO))
#define P_CS(l, off) ((float*)(WSP + WS_CS) + (size_t)(l) * CSL + (off))
#define P_ST(i) ((float*)(WSP + WS_ST) + (size_t)(i) * (2 * MT))
#define P_HMID ((bf16*)(WSP + WS_HMID))
#define P_QKV ((bf16*)(WSP + WS_QKV))
#define P_UG ((bf16*)(WSP + WS_UG))
#define P_OV ((bf16*)(WSP + WS_OV))
#define P_SC ((float*)(WSP + WS_SC))
#define P_PB ((bf16*)(WSP + WS_PB))
#define P_MIX ((bf16*)(WSP + WS_MIX))
#define P_YG ((bf16*)(WSP + WS_YG))
#define P_VS ((float*)(WSP + WS_VS))
#define P_W1GU ((bf16*)(WSP + WS_W1GU))
#define P_W1D ((bf16*)(WSP + WS_W1D))
#define P_W2GU ((bf16*)(WSP + WS_W2GU))
#define P_W2D ((bf16*)(WSP + WS_W2D))
#define P_WIN ((bf16*)(WSP + WS_WIN))
#define P_WGLU ((bf16*)(WSP + WS_WGLU))
#define P_WOUT ((bf16*)(WSP + WS_WOUT))
#define P_WQN ((bf16*)(WSP + WS_WQN))
#define P_WKVT ((bf16*)(WSP + WS_WKVT))
#define P_WOT ((bf16*)(WSP + WS_WOT))
#define P_TG ((bf16*)(WSP + WS_TG))
#define P_EM ((bf16*)(WSP + WS_EM))
#define P_MEMB ((bf16*)(WSP + WS_MEMB))
#define P_KVM ((bf16*)(WSP + WS_KVM))
#define P_MQT ((bf16*)(WSP + WS_MQT))
#define P_VWOT ((bf16*)(WSP + WS_VWOT))
__global__ void __launch_bounds__(NWAVES * 64, 2) fwd_kernel(Args args) {
    extern __shared__ __attribute__((aligned(16))) unsigned char lds[];
    LAS unsigned char* ldsl = (LAS unsigned char*)lds;
    volatile LAS unsigned* MISC = (volatile LAS unsigned*)(ldsl + MISC_OFF);
#define IDS() const int tid = pg8::otid(), lane = tid & 63, wave = __builtin_amdgcn_readfirstlane(tid >> 6); const int G = pg8::osgpr((int)gridDim.x), bx = pg8::osgpr((int)blockIdx.x), \
        vcu = (G % 8 == 0) ? (bx % 8) * (G / 8) + bx / 8 : bx, gw = vcu * NWAVES + wave, NGW = G * NWAVES; LAS float* scr = (LAS float*)(ldsl + RING_OFF + wave * 16384); \
        (void)lane; (void)gw; (void)NGW; (void)scr; (void)vcu
    { const int tid0 = threadIdx.x;
      for (int u = tid0; u < (LDS_BYTES - LDSCTL_OFF) / 4; u += NWAVES * 64) ((LAS unsigned*)(ldsl + LDSCTL_OFF))[u] = 0u; }
    __syncthreads();
    (void)xcd_barrier_post((unsigned*)((gu32*)(WSP + WS_CTL) + CW_BAR), MISC + 8);
#define GRID_BAR() do { XcdBarrier b_; b_.bar = (unsigned*)((gu32*)(WSP + WS_CTL) + CW_BAR); b_.x = xb_xcc_id(); b_.st = (volatile LAS unsigned*)(ldsl + MISC_OFF) + 8; xcd_barrier(b_); } while (0)

#define CONVERT_LAYER(L, MODE) do { const int L_ = (L); IDS();     \
        if ((MODE) != 2) { \
        conv_T(INP(I_F1G) + (size_t)L_ * DMODEL * FF, DMODEL, FF, P_W1GU, DMODEL, RmGate{0}, L_ ? INP(I_LN4G) + (L_ - 1) * DMODEL : nullptr, INP(I_LN4B) + (L_ ? L_ - 1 : 0) * DMODEL, P_CS(L_, CS1), P_CS(L_, CB1), scr, gw, NGW, lane, 0, 1.4426950408889634f); \
        conv_T(INP(I_F1U) + (size_t)L_ * DMODEL * FF, DMODEL, FF, P_W1GU, DMODEL, RmGate{128}, L_ ? INP(I_LN4G) + (L_ - 1) * DMODEL : nullptr, INP(I_LN4B) + (L_ ? L_ - 1 : 0) * DMODEL, P_CS(L_, CS1), P_CS(L_, CB1), scr, gw, NGW, lane, 704, 0.6931471805599453f); \
        conv_T(INP(I_F1D) + (size_t)L_ * DMODEL * FF, FF, DMODEL, P_W1D, FF, RmId{}, nullptr, nullptr, nullptr, nullptr, scr, gw, NGW, lane, 1408); \
        conv_T(INP(I_F2G) + (size_t)L_ * DMODEL * FF, DMODEL, FF, P_W2GU, DMODEL, RmGate{0}, INP(I_LN3G) + L_ * DMODEL, INP(I_LN3B) + L_ * DMODEL, P_CS(L_, CS2), P_CS(L_, CB2), scr, gw, NGW, lane, 2112, 1.4426950408889634f); \
        conv_T(INP(I_F2U) + (size_t)L_ * DMODEL * FF, DMODEL, FF, P_W2GU, DMODEL, RmGate{128}, INP(I_LN3G) + L_ * DMODEL, INP(I_LN3B) + L_ * DMODEL, P_CS(L_, CS2), P_CS(L_, CB2), scr, gw, NGW, lane, 2816, 0.6931471805599453f); \
        } if ((MODE) != 1) { \
        conv_T(INP(I_F2D) + (size_t)L_ * DMODEL * FF, FF, DMODEL, P_W2D, FF, RmId{}, nullptr, nullptr, nullptr, nullptr, scr, gw, NGW, lane, 3520); \
        } if ((MODE) != 2) { \
        conv_T(INP(I_WIN) + (size_t)L_ * DMODEL * INW, DMODEL, INW, P_WIN, DMODEL, RmId{}, INP(I_LN1G) + L_ * DMODEL, INP(I_LN1B) + L_ * DMODEL, P_CS(L_, CSW), P_CS(L_, CBW), scr, gw, NGW, lane, 4224); \
        conv_T(INP(I_GLUW) + (size_t)L_ * 1024 * 1024, 1024, 1024, P_WGLU, 1024, RmId{}, nullptr, nullptr, nullptr, nullptr, scr, gw, NGW, lane, 4736); \
        conv_T(INP(I_WOUT) + (size_t)L_ * DMODEL * DMODEL, DMODEL, DMODEL, P_WOUT, DMODEL, RmId{}, nullptr, nullptr, nullptr, nullptr, scr, gw, NGW, lane, 4800); \
        conv_copy(INP(I_XQ) + (size_t)L_ * DMODEL * DMODEL, P_WQN, (size_t)DMODEL * DMODEL, gw, NGW, lane); \
        conv_T(INP(I_XK) + (size_t)L_ * DMODEL * DMODEL, DMODEL, DMODEL, P_WKVT, DMODEL, RmId{}, nullptr, nullptr, nullptr, nullptr, scr, gw, NGW, lane, 5056); \
        conv_T(INP(I_XV) + (size_t)L_ * DMODEL * DMODEL, DMODEL, DMODEL, P_WKVT + (size_t)DMODEL * DMODEL, DMODEL, RmId{}, nullptr, nullptr, nullptr, nullptr, scr, gw, NGW, lane, 5312); \
        conv_T(INP(I_XO) + (size_t)L_ * DMODEL * DMODEL, DMODEL, DMODEL, P_WOT, DMODEL, RmId{}, nullptr, nullptr, nullptr, nullptr, scr, gw, NGW, lane, 5568); \
        __syncthreads(); \
        ssm_prep(INP(I_SLRE) + L_ * 4096, INP(I_SLIM) + L_ * 4096, INP(I_SLOG) + L_ * 64, INP(I_SBRE) + (size_t)L_ * 65536, INP(I_SBIM) + (size_t)L_ * 65536, \
                 INP(I_SCRE) + (size_t)L_ * 65536, INP(I_SCIM) + (size_t)L_ * 65536, P_TG, P_EM, ldsl + RING_OFF, vcu, G, tid, L_ > 0); \
        } \
    } while (0)
#define CONVERT_DUMMY(L) do { const int L_ = (L); IDS(); \
        conv_T(INP(I_F1G) + (size_t)L_ * DMODEL * FF, DMODEL, FF, ((bf16*)((unsigned char*)P_W1GU + (WS_END - WS_W))), DMODEL, RmGate{0}, L_ ? INP(I_LN4G) + (L_ - 1) * DMODEL : nullptr, INP(I_LN4B) + (L_ ? L_ - 1 : 0) * DMODEL, (P_DUMST + CS1), (P_DUMST + CB1), scr, gw, NGW, lane, 0, 1.4426950408889634f); \
        conv_T(INP(I_F1U) + (size_t)L_ * DMODEL * FF, DMODEL, FF, ((bf16*)((unsigned char*)P_W1GU + (WS_END - WS_W))), DMODEL, RmGate{128}, L_ ? INP(I_LN4G) + (L_ - 1) * DMODEL : nullptr, INP(I_LN4B) + (L_ ? L_ - 1 : 0) * DMODEL, (P_DUMST + CS1), (P_DUMST + CB1), scr, gw, NGW, lane, 704, 0.6931471805599453f); \
        conv_T(INP(I_F1D) + (size_t)L_ * DMODEL * FF, FF, DMODEL, ((bf16*)((unsigned char*)P_W1D + (WS_END - WS_W))), FF, RmId{}, nullptr, nullptr, nullptr, nullptr, scr, gw, NGW, lane, 1408); \
        conv_T(INP(I_F2G) + (size_t)L_ * DMODEL * FF, DMODEL, FF, ((bf16*)((unsigned char*)P_W2GU + (WS_END - WS_W))), DMODEL, RmGate{0}, INP(I_LN3G) + L_ * DMODEL, INP(I_LN3B) + L_ * DMODEL, (P_DUMST + CS2), (P_DUMST + CB2), scr, gw, NGW, lane, 2112, 1.4426950408889634f); \
        conv_T(INP(I_F2U) + (size_t)L_ * DMODEL * FF, DMODEL, FF, ((bf16*)((unsigned char*)P_W2GU + (WS_END - WS_W))), DMODEL, RmGate{128}, INP(I_LN3G) + L_ * DMODEL, INP(I_LN3B) + L_ * DMODEL, (P_DUMST + CS2), (P_DUMST + CB2), scr, gw, NGW, lane, 2816, 0.6931471805599453f); \
        conv_T(INP(I_F2D) + (size_t)L_ * DMODEL * FF, FF, DMODEL, ((bf16*)((unsigned char*)P_W2D + (WS_END - WS_W))), FF, RmId{}, nullptr, nullptr, nullptr, nullptr, scr, gw, NGW, lane, 3520); \
        conv_T(INP(I_WIN) + (size_t)L_ * DMODEL * INW, DMODEL, INW, ((bf16*)((unsigned char*)P_WIN + (WS_END - WS_W))), DMODEL, RmId{}, INP(I_LN1G) + L_ * DMODEL, INP(I_LN1B) + L_ * DMODEL, (P_DUMST + CSW), (P_DUMST + CBW), scr, gw, NGW, lane, 4224); \
        conv_T(INP(I_GLUW) + (size_t)L_ * 1024 * 1024, 1024, 1024, ((bf16*)((unsigned char*)P_WGLU + (WS_END - WS_W))), 1024, RmId{}, nullptr, nullptr, nullptr, nullptr, scr, gw, NGW, lane, 4736); \
        conv_T(INP(I_WOUT) + (size_t)L_ * DMODEL * DMODEL, DMODEL, DMODEL, ((bf16*)((unsigned char*)P_WOUT + (WS_END - WS_W))), DMODEL, RmId{}, nullptr, nullptr, nullptr, nullptr, scr, gw, NGW, lane, 4800); \
        conv_copy(INP(I_XQ) + (size_t)L_ * DMODEL * DMODEL, ((bf16*)((unsigned char*)P_WQN + (WS_END - WS_W))), (size_t)DMODEL * DMODEL, gw, NGW, lane); \
        conv_T(INP(I_XK) + (size_t)L_ * DMODEL * DMODEL, DMODEL, DMODEL, ((bf16*)((unsigned char*)P_WKVT + (WS_END - WS_W))), DMODEL, RmId{}, nullptr, nullptr, nullptr, nullptr, scr, gw, NGW, lane, 5056); \
        conv_T(INP(I_XV) + (size_t)L_ * DMODEL * DMODEL, DMODEL, DMODEL, ((bf16*)((unsigned char*)P_WKVT + (WS_END - WS_W))) + (size_t)DMODEL * DMODEL, DMODEL, RmId{}, nullptr, nullptr, nullptr, nullptr, scr, gw, NGW, lane, 5312); \
        conv_T(INP(I_XO) + (size_t)L_ * DMODEL * DMODEL, DMODEL, DMODEL, ((bf16*)((unsigned char*)P_WOT + (WS_END - WS_W))), DMODEL, RmId{}, nullptr, nullptr, nullptr, nullptr, scr, gw, NGW, lane, 5568); \
        __syncthreads(); \
        ssm_prep(INP(I_SLRE) + L_ * 4096, INP(I_SLIM) + L_ * 4096, INP(I_SLOG) + L_ * 64, INP(I_SBRE) + (size_t)L_ * 65536, INP(I_SBIM) + (size_t)L_ * 65536, \
                 INP(I_SCRE) + (size_t)L_ * 65536, INP(I_SCIM) + (size_t)L_ * 65536, ((bf16*)((unsigned char*)P_TG + (WS_END - WS_W))), ((bf16*)((unsigned char*)P_EM + (WS_END - WS_W))), ldsl + RING_OFF, vcu, G, tid); \
    } while (0)

    { IDS(); conv_copy(INP(I_X), P_XB, (size_t)MT * DMODEL, gw, NGW, lane);
      conv_copy(INP(I_MEM), P_MEMB, (size_t)NBATCH * NMEM * DMODEL, gw, NGW, lane); }
    CONVERT_LAYER(0, 0);
    GRID_BAR();

#pragma unroll 1
    for (int l = 0; l < DEPTH; ++l) {
        if (PH(1)) { IDS();
        { pg8::Gemm g{P_XB, P_W1GU, DMODEL, DMODEL, DMODEL}; pg8::Order<pg8::MapStd> S; S.init(MT / 256, 2 * FF / 256, G, bx, pg8::MapStd{DMODEL, DMODEL}, WGM_FF);
          pg8::EpiSwiGLU E{P_HMID, FF, pg8::Fold{P_ST(l ? 4 * l - 1 : 0), P_CS(l, CS1), P_CS(l, CB1), l == 0}, ldsl + GB_OFF}; GEMM_PHASE_SW(pg8::EpiSwiGLU, pg8::Order<pg8::MapStd>, g, S, E); }
        }
        GRID_BAR();
        if (PH(2)) { IDS(); stagger(bx, STAG_US);
        { pg8::Gemm g{P_HMID, P_W1D, FF, FF, FF}; pg8::Order<pg8::MapStdRev> S; S.init(MT / 256, DMODEL / 256, G, bx, pg8::MapStdRev{FF, FF, MT / 256}, WGM_N8);
          if (l == 0) { pg8::EpiResLn0 E{INP(I_X), nullptr, LGB, P_XB, P_YLO, nullptr, P_ST(0), ALPHA, 0.5f}; GEMM_PHASE(pg8::EpiResLn0, pg8::Order<pg8::MapStdRev>, g, S, E); }
          else { LOAD_GB(INP(I_LN4G) + (l - 1) * DMODEL, INP(I_LN4B) + (l - 1) * DMODEL); pg8::EpiResLn E{nullptr, P_ST(4 * l - 1), LGB, P_XB, P_YLO, nullptr, P_ST(4 * l), ALPHA, 0.5f}; GEMM_PHASE(pg8::EpiResLn, pg8::Order<pg8::MapStdRev>, g, S, E); } }
        }
        GRID_BAR();
        if (PH(4)) { IDS();
        { pg8::Gemm g{P_XB, P_WIN, DMODEL, DMODEL, DMODEL}; pg8::Order<pg8::MapStd> S; S.init(MT / 256, INW / 256, G, bx, pg8::MapStd{DMODEL, DMODEL});
          pg8::EpiWin<UGP> E{P_QKV, P_UG, attn_body::C2, pg8::Fold{P_ST(4 * l), P_CS(l, CSW), P_CS(l, CBW), 0}, ldsl + GB_OFF}; pg8::gemm_phase<pg8::EpiWin<UGP>, pg8::Order<pg8::MapStd>, false, true>(ldsl + RING_OFF, g, S, E); }
        }
        GRID_BAR();
        if (PH(5)) { IDS();
        { pg8::Gemm g{P_UG + 128, P_EM, UGP, 1024, 1024}; pg8::Order<MapSsmV> S; S.init(128, 1, G, bx, MapSsmV{});
          pg8::EpiF32<1> E{P_VS, 128}; GEMM_PHASE(pg8::EpiF32<1>, pg8::Order<MapSsmV>, g, S, E); }
        { pg8::Gemm g{P_MEMB, P_WKVT, DMODEL, DMODEL, DMODEL}; pg8::Order<pg8::MapStd> S; S.init(2, 16, G, bx - 128, pg8::MapStd{DMODEL, DMODEL});
          pg8::EpiBf16 E{P_KVM, 4096, 1.0f}; GEMM_PHASE(pg8::EpiBf16, pg8::Order<pg8::MapStd>, g, S, E); }
        if (l > 0 && bx >= 128 && G == 256) { conv_T(INP(I_F2D) + (size_t)l * DMODEL * FF, FF, DMODEL, P_W2D, FF, RmId{}, nullptr, nullptr, nullptr, nullptr, scr, (bx - 128) * NWAVES + wave, 128 * NWAVES, lane, 0); }
        else if (l > 0 && G != 256) { conv_T(INP(I_F2D) + (size_t)l * DMODEL * FF, FF, DMODEL, P_W2D, FF, RmId{}, nullptr, nullptr, nullptr, nullptr, scr, gw, NGW, lane, 0); }
        __syncthreads();
        }
        if (PH(6)) { IDS();
        { pg8::Order<MapSsmV> S5; S5.init(128, 1, G, bx, MapSsmV{}); pg8::Unit u5; const bool has5 = S5.next(0, u5);
          if (has5) { __builtin_amdgcn_fence(__ATOMIC_ACQUIRE, "agent"); asm volatile("s_waitcnt vmcnt(0)" ::: "memory");
              ssm_scan8(INP(I_SLRE) + l * 4096, INP(I_SLIM) + l * 4096, INP(I_SLOG) + l * 64, P_VS, P_UG, u5.pm, wave, lane, (LAS float*)(ldsl + RING_OFF)); } }
        { const attn_body::AttnTensors AT{(const attn_body::bf16*)P_QKV, (attn_body::bf16*)P_OV};
#if defined(ATTN_V64)
          const attn_body::StaticOrder S((int)G, (int)bx);
          attn_body::attn_phase<attn_body::StaticOrder>((char*)lds + RING_OFF, AT, S); }
#else
          const attn_body::StaticOrder2 S((int)G, (int)bx);
          attn_body::attn_phase2<attn_body::StaticOrder2>((char*)lds + RING_OFF, AT, S); }
#endif
        }
        GRID_BAR();
        if (PH(7)) { IDS();
        diff_combine(P_OV, P_MIX, INP(I_LQ1) + l * 64, INP(I_LK1) + l * 64, INP(I_LQ2) + l * 64, INP(I_LK2) + l * 64, INP(I_DNG) + l * 128, 0.8f - 0.6f * expf(-0.3f * (float)l), gw, NGW, lane);
        __syncthreads();
        { pg8::Gemm g{P_UG, P_TG, UGP, UGP, UGP}; pg8::Order<MapSsmY> S; S.init(128, 4, G, bx, MapSsmY{});
          pg8::EpiSsmY<UGP> E{P_UG, INP(I_SD) + l * 1024, P_YG}; GEMM_PHASE(pg8::EpiSsmY<UGP>, pg8::Order<MapSsmY>, g, S, E); }
        { pg8::Gemm g{P_KVM, P_WQN, 4096, DMODEL, 512}; pg8::Order<MapMQT> S; S.init(8, 8, G, bx, MapMQT{});
          pg8::EpiMqt E{P_MQT, DMODEL, 0.044194173824159216f, INP(I_LN2G) + l * DMODEL, INP(I_LN2B) + l * DMODEL, P_CS(l, CSM), P_CS(l, CBM)}; GEMM_PHASE(pg8::EpiMqt, pg8::Order<MapMQT>, g, S, E); }
        { pg8::Gemm g{P_WOT, P_KVM, DMODEL, 4096, 512}; pg8::Order<MapVWOT> S; S.init(16, 4, G, bx - 64, MapVWOT{});
          pg8::EpiBf16 E{P_VWOT, 1024, 1.0f}; GEMM_PHASE(pg8::EpiBf16, pg8::Order<MapVWOT>, g, S, E); }
        }
        GRID_BAR();
        if (PH(8)) { IDS();
        { pg8::Gemm g{P_YG, P_WGLU, 1024, 1024, 1024}; pg8::Order<pg8::MapStd> S; S.init(MT / 256, 4, G, bx, pg8::MapStd{1024, 1024});
          pg8::EpiGlu E{P_YG, INP(I_GLUB) + l * 1024, P_MIX}; GEMM_PHASE(pg8::EpiGlu, pg8::Order<pg8::MapStd>, g, S, E); }
        }
        GRID_BAR();
        if (PH(9)) { IDS(); stagger(bx, STAG_US);
        { pg8::Gemm g{P_MIX, P_WOUT, DMODEL, DMODEL, DMODEL}; pg8::Order<pg8::MapStd> S; S.init(MT / 256, DMODEL / 256, G, bx, pg8::MapStd{DMODEL, DMODEL}, WGM_N8);
          LOAD_GB(INP(I_LN1G) + l * DMODEL, INP(I_LN1B) + l * DMODEL); pg8::EpiResLn E{nullptr, P_ST(4 * l), LGB, P_XB, P_YLO, nullptr, P_ST(4 * l + 1), ALPHA, 1.0f}; GEMM_PHASE(pg8::EpiResLn, pg8::Order<pg8::MapStd>, g, S, E); }
        }
        GRID_BAR();
        if (PH(11)) { IDS();
        { pg8::Gemm g{P_XB, P_MQT, DMODEL, DMODEL, DMODEL}; pg8::Order<MapScores> S; S.init(MT / 256, 4, G, bx, MapScores{});
          pg8::EpiScoresSm E{P_PB, pg8::Fold{P_ST(4 * l + 1), P_CS(l, CSM), P_CS(l, CBM), 0}, (LAS float*)(ldsl + XCH_OFF)}; GEMM_PHASE(pg8::EpiScoresSm, pg8::Order<MapScores>, g, S, E); }
        }
        GRID_BAR();
        if (PH(13)) { IDS(); stagger(bx, STAG_US);
        { pg8::Gemm g{P_PB, P_VWOT, 1024, 1024, 1024}; pg8::Order<MapOut> S; S.init(MT / 256, DMODEL / 256, G, bx, MapOut{}, WGM_N8);
          LOAD_GB(INP(I_LN2G) + l * DMODEL, INP(I_LN2B) + l * DMODEL); pg8::EpiResLn E{nullptr, P_ST(4 * l + 1), LGB, P_XB, P_YLO, nullptr, P_ST(4 * l + 2), ALPHA, 1.0f}; GEMM_PHASE(pg8::EpiResLn, pg8::Order<MapOut>, g, S, E); }
        }
        GRID_BAR();
        if (PH(15)) { IDS();
        { pg8::Gemm g{P_XB, P_W2GU, DMODEL, DMODEL, DMODEL}; pg8::Order<pg8::MapStd> S; S.init(MT / 256, 2 * FF / 256, G, bx, pg8::MapStd{DMODEL, DMODEL}, WGM_FF);
          pg8::EpiSwiGLU E{P_HMID, FF, pg8::Fold{P_ST(4 * l + 2), P_CS(l, CS2), P_CS(l, CB2), 0}, ldsl + GB_OFF}; GEMM_PHASE_SW(pg8::EpiSwiGLU, pg8::Order<pg8::MapStd>, g, S, E); }
        }
        GRID_BAR();
        if (PH(16)) { IDS(); stagger(bx, STAG_US);
        { pg8::Gemm g{P_HMID, P_W2D, FF, FF, FF}; pg8::Order<pg8::MapStdRev> S; S.init(MT / 256, DMODEL / 256, G, bx, pg8::MapStdRev{FF, FF, MT / 256}, WGM_N8);
          LOAD_GB(INP(I_LN3G) + l * DMODEL, INP(I_LN3B) + l * DMODEL);
          { pg8::EpiResLn E{nullptr, P_ST(4 * l + 2), LGB, P_XB, P_YLO, nullptr, P_ST(4 * l + 3), ALPHA, 0.5f}; GEMM_PHASE(pg8::EpiResLn, pg8::Order<pg8::MapStdRev>, g, S, E); } }
        }
        if (l + 1 < DEPTH) { CONVERT_LAYER(l + 1, 1); GRID_BAR(); }
        else { GRID_BAR(); IDS(); final_ln_planes(P_XB, P_YLO, P_ST(4 * l + 3), INP(I_LN4G) + l * DMODEL, INP(I_LN4B) + l * DMODEL, P_X32, gw, NGW, lane); }
    }
}

extern "C" void kernel_launch(void* const* d_in, const int* in_sizes, int n_in, void* d_out, int out_size, void* d_ws, size_t ws_size, hipStream_t stream) {
    static int grid = 0;
    if (grid == 0) {
        if (n_in != NIN || in_sizes[0] != MT * DMODEL || out_size != MT * DMODEL || ws_size < WS_END) { fprintf(stderr, "kernel_launch: unexpected problem shape (n_in %d, in0 %d, out %d, ws %zu < %zu); nothing launched\n", n_in, n_in > 0 ? in_sizes[0] : -1, out_size, ws_size, (size_t)WS_END); grid = -1; return; }
        int dev = 0, cus = 0, per_cu = 0;
        if (hipGetDevice(&dev) != hipSuccess || hipDeviceGetAttribute(&cus, hipDeviceAttributeMultiprocessorCount, dev) != hipSuccess) { fprintf(stderr, "kernel_launch: device query failed\n"); grid = -1; return; }
        if (hipFuncSetAttribute((const void*)fwd_kernel, hipFuncAttributeMaxDynamicSharedMemorySize, LDS_BYTES) != hipSuccess) { fprintf(stderr, "kernel_launch: hipFuncSetAttribute failed\n"); grid = -1; return; }
        if (hipOccupancyMaxActiveBlocksPerMultiprocessor(&per_cu, (const void*)fwd_kernel, NWAVES * 64, LDS_BYTES) != hipSuccess || per_cu < 1)
            fprintf(stderr, "kernel_launch: note: occupancy query reports %d workgroups per CU\n", per_cu);
        (void)hipGetLastError();
        grid = cus;
    }
    if (grid < 0) return;
    if (hipMemsetAsync((char*)d_ws + WS_CTL, 0, CTL_ZERO_BYTES, stream) != hipSuccess) { fprintf(stderr, "kernel_launch: hipMemsetAsync failed\n"); return; }
    Args a{};
    for (int i = 0; i < NIN; ++i) a.in[i] = (const float*)d_in[i];
    a.out = (float*)d_out; a.ws = (unsigned char*)d_ws;
    hipLaunchKernelGGL(fwd_kernel, dim3(grid), dim3(NWAVES * 64), LDS_BYTES, stream, a);
    const hipError_t le = hipPeekAtLastError();
    if (le != hipSuccess) fprintf(stderr, "kernel_launch: launch failed: %s\n", hipGetErrorName(le));
}
```
